# Optimizing an MI355X kernel written in HIP

```python
import math
import jax
import jax.numpy as jnp
from jax import lax
import numpy as np

D_MODEL = 1024
BATCH = 4
SEQ = 4096
DEPTH = 2

GRID_W = 64
CTX_LEN = 256
HEAD_DIM = 64
N_BRANCH = 4
BRANCH_WIDTH = D_MODEL // N_BRANCH
A_HEADS = BRANCH_WIDTH // HEAD_DIM
B_HEADS = BRANCH_WIDTH // HEAD_DIM
B_GROUPS = 2
B_STATE = 128
B_CONV = 5
C_HEADS = BRANCH_WIDTH // HEAD_DIM
NA_WIN_R = 8
NA_WIN_C = 16
NA_QBLK = 16
NA_KSPAN = 32
D_HEADS = BRANCH_WIDTH // HEAD_DIM
D_KV_HEADS = 2
D_KV_WIDTH = D_KV_HEADS * HEAD_DIM
Q_BLOCK = 128
ROPE_BASE = 10000.0
SCAN_CHUNK = 64
LN_EPS = 1e-6
FFN_HIDDEN = -(-8 * D_MODEL // (3 * 256)) * 256
SSD_CONV_CH = BRANCH_WIDTH + 2 * B_GROUPS * B_STATE
IN_SPLITS = ((BRANCH_WIDTH,) * 5
             + (BRANCH_WIDTH, SSD_CONV_CH, B_HEADS, B_HEADS)
             + (BRANCH_WIDTH,) * 3
             + (BRANCH_WIDTH, D_KV_WIDTH, D_KV_WIDTH)
             + (N_BRANCH * D_MODEL,))
IN_COLS = sum(IN_SPLITS)
IN_OFFSETS = [int(o) for o in np.cumsum(IN_SPLITS)[:-1]]
DEEPNORM_ALPHA = (2.0 * DEPTH) ** 0.25
DEEPNORM_BETA = (8.0 * DEPTH) ** -0.25

kernel_name = "hybrid_gated_dit_block"


def layer_norm(x):
    xf = x.astype(jnp.float32)
    mu = jnp.mean(xf, -1, keepdims=True)
    var = jnp.mean(jnp.square(xf - mu), -1, keepdims=True)
    return ((xf - mu) * lax.rsqrt(var + LN_EPS)).astype(x.dtype)


def rms_norm(x, w):
    xf = x.astype(jnp.float32)
    return (xf * lax.rsqrt(jnp.mean(xf * xf, -1, keepdims=True) + LN_EPS)).astype(x.dtype) * w


def modulate(x, shift, scale):
    return layer_norm(x) * (1.0 + scale) + shift


def post_norm(x, y, g, b):
    return layer_norm(DEEPNORM_ALPHA * x + y) * g + b


def split_heads(a, n):
    return a.reshape(a.shape[0], a.shape[1], n, -1)


def head_major(a, n):
    return split_heads(a, n).transpose(0, 2, 1, 3)


def axial_rope_angles(T):
    t = jnp.arange(T)
    nf = HEAD_DIM // 4
    inv_freq = ROPE_BASE ** (-jnp.arange(nf, dtype=jnp.float32) / nf)
    row = (t // GRID_W).astype(jnp.float32)[:, None] * inv_freq
    col = (t % GRID_W).astype(jnp.float32)[:, None] * inv_freq
    return row, col


def rope_half(x, ang):
    x1, x2 = jnp.split(x, 2, axis=-1)
    cos = jnp.cos(ang)[:, None, :].astype(x.dtype)
    sin = jnp.sin(ang)[:, None, :].astype(x.dtype)
    return jnp.concatenate([x1 * cos - x2 * sin, x2 * cos + x1 * sin], axis=-1)


def rope_2d(x, ang_r, ang_c):
    xr, xc = jnp.split(x, 2, axis=-1)
    return jnp.concatenate([rope_half(xr, ang_r), rope_half(xc, ang_c)], axis=-1)


def dwconv_centred(x, w, b):
    K = w.shape[0]
    y = lax.conv_general_dilated(x, w[:, None, :], window_strides=(1,), padding=[(K // 2, K // 2)],
                                 dimension_numbers=('NWC', 'WIO', 'NWC'), feature_group_count=x.shape[-1])
    return y + b


def chunked_scan(q, k, v, logf, s0):
    Bsz, H, T, _ = q.shape
    n = T // SCAN_CHUNK
    out_dtype = v.dtype

    def chunks(a):
        return a.astype(jnp.float32).reshape(Bsz, H, n, SCAN_CHUNK, a.shape[-1]).transpose(2, 0, 1, 3, 4)

    tri = jnp.tril(jnp.ones((SCAN_CHUNK, SCAN_CHUNK), dtype=bool))[:, :, None]
    scalar = logf.shape[-1] == 1

    def step(S, inp):
        qc, kc, vc, gc = inp
        b = jnp.cumsum(gc, axis=2)
        decay = jnp.exp(jnp.where(tri, b[:, :, :, None, :] - b[:, :, None, :, :], -jnp.inf))
        if scalar:
            scores = jnp.einsum('bhtk,bhsk->bhts', qc, kc) * decay[..., 0]
        else:
            scores = jnp.einsum('bhtk,bhsk,bhtsk->bhts', qc, kc, decay)
        o = jnp.einsum('bhts,bhsv->bhtv', scores, vc) + jnp.einsum('bhtk,bhkv->bhtv', qc * jnp.exp(b), S)
        b_end = b[:, :, -1:, :]
        S = S * jnp.exp(b_end[:, :, 0, :])[..., None] + jnp.einsum('bhsk,bhsv->bhkv', kc * jnp.exp(b_end - b), vc)
        return S, o

    S, o = lax.scan(step, s0, (chunks(q), chunks(k), chunks(v), chunks(logf)))
    return o.transpose(1, 2, 0, 3, 4).reshape(Bsz, H, T, v.shape[-1]).astype(out_dtype), S


def bidir_scan(q, dirs, qc, dirs_c):
    o_lat, o_ctx = [], []
    for rev, ((k, v, g), (kc, vc, gc)) in zip((False, True), zip(dirs, dirs_c)):
        fl = (lambda a: jnp.flip(a, axis=2)) if rev else (lambda a: a)
        s0 = jnp.zeros(q.shape[:2] + (k.shape[-1], v.shape[-1]), jnp.float32)
        oc, s_ctx = chunked_scan(fl(qc), fl(kc), fl(vc), fl(gc), s0)
        ol, _ = chunked_scan(fl(q), fl(k), fl(v), fl(g), s_ctx)
        o_lat.append(fl(ol))
        o_ctx.append(fl(oc))
    return o_lat[0] + o_lat[1], o_ctx[0] + o_ctx[1]


def hgrn_lower_bound(lb_param, l):
    sm = jax.nn.softmax(lb_param.astype(jnp.float32), axis=0)
    return jnp.cumsum(sm, axis=0)[l] - sm[0]


def hgrn2_inputs(q, f_fwd, f_bwd, v, lb_fwd, lb_bwd):
    dirs = []
    for f, lb in ((f_fwd, lb_fwd), (f_bwd, lb_bwd)):
        fg = lb + (1.0 - lb) * jax.nn.sigmoid(f.astype(jnp.float32))
        dirs.append((head_major(1.0 - fg, A_HEADS), head_major(v, A_HEADS), head_major(jnp.log(fg), A_HEADS)))
    return head_major(q, A_HEADS), dirs


def hgrn2_out(o, g, w):
    o = rms_norm(o.transpose(0, 2, 1, 3), w.reshape(A_HEADS, HEAD_DIM))
    return o.reshape(o.shape[0], o.shape[1], BRANCH_WIDTH) * jax.nn.silu(g)


def ssd_inputs(xbc, dt_fwd, dt_bwd, conv_w, conv_b, dt_bias, a_log):
    xbc = jax.nn.silu(dwconv_centred(xbc, conv_w, conv_b))
    xs, bm, cm = jnp.split(xbc, [BRANCH_WIDTH, BRANCH_WIDTH + B_GROUPS * B_STATE], axis=-1)
    rep = B_HEADS // B_GROUPS

    def group_heads(a):
        return jnp.repeat(split_heads(a, B_GROUPS), rep, axis=2).transpose(0, 2, 1, 3)

    xh = split_heads(xs, B_HEADS)
    k = group_heads(bm)
    dirs = []
    for dt_raw, bias, alog in ((dt_fwd, dt_bias[0], a_log[0]), (dt_bwd, dt_bias[1], a_log[1])):
        dt = jax.nn.softplus(dt_raw + bias)
        v = (xh * dt[..., None]).transpose(0, 2, 1, 3)
        g = (dt * -jnp.exp(alog)).transpose(0, 2, 1)[..., None]
        dirs.append((k, v, g))
    return group_heads(cm), dirs, xh


def ssd_out(y, xh, z, d_skip, w):
    y = y.transpose(0, 2, 1, 3) + xh * d_skip[:, None]
    y = y.reshape(xh.shape[0], xh.shape[1], BRANCH_WIDTH) * jax.nn.silu(z)
    return rms_norm(y, w)


def attend_dense(q, k, v):
    Bsz, S, Hq, d = q.shape
    Hkv = k.shape[2]
    qg = q.reshape(Bsz, S, Hkv, Hq // Hkv, d)
    s = jnp.einsum('bqkgd,bskd->bkgqs', qg, k).astype(jnp.float32) * d ** -0.5
    p = jax.nn.softmax(s, axis=-1).astype(v.dtype)
    return jnp.einsum('bkgqs,bskd->bqkgd', p, v).reshape(Bsz, S, Hq * d)


def na_latent(q, k, v, kc, vc, rpb):
    Bsz, T, H, d = q.shape
    rows = T // GRID_W
    wr = min(NA_WIN_R, rows)
    ncb = GRID_W // NA_QBLK
    r = np.arange(rows)
    row_idx = np.clip(r - wr // 2, 0, rows - wr)[:, None] + np.arange(wr)
    qcol = np.arange(GRID_W).reshape(ncb, NA_QBLK)
    kcol = np.clip(qcol[:, :1] - NA_WIN_C // 2, 0, GRID_W - NA_KSPAN) + np.arange(NA_KSPAN)
    win0 = np.clip(qcol - NA_WIN_C // 2, 0, GRID_W - NA_WIN_C)[:, :, None]
    in_win = (kcol[:, None, :] >= win0) & (kcol[:, None, :] < win0 + NA_WIN_C)
    dcol = np.clip(kcol[:, None, :] - qcol[:, :, None] + NA_WIN_C - 1, 0, 2 * NA_WIN_C - 2)
    drow = row_idx - r[:, None] + NA_WIN_R - 1
    bias = rpb[:, drow[:, None, None, :, None], dcol[None, :, :, None, :]]
    bias = jnp.where(in_win[None, None, :, :, None, :], bias, -jnp.inf)
    ridx = row_idx[:, :, None, None]
    cidx = kcol[None, None]
    kg = k.reshape(Bsz, rows, GRID_W, H, d)[:, ridx, cidx]
    vg = v.reshape(Bsz, rows, GRID_W, H, d)[:, ridx, cidx]
    qg = q.reshape(Bsz, rows, ncb, NA_QBLK, H, d)
    scale = d ** -0.5
    s_win = jnp.einsum('brjqhd,brwjkhd->bhrjqwk', qg, kg).astype(jnp.float32) * scale + bias
    s_ctx = jnp.einsum('brjqhd,bchd->bhrjqc', qg, kc).astype(jnp.float32) * scale
    nw = wr * NA_KSPAN
    p = jax.nn.softmax(jnp.concatenate([s_win.reshape(s_win.shape[:5] + (nw,)), s_ctx], axis=-1), axis=-1).astype(v.dtype)
    o = (jnp.einsum('bhrjqwk,brwjkhd->brjqhd', p[..., :nw].reshape(s_win.shape), vg)
         + jnp.einsum('bhrjqc,bchd->brjqhd', p[..., nw:], vc))
    return o.reshape(Bsz, T, H * d)


def gqa_latent(q, k, v, kc, vc):
    Bsz, T, Hq, d = q.shape
    Hkv = k.shape[2]
    k_all = jnp.concatenate([k, kc], axis=1)
    v_all = jnp.concatenate([v, vc], axis=1)
    qb = q.reshape(Bsz, T // Q_BLOCK, Q_BLOCK, Hkv, Hq // Hkv, d).transpose(1, 0, 2, 3, 4, 5)

    def block(qi):
        s = jnp.einsum('bqkgd,bskd->bkgqs', qi, k_all).astype(jnp.float32) * d ** -0.5
        p = jax.nn.softmax(s, axis=-1).astype(v_all.dtype)
        return jnp.einsum('bkgqs,bskd->bqkgd', p, v_all)

    o = lax.map(block, qb)
    return o.transpose(1, 0, 2, 3, 4, 5).reshape(Bsz, T, Hq * d)


def gated_merge(branches, gate_logits, w_branch, w_out):
    br = jnp.stack(branches, axis=2)
    proj = jnp.einsum('btnw,nwd->btnd', br, w_branch)
    g = jax.nn.sigmoid(gate_logits.reshape(proj.shape))
    return jnp.sum(g * proj, axis=2) @ w_out


def token_mixers(h, hc, w_in, lb_f, lb_b, hgrn_norm, conv_w, conv_b, dt_bias, a_log, d_skip, ssd_norm,
                 rpb, q_norm, k_norm, w_branch, w_out, ang_r, ang_c, ctx_out):
    (a_q, a_ff, a_fb, a_v, a_g, b_z, b_xbc, b_dtf, b_dtb, c_q, c_k, c_v, d_q, d_k, d_v, gate) = jnp.split(h @ w_in, IN_OFFSETS, axis=-1)
    (ac_q, ac_ff, ac_fb, ac_v, ac_g, bc_z, bc_xbc, bc_dtf, bc_dtb, cc_q, cc_k, cc_v, dc_q, dc_k, dc_v, gate_c) = jnp.split(hc @ w_in, IN_OFFSETS, axis=-1)
    qa, dirs_a = hgrn2_inputs(a_q, a_ff, a_fb, a_v, lb_f, lb_b)
    qac, dirs_ac = hgrn2_inputs(ac_q, ac_ff, ac_fb, ac_v, lb_f, lb_b)
    oa, oac = bidir_scan(qa, dirs_a, qac, dirs_ac)
    qb, dirs_b, xb = ssd_inputs(b_xbc, b_dtf, b_dtb, conv_w, conv_b, dt_bias, a_log)
    qbc, dirs_bc, xbc_ = ssd_inputs(bc_xbc, bc_dtf, bc_dtb, conv_w, conv_b, dt_bias, a_log)
    ob, obc = bidir_scan(qb, dirs_b, qbc, dirs_bc)
    kc_na, vc_na = split_heads(cc_k, C_HEADS), split_heads(cc_v, C_HEADS)
    y_c = na_latent(split_heads(c_q, C_HEADS), split_heads(c_k, C_HEADS), split_heads(c_v, C_HEADS), kc_na, vc_na, rpb)
    kc_g, vc_g = rms_norm(split_heads(dc_k, D_KV_HEADS), k_norm), split_heads(dc_v, D_KV_HEADS)
    q_g = rope_2d(rms_norm(split_heads(d_q, D_HEADS), q_norm), ang_r, ang_c)
    k_g = rope_2d(rms_norm(split_heads(d_k, D_KV_HEADS), k_norm), ang_r, ang_c)
    y_d = gqa_latent(q_g, k_g, split_heads(d_v, D_KV_HEADS), kc_g, vc_g)
    y = gated_merge([hgrn2_out(oa, a_g, hgrn_norm), ssd_out(ob, xb, b_z, d_skip, ssd_norm), y_c, y_d], gate, w_branch, w_out)
    if not ctx_out:
        return y, None
    yc_c = attend_dense(split_heads(cc_q, C_HEADS), kc_na, vc_na)
    yc_d = attend_dense(rms_norm(split_heads(dc_q, D_HEADS), q_norm), kc_g, vc_g)
    yc = gated_merge([hgrn2_out(oac, ac_g, hgrn_norm), ssd_out(obc, xbc_, bc_z, d_skip, ssd_norm), yc_c, yc_d], gate_c, w_branch, w_out)
    return y, yc


def swiglu(h, w_up, w_down):
    g, u = jnp.split(h @ w_up, 2, axis=-1)
    return (jax.nn.silu(g) * u) @ w_down


def setup_inputs(seed: int = 0) -> dict:
    key = jax.random.key(seed)
    ks = jax.random.split(key, 26)
    L = DEPTH

    def nrm(k, shape, scale):
        return jax.random.normal(k, shape, jnp.float32) * scale

    def gain(k, shape):
        return 1.0 + nrm(k, shape, 0.02)

    dt = jnp.exp(jax.random.uniform(ks[12], (L, 2, B_HEADS), jnp.float32, math.log(1e-3), math.log(1e-1)))
    return {
        "x": nrm(ks[0], (BATCH, SEQ, D_MODEL), 1.0),
        "c": nrm(ks[1], (BATCH, D_MODEL), 1.0),
        "ctx": nrm(ks[2], (BATCH, CTX_LEN, D_MODEL), 1.0),
        "c_ctx": nrm(ks[3], (D_MODEL,), 1.0),
        "ada_w": nrm(ks[4], (L, D_MODEL, 6 * D_MODEL), 0.5 * D_MODEL ** -0.5),
        "ada_b": nrm(ks[5], (L, 6 * D_MODEL), 0.02),
        "w_in": nrm(ks[6], (L, D_MODEL, IN_COLS), D_MODEL ** -0.5),
        "hgrn_lb": nrm(ks[7], (2, L, BRANCH_WIDTH), 0.5),
        "hgrn_norm": gain(ks[8], (L, BRANCH_WIDTH)),
        "ssd_conv_w": nrm(ks[9], (L, B_CONV, SSD_CONV_CH), B_CONV ** -0.5),
        "ssd_conv_b": nrm(ks[10], (L, SSD_CONV_CH), 0.02),
        "ssd_dt_bias": dt + jnp.log(-jnp.expm1(-dt)),
        "ssd_a_log": jnp.log(jax.random.uniform(ks[11], (L, 2, B_HEADS), jnp.float32, 1.0, 16.0)),
        "ssd_d": gain(ks[13], (L, B_HEADS)),
        "ssd_norm": gain(ks[14], (L, BRANCH_WIDTH)),
        "na_rpb": nrm(ks[15], (L, C_HEADS, 2 * NA_WIN_R - 1, 2 * NA_WIN_C - 1), 0.1),
        "q_norm": gain(ks[16], (L, HEAD_DIM)),
        "k_norm": gain(ks[17], (L, HEAD_DIM)),
        "w_branch": nrm(ks[18], (L, N_BRANCH, BRANCH_WIDTH, D_MODEL), BRANCH_WIDTH ** -0.5),
        "w_out": nrm(ks[19], (L, D_MODEL, D_MODEL), DEEPNORM_BETA * D_MODEL ** -0.5),
        "ln1_g": gain(ks[20], (L, D_MODEL)),
        "ln1_b": nrm(ks[21], (L, D_MODEL), 0.02),
        "ffn_w_up": nrm(ks[22], (L, D_MODEL, 2 * FFN_HIDDEN), D_MODEL ** -0.5),
        "ffn_w_down": nrm(ks[23], (L, FFN_HIDDEN, D_MODEL), DEEPNORM_BETA * FFN_HIDDEN ** -0.5),
        "ln2_g": gain(ks[24], (L, D_MODEL)),
        "ln2_b": nrm(ks[25], (L, D_MODEL), 0.02),
    }


def reference(x, c, ctx, c_ctx, ada_w, ada_b, w_in, hgrn_lb, hgrn_norm, ssd_conv_w, ssd_conv_b, ssd_dt_bias,
              ssd_a_log, ssd_d, ssd_norm, na_rpb, q_norm, k_norm, w_branch, w_out, ln1_g, ln1_b,
              ffn_w_up, ffn_w_down, ln2_g, ln2_b):
    ang_r, ang_c = axial_rope_angles(x.shape[1])
    xc = ctx
    for l in range(DEPTH):
        last = l == DEPTH - 1
        mod = jnp.split(jax.nn.silu(c) @ ada_w[l] + ada_b[l], 6, axis=-1)
        shift1, scale1, gate1, shift2, scale2, gate2 = [m[:, None, :] for m in mod]
        shift1c, scale1c, gate1c, shift2c, scale2c, gate2c = jnp.split(jax.nn.silu(c_ctx) @ ada_w[l] + ada_b[l], 6, axis=-1)
        h = modulate(x, shift1, scale1)
        hc = modulate(xc, shift1c, scale1c)
        y, yc = token_mixers(h, hc, w_in[l], hgrn_lower_bound(hgrn_lb[0], l), hgrn_lower_bound(hgrn_lb[1], l),
                             hgrn_norm[l], ssd_conv_w[l], ssd_conv_b[l], ssd_dt_bias[l], ssd_a_log[l], ssd_d[l],
                             ssd_norm[l], na_rpb[l], q_norm[l], k_norm[l], w_branch[l], w_out[l], ang_r, ang_c,
                             not last)
        x = post_norm(x, gate1 * y, ln1_g[l], ln1_b[l])
        x = post_norm(x, gate2 * swiglu(modulate(x, shift2, scale2), ffn_w_up[l], ffn_w_down[l]), ln2_g[l], ln2_b[l])
        if not last:
            xc = post_norm(xc, gate1c * yc, ln1_g[l], ln1_b[l])
            xc = post_norm(xc, gate2c * swiglu(modulate(xc, shift2c, scale2c), ffn_w_up[l], ffn_w_down[l]), ln2_g[l], ln2_b[l])
    return x
```

```cpp
#include <hip/hip_runtime.h>
#include <cstdio>
#include <cstdint>

#define LAS __attribute__((address_space(3)))
typedef unsigned short bf16_t;
typedef short bf16x8 __attribute__((ext_vector_type(8)));
typedef float f32x4 __attribute__((ext_vector_type(4)));
typedef unsigned u32x4 __attribute__((ext_vector_type(4)));
typedef unsigned u32x2 __attribute__((ext_vector_type(2)));

constexpr int DM = 1024, NB = 4, SEQ = 4096, CTXL = 256, DEPTH = 2;
constexpr int MLAT = NB * SEQ;
constexpr int MCTX = NB * CTXL;
constexpr int MALL = MLAT + MCTX;
constexpr int INC = 7688;
constexpr int NMIX = 3584;
constexpr int FFH = 2816;
constexpr float LN_EPS = 1e-6f;
constexpr float ALPHA = 1.4142135623730951f;
constexpr int C_AQ = 0, C_AFF = 256, C_AFB = 512, C_AV = 768, C_AG = 1024, C_BZ = 1280, C_BX = 1536, C_BB = 1792, C_BC = 2048,
              C_CQ = 2304, C_CK = 2560, C_CV = 2816, C_DQ = 3072, C_DK = 3328, C_DV = 3456;

constexpr size_t MiB = 1u << 20;
constexpr size_t WS_CTL = 0, CTL_ZERO_BYTES = 16384;
constexpr size_t WS_MODS = 1 * MiB;
constexpr size_t WS_DT = 2 * MiB;
constexpr size_t WS_XC = 3 * MiB;
constexpr size_t WS_WIN = 8 * MiB;
constexpr size_t WS_WBR = 23 * MiB;
constexpr size_t WS_WOUT = 25 * MiB;
constexpr size_t WS_WUP = 33 * MiB;
constexpr size_t WS_WDN = 44 * MiB;
constexpr size_t WS_RA = 50 * MiB;
constexpr size_t WS_RB = 84 * MiB;
constexpr size_t WS_RC = 118 * MiB;
constexpr size_t WS_OBA = WS_RC + 119 * MiB;
constexpr size_t WS_OBB = WS_OBA + 17 * MiB / 2;
constexpr size_t WS_END = 254 * MiB;
constexpr size_t WS_STA = 33 * MiB;
constexpr size_t WS_STB = WS_STA + (size_t)32 * 17 * 4096 * 2;
constexpr size_t WS_DLA = 46 * MiB;
constexpr size_t WS_DLB = 47 * MiB;
static_assert(WS_STB + (size_t)64 * 17 * 4096 * 2 <= WS_DLA, "scan state map");

constexpr int NWAVES = 8, NTHREADS = 512;
constexpr int LDS_BYTES = 155648 + 64 + 2048;
constexpr int WLDS = 19456;

__device__ __forceinline__ float bf2f(unsigned u) { return __uint_as_float(u << 16); }
__device__ __forceinline__ float bflo(unsigned w) { return __uint_as_float(w << 16); }
__device__ __forceinline__ float bfhi(unsigned w) { return __uint_as_float(w & 0xffff0000u); }
__device__ __forceinline__ unsigned f2bf(float f) { unsigned u = __float_as_uint(f); return (u + 0x7fffu + ((u >> 16) & 1u)) >> 16; }
__device__ __forceinline__ unsigned pk2(float lo, float hi) { return f2bf(lo) | (f2bf(hi) << 16); }
__device__ __forceinline__ float sigmoidf_(float x) { return __builtin_amdgcn_rcpf(1.f + __expf(-x)); }
__device__ __forceinline__ float siluf_(float x) { return x * sigmoidf_(x); }
template <int CTRL, int RMASK, bool BC> __device__ __forceinline__ float dppf_(float v) { return __int_as_float(__builtin_amdgcn_update_dpp(0, __float_as_int(v), CTRL, RMASK, 0xF, BC)); }
__device__ __forceinline__ float wave_sum(float v) {
    v += dppf_<0xB1, 0xF, true>(v);
    v += dppf_<0x4E, 0xF, true>(v);
    v += dppf_<0x141, 0xF, true>(v);
    v += dppf_<0x140, 0xF, true>(v);
    v += dppf_<0x142, 0xA, false>(v);
    v += dppf_<0x143, 0xC, false>(v);
    return __int_as_float(__builtin_amdgcn_readlane(__float_as_int(v), 63));
}
#define LDS_WAIT() asm volatile("s_waitcnt lgkmcnt(0)" ::: "memory")

__device__ __forceinline__ void wt8a(void* p, u32x2 v) { __hip_atomic_store((unsigned long long*)p, ((unsigned long long)v.y << 32) | v.x, __ATOMIC_RELAXED, __HIP_MEMORY_SCOPE_AGENT); }

namespace pg8 {
constexpr int BM = 256, BK = 64, HALF = 128, HTB = HALF * BK * 2, STAGE_BYTES = 8 * HTB, NXCD = 8, WGM = 8;
__host__ __device__ __forceinline__ int lds_byte(int r, int c) { const int st = (r >> 4) * 2 + (c >> 5), rr = r & 15, cc = c & 31, ob = rr * 64 + cc * 2; return st * 1024 + (ob ^ (((ob >> 9) & 1) << 5)); }
__host__ __device__ __forceinline__ void stage_rc(int b, int& R, int& C) { const int st = b / 1024, sb = b % 1024, swz = sb ^ (((sb >> 9) & 1) << 5); R = (st >> 1) * 16 + swz / 64; C = (st & 1) * 32 + (swz % 64) / 2; }
__host__ __device__ __forceinline__ int perm32(int rho) { const int n = rho >> 4, i = rho & 15; return 8 * (i >> 2) + 4 * n + (i & 3); }

struct Unit { int pm, pn, kc; };
struct Gemm { const bf16_t* A; const bf16_t* Bt; int M, N; };

__device__ __forceinline__ void st16_wt(void* p, u32x4 v) { asm volatile("global_store_dwordx4 %0, %1, off sc1\n\ts_nop 1" :: "v"(p), "v"(v) : "memory"); }
struct StaticOrder {
    int nM, nN, nwg, G, c;
    __device__ void init(int M, int N, int G_, int c_) { nM = M / BM; nN = N / BM; nwg = nM * nN; G = G_; c = c_; }
    __device__ bool next(int i, Unit& u) const {
        const long L = (long)i * G + c; if (L >= nwg) return false;
        int wgid = (int)L; { const int q = nwg / NXCD, r = nwg % NXCD, xcd = wgid % NXCD, off = wgid / NXCD; wgid = (xcd < r ? xcd * (q + 1) : r * (q + 1) + (xcd - r) * q) + off; }
        const int nig = WGM * nN, gid = wgid / nig, fm = gid * WGM, gsz = (nM - fm) < WGM ? (nM - fm) : WGM;
        u.pm = fm + ((wgid % nig) % gsz); u.pn = (wgid % nig) / gsz; u.kc = 0; return true;
    }
};

struct SplitOrder {
    int nsub, G, c, nkc, nn, pm0;
    __device__ void init(int ntiles_m, int nn_, int nkc_, int pm0_, int G_, int c_) { nn = nn_; nkc = nkc_; pm0 = pm0_; nsub = ntiles_m * nn_ * nkc_; G = G_; c = c_; }
    __device__ bool next(int i, Unit& u) const { const int L = i * G + c; if (L >= nsub) return false; const int tile = L / nkc; u.kc = L % nkc; u.pm = pm0 + tile / nn; u.pn = tile % nn; return true; }
};
struct GroupOrder {
    int ngrp, G, c;
    __device__ void init(int M, int G_, int c_) { ngrp = (M / BM) * 4; G = G_; c = c_; }
    __device__ bool next(int i, Unit& u) const { const int grp = (i >> 2) * G + c; if (grp >= ngrp) return false; u.pm = grp >> 2; u.pn = 4 * (i & 3) + (grp & 3); u.kc = 0; return true; }
};
typedef float f32x2c_t __attribute__((ext_vector_type(2))); typedef __bf16 bf16x2c_t __attribute__((ext_vector_type(2)));
__device__ __forceinline__ unsigned cvt_pk_bf16(float lo, float hi) { f32x2c_t v = {lo, hi}; bf16x2c_t b = __builtin_convertvector(v, bf16x2c_t); return __builtin_bit_cast(unsigned, b); }

struct EpiStore {
    bf16_t* O; int ldc;
    __device__ __forceinline__ void operator()(const f32x4 (&acc)[2][2][4][2], const Unit& u, int wr, int wc, int fr, int fq) const {
        const int row0 = u.pm * BM + wr * 64 + fr; const int col0 = u.pn * BM + wc * 32 + 8 * fq;
#pragma unroll
        for (int ai = 0; ai < 2; ++ai)
#pragma unroll
            for (int m = 0; m < 4; ++m) { bf16_t* rowp = O + (size_t)(row0 + ai * HALF + m * 16) * ldc + col0;
#pragma unroll
                for (int bj = 0; bj < 2; ++bj) { const f32x4 v0 = acc[ai][bj][m][0], v1 = acc[ai][bj][m][1];
                    u32x4 w; w.x = cvt_pk_bf16(v0[0], v0[1]); w.y = cvt_pk_bf16(v0[2], v0[3]); w.z = cvt_pk_bf16(v1[0], v1[1]); w.w = cvt_pk_bf16(v1[2], v1[3]);
                    st16_wt((rowp + bj * HALF), w); } }
    }
};
struct EpiStoreFG {
    bf16_t* O; int ldc; const float* lbp;
    __device__ __forceinline__ void operator()(const f32x4 (&acc)[2][2][4][2], const Unit& u, int wr, int wc, int fr, int fq) const {
        const int row0 = u.pm * BM + wr * 64 + fr; const int col0 = u.pn * BM + wc * 32 + 8 * fq;
        const bool isg = (u.pn == 1) || (u.pn == 2);
        float lb[2][8];
#pragma unroll
        for (int bj = 0; bj < 2; ++bj)
#pragma unroll
            for (int j = 0; j < 8; ++j) lb[bj][j] = 0.f;
        if (isg && lbp) { const float* p = lbp + (u.pn - 1) * 512 + wc * 32 + 8 * fq;
#pragma unroll
            for (int bj = 0; bj < 2; ++bj)
#pragma unroll
                for (int j = 0; j < 8; ++j) lb[bj][j] = __builtin_amdgcn_rcpf(1.f + __expf(p[bj * HALF + j] - p[256 + bj * HALF + j])); }
#pragma unroll
        for (int ai = 0; ai < 2; ++ai)
#pragma unroll
            for (int m = 0; m < 4; ++m) { bf16_t* rowp = O + (size_t)(row0 + ai * HALF + m * 16) * ldc + col0;
#pragma unroll
                for (int bj = 0; bj < 2; ++bj) { f32x4 v0 = acc[ai][bj][m][0], v1 = acc[ai][bj][m][1];
                    if (isg) {
#pragma unroll
                        for (int j = 0; j < 4; ++j) { v0[j] = fmaxf(__log2f(lb[bj][j] + (1.f - lb[bj][j]) * sigmoidf_(v0[j])), -126.f); v1[j] = fmaxf(__log2f(lb[bj][4 + j] + (1.f - lb[bj][4 + j]) * sigmoidf_(v1[j])), -126.f); } }
                    u32x4 w; w.x = cvt_pk_bf16(v0[0], v0[1]); w.y = cvt_pk_bf16(v0[2], v0[3]); w.z = cvt_pk_bf16(v1[0], v1[1]); w.w = cvt_pk_bf16(v1[2], v1[3]);
                    st16_wt((rowp + bj * HALF), w); } }
    }
};
struct EpiGateMul {
    bf16_t* O; int ldc;
    __device__ __forceinline__ void operator()(const f32x4 (&acc)[2][2][4][2], const Unit& u, int wr, int wc, int fr, int fq) const {
        const int row0 = u.pm * BM + wr * 64 + fr; const int col0 = u.pn * BM + wc * 32 + 8 * fq;
#pragma unroll
        for (int ai = 0; ai < 2; ++ai)
#pragma unroll
            for (int m = 0; m < 4; ++m) { bf16_t* rowp = O + (size_t)(row0 + ai * HALF + m * 16) * ldc + col0;
#pragma unroll
                for (int bj = 0; bj < 2; ++bj) { const f32x4 v0 = acc[ai][bj][m][0], v1 = acc[ai][bj][m][1];
                    const u32x4 g = *(const u32x4*)(rowp + bj * HALF);
                    u32x4 w;
                    w.x = cvt_pk_bf16(v0[0] * sigmoidf_(bflo(g.x)), v0[1] * sigmoidf_(bfhi(g.x)));
                    w.y = cvt_pk_bf16(v0[2] * sigmoidf_(bflo(g.y)), v0[3] * sigmoidf_(bfhi(g.y)));
                    w.z = cvt_pk_bf16(v1[0] * sigmoidf_(bflo(g.z)), v1[1] * sigmoidf_(bfhi(g.z)));
                    w.w = cvt_pk_bf16(v1[2] * sigmoidf_(bflo(g.w)), v1[3] * sigmoidf_(bfhi(g.w)));
                    st16_wt((rowp + bj * HALF), w); } }
    }
};
__device__ __forceinline__ size_t gate_frag_off(int pm, int pn16, int ai, int m, int bj, int tid) { return ((size_t)(pm * 16 + pn16) << 16) + (size_t)((((ai * 4 + m) * 2 + bj) * 512 + tid) * 8); }
struct EpiGateStore {
    bf16_t* G;
    __device__ __forceinline__ void operator()(const f32x4 (&acc)[2][2][4][2], const Unit& u, int wr, int wc, int fr, int fq) const {
        const int tid = (wr * 4 + wc) * 64 + fq * 16 + fr;
#pragma unroll
        for (int ai = 0; ai < 2; ++ai)
#pragma unroll
            for (int m = 0; m < 4; ++m)
#pragma unroll
                for (int bj = 0; bj < 2; ++bj) { const f32x4 v0 = acc[ai][bj][m][0], v1 = acc[ai][bj][m][1];
                    u32x4 w; w.x = cvt_pk_bf16(sigmoidf_(v0[0]), sigmoidf_(v0[1])); w.y = cvt_pk_bf16(sigmoidf_(v0[2]), sigmoidf_(v0[3]));
                    w.z = cvt_pk_bf16(sigmoidf_(v1[0]), sigmoidf_(v1[1])); w.w = cvt_pk_bf16(sigmoidf_(v1[2]), sigmoidf_(v1[3]));
                    st16_wt((G + gate_frag_off(u.pm, u.pn, ai, m, bj, tid)), w); }
    }
};
struct EpiGateAcc {
    const bf16_t* GATE; bf16_t* O;
    __device__ __forceinline__ void operator()(const f32x4 (&acc)[2][2][4][2], const Unit& u, int wr, int wc, int fr, int fq) const {
        const int row0 = u.pm * BM + wr * 64 + fr; const int colo = (u.pn & 3) * BM + wc * 32 + 8 * fq; const bool first = (u.pn < 4); const int tid = (wr * 4 + wc) * 64 + fq * 16 + fr;
#pragma unroll
        for (int ai = 0; ai < 2; ++ai)
#pragma unroll
            for (int m = 0; m < 4; ++m) { const size_t r = (size_t)(row0 + ai * HALF + m * 16); bf16_t* op = O + r * 1024 + colo;
#pragma unroll
                for (int bj = 0; bj < 2; ++bj) { const f32x4 v0 = acc[ai][bj][m][0], v1 = acc[ai][bj][m][1];
                    const u32x4 g = *(const u32x4*)(GATE + gate_frag_off(u.pm, u.pn, ai, m, bj, tid));
                    u32x4 p = (u32x4){0u, 0u, 0u, 0u}; if (!first) p = *(const u32x4*)(op + bj * HALF);
                    u32x4 w;
                    w.x = cvt_pk_bf16(bflo(p.x) + v0[0] * bflo(g.x), bfhi(p.x) + v0[1] * bfhi(g.x));
                    w.y = cvt_pk_bf16(bflo(p.y) + v0[2] * bflo(g.y), bfhi(p.y) + v0[3] * bfhi(g.y));
                    w.z = cvt_pk_bf16(bflo(p.z) + v1[0] * bflo(g.z), bfhi(p.z) + v1[1] * bfhi(g.z));
                    w.w = cvt_pk_bf16(bflo(p.w) + v1[2] * bflo(g.w), bfhi(p.w) + v1[3] * bfhi(g.w));
                    st16_wt((op + bj * HALF), w); } }
    }
};
struct EpiHorner {
    const bf16_t* GATE; bf16_t* O;
    static __device__ __forceinline__ float ratio_(float ga, float gb) { return ga * __builtin_amdgcn_rcpf(fmaxf(gb, 1e-30f)); }
    __device__ __forceinline__ void mid(f32x4 (&acc)[2][2][4][2], const Unit& u, int wr, int wc, int fr, int fq, int nb) const {
        const int tid = (wr * 4 + wc) * 64 + fq * 16 + fr;
        typedef __attribute__((address_space(1))) const u32x4 gu32x4;
        const gu32x4* ga = (const gu32x4*)(GATE + gate_frag_off(u.pm, nb * 4 + u.pn, 0, 0, 0, tid));
        const gu32x4* gb = (const gu32x4*)(GATE + gate_frag_off(u.pm, (nb + 1) * 4 + u.pn, 0, 0, 0, tid));
#pragma unroll
        for (int ai = 0; ai < 2; ++ai) {
            u32x4 a[8], b[8];
#pragma unroll
            for (int p = 0; p < 8; ++p) { a[p] = ga[(ai * 8 + p) * 512]; b[p] = gb[(ai * 8 + p) * 512]; }
            asm volatile("" ::: "memory");
#pragma unroll
            for (int m = 0; m < 4; ++m)
#pragma unroll
                for (int bj = 0; bj < 2; ++bj) { const u32x4 av = a[m * 2 + bj], bv = b[m * 2 + bj];
                    f32x4& v0 = acc[ai][bj][m][0]; f32x4& v1 = acc[ai][bj][m][1];
                    v0[0] *= ratio_(bflo(av.x), bflo(bv.x)); v0[1] *= ratio_(bfhi(av.x), bfhi(bv.x)); v0[2] *= ratio_(bflo(av.y), bflo(bv.y)); v0[3] *= ratio_(bfhi(av.y), bfhi(bv.y));
                    v1[0] *= ratio_(bflo(av.z), bflo(bv.z)); v1[1] *= ratio_(bfhi(av.z), bfhi(bv.z)); v1[2] *= ratio_(bflo(av.w), bflo(bv.w)); v1[3] *= ratio_(bfhi(av.w), bfhi(bv.w)); }
        }
    }
    __device__ __forceinline__ void operator()(const f32x4 (&acc)[2][2][4][2], const Unit& u, int wr, int wc, int fr, int fq) const {
        const int row0 = u.pm * BM + wr * 64 + fr; const int col0 = u.pn * BM + wc * 32 + 8 * fq; const int tid = (wr * 4 + wc) * 64 + fq * 16 + fr;
        typedef __attribute__((address_space(1))) const u32x4 gu32x4;
        const gu32x4* gg = (const gu32x4*)(GATE + gate_frag_off(u.pm, 12 + u.pn, 0, 0, 0, tid));
#pragma unroll
        for (int ai = 0; ai < 2; ++ai) {
            u32x4 g[8];
#pragma unroll
            for (int p = 0; p < 8; ++p) g[p] = gg[(ai * 8 + p) * 512];
            asm volatile("" ::: "memory");
#pragma unroll
            for (int m = 0; m < 4; ++m) { bf16_t* op = O + (size_t)(row0 + ai * HALF + m * 16) * 1024 + col0;
#pragma unroll
                for (int bj = 0; bj < 2; ++bj) { const f32x4 v0 = acc[ai][bj][m][0], v1 = acc[ai][bj][m][1]; const u32x4 gv = g[m * 2 + bj];
                    u32x4 w;
                    w.x = cvt_pk_bf16(v0[0] * bflo(gv.x), v0[1] * bfhi(gv.x)); w.y = cvt_pk_bf16(v0[2] * bflo(gv.y), v0[3] * bfhi(gv.y));
                    w.z = cvt_pk_bf16(v1[0] * bflo(gv.z), v1[1] * bfhi(gv.z)); w.w = cvt_pk_bf16(v1[2] * bflo(gv.w), v1[3] * bfhi(gv.w));
                    st16_wt((op + bj * HALF), w); } }
        }
    }
};
struct EpiSlab {
    bf16_t* S; int pm0, rows;
    __device__ __forceinline__ void operator()(const f32x4 (&acc)[2][2][4][2], const Unit& u, int wr, int wc, int fr, int fq) const {
        const int row0 = (u.pm - pm0) * BM + wr * 64 + fr; const int col0 = u.pn * BM + wc * 32 + 8 * fq; bf16_t* base = S + (size_t)u.kc * rows * 1024;
#pragma unroll
        for (int ai = 0; ai < 2; ++ai)
#pragma unroll
            for (int m = 0; m < 4; ++m) { bf16_t* rowp = base + (size_t)(row0 + ai * HALF + m * 16) * 1024 + col0;
#pragma unroll
                for (int bj = 0; bj < 2; ++bj) { const f32x4 v0 = acc[ai][bj][m][0], v1 = acc[ai][bj][m][1];
                    u32x4 w; w.x = cvt_pk_bf16(v0[0], v0[1]); w.y = cvt_pk_bf16(v0[2], v0[3]); w.z = cvt_pk_bf16(v1[0], v1[1]); w.w = cvt_pk_bf16(v1[2], v1[3]);
                    st16_wt((rowp + bj * HALF), w); } }
    }
};
struct EpiSwiGLU {
    bf16_t* O; int ldc;
    __device__ __forceinline__ void operator()(const f32x4 (&acc)[2][2][4][2], const Unit& u, int wr, int wc, int fr, int fq) const {
        const int row0 = u.pm * BM + wr * 64 + fr; const int col0 = u.pn * HALF + wc * 32 + 8 * fq;
#pragma unroll
        for (int ai = 0; ai < 2; ++ai)
#pragma unroll
            for (int m = 0; m < 4; ++m) { bf16_t* rowp = O + (size_t)(row0 + ai * HALF + m * 16) * ldc + col0;
                const f32x4 g0 = acc[ai][0][m][0], g1 = acc[ai][0][m][1], u0 = acc[ai][1][m][0], u1 = acc[ai][1][m][1];
                u32x4 w;
                w.x = cvt_pk_bf16(siluf_(g0[0]) * u0[0], siluf_(g0[1]) * u0[1]); w.y = cvt_pk_bf16(siluf_(g0[2]) * u0[2], siluf_(g0[3]) * u0[3]);
                w.z = cvt_pk_bf16(siluf_(g1[0]) * u1[0], siluf_(g1[1]) * u1[1]); w.w = cvt_pk_bf16(siluf_(g1[2]) * u1[2], siluf_(g1[3]) * u1[3]);
                st16_wt(rowp, w); }
    }
};

template <class Epi, int K, int LDA, int LDB, int ADIV, int ACOLS, class Sched = StaticOrder, int MIDK = 0, bool ALIGN_EPI = true>
__device__ __forceinline__ void gemm_phase(LAS unsigned char* lds, const Gemm g, const Sched& S, const Epi& E, int tid_) {
    const int tid = tid_, wid = __builtin_amdgcn_readfirstlane(tid >> 6), lane = tid & 63, wr = wid >> 2, wc = wid & 3, fr = lane & 15, fq = lane >> 4;
    constexpr int nt = K / BK;
    unsigned voffA, voffB;
    { int R, C; stage_rc(tid * 16, R, C); const int Rb = (R & ~31) + perm32(R & 31); voffA = (unsigned)(R * LDA + C) * 2u; voffB = (unsigned)(Rb * LDB + C) * 2u; }
    constexpr size_t p1offA = (size_t)64 * LDA * 2, p1offB = (size_t)64 * LDB * 2;
    constexpr size_t kstep = (size_t)(BK * 2);
    constexpr size_t hstepA = (size_t)HALF * LDA * 2, hstepB = (size_t)HALF * LDB * 2;
    constexpr size_t tstepA = 2 * hstepA, tstepB = 2 * hstepB;
    const unsigned ldsw = (unsigned)wid * 1024u;
    const int aoff = lds_byte(wr * 64 + fr, fq * 8), boff = lds_byte(wc * 32 + fr, fq * 8);
#define PG8_SA(b, h) (((b) * 2 + (h)) * HTB)
#define PG8_SB(b, h) ((4 + (b) * 2 + (h)) * HTB)
#define PG8_STAGE(bufoff, gbase, voff) do { _Pragma("unroll") for (int _i = 0; _i < 2; ++_i) \
        __builtin_amdgcn_global_load_lds((const unsigned*)((const char*)(gbase) + _i * p1##voff + (v##voff)), (LAS unsigned*)(lds + (bufoff) + ldsw + _i * 8192), 16, 0, 0); } while (0)
#define PG8_LDA(dst, b, h) do { _Pragma("unroll") for (int m = 0; m < 4; ++m) _Pragma("unroll") for (int k = 0; k < 2; ++k) dst[m][k] = *(const LAS bf16x8*)(lds + PG8_SA(b, h) + aoff + m * 2048 + k * 1024); } while (0)
#define PG8_LDB(dst, b, h) do { _Pragma("unroll") for (int n = 0; n < 2; ++n) _Pragma("unroll") for (int k = 0; k < 2; ++k) dst[n][k] = *(const LAS bf16x8*)(lds + PG8_SB(b, h) + boff + n * 2048 + k * 1024); } while (0)
#define PG8_MMA(ai, bj, At, Bt) do { __builtin_amdgcn_s_setprio(1); _Pragma("unroll") for (int m = 0; m < 4; ++m) _Pragma("unroll") for (int n = 0; n < 2; ++n) _Pragma("unroll") for (int k = 0; k < 2; ++k) \
        acc[ai][bj][m][n] = __builtin_amdgcn_mfma_f32_16x16x32_bf16(Bt[n][k], At[m][k], acc[ai][bj][m][n], 0, 0, 0); __builtin_amdgcn_s_setprio(0); } while (0)
#define PG8_WAIT_V(n) asm volatile("s_waitcnt vmcnt(" #n ")" ::: "memory")
#define PG8_WAIT_L(n) asm volatile("s_waitcnt lgkmcnt(" #n ")" ::: "memory")
#define PG8_BAR __builtin_amdgcn_s_barrier()
#define PG8_SCHED __builtin_amdgcn_sched_barrier(0)
#define PG8_ACOL(pn) (ADIV ? (size_t)(((pn) / (ADIV ? ADIV : 1)) * ACOLS) * 2 : (size_t)0)
    Unit cur, nxt; int ui = 0;
    if (!S.next(0, cur)) return;
    f32x4 acc[2][2][4][2];
#pragma unroll
    for (int a = 0; a < 2; ++a)
#pragma unroll
        for (int b = 0; b < 2; ++b)
#pragma unroll
            for (int m = 0; m < 4; ++m)
#pragma unroll
                for (int n = 0; n < 2; ++n) acc[a][b][m][n] = (f32x4){0.f, 0.f, 0.f, 0.f};
    bf16x8 At[4][2], B0[2][2], B1[2][2];
    const char* cA = (const char*)g.A + (size_t)cur.pm * tstepA + PG8_ACOL(cur.pn) + (size_t)cur.kc * (K * 2); const char* cB = (const char*)g.Bt + (size_t)cur.pn * tstepB + (size_t)cur.kc * (K * 2);
    PG8_STAGE(PG8_SB(0, 0), cB, offB); PG8_STAGE(PG8_SB(0, 1), cB + hstepB, offB); PG8_STAGE(PG8_SA(0, 0), cA, offA); PG8_STAGE(PG8_SA(0, 1), cA + hstepA, offA);
    if (wr == 1) PG8_BAR;
    PG8_WAIT_V(2); PG8_BAR;
    PG8_STAGE(PG8_SB(1, 0), cB + kstep, offB); PG8_STAGE(PG8_SA(1, 0), cA + kstep, offA); PG8_STAGE(PG8_SB(1, 1), cB + hstepB + kstep, offB);
    PG8_WAIT_V(6); PG8_BAR;
    for (;;) {
        const bool has_next = S.next(ui + 1, nxt);
        const char* nA = has_next ? (const char*)g.A + (size_t)nxt.pm * tstepA + PG8_ACOL(nxt.pn) + (size_t)nxt.kc * (K * 2) : cA; const char* nB = has_next ? (const char*)g.Bt + (size_t)nxt.pn * tstepB + (size_t)nxt.kc * (K * 2) : cB;
#pragma unroll 1
        for (int t = 0; t < nt; t += 2) {
            const bool last = (t == nt - 2);
            const char* a1 = cA + (size_t)(t + 1) * kstep;
            const char* a2 = last ? nA : cA + (size_t)(t + 2) * kstep; const char* b2 = last ? nB : cB + (size_t)(t + 2) * kstep;
            const char* a3 = a2 + kstep; const char* b3 = b2 + kstep;
            PG8_LDB(B0, 0, 0); PG8_LDB(B1, 0, 1); PG8_SCHED; PG8_LDA(At, 0, 0); PG8_STAGE(PG8_SA(1, 1), a1 + hstepA, offA);
            PG8_WAIT_V(8); PG8_WAIT_L(0); PG8_BAR; PG8_MMA(0, 0, At, B0); PG8_MMA(0, 1, At, B1); PG8_BAR; PG8_SCHED;
            PG8_LDA(At, 0, 1); PG8_STAGE(PG8_SB(0, 0), b2, offB); PG8_STAGE(PG8_SB(0, 1), b2 + hstepB, offB); PG8_STAGE(PG8_SA(0, 0), a2, offA);
            PG8_WAIT_V(8); PG8_WAIT_L(0); PG8_BAR; PG8_MMA(1, 0, At, B0); PG8_MMA(1, 1, At, B1); PG8_BAR; PG8_SCHED;
            PG8_LDB(B0, 1, 0); PG8_LDB(B1, 1, 1); PG8_SCHED; PG8_LDA(At, 1, 0); PG8_STAGE(PG8_SA(0, 1), a2 + hstepA, offA);
            PG8_WAIT_V(8); PG8_WAIT_L(0); PG8_BAR; PG8_MMA(0, 0, At, B0); PG8_MMA(0, 1, At, B1); PG8_BAR; PG8_SCHED;
            PG8_LDA(At, 1, 1); PG8_STAGE(PG8_SB(1, 0), b3, offB); PG8_STAGE(PG8_SB(1, 1), b3 + hstepB, offB); PG8_STAGE(PG8_SA(1, 0), a3, offA);
            PG8_WAIT_V(8); PG8_WAIT_L(0); PG8_BAR; PG8_MMA(1, 0, At, B0); PG8_MMA(1, 1, At, B1); PG8_BAR; PG8_SCHED;
            if constexpr (MIDK > 0) {
                constexpr int seg = MIDK / BK; if (((t + 2) % seg) == 0 && t + 2 < nt) E.mid(acc, cur, wr, wc, fr, fq, (t + 2) / seg - 1); }
        }
        if constexpr (ALIGN_EPI) { if (wr == 0) PG8_BAR; }
        E(acc, cur, wr, wc, fr, fq);
        if (!has_next) break;
#pragma unroll
        for (int a = 0; a < 2; ++a)
#pragma unroll
            for (int b = 0; b < 2; ++b)
#pragma unroll
                for (int m = 0; m < 4; ++m)
#pragma unroll
                    for (int n = 0; n < 2; ++n) acc[a][b][m][n] = (f32x4){0.f, 0.f, 0.f, 0.f};
        cur = nxt; cA = nA; cB = nB; ++ui;
        if constexpr (ALIGN_EPI) { if (wr == 1) PG8_BAR; }
    }
    PG8_WAIT_V(0);
    if constexpr (!ALIGN_EPI) { if (wr == 0) PG8_BAR; }
    PG8_BAR;
#undef PG8_SA
#undef PG8_SB
#undef PG8_STAGE
#undef PG8_LDA
#undef PG8_LDB
#undef PG8_MMA
#undef PG8_WAIT_V
#undef PG8_WAIT_L
#undef PG8_BAR
#undef PG8_SCHED
#undef PG8_ACOL
}
}

#define GAS __attribute__((address_space(1)))
struct Args { GAS const float* in[26]; GAS float* out; GAS unsigned char* ws; };

struct Frame {
    LAS unsigned char* lds;
    int tid, lane, wave, G, bid, wave_s;
    const Args* a; GAS unsigned char* ws; GAS unsigned char* ws0;
};
constexpr int TIDTAB_OFF = 8 * 19456 + 64;
__device__ __forceinline__ int tid_from_lds(LAS unsigned char* lds, int wave_s) {
    int ln; asm volatile("v_mbcnt_lo_u32_b32 %0, -1, 0\n\tv_mbcnt_hi_u32_b32 %0, -1, %0" : "=v"(ln));
    const int t = *(const volatile LAS int*)(lds + TIDTAB_OFF + (wave_s * 64 + ln) * 4);
    __builtin_assume(t >= 0 && t < 512);
    return t;
}
#define FIN(i) ((const float*)(F.a->in[i]))
__device__ __forceinline__ void refresh(Frame& F) { const int t = tid_from_lds(F.lds, F.wave_s); F.tid = t; F.lane = t & 63; F.wave = __builtin_amdgcn_readfirstlane(t >> 6);
    GAS unsigned char* w = F.ws0; asm volatile("" : "+s"(w)); F.ws = w; }

__device__ __forceinline__ void transpose_item(const float* W, int ldw, int k0, int nsrc0, bf16_t* WT, int ldt, int drow0, int dcol0, int nrep, int drep, LAS float* scr, int lane) {
    float tv[32];
#pragma unroll
    for (int i = 0; i < 32; ++i) { const int kk = 2 * i + (lane >> 5); tv[i] = __builtin_nontemporal_load(W + (size_t)(k0 + kk) * ldw + nsrc0 + (lane & 31)); }
#pragma unroll
    for (int i = 0; i < 32; ++i) { const int kk = 2 * i + (lane >> 5); scr[kk * 33 + (lane & 31)] = tv[i]; }
    LDS_WAIT(); asm volatile("" ::: "memory");
    const int c = lane & 7;
#pragma unroll
    for (int j = 0; j < 4; ++j) { const int n = (lane >> 3) + 8 * j; const LAS float* s = scr + (8 * c) * 33 + n;
        u32x4 o; o.x = pk2(s[0 * 33], s[1 * 33]); o.y = pk2(s[2 * 33], s[3 * 33]); o.z = pk2(s[4 * 33], s[5 * 33]); o.w = pk2(s[6 * 33], s[7 * 33]);
        for (int r = 0; r < nrep; ++r) *(u32x4*)(WT + (size_t)(drow0 + n) * ldt + dcol0 + r * drep + k0 + 8 * c) = o; }
    LDS_WAIT(); asm volatile("" ::: "memory");
}
template <int PART>
__device__ __forceinline__ void convert_weights(Frame& F, int l, int b0 = 0, int nb = 0) {
    refresh(F);
    LAS float* scr = (LAS float*)(F.lds + F.wave * 16384);
    if (nb == 0) nb = F.G;
    if (F.bid < b0 || F.bid >= b0 + nb) return;
    const int gw = (F.bid - b0) * NWAVES + F.wave, NGW = nb * NWAVES;
    const float* w_in = FIN(6) + (size_t)l * DM * INC;
    const float* w_br = FIN(18) + (size_t)l * 4 * 256 * DM;
    const float* w_out = FIN(19) + (size_t)l * DM * DM;
    const float* w_up = FIN(22) + (size_t)l * DM * 2 * FFH;
    const float* w_dn = FIN(23) + (size_t)l * FFH * DM;
    bf16_t* WIN = (bf16_t*)(F.ws + WS_WIN); bf16_t* WBR = (bf16_t*)(F.ws + WS_WBR); bf16_t* WOUT = (bf16_t*)(F.ws + WS_WOUT);
    bf16_t* WUP = (bf16_t*)(F.ws + WS_WUP); bf16_t* WDN = (bf16_t*)(F.ws + WS_WDN);
    constexpr int I_IN = 16 * 240, I_BR = 4 * 4 * 32, I_OUT = 16 * 32, I_UP = 16 * 176, I_DN = 44 * 32;
    if (PART == 0) {
        for (int it = gw; it < I_IN + I_BR + I_OUT; it += NGW) {
            int r = it;
            if (r < I_IN) { const int kb = r / 240, nb = r % 240, d0 = nb * 32; const int s0 = d0 < 2304 ? d0 : d0 + 8;
                transpose_item(w_in, INC, kb * 64, s0, WIN, DM, d0, 0, 1, 0, scr, F.lane); continue; } r -= I_IN;
            if (r < I_BR) { const int n = r / 128, rr = r % 128, kb = rr / 32, nb = rr % 32;
                transpose_item(w_br + (size_t)n * 256 * DM, DM, kb * 64, nb * 32, WBR, DM, nb * 32, n * 256, 1, 0, scr, F.lane); continue; } r -= I_BR;
            { const int kb = r / 32, nb = r % 32; transpose_item(w_out, DM, kb * 64, nb * 32, WOUT, DM, nb * 32, 0, 1, 0, scr, F.lane); }
        }
    } else {
        for (int it = gw; it < I_UP + I_DN; it += NGW) {
            int r = it;
            if (r < I_UP) { const int kb = r / 176, nb = r % 176, d0 = nb * 32, tile = d0 >> 8, within = d0 & 255;
                const int s0 = within < 128 ? tile * 128 + within : FFH + tile * 128 + (within - 128);
                transpose_item(w_up, 2 * FFH, kb * 64, s0, WUP, DM, d0, 0, 1, 0, scr, F.lane); continue; } r -= I_UP;
            { const int kb = r / 32, nb = r % 32; transpose_item(w_dn, DM, kb * 64, nb * 32, WDN, FFH, nb * 32, 0, 1, 0, scr, F.lane); }
        }
    }
}

__device__ __forceinline__ void mods_phase(Frame& F) {
    refresh(F);
    LAS float* sil = (LAS float*)(F.lds);
    LAS float* part = sil + 5 * 1024;
    if (F.bid >= 192) return;
    const int l = F.bid / 96, cgp = F.bid % 96;
    for (int i = F.tid; i < 5 * 1024; i += NTHREADS) { const int r = i >> 10, k = i & 1023; const float cv = r < 4 ? FIN(1)[r * 1024 + k] : FIN(3)[k]; sil[i] = siluf_(cv); }
    __syncthreads();
    const float* aw = FIN(4) + (size_t)l * DM * 6144 + cgp * 64 + F.lane;
    float a0 = 0.f, a1 = 0.f, a2 = 0.f, a3 = 0.f, a4 = 0.f;
    const int kb = F.wave * 128;
#pragma unroll 32
    for (int k = 0; k < 128; ++k) { const float w = __builtin_nontemporal_load(aw + (size_t)(kb + k) * 6144);
        a0 += sil[kb + k] * w; a1 += sil[1024 + kb + k] * w; a2 += sil[2048 + kb + k] * w; a3 += sil[3072 + kb + k] * w; a4 += sil[4096 + kb + k] * w; }
    part[(F.wave * 5 + 0) * 64 + F.lane] = a0; part[(F.wave * 5 + 1) * 64 + F.lane] = a1; part[(F.wave * 5 + 2) * 64 + F.lane] = a2;
    part[(F.wave * 5 + 3) * 64 + F.lane] = a3; part[(F.wave * 5 + 4) * 64 + F.lane] = a4;
    __syncthreads();
    if (F.wave < 5) { float s = FIN(5)[l * 6144 + cgp * 64 + F.lane];
#pragma unroll
        for (int w = 0; w < 8; ++w) s += part[(w * 5 + F.wave) * 64 + F.lane];
        ((float*)(F.ws + WS_MODS))[(size_t)(l * 5 + F.wave) * 6144 + cgp * 64 + F.lane] = s; }
    __syncthreads();
}

struct RowOp {
    int nrows;
    const float* xlat_in; const float* xctx_in;
    bool post;
    const bf16_t* Y; const bf16_t* slabs; int nslab; int slab_row0;
    int gate_chunk; const float* lng; const float* lnb; const float* mods_post;
    float* xlat_out; float* xctx_out;
    bool domod;
    const float* mods_mod; int shift_chunk, scale_chunk; bf16_t* Hout;
    bool dodt; float* DTout;
};
__device__ __forceinline__ void row_pass(Frame& F, const RowOp& R, const float* w_in_l) {
    refresh(F);
    LAS float* wdt = (LAS float*)F.lds;
    if (R.dodt) {
        for (int i = F.tid; i < 8192; i += NTHREADS) { const int c = i >> 10, k = i & 1023; wdt[i] = w_in_l[(size_t)k * INC + 2304 + c]; }
    }
    __syncthreads();
    const int gw = F.bid * NWAVES + F.wave, NGW = F.G * NWAVES;
    const int m0 = gw, m1 = R.nrows;
    const int lane = F.lane;
    f32x4 lg[4], lb[4], gt4[4], sh4[4], sc4[4];
    if (R.post) {
#pragma unroll
        for (int j = 0; j < 4; ++j) { lg[j] = *(const f32x4*)(R.lng + 4 * (lane + 64 * j)); lb[j] = *(const f32x4*)(R.lnb + 4 * (lane + 64 * j)); }
    }
    int cur_r5 = -1;
    f32x4 xn[4]; u32x2 yn[4];
#define RP_LOAD(M) do { const int m_ = (M); const float* xr_ = m_ < MLAT ? R.xlat_in + (size_t)m_ * DM : R.xctx_in + (size_t)(m_ - MLAT) * DM; \
        _Pragma("unroll") for (int j = 0; j < 4; ++j) xn[j] = __builtin_nontemporal_load((const f32x4*)(xr_ + 4 * (lane + 64 * j))); \
        if (R.post && !(R.nslab > 0 && m_ >= R.slab_row0)) { const bf16_t* yr_ = R.Y + (size_t)m_ * DM; _Pragma("unroll") for (int j = 0; j < 4; ++j) yn[j] = __builtin_nontemporal_load((const u32x2*)(yr_ + 4 * (lane + 64 * j))); } } while (0)
    if (m0 < m1) RP_LOAD(m0);
#pragma unroll 1
    for (int m = m0; m < m1; m += NGW) {
        const int r5 = m < MLAT ? (m >> 12) : 4;
        if (r5 != cur_r5) { cur_r5 = r5;
            if (R.post) { const float* gt = R.mods_post + (size_t)r5 * 6144 + R.gate_chunk * 1024;
#pragma unroll
                for (int j = 0; j < 4; ++j) gt4[j] = *(const f32x4*)(gt + 4 * (lane + 64 * j)); }
            if (R.domod) { const float* sh = R.mods_mod + (size_t)r5 * 6144 + R.shift_chunk * 1024; const float* sc = R.mods_mod + (size_t)r5 * 6144 + R.scale_chunk * 1024;
#pragma unroll
                for (int j = 0; j < 4; ++j) { sh4[j] = *(const f32x4*)(sh + 4 * (lane + 64 * j)); sc4[j] = *(const f32x4*)(sc + 4 * (lane + 64 * j)); } }
        }
        f32x4 v[4]; u32x2 yv[4];
#pragma unroll
        for (int j = 0; j < 4; ++j) { v[j] = xn[j]; yv[j] = yn[j]; }
        const bool slabrow = R.post && R.nslab > 0 && m >= R.slab_row0;
        float ys[4][4];
        if (slabrow) {
#pragma unroll
            for (int j = 0; j < 4; ++j) { const int c = 4 * (lane + 64 * j); ys[j][0] = ys[j][1] = ys[j][2] = ys[j][3] = 0.f; const bf16_t* sp = R.slabs + (size_t)(m - R.slab_row0) * 1024 + c;
                for (int sidx = 0; sidx < R.nslab; ++sidx) { const u32x2 yw = *(const u32x2*)(sp + (size_t)sidx * (MALL - R.slab_row0) * 1024); ys[j][0] += bflo(yw.x); ys[j][1] += bfhi(yw.x); ys[j][2] += bflo(yw.y); ys[j][3] += bfhi(yw.y); } }
        }
        if (m + NGW < m1) RP_LOAD(m + NGW);
        if (R.post) {
#pragma unroll
            for (int j = 0; j < 4; ++j) { const f32x4 g4 = gt4[j];
                const float y0 = slabrow ? ys[j][0] : bflo(yv[j].x), y1 = slabrow ? ys[j][1] : bfhi(yv[j].x), y2 = slabrow ? ys[j][2] : bflo(yv[j].y), y3 = slabrow ? ys[j][3] : bfhi(yv[j].y);
                v[j].x = ALPHA * v[j].x + g4.x * y0; v[j].y = ALPHA * v[j].y + g4.y * y1;
                v[j].z = ALPHA * v[j].z + g4.z * y2; v[j].w = ALPHA * v[j].w + g4.w * y3; }
            float s = 0.f;
#pragma unroll
            for (int j = 0; j < 4; ++j) s += (v[j].x + v[j].y) + (v[j].z + v[j].w);
            const float mean = wave_sum(s) * (1.f / DM); float s2 = 0.f;
#pragma unroll
            for (int j = 0; j < 4; ++j) { v[j] = v[j] - mean; s2 += (v[j].x * v[j].x + v[j].y * v[j].y) + (v[j].z * v[j].z + v[j].w * v[j].w); }
            const float rstd = 1.f / sqrtf(wave_sum(s2) * (1.f / DM) + LN_EPS);
            float* xo = m < MLAT ? R.xlat_out + (size_t)m * DM : R.xctx_out + (size_t)(m - MLAT) * DM;
#pragma unroll
            for (int j = 0; j < 4; ++j) { const int c = 4 * (lane + 64 * j); v[j] = v[j] * rstd * lg[j] + lb[j]; __builtin_nontemporal_store(v[j], (f32x4*)(xo + c)); }
        }
        if (R.domod) {
            float s = 0.f;
#pragma unroll
            for (int j = 0; j < 4; ++j) s += (v[j].x + v[j].y) + (v[j].z + v[j].w);
            const float mean = wave_sum(s) * (1.f / DM); float s2 = 0.f;
#pragma unroll
            for (int j = 0; j < 4; ++j) { v[j] = v[j] - mean; s2 += (v[j].x * v[j].x + v[j].y * v[j].y) + (v[j].z * v[j].z + v[j].w * v[j].w); }
            const float rstd = 1.f / sqrtf(wave_sum(s2) * (1.f / DM) + LN_EPS);
            bf16_t* hr = R.Hout + (size_t)m * DM;
#pragma unroll
            for (int j = 0; j < 4; ++j) { const int c = 4 * (lane + 64 * j);
                v[j] = v[j] * rstd * (sc4[j] + 1.f) + sh4[j];
                u32x2 w; w.x = pk2(v[j].x, v[j].y); w.y = pk2(v[j].z, v[j].w); *(u32x2*)(hr + c) = w; }
            if (R.dodt) {
                float d[8];
#pragma unroll
                for (int c = 0; c < 8; ++c) { float a = 0.f;
                    asm volatile("" ::: "memory");
#pragma unroll
                    for (int j = 0; j < 4; ++j) { const f32x4 w4 = *(const LAS f32x4*)(wdt + c * 1024 + 4 * (lane + 64 * j)); a += (v[j].x * w4.x + v[j].y * w4.y) + (v[j].z * w4.z + v[j].w * w4.w); }
                    d[c] = wave_sum(a); }
                if (lane == 0) { *(f32x4*)(R.DTout + (size_t)m * 8) = (f32x4){d[0], d[1], d[2], d[3]}; *(f32x4*)(R.DTout + (size_t)m * 8 + 4) = (f32x4){d[4], d[5], d[6], d[7]}; }
            }
        }
    }
#undef RP_LOAD
    __syncthreads();
}

__device__ __forceinline__ void prep_phase(Frame& F, int l) {
    refresh(F);
    bf16_t* MIX = (bf16_t*)(F.ws + WS_RC);
    const float* qn = FIN(16) + l * 64; const float* kn = FIN(17) + l * 64;
    const int gt = F.bid * NTHREADS + F.tid, NGT = F.G * NTHREADS;
    for (int it = gt; it < MALL * 6; it += NGT) {
        const int m = it / 6, slot = it % 6;
        bf16_t* p = MIX + (size_t)m * NMIX + (slot < 4 ? C_DQ + 64 * slot : C_DK + 64 * (slot - 4));
        const float* nw = slot < 4 ? qn : kn;
        float x[64];
#pragma unroll
        for (int w = 0; w < 8; ++w) { const u32x4 u = *(const u32x4*)(p + 8 * w);
            x[8 * w + 0] = bflo(u.x); x[8 * w + 1] = bfhi(u.x); x[8 * w + 2] = bflo(u.y); x[8 * w + 3] = bfhi(u.y);
            x[8 * w + 4] = bflo(u.z); x[8 * w + 5] = bfhi(u.z); x[8 * w + 6] = bflo(u.w); x[8 * w + 7] = bfhi(u.w); }
        float ss = 0.f;
#pragma unroll
        for (int d = 0; d < 64; ++d) ss += x[d] * x[d];
        const float rs = 1.f / sqrtf(ss * (1.f / 64.f) + LN_EPS);
#pragma unroll
        for (int d = 0; d < 64; ++d) x[d] = x[d] * rs * nw[d];
        if (m < MLAT && slot < 4) {
#pragma unroll
            for (int d = 0; d < 64; ++d) x[d] *= 0.125f * 1.4426950408889634f; }
        if (m < MLAT) {
            const int t = m & 4095; const float prow = (float)(t >> 6), pcol = (float)(t & 63);
#pragma unroll
            for (int i = 0; i < 16; ++i) {
                const float inv = expf(-(float)i * (9.210340371976184f / 16.f));
                const float ar = prow * inv, ac = pcol * inv;
                const float sr = __sinf(ar), cr = __cosf(ar), sc = __sinf(ac), cc = __cosf(ac);
                const float a1 = x[i], a2 = x[16 + i]; x[i] = a1 * cr - a2 * sr; x[16 + i] = a2 * cr + a1 * sr;
                const float b1 = x[32 + i], b2 = x[48 + i]; x[32 + i] = b1 * cc - b2 * sc; x[48 + i] = b2 * cc + b1 * sc;
            }
        }
#pragma unroll
        for (int w = 0; w < 8; ++w) { u32x4 u; u.x = pk2(x[8 * w], x[8 * w + 1]); u.y = pk2(x[8 * w + 2], x[8 * w + 3]); u.z = pk2(x[8 * w + 4], x[8 * w + 5]); u.w = pk2(x[8 * w + 6], x[8 * w + 7]);
            *(u32x4*)(p + 8 * w) = u; }
    }
}

__device__ __forceinline__ void conv_to_lds(Frame& F, int l) {
    refresh(F);
    const bf16_t* MIX = (const bf16_t*)(F.ws + WS_RC);
    const float* cw = FIN(9) + (size_t)l * 5 * 768; const float* cb = FIN(10) + l * 768;
    LAS unsigned* cv = (LAS unsigned*)F.lds;
    if (F.tid < 384) {
        const int c = 2 * F.tid, r0 = 68 * F.bid;
        float w0[5], w1[5];
#pragma unroll
        for (int j = 0; j < 5; ++j) { w0[j] = cw[j * 768 + c]; w1[j] = cw[j * 768 + c + 1]; }
        const float b0 = cb[c], b1 = cb[c + 1];
        unsigned win[72];
#pragma unroll
        for (int j = 0; j < 72; ++j) { const int mm = r0 - 2 + j; win[j] = (mm >= 0 && mm < MALL) ? *(const unsigned*)(MIX + (size_t)mm * NMIX + C_BX + c) : 0u; }
#pragma unroll
        for (int r = 0; r < 68; ++r) {
            const int m = r0 + r;
            const int lo = m < MLAT ? (m & ~4095) : MLAT + ((m - MLAT) & ~255), hi = lo + (m < MLAT ? SEQ : CTXL);
            float a0 = b0, a1 = b1;
#pragma unroll
            for (int j = 0; j < 5; ++j) { const int mm = m + j - 2; const bool ok = (mm >= lo) && (mm < hi); a0 += ok ? w0[j] * bflo(win[r + j]) : 0.f; a1 += ok ? w1[j] * bfhi(win[r + j]) : 0.f; }
            cv[r * 384 + F.tid] = pk2(siluf_(a0), siluf_(a1));
        }
    }
}
__device__ __forceinline__ void conv_from_lds(Frame& F) {
    refresh(F);
    bf16_t* MIX = (bf16_t*)(F.ws + WS_RC);
    const LAS unsigned* cv = (const LAS unsigned*)F.lds;
    if (F.tid < 384) { const int r0 = 68 * F.bid;
        for (int r = 0; r < 68; ++r) *(unsigned*)(MIX + (size_t)(r0 + r) * NMIX + C_BX + 2 * F.tid) = cv[r * 384 + F.tid]; }
}

typedef short s16x4 __attribute__((ext_vector_type(4)));
typedef float f32x16 __attribute__((ext_vector_type(16)));
typedef float f32x2_t __attribute__((ext_vector_type(2))); typedef __bf16 bf16x2_t __attribute__((ext_vector_type(2)));
#define MFMA32(a, b, c) __builtin_amdgcn_mfma_f32_32x32x16_bf16((a), (b), (c), 0, 0, 0)
__device__ __forceinline__ unsigned cvtpk(float lo, float hi) { f32x2_t v = {lo, hi}; bf16x2_t b = __builtin_convertvector(v, bf16x2_t); return __builtin_bit_cast(unsigned, b); }
__device__ __forceinline__ int crow(int reg, int h) { return (reg & 3) + 8 * (reg >> 2) + 4 * h; }
template <int S_> __device__ __forceinline__ bf16x8 pack8(const f32x16& x) {
    u32x4 p; p.x = cvtpk(x[8 * S_], x[8 * S_ + 1]); p.y = cvtpk(x[8 * S_ + 2], x[8 * S_ + 3]); p.z = cvtpk(x[8 * S_ + 4], x[8 * S_ + 5]); p.w = cvtpk(x[8 * S_ + 6], x[8 * S_ + 7]);
    return __builtin_bit_cast(bf16x8, p);
}
__device__ __forceinline__ bf16x8 ld_row8(const LAS unsigned char* tb, int P, int r, int c0) { return *(const LAS bf16x8*)(tb + r * P + c0 * 2); }
__device__ __forceinline__ bf16x8 ld_row8_perm(const LAS unsigned char* tb, int P, int r, int c0, int h) {
    const s16x4 lo = *(const LAS s16x4*)(tb + r * P + (c0 + 4 * h) * 2), hi = *(const LAS s16x4*)(tb + r * P + (c0 + 8 + 4 * h) * 2);
    return __builtin_shufflevector(lo, hi, 0, 1, 2, 3, 4, 5, 6, 7);
}
__device__ __forceinline__ s16x4 tr4(const LAS unsigned char* tb, int P, int row0, int col0, int lane) {
    const int q = (lane & 15) >> 2, p = lane & 3, blk = (lane >> 4) & 1;
    return __builtin_bit_cast(s16x4, __builtin_amdgcn_ds_read_tr16_b64_v4i16((LAS s16x4*)(tb + (row0 + q) * P + (col0 + 16 * blk + 4 * p) * 2)));
}
__device__ __forceinline__ bf16x8 ld_tr8(const LAS unsigned char* tb, int P, int row_lo, int row_hi, int col0, int lane) {
    const s16x4 lo = tr4(tb, P, row_lo, col0, lane), hi = tr4(tb, P, row_hi, col0, lane);
    return __builtin_shufflevector(lo, hi, 0, 1, 2, 3, 4, 5, 6, 7);
}
__device__ __forceinline__ float bperm_(float v, int src_lane) { return __int_as_float(__builtin_amdgcn_ds_bpermute(src_lane * 4, __float_as_int(v))); }
__device__ __forceinline__ float softplusf_(float x) { return fmaxf(x, 0.f) + __logf(1.f + __expf(-fabsf(x))); }
constexpr int NCH = 17;
constexpr int TP64 = 144, TP32 = 80;

template <int NC> __device__ __forceinline__ void stage_tile(LAS unsigned char* tb, const bf16_t* MIX, int R0, int dir, int I, int col, int lane) {
    constexpr int CPR = NC / 8, NP = 32 * CPR / 64, P = NC == 64 ? TP64 : TP32;
#pragma unroll
    for (int t = 0; t < NP; ++t) { const int id = lane + 64 * t, r = id / CPR, ck = id % CPR; const int i = 32 * I + r; const int m = dir ? R0 + 255 - i : R0 + i;
        *(LAS u32x4*)(tb + r * P + ck * 16) = *(const u32x4*)(MIX + (size_t)m * NMIX + col + ck * 8); }
}

template <int NC> __device__ __forceinline__ void tile_load(u32x4 (&rg)[NC / 16], const bf16_t* MIX, int R0, int dir, int I, int col, int lane) {
    constexpr int CPR = NC / 8, NP = NC / 16;
#pragma unroll
    for (int t = 0; t < NP; ++t) { const int id = lane + 64 * t, r = id / CPR, ck = id % CPR; const int i = 32 * I + r; const int m = dir ? R0 + 255 - i : R0 + i;
        const unsigned off = (unsigned)m * (unsigned)(NMIX * 2) + (unsigned)((col + ck * 8) * 2);
        rg[t] = *(const u32x4*)((const char*)MIX + off); }
}
template <int NC> __device__ __forceinline__ void tile_store(LAS unsigned char* tb, const u32x4 (&rg)[NC / 16], int lane) {
    constexpr int CPR = NC / 8, NP = NC / 16, P = NC == 64 ? TP64 : TP32;
#pragma unroll
    for (int t = 0; t < NP; ++t) { const int id = lane + 64 * t, r = id / CPR, ck = id % CPR; *(LAS u32x4*)(tb + r * P + ck * 16) = rg[t]; }
}

template <bool PASS_C>
__device__ __forceinline__ void hgrn_task(Frame& F, int l, int seq, int pc, bf16_t* OUT, int ldo) {
    const bf16_t* MIX = (const bf16_t*)(F.ws + WS_RC);
    const int lane_ = tid_from_lds(F.lds, F.wave_s) & 63;
    const int lane = lane_, h = lane >> 5, c31 = lane & 31;
    const int dir = seq >> 4, b = (seq >> 2) & 3, head = seq & 3;
    LAS unsigned char* wl = F.lds + F.wave * WLDS;
    LAS unsigned char* TQ = wl; LAS unsigned char* TK = wl + 4608; LAS unsigned char* TH = wl + 9216; LAS unsigned char* TV = wl + 13824; LAS float* Dv = (LAS float*)(wl + 18432);
    const int R0 = pc == 0 ? MLAT + b * CTXL : b * SEQ + (dir ? 16 - pc : pc - 1) * 256;
    const int fcol = (dir ? C_AFB : C_AFF) + head * 64;
    bf16_t* ST = (bf16_t*)(F.ws + WS_STA) + ((size_t)seq * NCH + pc) * 4096;
    f32x16 S[2][2];
#pragma unroll
    for (int kb = 0; kb < 2; ++kb)
#pragma unroll
        for (int vb = 0; vb < 2; ++vb) {
            if (PASS_C) {
#pragma unroll
                for (int q4 = 0; q4 < 2; ++q4) { const u32x4 w = *(const u32x4*)(ST + lane * 64 + (kb * 2 + vb) * 16 + q4 * 8);
                    S[kb][vb][8 * q4 + 0] = bflo(w.x); S[kb][vb][8 * q4 + 1] = bfhi(w.x); S[kb][vb][8 * q4 + 2] = bflo(w.y); S[kb][vb][8 * q4 + 3] = bfhi(w.y);
                    S[kb][vb][8 * q4 + 4] = bflo(w.z); S[kb][vb][8 * q4 + 5] = bfhi(w.z); S[kb][vb][8 * q4 + 6] = bflo(w.w); S[kb][vb][8 * q4 + 7] = bfhi(w.w); }
            } else {
#pragma unroll
                for (int reg = 0; reg < 16; ++reg) S[kb][vb][reg] = 0.f; } }
    float gtot = 0.f;
    u32x4 pg[4], pq[4], pv[4];
    tile_load<64>(pg, MIX, R0, dir, 0, fcol, lane); if (PASS_C) tile_load<64>(pq, MIX, R0, dir, 0, C_AQ + head * 64, lane); tile_load<64>(pv, MIX, R0, dir, 0, C_AV + head * 64, lane);
#pragma unroll 1
    for (int I = 0; I < 8; ++I) {
        tile_store<64>(TH, pg, lane); if (PASS_C) tile_store<64>(TQ, pq, lane); tile_store<64>(TV, pv, lane);
        LDS_WAIT();
        if (I + 1 < 8) { tile_load<64>(pg, MIX, R0, dir, I + 1, fcol, lane); if (PASS_C) tile_load<64>(pq, MIX, R0, dir, I + 1, C_AQ + head * 64, lane); tile_load<64>(pv, MIX, R0, dir, I + 1, C_AV + head * 64, lane); }
        float br[32], kkv[32];
        float run = 0.f;
#pragma unroll
        for (int r = 0; r < 32; ++r) {
            if ((r & 7) == 0) asm volatile("" ::: "memory");
            const float g2 = bf2f(*(const LAS bf16_t*)(TH + r * TP64 + lane * 2));
            run += g2; br[r] = run; const float kk = 1.f - __builtin_amdgcn_exp2f(g2); kkv[r] = kk;
            if (PASS_C) { const float e = __builtin_amdgcn_exp2f(fmaxf(run, -120.f)); const float q = bf2f(*(const LAS bf16_t*)(TQ + r * TP64 + lane * 2));
                const unsigned w = cvtpk(q * e, kk * __builtin_amdgcn_rcpf(e));
                *(LAS bf16_t*)(TQ + r * TP64 + lane * 2) = (bf16_t)w; *(LAS bf16_t*)(TK + r * TP64 + lane * 2) = (bf16_t)(w >> 16); }
        }
        const float total = run; gtot += total;
#pragma unroll
        for (int r = 0; r < 32; r += 2) { const unsigned w = cvtpk(kkv[r] * __builtin_amdgcn_exp2f(total - br[r]), kkv[r + 1] * __builtin_amdgcn_exp2f(total - br[r + 1]));
            *(LAS bf16_t*)(TH + r * TP64 + lane * 2) = (bf16_t)w; *(LAS bf16_t*)(TH + (r + 1) * TP64 + lane * 2) = (bf16_t)(w >> 16); }
        Dv[lane] = __builtin_amdgcn_exp2f(total);
        LDS_WAIT();
        if (PASS_C) {
            f32x16 P;
#pragma unroll
            for (int reg = 0; reg < 16; ++reg) P[reg] = 0.f;
#pragma unroll
            for (int s = 0; s < 4; ++s) P = MFMA32(ld_row8(TK, TP64, c31, 16 * s + 8 * h), ld_row8(TQ, TP64, c31, 16 * s + 8 * h), P);
#pragma unroll
            for (int reg = 0; reg < 16; ++reg) if (crow(reg, h) > c31) P[reg] = 0.f;
            const bf16x8 pa0 = pack8<0>(P), pa1 = pack8<1>(P);
#pragma unroll
            for (int vb = 0; vb < 2; ++vb) {
                f32x16 o;
#pragma unroll
                for (int reg = 0; reg < 16; ++reg) o[reg] = 0.f;
                o = MFMA32(pa0, ld_tr8(TV, TP64, 4 * h, 8 + 4 * h, 32 * vb, lane), o);
                o = MFMA32(pa1, ld_tr8(TV, TP64, 16 + 4 * h, 24 + 4 * h, 32 * vb, lane), o);
#pragma unroll
                for (int kb = 0; kb < 2; ++kb) {
                    o = MFMA32(ld_row8_perm(TQ, TP64, c31, 32 * kb, h), pack8<0>(S[kb][vb]), o);
                    o = MFMA32(ld_row8_perm(TQ, TP64, c31, 32 * kb + 16, h), pack8<1>(S[kb][vb]), o);
                }
#pragma unroll
                for (int reg = 0; reg < 16; reg += 2) { const unsigned w0 = cvtpk(o[reg], o[reg + 1]);
                    *(LAS bf16_t*)(TK + crow(reg, h) * TP64 + (32 * vb + c31) * 2) = (bf16_t)w0; *(LAS bf16_t*)(TK + crow(reg + 1, h) * TP64 + (32 * vb + c31) * 2) = (bf16_t)(w0 >> 16); }
            }
            LDS_WAIT();
#pragma unroll
            for (int t = 0; t < 4; ++t) { const int id = lane + 64 * t, r = id >> 3, ck = id & 7; const int i = 32 * I + r; const int m = dir ? R0 + 255 - i : R0 + i;
                __builtin_nontemporal_store(*(const LAS u32x4*)(TK + r * TP64 + ck * 16), (u32x4*)((char*)OUT + ((unsigned)m * (unsigned)ldo + (unsigned)(head * 64 + ck * 8)) * 2u)); }
        }
#pragma unroll
        for (int kb = 0; kb < 2; ++kb) {
            float dr[16];
#pragma unroll
            for (int g = 0; g < 4; ++g) { const f32x4 d4 = *(const LAS f32x4*)(Dv + 32 * kb + 8 * g + 4 * h); dr[4 * g] = d4.x; dr[4 * g + 1] = d4.y; dr[4 * g + 2] = d4.z; dr[4 * g + 3] = d4.w; }
#pragma unroll
            for (int vb = 0; vb < 2; ++vb)
#pragma unroll
                for (int reg = 0; reg < 16; ++reg) S[kb][vb][reg] *= dr[reg];
#pragma unroll
            for (int s = 0; s < 2; ++s) { const bf16x8 a = ld_tr8(TH, TP64, 16 * s + 8 * h, 16 * s + 8 * h + 4, 32 * kb, lane);
#pragma unroll
                for (int vb = 0; vb < 2; ++vb) S[kb][vb] = MFMA32(a, ld_tr8(TV, TP64, 16 * s + 8 * h, 16 * s + 8 * h + 4, 32 * vb, lane), S[kb][vb]); }
        }
        LDS_WAIT();
    }
    if (!PASS_C) {
#pragma unroll
        for (int kb = 0; kb < 2; ++kb)
#pragma unroll
            for (int vb = 0; vb < 2; ++vb)
#pragma unroll
                for (int q4 = 0; q4 < 2; ++q4) { const f32x16& T = S[kb][vb]; u32x4 w; w.x = cvtpk(T[8 * q4], T[8 * q4 + 1]); w.y = cvtpk(T[8 * q4 + 2], T[8 * q4 + 3]); w.z = cvtpk(T[8 * q4 + 4], T[8 * q4 + 5]); w.w = cvtpk(T[8 * q4 + 6], T[8 * q4 + 7]);
                    *(u32x4*)(ST + lane * 64 + (kb * 2 + vb) * 16 + q4 * 8) = w; }
        ((float*)(F.ws + WS_DLA))[((size_t)seq * NCH + pc) * 64 + lane] = gtot;
    }
}

template <bool PASS_C>
__device__ __forceinline__ void ssd_task(Frame& F, int l, int seq2, int pc, bf16_t* OUT, int ldo) {
    const bf16_t* MIX = (const bf16_t*)(F.ws + WS_RC);
    const float* DT = (const float*)(F.ws + WS_DT);
    const int lane_ = tid_from_lds(F.lds, F.wave_s) & 63;
    const int lane = lane_, h = lane >> 5, c31 = lane & 31;
    const int seq = seq2 >> 1, vb = seq2 & 1, dir = seq >> 4, b = (seq >> 2) & 3, head = seq & 3, g = head >> 1;
    LAS unsigned char* wl = F.lds + F.wave * WLDS;
    LAS unsigned char* TC = wl; LAS unsigned char* TB = wl + 4608; LAS unsigned char* TX = wl + 9216; LAS unsigned char* TXh = wl + 11776;
    LAS float* brn = (LAS float*)(wl + 18432); LAS float* dtv = brn + 32;
    const int R0 = pc == 0 ? MLAT + b * CTXL : b * SEQ + (dir ? 16 - pc : pc - 1) * 256;
    const float Aneg = -expf(FIN(12)[(l * 2 + dir) * 4 + head]); const float dtb = FIN(11)[(l * 2 + dir) * 4 + head];
    bf16_t* ST = (bf16_t*)(F.ws + WS_STB) + ((size_t)seq2 * NCH + pc) * 4096;
    f32x16 S[4];
#pragma unroll
    for (int kb = 0; kb < 4; ++kb) {
        if (PASS_C) {
#pragma unroll
            for (int q4 = 0; q4 < 2; ++q4) { const u32x4 w = *(const u32x4*)(ST + lane * 64 + kb * 16 + q4 * 8);
                S[kb][8 * q4 + 0] = bflo(w.x); S[kb][8 * q4 + 1] = bfhi(w.x); S[kb][8 * q4 + 2] = bflo(w.y); S[kb][8 * q4 + 3] = bfhi(w.y);
                S[kb][8 * q4 + 4] = bflo(w.z); S[kb][8 * q4 + 5] = bfhi(w.z); S[kb][8 * q4 + 6] = bflo(w.w); S[kb][8 * q4 + 7] = bfhi(w.w); }
        } else {
#pragma unroll
            for (int reg = 0; reg < 16; ++reg) S[kb][reg] = 0.f; } }
    float gtot = 0.f;
    u32x4 pxx[2], pcq[4], pbb[4]; float dtraw;
    const int xcol = C_BX + head * 64 + vb * 32, ccol = C_BC + g * 128, bcol = C_BB + g * 128;
    { const int i_o = c31; const int m_o = dir ? R0 + 255 - i_o : R0 + i_o; dtraw = DT[(size_t)m_o * 8 + dir * 4 + head]; }
    if (PASS_C) tile_load<64>(pcq, MIX, R0, dir, 0, ccol, lane); tile_load<64>(pbb, MIX, R0, dir, 0, bcol, lane);
#pragma unroll 1
    for (int I = 0; I < 8; ++I) {
        tile_load<32>(pxx, MIX, R0, dir, I, xcol, lane);
        const float dt = softplusf_(dtraw + dtb);
        float run = dt * Aneg;
#pragma unroll
        for (int off = 1; off < 32; off <<= 1) { const float t = bperm_(run, (lane - off) & 63); if (c31 >= off) run += t; }
        const float total = bperm_(run, (lane & 32) | 31); gtot += total;
        const float wown = dt * __expf(total - run);
        if (lane < 32) { brn[c31] = run; dtv[c31] = dt; }
        tile_store<32>(TX, pxx, lane);
#pragma unroll
        for (int t = 0; t < 2; ++t) { const int id = lane + 64 * t, r = id >> 2, ck = id & 3;
            const u32x4 x4 = pxx[t];
            const float w = bperm_(wown, r);
            u32x4 y; y.x = cvtpk(bflo(x4.x) * w, bfhi(x4.x) * w); y.y = cvtpk(bflo(x4.y) * w, bfhi(x4.y) * w); y.z = cvtpk(bflo(x4.z) * w, bfhi(x4.z) * w); y.w = cvtpk(bflo(x4.w) * w, bfhi(x4.w) * w);
            *(LAS u32x4*)(TXh + r * TP32 + ck * 16) = y; }
        const float dsub = __expf(total);
        f32x16 P, oi;
#pragma unroll
        for (int reg = 0; reg < 16; ++reg) { P[reg] = 0.f; oi[reg] = 0.f; }
#pragma unroll
        for (int nh = 0; nh < 2; ++nh) {
            if (PASS_C) tile_store<64>(TC, pcq, lane);
            tile_store<64>(TB, pbb, lane);
            LDS_WAIT();
            if (nh == 0) { if (PASS_C) tile_load<64>(pcq, MIX, R0, dir, I, ccol + 64, lane); tile_load<64>(pbb, MIX, R0, dir, I, bcol + 64, lane); }
            else if (I + 1 < 8) { if (PASS_C) tile_load<64>(pcq, MIX, R0, dir, I + 1, ccol, lane); tile_load<64>(pbb, MIX, R0, dir, I + 1, bcol, lane);
                const int i_o = 32 * (I + 1) + c31; const int m_o = dir ? R0 + 255 - i_o : R0 + i_o; dtraw = DT[(size_t)m_o * 8 + dir * 4 + head]; }
            if (PASS_C) {
#pragma unroll
                for (int s = 0; s < 4; ++s) P = MFMA32(ld_row8(TB, TP64, c31, 16 * s + 8 * h), ld_row8(TC, TP64, c31, 16 * s + 8 * h), P);
#pragma unroll
                for (int kk = 0; kk < 2; ++kk) {
                    oi = MFMA32(ld_row8_perm(TC, TP64, c31, 32 * kk, h), pack8<0>(S[2 * nh + kk]), oi);
                    oi = MFMA32(ld_row8_perm(TC, TP64, c31, 32 * kk + 16, h), pack8<1>(S[2 * nh + kk]), oi);
                }
            }
#pragma unroll
            for (int kk = 0; kk < 2; ++kk) {
#pragma unroll
                for (int reg = 0; reg < 16; ++reg) S[2 * nh + kk][reg] *= dsub;
#pragma unroll
                for (int s = 0; s < 2; ++s)
                    S[2 * nh + kk] = MFMA32(ld_tr8(TB, TP64, 16 * s + 8 * h, 16 * s + 8 * h + 4, 32 * kk, lane), ld_tr8(TXh, TP32, 16 * s + 8 * h, 16 * s + 8 * h + 4, 0, lane), S[2 * nh + kk]);
            }
            LDS_WAIT();
        }
        if (PASS_C) {
            float bj[16], dj[16];
#pragma unroll
            for (int gq = 0; gq < 4; ++gq) { const f32x4 b4 = *(const LAS f32x4*)(brn + 8 * gq + 4 * h), d4 = *(const LAS f32x4*)(dtv + 8 * gq + 4 * h);
                bj[4 * gq] = b4.x; bj[4 * gq + 1] = b4.y; bj[4 * gq + 2] = b4.z; bj[4 * gq + 3] = b4.w; dj[4 * gq] = d4.x; dj[4 * gq + 1] = d4.y; dj[4 * gq + 2] = d4.z; dj[4 * gq + 3] = d4.w; }
#pragma unroll
            for (int reg = 0; reg < 16; ++reg) P[reg] = (crow(reg, h) <= c31) ? P[reg] * dj[reg] * __expf(run - bj[reg]) : 0.f;
#pragma unroll
            for (int reg = 0; reg < 16; ++reg) oi[reg] = oi[reg] * __expf(bj[reg]);
            oi = MFMA32(pack8<0>(P), ld_tr8(TX, TP32, 4 * h, 8 + 4 * h, 0, lane), oi);
            oi = MFMA32(pack8<1>(P), ld_tr8(TX, TP32, 16 + 4 * h, 24 + 4 * h, 0, lane), oi);
#pragma unroll
            for (int reg = 0; reg < 16; reg += 2) { const unsigned w0 = cvtpk(oi[reg], oi[reg + 1]);
                *(LAS bf16_t*)(TXh + crow(reg, h) * TP32 + c31 * 2) = (bf16_t)w0; *(LAS bf16_t*)(TXh + crow(reg + 1, h) * TP32 + c31 * 2) = (bf16_t)(w0 >> 16); }
            LDS_WAIT();
#pragma unroll
            for (int t = 0; t < 2; ++t) { const int id = lane + 64 * t, r = id >> 2, ck = id & 3; const int i = 32 * I + r; const int m = dir ? R0 + 255 - i : R0 + i;
                __builtin_nontemporal_store(*(const LAS u32x4*)(TXh + r * TP32 + ck * 16), (u32x4*)((char*)OUT + ((unsigned)m * (unsigned)ldo + (unsigned)(head * 64 + 32 * vb + ck * 8)) * 2u)); }
        }
        LDS_WAIT();
    }
    if (!PASS_C) {
#pragma unroll
        for (int kb = 0; kb < 4; ++kb)
#pragma unroll
            for (int q4 = 0; q4 < 2; ++q4) { const f32x16& T = S[kb]; u32x4 w; w.x = cvtpk(T[8 * q4], T[8 * q4 + 1]); w.y = cvtpk(T[8 * q4 + 2], T[8 * q4 + 3]); w.z = cvtpk(T[8 * q4 + 4], T[8 * q4 + 5]); w.w = cvtpk(T[8 * q4 + 6], T[8 * q4 + 7]);
                *(u32x4*)(ST + lane * 64 + kb * 16 + q4 * 8) = w; }
        if (vb == 0 && lane == 0) ((float*)(F.ws + WS_DLB))[seq * NCH + pc] = gtot;
    }
}

constexpr int NA_GQA = 2048, NA_NA = 2048, NA_CTX = 256;
template <int TYPE> __device__ __forceinline__ void attn_task(Frame& F, int l, int u, bf16_t* BR) {
    const bf16_t* MIX = (const bf16_t*)(F.ws + WS_RC);
    const int lane_ = tid_from_lds(F.lds, F.wave_s) & 63;
    const int lane = lane_, h = lane >> 5, c31 = lane & 31;
    LAS unsigned char* wl = F.lds + F.wave * WLDS; LAS unsigned char* TV = wl; LAS float* al = (LAS float*)(wl + 4608);
    int qrow0, qcol, kcol, vcol, ocol, b, ntiles, r = 0, c0 = 0, hh = 0;
    if (TYPE == 0) { b = u >> 9; const int hq = (u >> 7) & 3, tb = u & 127; qrow0 = b * SEQ + tb * 32; qcol = C_DQ + hq * 64; kcol = C_DK + (hq >> 1) * 64; vcol = C_DV + (hq >> 1) * 64; ocol = 768 + hq * 64; ntiles = 8 + 128; }
    else if (TYPE == 1) { b = u >> 9; hh = (u >> 7) & 3; r = (u >> 1) & 63; c0 = (u & 1) * 32; qrow0 = b * SEQ + r * 64 + c0; qcol = C_CQ + hh * 64; kcol = C_CK + hh * 64; vcol = C_CV + hh * 64; ocol = 512 + hh * 64; ntiles = 8 + 16; }
    else { b = u >> 6; const int h8 = (u >> 3) & 7, tb = u & 7; qrow0 = MLAT + b * CTXL + tb * 32; ntiles = 8;
        if (h8 < 4) { qcol = C_CQ + h8 * 64; kcol = C_CK + h8 * 64; vcol = C_CV + h8 * 64; ocol = 512 + h8 * 64; } else { const int hq = h8 - 4; qcol = C_DQ + hq * 64; kcol = C_DK + (hq >> 1) * 64; vcol = C_DV + (hq >> 1) * 64; ocol = 768 + hq * 64; } }
    const int rs = min(max(r - 4, 0), 56);
    const float* rpb = FIN(15) + (size_t)(l * 4 + hh) * 15 * 31;
    const int cq = c0 + c31, cs = min(max(cq - 8, 0), 48);
#define TILE_ROW(t) ((t) < 8 ? MLAT + b * CTXL + 32 * (t) : (TYPE == 1 ? b * SEQ + (rs + (((t) - 8) >> 1)) * 64 + 32 * (((t) - 8) & 1) : b * SEQ + 32 * ((t) - 8)))
    bf16x8 qf[4];
#pragma unroll
    for (int s = 0; s < 4; ++s) qf[s] = *(const bf16x8*)(MIX + (size_t)(qrow0 + c31) * NMIX + qcol + 16 * s + 8 * h);
    f32x16 O0, O1;
#pragma unroll
    for (int reg = 0; reg < 16; ++reg) { O0[reg] = 0.f; O1[reg] = 0.f; }
    float m_run = -1e30f, l_run = 0.f;
    bf16x8 kf[4]; u32x4 vr[4];
    { const int kr0 = TILE_ROW(0);
#pragma unroll
      for (int s = 0; s < 4; ++s) kf[s] = *(const bf16x8*)(MIX + (size_t)(kr0 + c31) * NMIX + kcol + 16 * s + 8 * h);
#pragma unroll
      for (int t4 = 0; t4 < 4; ++t4) { const int id = lane + 64 * t4; vr[t4] = *(const u32x4*)(MIX + (size_t)(kr0 + (id >> 3)) * NMIX + vcol + (id & 7) * 8); } }
#pragma unroll 1
    for (int t = 0; t < ntiles; ++t) {
#pragma unroll
        for (int t4 = 0; t4 < 4; ++t4) { const int id = lane + 64 * t4; *(LAS u32x4*)(TV + (id >> 3) * TP64 + (id & 7) * 16) = vr[t4]; }
        asm volatile("" ::: "memory");
        f32x16 S;
#pragma unroll
        for (int reg = 0; reg < 16; ++reg) S[reg] = 0.f;
#pragma unroll
        for (int s = 0; s < 4; ++s) S = MFMA32(kf[s], qf[s], S);
        if (t + 1 < ntiles) { const int kr1 = TILE_ROW(t + 1);
#pragma unroll
            for (int s = 0; s < 4; ++s) kf[s] = *(const bf16x8*)(MIX + (size_t)(kr1 + c31) * NMIX + kcol + 16 * s + 8 * h);
#pragma unroll
            for (int t4 = 0; t4 < 4; ++t4) { const int id = lane + 64 * t4; vr[t4] = *(const u32x4*)(MIX + (size_t)(kr1 + (id >> 3)) * NMIX + vcol + (id & 7) * 8); } }
        if (TYPE == 1 && t >= 8) {
            const int kr = rs + ((t - 8) >> 1), kc0 = 32 * ((t - 8) & 1); const float* rb = rpb + (kr - r + 7) * 31 + (15 - cq);
#pragma unroll
            for (int reg = 0; reg < 16; ++reg) { const int kc = kc0 + crow(reg, h); const bool ok = (kc >= cs) && (kc < cs + 16);
                const float bias = ok ? rb[kc] : 0.f; S[reg] = ok ? S[reg] * 0.125f + bias : -1e30f; }
        } else {
#pragma unroll
            for (int reg = 0; reg < 16; ++reg) S[reg] *= 0.125f;
        }
        float mloc = fmaxf(fmaxf(fmaxf(S[0], S[1]), fmaxf(S[2], S[3])), fmaxf(fmaxf(S[4], S[5]), fmaxf(S[6], S[7])));
        mloc = fmaxf(mloc, fmaxf(fmaxf(fmaxf(S[8], S[9]), fmaxf(S[10], S[11])), fmaxf(fmaxf(S[12], S[13]), fmaxf(S[14], S[15]))));
        mloc = fmaxf(mloc, bperm_(mloc, lane ^ 32));
        const float m_new = fmaxf(m_run, mloc);
        const float alpha = __expf(m_run - m_new);
        m_run = m_new;
        float ls = 0.f;
#pragma unroll
        for (int reg = 0; reg < 16; ++reg) { const float p = __expf(S[reg] - m_new); ls += p; S[reg] = p; }
        l_run = l_run * alpha + ls;
        if (lane < 32) al[c31] = alpha;
        LDS_WAIT();
        const bf16x8 pa0 = pack8<0>(S), pa1 = pack8<1>(S);
        {
#pragma unroll
            for (int g = 0; g < 4; ++g) { const f32x4 a4 = *(const LAS f32x4*)(al + 8 * g + 4 * h);
                O0[4 * g] *= a4.x; O0[4 * g + 1] *= a4.y; O0[4 * g + 2] *= a4.z; O0[4 * g + 3] *= a4.w;
                O1[4 * g] *= a4.x; O1[4 * g + 1] *= a4.y; O1[4 * g + 2] *= a4.z; O1[4 * g + 3] *= a4.w; }
        }
        O0 = MFMA32(pa0, ld_tr8(TV, TP64, 4 * h, 8 + 4 * h, 0, lane), O0);
        O0 = MFMA32(pa1, ld_tr8(TV, TP64, 16 + 4 * h, 24 + 4 * h, 0, lane), O0);
        O1 = MFMA32(pa0, ld_tr8(TV, TP64, 4 * h, 8 + 4 * h, 32, lane), O1);
        O1 = MFMA32(pa1, ld_tr8(TV, TP64, 16 + 4 * h, 24 + 4 * h, 32, lane), O1);
    }
#undef TILE_ROW
    l_run += bperm_(l_run, lane ^ 32);
    if (lane < 32) al[c31] = 1.f / l_run;
    LDS_WAIT();
#pragma unroll
    for (int g = 0; g < 4; ++g) { const f32x4 a4 = *(const LAS f32x4*)(al + 8 * g + 4 * h);
        O0[4 * g] *= a4.x; O0[4 * g + 1] *= a4.y; O0[4 * g + 2] *= a4.z; O0[4 * g + 3] *= a4.w;
        O1[4 * g] *= a4.x; O1[4 * g + 1] *= a4.y; O1[4 * g + 2] *= a4.z; O1[4 * g + 3] *= a4.w; }
#pragma unroll
    for (int reg = 0; reg < 16; ++reg) { bf16_t* op = BR + (size_t)(qrow0 + crow(reg, h)) * DM + ocol + c31; op[0] = (bf16_t)f2bf(O0[reg]); op[32] = (bf16_t)f2bf(O1[reg]); }
    LDS_WAIT();
}

constexpr int AB_TILE = 9216;
constexpr int AB_AL = 4 * AB_TILE;
template <int TYPE>
__device__ __forceinline__ void attn_block_task(Frame& F, int l, int u, bf16_t* BR) {
    const bf16_t* MIX = (const bf16_t*)(F.ws + WS_RC);
    const int lane_ = tid_from_lds(F.lds, F.wave_s) & 63;
    const int lane = lane_, h = lane >> 5, c31 = lane & 31, tid = F.wave * 64 + lane;
    int b, qrow0, qcol, kcol, vcol, ocol, ntile, r = 0, c0 = 0, hh = 0, r0 = 0;
    if (TYPE == 0) { b = u >> 6; const int hq = (u >> 4) & 3, qblk = u & 15; qrow0 = b * SEQ + qblk * 256 + F.wave * 32; qcol = C_DQ + hq * 64; kcol = C_DK + (hq >> 1) * 64; vcol = C_DV + (hq >> 1) * 64; ocol = 768 + hq * 64; ntile = 4 + 64; }
    else { b = u >> 6; hh = (u >> 4) & 3; r0 = (u & 15) * 4; r = r0 + (F.wave >> 1); c0 = (F.wave & 1) * 32; qrow0 = b * SEQ + r * 64 + c0; qcol = C_CQ + hh * 64; kcol = C_CK + hh * 64; vcol = C_CV + hh * 64; ocol = 512 + hh * 64;
           ntile = 4 + (min(max(r0 + 3 - 4, 0), 56) - min(max(r0 - 4, 0), 56) + 8); }
    const int rs_blk = min(max(r0 - 4, 0), 56), rs = min(max(r - 4, 0), 56);
    const float* rpb = FIN(15) + (size_t)(l * 4 + hh) * 15 * 31;
    const int cq = c0 + c31, cs = min(max(cq - 8, 0), 48);
    LAS unsigned char* lds = F.lds; LAS float* al = (LAS float*)(lds + AB_AL + F.wave * 128);
    LAS float* rpbL = (LAS float*)(lds + AB_AL + 1024);
    if (TYPE == 1) { if (tid < 465) rpbL[tid] = rpb[tid]; }
    const int prow = tid >> 3, pck = tid & 7;
    const unsigned pdst = prow * TP64 + pck * 16;
    const int NTILE = ntile;
#define AB_TROW(t) ((t) < 4 ? MLAT + b * CTXL + 64 * (t) : (TYPE == 0 ? b * SEQ + 64 * ((t) - 4) : b * SEQ + 64 * (rs_blk + (t) - 4)))
    bf16x8 qf[4];
#pragma unroll
    for (int s = 0; s < 4; ++s) qf[s] = *(const bf16x8*)(MIX + (size_t)(qrow0 + c31) * NMIX + qcol + 16 * s + 8 * h);
    f32x16 O0, O1;
#pragma unroll
    for (int reg = 0; reg < 16; ++reg) { O0[reg] = 0.f; O1[reg] = 0.f; }
    float m_run = -1e30f, l_run = 0.f;
    constexpr float SC2 = 0.125f * 1.4426950408889634f;
    constexpr float L2E = 1.4426950408889634f;
    u32x4 kr0, vr0, kr1, vr1, kr2, vr2;
#define AB_LOAD(T, KR, VR) do { const size_t ro_ = (size_t)(AB_TROW(T) + prow) * NMIX + pck * 8; KR = *(const u32x4*)(MIX + ro_ + kcol); VR = *(const u32x4*)(MIX + ro_ + vcol); } while (0)
    AB_LOAD(0, kr0, vr0);
    *(LAS u32x4*)(lds + pdst) = kr0; *(LAS u32x4*)(lds + AB_TILE + pdst) = vr0;
    AB_LOAD(1, kr0, vr0); AB_LOAD(2, kr1, vr1); AB_LOAD(3, kr2, vr2);
    __syncthreads();
#define AB_BODY(T, KR, VR) do { \
        LAS unsigned char* KB = lds + ((T) & 1) * 2 * AB_TILE; LAS unsigned char* VB = KB + AB_TILE; \
        const int kr_ = rs_blk + (T) - 4;                                  \
        if (TYPE == 0 || (T) < 4 || (kr_ >= rs && kr_ < rs + 8)) {         \
        f32x16 S0, S1; \
        _Pragma("unroll") for (int reg = 0; reg < 16; ++reg) { S0[reg] = 0.f; S1[reg] = 0.f; } \
        _Pragma("unroll") for (int s = 0; s < 4; ++s) { S0 = MFMA32(ld_row8(KB, TP64, c31, 16 * s + 8 * h), qf[s], S0); S1 = MFMA32(ld_row8(KB, TP64, 32 + c31, 16 * s + 8 * h), qf[s], S1); } \
        if (TYPE == 1 && (T) >= 4) {                                       \
            const LAS float* rbl = rpbL + (kr_ - r + 7) * 31; \
            _Pragma("unroll") for (int reg = 0; reg < 16; ++reg) { const int kc = crow(reg, h); \
                const bool ok0 = (kc >= cs) && (kc < cs + 16), ok1 = (kc + 32 >= cs) && (kc + 32 < cs + 16); \
                const float b0 = rbl[min(max(kc - cq + 15, 0), 30)], b1 = rbl[min(max(kc + 32 - cq + 15, 0), 30)];     \
                S0[reg] = ok0 ? fmaf(S0[reg], SC2, b0 * L2E) : -1e30f; S1[reg] = ok1 ? fmaf(S1[reg], SC2, b1 * L2E) : -1e30f; } \
        } \
        const bool pre = (TYPE == 1 && (T) >= 4);                  \
        float mloc = fmaxf(fmaxf(fmaxf(S0[0], S0[1]), fmaxf(S0[2], S0[3])), fmaxf(fmaxf(S0[4], S0[5]), fmaxf(S0[6], S0[7]))); \
        mloc = fmaxf(mloc, fmaxf(fmaxf(fmaxf(S0[8], S0[9]), fmaxf(S0[10], S0[11])), fmaxf(fmaxf(S0[12], S0[13]), fmaxf(S0[14], S0[15])))); \
        mloc = fmaxf(mloc, fmaxf(fmaxf(fmaxf(S1[0], S1[1]), fmaxf(S1[2], S1[3])), fmaxf(fmaxf(S1[4], S1[5]), fmaxf(S1[6], S1[7])))); \
        mloc = fmaxf(mloc, fmaxf(fmaxf(fmaxf(S1[8], S1[9]), fmaxf(S1[10], S1[11])), fmaxf(fmaxf(S1[12], S1[13]), fmaxf(S1[14], S1[15])))); \
        if (!pre) mloc *= SC2; \
        { const auto rr_ = __builtin_amdgcn_permlane32_swap(__float_as_uint(mloc), __float_as_uint(mloc), false, false); mloc = fmaxf(__uint_as_float(rr_[0]), __uint_as_float(rr_[1])); } \
        if (__any(mloc > m_run + 8.f)) {                         \
            const float m_new = fmaxf(m_run, mloc); \
            const float alpha = __builtin_amdgcn_exp2f(m_run - m_new); \
            m_run = m_new; l_run *= alpha; \
            if (lane < 32) al[c31] = alpha; \
            LDS_WAIT(); \
            _Pragma("unroll") for (int g = 0; g < 4; ++g) { const f32x4 a4 = *(const LAS f32x4*)(al + 8 * g + 4 * h); \
                O0[4 * g] *= a4.x; O0[4 * g + 1] *= a4.y; O0[4 * g + 2] *= a4.z; O0[4 * g + 3] *= a4.w; \
                O1[4 * g] *= a4.x; O1[4 * g + 1] *= a4.y; O1[4 * g + 2] *= a4.z; O1[4 * g + 3] *= a4.w; } \
            LDS_WAIT(); \
        } \
        float ls = 0.f; \
        if (pre) { _Pragma("unroll") for (int reg = 0; reg < 16; ++reg) { const float p0 = __builtin_amdgcn_exp2f(S0[reg] - m_run), p1 = __builtin_amdgcn_exp2f(S1[reg] - m_run); ls += p0 + p1; S0[reg] = p0; S1[reg] = p1; } } \
        else     { _Pragma("unroll") for (int reg = 0; reg < 16; ++reg) { const float p0 = __builtin_amdgcn_exp2f(fmaf(S0[reg], SC2, -m_run)), p1 = __builtin_amdgcn_exp2f(fmaf(S1[reg], SC2, -m_run)); ls += p0 + p1; S0[reg] = p0; S1[reg] = p1; } } \
        l_run += ls; \
        const bf16x8 pa0 = pack8<0>(S0), pa1 = pack8<1>(S0), pa2 = pack8<0>(S1), pa3 = pack8<1>(S1); \
        O0 = MFMA32(pa0, ld_tr8(VB, TP64, 4 * h, 8 + 4 * h, 0, lane), O0); \
        O1 = MFMA32(pa0, ld_tr8(VB, TP64, 4 * h, 8 + 4 * h, 32, lane), O1); \
        O0 = MFMA32(pa1, ld_tr8(VB, TP64, 16 + 4 * h, 24 + 4 * h, 0, lane), O0); \
        O1 = MFMA32(pa1, ld_tr8(VB, TP64, 16 + 4 * h, 24 + 4 * h, 32, lane), O1); \
        O0 = MFMA32(pa2, ld_tr8(VB, TP64, 32 + 4 * h, 40 + 4 * h, 0, lane), O0); \
        O1 = MFMA32(pa2, ld_tr8(VB, TP64, 32 + 4 * h, 40 + 4 * h, 32, lane), O1); \
        O0 = MFMA32(pa3, ld_tr8(VB, TP64, 48 + 4 * h, 56 + 4 * h, 0, lane), O0); \
        O1 = MFMA32(pa3, ld_tr8(VB, TP64, 48 + 4 * h, 56 + 4 * h, 32, lane), O1); \
        } \
        if ((T) + 1 < NTILE) { LAS unsigned char* KN = lds + (((T) + 1) & 1) * 2 * AB_TILE; *(LAS u32x4*)(KN + pdst) = KR; *(LAS u32x4*)(KN + AB_TILE + pdst) = VR; } \
        if ((T) + 4 < NTILE) AB_LOAD((T) + 4, KR, VR); \
        __syncthreads(); \
    } while (0)
#pragma unroll 1
    for (int t = 0; t < NTILE; t += 3) {
        AB_BODY(t, kr0, vr0);
        if (t + 1 < NTILE) AB_BODY(t + 1, kr1, vr1);
        if (t + 2 < NTILE) AB_BODY(t + 2, kr2, vr2);
    }
#undef AB_BODY
#undef AB_LOAD
#undef AB_TROW
    l_run += bperm_(l_run, lane ^ 32);
    if (lane < 32) al[c31] = 1.f / l_run;
    LDS_WAIT();
#pragma unroll
    for (int g = 0; g < 4; ++g) { const f32x4 a4 = *(const LAS f32x4*)(al + 8 * g + 4 * h);
        O0[4 * g] *= a4.x; O0[4 * g + 1] *= a4.y; O0[4 * g + 2] *= a4.z; O0[4 * g + 3] *= a4.w;
        O1[4 * g] *= a4.x; O1[4 * g + 1] *= a4.y; O1[4 * g + 2] *= a4.z; O1[4 * g + 3] *= a4.w; }
#pragma unroll
    for (int reg = 0; reg < 16; ++reg) { bf16_t* op = BR + (size_t)(qrow0 + crow(reg, h)) * DM + ocol + c31; op[0] = (bf16_t)f2bf(O0[reg]); op[32] = (bf16_t)f2bf(O1[reg]); }
    __syncthreads();
}


namespace gx {
constexpr int NSLOT = 3, SLOTB = 8192, KVBLK = 64;
constexpr int LDS_K = 0, LDS_V = NSLOT * SLOTB, LDS_WS = 2 * NSLOT * SLOTB, LDS_OST = LDS_WS + 8 * 64 * 4, LDS_BYTES_GX = LDS_OST + 8 * 4096;
typedef LAS const char* lds_cptr;
typedef short v4i16_t __attribute__((ext_vector_type(4)));
#define GX_SBAR() __builtin_amdgcn_sched_barrier(0)
__device__ __forceinline__ void glds16(const void* gsrc, unsigned lds_dst) { unsigned keep;
    asm volatile("s_mov_b32 %0, m0\n\ts_mov_b32 m0, %2\n\ts_nop 0\n\tglobal_load_lds_dwordx4 %1, off\n\ts_mov_b32 m0, %0" : "=&s"(keep) : "v"(gsrc), "s"(lds_dst) : "memory"); }
__device__ __forceinline__ float max3f(float a, float b, float c) { float r; asm("v_max3_f32 %0, %1, %2, %3" : "=v"(r) : "v"(a), "v"(b), "v"(c)); return r; }
__device__ __forceinline__ float max2f(float a, float b) { float r; asm("v_max_f32_e32 %0, %1, %2" : "=v"(r) : "v"(a), "v"(b)); return r; }
__device__ __forceinline__ float fadd_s(float a, float b) { float r; asm("v_add_f32_e32 %0, %1, %2" : "=v"(r) : "v"(a), "v"(b)); return r; }
__device__ __forceinline__ float fsub_s(float a, float b) { float r; asm("v_sub_f32_e32 %0, %1, %2" : "=v"(r) : "v"(a), "v"(b)); return r; }
__device__ __forceinline__ unsigned cvtpk_s(float lo, float hi) { f32x2_t v = {lo, hi}; bf16x2_t b = __builtin_convertvector(v, bf16x2_t); return __builtin_bit_cast(unsigned, b); }
#define GX_WAIT_BAR(N) asm volatile("s_waitcnt vmcnt(" #N ") lgkmcnt(0)\n\ts_barrier" ::: "memory")
__device__ __forceinline__ void qkt(f32x16& p0, f32x16& p1, lds_cptr Kslot, const bf16x8* qr, const f32x16& negm, int r32, int hi) {
    lds_cptr kb = Kslot + hi * 1024 + r32 * 16;
#pragma unroll
    for (int d0 = 0; d0 < 4; ++d0) {
        const bf16x8 b0 = *(const LAS bf16x8*)(kb + d0 * 2048);
        const bf16x8 b1 = *(const LAS bf16x8*)(kb + d0 * 2048 + 512);
        if (d0 == 0) { p0 = __builtin_amdgcn_mfma_f32_32x32x16_bf16(b0, qr[0], negm, 0, 0, 0); p1 = __builtin_amdgcn_mfma_f32_32x32x16_bf16(b1, qr[0], negm, 0, 0, 0); }
        else { p0 = __builtin_amdgcn_mfma_f32_32x32x16_bf16(b0, qr[d0], p0, 0, 0, 0); p1 = __builtin_amdgcn_mfma_f32_32x32x16_bf16(b1, qr[d0], p1, 0, 0, 0); } }
}
__device__ __forceinline__ void kload8(bf16x8* kf, lds_cptr kp) {
    kf[0] = *(const LAS bf16x8*)(kp);        kf[1] = *(const LAS bf16x8*)(kp + 512);
    kf[2] = *(const LAS bf16x8*)(kp + 2048); kf[3] = *(const LAS bf16x8*)(kp + 2560);
    kf[4] = *(const LAS bf16x8*)(kp + 4096); kf[5] = *(const LAS bf16x8*)(kp + 4608);
    kf[6] = *(const LAS bf16x8*)(kp + 6144); kf[7] = *(const LAS bf16x8*)(kp + 6656);
}
__device__ __forceinline__ void kload2(bf16x8* kf, lds_cptr kp, int j) { kf[2 * j] = *(const LAS bf16x8*)(kp + j * 2048); kf[2 * j + 1] = *(const LAS bf16x8*)(kp + j * 2048 + 512); }
__device__ __forceinline__ s16x4 vtr(lds_cptr p) { return __builtin_bit_cast(s16x4, __builtin_amdgcn_ds_read_tr16_b64_v4i16((LAS v4i16_t*)p)); }
__device__ __forceinline__ float rowmax(const f32x16& p0, const f32x16& p1) {
    float a = max3f(p0[0], p0[1], p1[0]), b = max3f(p0[2], p0[3], p1[1]); a = max3f(a, p1[2], p1[3]);
#pragma unroll
    for (int r = 4; r < 16; r += 4) { a = max3f(a, p0[r], p0[r + 1]); b = max3f(b, p0[r + 2], p0[r + 3]); a = max3f(a, p1[r], p1[r + 1]); b = max3f(b, p1[r + 2], p1[r + 3]); }
    const float m = max2f(a, b);
    auto rr = __builtin_amdgcn_permlane32_swap(__float_as_uint(m), __float_as_uint(m), false, false);
    return max2f(__uint_as_float(rr[0]), __uint_as_float(rr[1]));
}
__device__ __forceinline__ void pv(f32x16* o, int vb, bf16x8 pa0, bf16x8 pa1, bf16x8 pa2, bf16x8 pa3) {
#pragma unroll
    for (int d0 = 0; d0 < 2; ++d0) { s16x4 lo[4], hi[4];
#pragma unroll
        for (int ks = 0; ks < 4; ++ks) {
            asm volatile("ds_read_b64_tr_b16 %0,%1 offset:%c2" : "=&v"(lo[ks]) : "v"(vb), "i"(d0 * 4096 + ks * 1024) : "memory");
            asm volatile("ds_read_b64_tr_b16 %0,%1 offset:%c2" : "=&v"(hi[ks]) : "v"(vb), "i"(d0 * 4096 + ks * 1024 + 512) : "memory"); }
        asm volatile("s_waitcnt lgkmcnt(0)" ::: "memory"); GX_SBAR();
#define GX_PK(k) (bf16x8){lo[k][0], lo[k][1], lo[k][2], lo[k][3], hi[k][0], hi[k][1], hi[k][2], hi[k][3]}
        o[d0] = __builtin_amdgcn_mfma_f32_32x32x16_bf16(pa0, GX_PK(0), o[d0], 0, 0, 0);
        o[d0] = __builtin_amdgcn_mfma_f32_32x32x16_bf16(pa1, GX_PK(1), o[d0], 0, 0, 0);
        o[d0] = __builtin_amdgcn_mfma_f32_32x32x16_bf16(pa2, GX_PK(2), o[d0], 0, 0, 0);
        o[d0] = __builtin_amdgcn_mfma_f32_32x32x16_bf16(pa3, GX_PK(3), o[d0], 0, 0, 0);
#undef GX_PK
    }
}
template <int THRL> __device__ __forceinline__ void gqa_unit(Frame& F, int u, bf16_t* BR) {
    const bf16_t* MIX = (const bf16_t*)(F.ws + WS_RC);
    const int lane_ = tid_from_lds(F.lds, F.wave_s) & 63;
    const int lane = lane_, r32 = lane & 31, hi = lane >> 5, wid = F.wave;
    const int ux = u & 7, uj = u >> 3;
    const int b = ux >> 1, hq = 2 * (ux & 1) + (uj >> 4), qblk = uj & 15;
    const int qrow0 = b * SEQ + qblk * 256 + wid * 32, qcol = C_DQ + hq * 64, kcol = C_DK + (hq >> 1) * 64, vcol = C_DV + (hq >> 1) * 64, ocol = 768 + hq * 64;
    constexpr int NT = 64 + 4;
#define GX_TROW(t) ((t) < 64 ? b * SEQ + 64 * (t) : MLAT + b * CTXL + 64 * ((t) - 64))
    const bf16_t* Qw = MIX + (size_t)qrow0 * NMIX + qcol;
    LAS unsigned char* shm = F.lds;
    const unsigned lds0 = 0u;
    LAS float* wsf = (LAS float*)(shm + LDS_WS) + wid * 64;
    const bf16_t* ksrc = MIX + (size_t)lane * NMIX + kcol + wid * 8;
    const bf16_t* vsrc = MIX + (size_t)(16 * (wid & 3) + (lane >> 2)) * NMIX + vcol + (wid >> 2) * 32 + (lane & 3) * 8;
    const unsigned kdst = lds0 + LDS_K + wid * 1024, vdst = lds0 + LDS_V + wid * 1024;
#define GX_DMA_K(t, slot) glds16(ksrc + (size_t)GX_TROW(t) * NMIX, (unsigned)__builtin_amdgcn_readfirstlane(kdst + (slot)))
#define GX_DMA_V(t, slot) glds16(vsrc + (size_t)GX_TROW(t) * NMIX, (unsigned)__builtin_amdgcn_readfirstlane(vdst + (slot)))
    const int vb0 = (int)(lds0 + LDS_V) + ((lane >> 4) & 1) * 32 + (lane & 3) * 8 + (4 * hi + ((lane & 15) >> 2)) * 64;
    bf16x8 kf[8];
    const lds_cptr shm3 = (lds_cptr)shm; const lds_cptr kp0 = shm3 + LDS_K + hi * 1024 + r32 * 16; const lds_cptr vp0 = shm3 + LDS_V + ((lane >> 4) & 1) * 32 + (lane & 3) * 8 + (4 * hi + ((lane & 15) >> 2)) * 64;
    GX_DMA_K(0, 0); GX_DMA_V(0, 0); GX_DMA_K(1, SLOTB);
    bf16x8 qr[4];
#pragma unroll
    for (int d0 = 0; d0 < 4; ++d0) qr[d0] = *(const bf16x8*)(Qw + (size_t)r32 * NMIX + d0 * 16 + hi * 8);
    float mhat = 0.f, l_reg = 0.f; f32x16 o[2]; o[0] = f32x16{}; o[1] = f32x16{}; f32x16 negm = f32x16{}; asm volatile("" : "+v"(negm));
    bool resc = false;
#define GX_START(P0, P1) do { const float rm = rowmax(P0, P1); resc = false; \
    { const float dl = rm; mhat = fadd_s(mhat, dl); \
      _Pragma("unroll") for (int r = 0; r < 16; ++r) { P0[r] = fsub_s(P0[r], dl); P1[r] = fsub_s(P1[r], dl); } \
      _Pragma("unroll") for (int r = 0; r < 16; ++r) negm[r] = -mhat; asm volatile("" : "+v"(negm)); } \
    _Pragma("unroll") for (int r = 0; r < 16; ++r) P0[r] = __builtin_amdgcn_exp2f(P0[r]); } while (0)
#define GX_RESC() do { if (resc) { asm volatile("s_waitcnt lgkmcnt(0)" ::: "memory"); \
      _Pragma("unroll") for (int d_ = 0; d_ < 2; ++d_) _Pragma("unroll") for (int r = 0; r < 16; ++r) o[d_][r] *= wsf[crow(r, hi)]; } } while (0)
    f32x16 pA0, pA1, pB0, pB1;
    int sl_prev = 0, sl_cur = 0, sl_next = SLOTB;
#define GX_ROT() do { sl_prev = sl_cur; sl_cur = sl_next; sl_next = (sl_next == (NSLOT - 1) * SLOTB) ? 0 : sl_next + SLOTB; } while (0)
    GX_DMA_K(2, 2 * SLOTB);
    GX_WAIT_BAR(3);
    qkt(pA0, pA1, shm3 + LDS_K, qr, negm, r32, hi); asm volatile("s_nop 15\n\ts_nop 7" : "+v"(pA0), "+v"(pA1));
    GX_START(pA0, pA1);
    _Pragma("unroll") for (int r = 0; r < 16; ++r) pA1[r] = __builtin_amdgcn_exp2f(pA1[r]);
    GX_WAIT_BAR(0);
    GX_DMA_K(3, 0); GX_DMA_V(1, SLOTB);
    GX_ROT();
    kload8(kf, kp0 + sl_cur);
    GX_WAIT_BAR(2);
    s16x4 vlo[8], vhi[8]; u32x4 pw0, pw1, pw2, pw3;
#define GX_PKW(P, B) cvtpk_s(P[B], P[B + 1])
#define GX_PAF(k) __builtin_bit_cast(bf16x8, pw##k)
#define GX_VFR(i) (bf16x8){vlo[i][0], vlo[i][1], vlo[i][2], vlo[i][3], vhi[i][0], vhi[i][1], vhi[i][2], vhi[i][3]}
#define GX_PIN(x) asm volatile("" : "+v"(x))
#define GX_MX3(a, b, c) __builtin_fmaxf(__builtin_fmaxf((a), (b)), (c))
#define GX_GAPA(MF, A0, A1, A2, A3, W0, W1, PW) do { MF; sacc += A0; sacc += A1; sacc += A2; sacc += A3; GX_PIN(sacc); W0; W1; GX_PIN(PW); GX_SBAR(); } while (0)
#define GX_EX(v) __builtin_amdgcn_exp2f(v)
#define GX_GAPB(MF, X, B) do { MF; X[B] = GX_EX(X[B]); X[B + 1] = GX_EX(X[B + 1]); X[B + 2] = GX_EX(X[B + 2]); X[B + 3] = GX_EX(X[B + 3]); GX_PIN(X); GX_SBAR(); } while (0)
#define GX_VRD(i) do { vlo[i] = vtr(vp_ + (((i) >> 2) * 4096 + ((i) & 3) * 1024)); vhi[i] = vtr(vp_ + (((i) >> 2) * 4096 + ((i) & 3) * 1024 + 512)); } while (0)
#define GX_KRD(G, j) do { if (G) { kload2(kf, kp0 + sl_next, j); GX_SBAR(); } } while (0)
#define GX_MFMA __builtin_amdgcn_mfma_f32_32x32x16_bf16
#define GX_STEP(C0, C1, P0, P1, t, GK, GV, GL) do { GX_SBAR(); \
    const lds_cptr vp_ = vp0 + sl_prev; \
    GX_VRD(0); GX_SBAR(); float sacc = (P0[0] + P0[1]); \
    GX_GAPA(C0 = GX_MFMA(kf[0], qr[0], negm, 0, 0, 0), P0[2], P0[3], P0[4], P0[5],     pw0[0] = GX_PKW(P0, 0), pw0[1] = GX_PKW(P0, 2), pw0); \
    GX_VRD(4); GX_SBAR(); GX_GAPA(C1 = GX_MFMA(kf[1], qr[0], negm, 0, 0, 0), P0[6], P0[7], P0[8], P0[9],     pw0[2] = GX_PKW(P0, 4), pw0[3] = GX_PKW(P0, 6), pw0); \
    GX_VRD(1); GX_SBAR(); GX_GAPA(C0 = GX_MFMA(kf[2], qr[1], C0, 0, 0, 0),   P0[10], P0[11], P0[12], P0[13], pw1[0] = GX_PKW(P0, 8), pw1[1] = GX_PKW(P0, 10), pw1); \
    GX_VRD(5); GX_SBAR(); GX_GAPA(C1 = GX_MFMA(kf[3], qr[1], C1, 0, 0, 0),   P0[14], P0[15], P1[0], P1[1],   pw1[2] = GX_PKW(P0, 12), pw1[3] = GX_PKW(P0, 14), pw1); \
    GX_VRD(2); GX_SBAR(); GX_GAPA(C0 = GX_MFMA(kf[4], qr[2], C0, 0, 0, 0),   P1[2], P1[3], P1[4], P1[5],     pw2[0] = GX_PKW(P1, 0), pw2[1] = GX_PKW(P1, 2), pw2); \
    GX_VRD(6); GX_SBAR(); GX_GAPA(C1 = GX_MFMA(kf[5], qr[2], C1, 0, 0, 0),   P1[6], P1[7], P1[8], P1[9],     pw2[2] = GX_PKW(P1, 4), pw2[3] = GX_PKW(P1, 6), pw2); \
    GX_VRD(3); GX_SBAR(); GX_GAPA(C0 = GX_MFMA(kf[6], qr[3], C0, 0, 0, 0),   P1[10], P1[11], P1[12], P1[13], pw3[0] = GX_PKW(P1, 8), pw3[1] = GX_PKW(P1, 10), pw3); \
    GX_VRD(7); GX_SBAR(); GX_GAPA(C1 = GX_MFMA(kf[7], qr[3], C1, 0, 0, 0),   P1[14], P1[15], 0.f, 0.f,       pw3[2] = GX_PKW(P1, 12), pw3[3] = GX_PKW(P1, 14), pw3); \
    l_reg += sacc; \
    if (GK) { GX_DMA_K((t) + 3, sl_cur); } if (GV) { GX_DMA_V((t) + 1, sl_next); } \
    { float a = GX_MX3(C0[0], C0[1], C1[0]), b_ = GX_MX3(C0[2], C0[3], C1[1]); a = GX_MX3(a, C1[2], C1[3]); \
      _Pragma("unroll") for (int r = 4; r < 16; r += 4) { a = GX_MX3(a, C0[r], C0[r + 1]); b_ = GX_MX3(b_, C0[r + 2], C0[r + 3]); a = GX_MX3(a, C1[r], C1[r + 1]); b_ = GX_MX3(b_, C1[r + 2], C1[r + 3]); } \
      float rm = __builtin_fmaxf(a, b_); { auto rr = __builtin_amdgcn_permlane32_swap(__float_as_uint(rm), __float_as_uint(rm), false, false); rm = __builtin_fmaxf(__uint_as_float(rr[0]), __uint_as_float(rr[1])); } \
      resc = false; \
      if (__builtin_expect(__any(rm > (float)THRL), 0)) { const float dl = __builtin_fmaxf(rm, 0.f); mhat += dl; \
        _Pragma("unroll") for (int r = 0; r < 16; ++r) { C0[r] -= dl; C1[r] -= dl; } \
        _Pragma("unroll") for (int r = 0; r < 16; ++r) negm[r] = -mhat; asm volatile("" : "+v"(negm)); \
        const float f = __builtin_amdgcn_exp2f(-dl); l_reg *= f; if (hi == 0) wsf[r32] = f; resc = true; } } \
    GX_SBAR(); \
    GX_GAPB(o[0] = GX_MFMA(GX_PAF(0), GX_VFR(0), o[0], 0, 0, 0), C0, 0); \
    GX_GAPB(o[1] = GX_MFMA(GX_PAF(0), GX_VFR(4), o[1], 0, 0, 0), C0, 4); \
    GX_KRD(GL, 0); GX_GAPB(o[0] = GX_MFMA(GX_PAF(1), GX_VFR(1), o[0], 0, 0, 0), C0, 8); \
    GX_KRD(GL, 1); GX_GAPB(o[1] = GX_MFMA(GX_PAF(1), GX_VFR(5), o[1], 0, 0, 0), C0, 12); \
    GX_KRD(GL, 2); GX_GAPB(o[0] = GX_MFMA(GX_PAF(2), GX_VFR(2), o[0], 0, 0, 0), C1, 0); \
    GX_KRD(GL, 3); GX_GAPB(o[1] = GX_MFMA(GX_PAF(2), GX_VFR(6), o[1], 0, 0, 0), C1, 4); \
    GX_GAPB(o[0] = GX_MFMA(GX_PAF(3), GX_VFR(3), o[0], 0, 0, 0), C1, 8); \
    GX_GAPB(o[1] = GX_MFMA(GX_PAF(3), GX_VFR(7), o[1], 0, 0, 0), C1, 12); \
    } while (0)
    int t = 1;
#pragma unroll 1
    for (; t + 5 < NT; t += 2) {
        GX_STEP(pB0, pB1, pA0, pA1, t, true, true, true);     GX_WAIT_BAR(2); GX_RESC(); GX_ROT();
        GX_STEP(pA0, pA1, pB0, pB1, t + 1, true, true, true); GX_WAIT_BAR(2); GX_RESC(); GX_ROT();
    }
#define GX_ENDW(tt) do { if ((tt) + 3 < NT) { GX_WAIT_BAR(2); } else if ((tt) + 2 < NT) { GX_WAIT_BAR(1); } else { GX_WAIT_BAR(0); } } while (0)
#pragma unroll 1
    for (; t + 1 < NT; t += 2) {
        GX_STEP(pB0, pB1, pA0, pA1, t, (t + 3 < NT), (t + 1 < NT), (t + 1 < NT));         GX_ENDW(t);     GX_RESC(); GX_ROT();
        GX_STEP(pA0, pA1, pB0, pB1, t + 1, (t + 4 < NT), (t + 2 < NT), (t + 2 < NT));     GX_ENDW(t + 1); GX_RESC(); GX_ROT();
    }
    GX_STEP(pB0, pB1, pA0, pA1, NT - 1, false, false, false); GX_RESC();
    { float sacc = pB0[0] + pB0[1]; _Pragma("unroll") for (int r = 2; r < 16; ++r) sacc += pB0[r]; _Pragma("unroll") for (int r = 0; r < 16; ++r) sacc += pB1[r]; l_reg += sacc;
      pw0 = (u32x4){GX_PKW(pB0, 0), GX_PKW(pB0, 2), GX_PKW(pB0, 4), GX_PKW(pB0, 6)}; pw1 = (u32x4){GX_PKW(pB0, 8), GX_PKW(pB0, 10), GX_PKW(pB0, 12), GX_PKW(pB0, 14)};
      pw2 = (u32x4){GX_PKW(pB1, 0), GX_PKW(pB1, 2), GX_PKW(pB1, 4), GX_PKW(pB1, 6)}; pw3 = (u32x4){GX_PKW(pB1, 8), GX_PKW(pB1, 10), GX_PKW(pB1, 12), GX_PKW(pB1, 14)};
      GX_SBAR(); pv(o, vb0 + sl_cur, GX_PAF(0), GX_PAF(1), GX_PAF(2), GX_PAF(3)); }
    { auto rr = __builtin_amdgcn_permlane32_swap(__float_as_uint(l_reg), __float_as_uint(l_reg), false, false); l_reg = __uint_as_float(rr[0]) + __uint_as_float(rr[1]); }
    if (hi == 0) wsf[32 + r32] = l_reg; asm volatile("s_waitcnt lgkmcnt(0)" ::: "memory");
    float rli[16];
#pragma unroll
    for (int r = 0; r < 16; ++r) rli[r] = __builtin_amdgcn_rcpf(wsf[32 + crow(r, hi)]);
    bf16_t* Ow = BR + (size_t)qrow0 * DM + ocol;
    { LAS bf16_t* stg = (LAS bf16_t*)(shm + LDS_OST) + wid * 2048;
#pragma unroll
      for (int r = 0; r < 16; ++r) { const int orow = crow(r, hi);
#pragma unroll
        for (int d0 = 0; d0 < 2; ++d0) stg[orow * 64 + d0 * 32 + r32] = (bf16_t)f2bf(o[d0][r] * rli[r]); }
      asm volatile("s_waitcnt lgkmcnt(0)" ::: "memory");
#pragma unroll
      for (int i = 0; i < 4; ++i) { const int row = i * 8 + (lane >> 3), ch = lane & 7; const u32x4 v = *(const LAS u32x4*)(stg + row * 64 + ch * 8); pg8::st16_wt(Ow + (size_t)row * DM + ch * 8, v); } }
    asm volatile("s_waitcnt lgkmcnt(0)\n\ts_barrier" ::: "memory");
#undef GX_TROW
#undef GX_DMA_K
#undef GX_DMA_V
#undef GX_START
#undef GX_RESC
#undef GX_ROT
#undef GX_PKW
#undef GX_PAF
#undef GX_VFR
#undef GX_PIN
#undef GX_MX3
#undef GX_GAPA
#undef GX_EX
#undef GX_GAPB
#undef GX_VRD
#undef GX_KRD
#undef GX_MFMA
#undef GX_STEP
#undef GX_ENDW
}
}

constexpr int NT_HGRN = 32 * NCH, NT_SSD = 64 * NCH, NT_SCAN = NT_HGRN + NT_SSD;
template <bool PASS_C> __device__ __forceinline__ void scan_tasks(Frame& F, int l, bf16_t* BR) {
    bf16_t* OBA = (bf16_t*)(F.ws + WS_OBA); bf16_t* OBB = (bf16_t*)(F.ws + WS_OBB);
    const int slot = F.wave * F.G + F.bid, nslots = NWAVES * F.G;
#pragma unroll 1
    for (int t = slot; t < NT_SCAN; t += nslots) {
        if (t < NT_HGRN) { const int seq = t / NCH, pc = t % NCH; if (PASS_C && l == 1 && pc == 0) continue;
            hgrn_task<PASS_C>(F, l, seq, pc, seq < 16 ? BR : OBA, seq < 16 ? DM : 256);
        } else { const int t2 = t - NT_HGRN, seq2 = t2 / NCH, pc = t2 % NCH; if (PASS_C && l == 1 && pc == 0) continue;
            ssd_task<PASS_C>(F, l, seq2, pc, seq2 < 32 ? BR + 256 : OBB, seq2 < 32 ? DM : 256);
        }
    }
}
__device__ __forceinline__ void scan_carry(Frame& F) {
    refresh(F);
    bf16_t* STA = (bf16_t*)(F.ws + WS_STA); bf16_t* STB = (bf16_t*)(F.ws + WS_STB);
    const float* DLA = (const float*)(F.ws + WS_DLA); const float* DLB = (const float*)(F.ws + WS_DLB);
    const int gt = F.bid * NTHREADS + F.tid, NGT = F.G * NTHREADS;
    for (int e = gt; e < (32 * 4096 + 64 * 4096) / 2; e += NGT) {
        unsigned kvw[NCH]; float d0[NCH], d1[NCH];
        const bool isA = e < 32 * 2048;
        bf16_t* base;
        if (isA) { const int seq = e >> 11, idx = (e & 2047) * 2; base = STA + (size_t)seq * NCH * 4096 + idx;
            const int k = 32 * (((idx >> 4) & 3) >> 1) + crow(idx & 15, idx >> 11);
#pragma unroll
            for (int pc = 0; pc < NCH; ++pc) { kvw[pc] = *(const unsigned*)(base + (size_t)pc * 4096); const float* dl = DLA + ((size_t)seq * NCH + pc) * 64 + k; d0[pc] = dl[0]; d1[pc] = dl[1]; }
        } else { const int e2 = e - 32 * 2048, seq2 = e2 >> 11, idx = (e2 & 2047) * 2; base = STB + (size_t)seq2 * NCH * 4096 + idx;
#pragma unroll
            for (int pc = 0; pc < NCH; ++pc) { kvw[pc] = *(const unsigned*)(base + (size_t)pc * 4096); d0[pc] = d1[pc] = DLB[(seq2 >> 1) * NCH + pc] * 1.4426950408889634f; }
        }
        float S0 = 0.f, S1 = 0.f;
#pragma unroll
        for (int pc = 0; pc < NCH; ++pc) { const unsigned out = cvtpk(S0, S1);
            S0 = __builtin_amdgcn_exp2f(d0[pc]) * S0 + bflo(kvw[pc]); S1 = __builtin_amdgcn_exp2f(d1[pc]) * S1 + bfhi(kvw[pc]); kvw[pc] = out; }
#pragma unroll
        for (int pc = 0; pc < NCH; ++pc) *(unsigned*)(base + (size_t)pc * 4096) = kvw[pc];
    }
}

template <int STAGE> __device__ __forceinline__ void mixers_phase(Frame& F, int l, bf16_t* BR) {
    refresh(F);
    scan_tasks<STAGE == 2>(F, l, BR);
    refresh(F);
    const int slot = F.wave * F.G + F.bid, nslots = NWAVES * F.G;
    if (STAGE == 0) {
        if (l == 0) {
#pragma unroll 1
            for (int u = nslots - 1 - slot; u < NA_CTX; u += nslots) attn_task<2>(F, l, u, BR); }
        __syncthreads();
#pragma unroll 1
        for (int u = F.bid; u < 256; u += F.G) attn_block_task<1>(F, l, u, BR);
    } else {
        __syncthreads();
#pragma unroll 1
        for (int u = F.bid; u < 256; u += F.G) gx::gqa_unit<8>(F, u, BR);
    }
}

__device__ __forceinline__ void combine_phase(Frame& F, int l, bf16_t* BR, int nrows) {
    refresh(F);
    const bf16_t* MIX = (const bf16_t*)(F.ws + WS_RC);
    const bf16_t* OBA = (const bf16_t*)(F.ws + WS_OBA); const bf16_t* OBB = (const bf16_t*)(F.ws + WS_OBB);
    const int gw = F.bid * NWAVES + F.wave, NGW = F.G * NWAVES;
    const int m0 = gw, m1 = nrows;
    const int c0 = 4 * F.lane, head = F.lane >> 4;
    const f32x4 hw4 = *(const f32x4*)(FIN(8) + l * 256 + c0), sw4 = *(const f32x4*)(FIN(14) + l * 256 + c0); const float dk = FIN(13)[l * 4 + head];
    u32x2 n_of, n_ob, n_ag, n_sf, n_sb, n_zz, n_xc;
#define CB_LOAD(M) do { const size_t m_ = (size_t)(M); const bf16_t* br_ = BR + m_ * DM; const bf16_t* mx_ = MIX + m_ * NMIX; \
        n_of = __builtin_nontemporal_load((const u32x2*)(br_ + c0)); n_ob = __builtin_nontemporal_load((const u32x2*)(OBA + m_ * 256 + c0)); n_ag = __builtin_nontemporal_load((const u32x2*)(mx_ + C_AG + c0)); \
        n_sf = __builtin_nontemporal_load((const u32x2*)(br_ + 256 + c0)); n_sb = __builtin_nontemporal_load((const u32x2*)(OBB + m_ * 256 + c0)); n_zz = __builtin_nontemporal_load((const u32x2*)(mx_ + C_BZ + c0)); n_xc = __builtin_nontemporal_load((const u32x2*)(mx_ + C_BX + c0)); } while (0)
    if (m0 < m1) CB_LOAD(m0);
#pragma unroll 1
    for (int m = m0; m < m1; m += NGW) {
        const u32x2 of = n_of, ob = n_ob, ag = n_ag, sf = n_sf, sb = n_sb, zz = n_zz, xc = n_xc;
        if (m + NGW < m1) CB_LOAD(m + NGW);
        bf16_t* br = BR + (size_t)m * DM;
        { float t0 = bflo(of.x) + bflo(ob.x), t1 = bfhi(of.x) + bfhi(ob.x), t2 = bflo(of.y) + bflo(ob.y), t3 = bfhi(of.y) + bfhi(ob.y);
          float ss = (t0 * t0 + t1 * t1) + (t2 * t2 + t3 * t3);
          ss += dppf_<0xB1, 0xF, true>(ss); ss += dppf_<0x4E, 0xF, true>(ss); ss += dppf_<0x141, 0xF, true>(ss); ss += dppf_<0x140, 0xF, true>(ss);
          const float rs = 1.f / sqrtf(ss * (1.f / 64.f) + LN_EPS);
          u32x2 w; w.x = pk2(t0 * rs * hw4.x * siluf_(bflo(ag.x)), t1 * rs * hw4.y * siluf_(bfhi(ag.x)));
          w.y = pk2(t2 * rs * hw4.z * siluf_(bflo(ag.y)), t3 * rs * hw4.w * siluf_(bfhi(ag.y)));
          wt8a(br + c0, w); }
        { float y0 = (bflo(sf.x) + bflo(sb.x) + bflo(xc.x) * dk) * siluf_(bflo(zz.x));
          float y1 = (bfhi(sf.x) + bfhi(sb.x) + bfhi(xc.x) * dk) * siluf_(bfhi(zz.x));
          float y2 = (bflo(sf.y) + bflo(sb.y) + bflo(xc.y) * dk) * siluf_(bflo(zz.y));
          float y3 = (bfhi(sf.y) + bfhi(sb.y) + bfhi(xc.y) * dk) * siluf_(bfhi(zz.y));
          const float ss = wave_sum((y0 * y0 + y1 * y1) + (y2 * y2 + y3 * y3));
          const float rs = 1.f / sqrtf(ss * (1.f / 256.f) + LN_EPS);
          u32x2 w; w.x = pk2(y0 * rs * sw4.x, y1 * rs * sw4.y); w.y = pk2(y2 * rs * sw4.z, y3 * rs * sw4.w);
          wt8a(br + 256 + c0, w); }
    }
#undef CB_LOAD
}

#define XB_TMO      128
#define XB_XCNT(j)  (256  + 64 * (j))
#define XB_XSUB(j)  (1280 + 64 * (j))
#define XB_XGEN(j)  (2304 + 64 * (j))
#define XB_TOP      3328
#define XB_TOPGEN   3392
#define XCD_BAR_WORDS 3456
#define XB_SPIN_CAP (1u << 18)
__device__ __forceinline__ unsigned xb_ld(unsigned* p)              { return __hip_atomic_load(p, __ATOMIC_RELAXED, __HIP_MEMORY_SCOPE_AGENT); }
__device__ __forceinline__ unsigned xb_add(unsigned* p, unsigned v) { return __hip_atomic_fetch_add(p, v, __ATOMIC_RELAXED, __HIP_MEMORY_SCOPE_AGENT); }
__device__ __forceinline__ unsigned xb_xcc_id() { return (unsigned)__builtin_amdgcn_s_getreg((3 << 11) | 20) & 0xFu; }
#define XB_SPIN(cond, bar) do { unsigned _sp = 0; while (cond) { __builtin_amdgcn_s_sleep(1); \
    if ((++_sp & 255u) == 0u) { if (xb_ld(&(bar)[XB_TMO])) break; if (_sp > XB_SPIN_CAP) { atomicAdd(&(bar)[XB_TMO], 1u); break; } } } } while (0)
struct XcdBarrier { unsigned* bar; unsigned x; volatile LAS unsigned* st; };
__device__ __forceinline__ XcdBarrier xcd_barrier_post(unsigned* bar, volatile LAS unsigned* st, bool t0) {
    XcdBarrier b; b.bar = bar; b.x = xb_xcc_id(); b.st = st;
    if (t0) (void)xb_add(&bar[XB_XCNT(b.x)], 1u);
    return b;
}
__device__ __forceinline__ void xcd_barrier_complete(unsigned* bar, unsigned x, unsigned& nloc, unsigned& nx) {
    const unsigned G = gridDim.x * gridDim.y * gridDim.z;
    unsigned sum, cnt, mine, sp = 0u;
    for (;;) {
        sum = 0u; cnt = 0u; mine = 0u;
#pragma unroll
        for (unsigned j = 0; j < 16; ++j) { const unsigned c = xb_ld(&bar[XB_XCNT(j)]); sum += c; cnt += (c > 0u) ? 1u : 0u; mine = (j == x) ? c : mine; }
        if (sum == G) break;
        __builtin_amdgcn_s_sleep(1);
        if ((++sp & 255u) == 0u) { if (xb_ld(&bar[XB_TMO])) break; if (sp > XB_SPIN_CAP) { atomicAdd(&bar[XB_TMO], 1u); break; } }
    }
    nloc = mine > 0u ? mine : 1u; nx = cnt > 0u ? cnt : 1u;
}
__device__ __forceinline__ void xcd_barrier(const XcdBarrier& b, int wave_s) {
    asm volatile("s_waitcnt vmcnt(0)" ::: "memory");
    __syncthreads();
    int ln_; asm volatile("v_mbcnt_lo_u32_b32 %0, -1, 0\n\tv_mbcnt_hi_u32_b32 %0, -1, %0" : "=v"(ln_));
    if (wave_s == 0 && ln_ == 0) {
        unsigned* bar = b.bar;
        __builtin_amdgcn_s_waitcnt(0);
        unsigned nloc = b.st[0], nx = b.st[1];
        if (nloc == 0u) { xcd_barrier_complete(bar, b.x, nloc, nx); b.st[0] = nloc; b.st[1] = nx; }
        const unsigned old = xb_add(&bar[XB_XSUB(b.x)], 1u);
        const unsigned gen = old / nloc;
        if (old + 1u == (gen + 1u) * nloc) {
            __builtin_amdgcn_fence(__ATOMIC_RELEASE, "agent");
            asm volatile("s_waitcnt vmcnt(0)" ::: "memory");
            const unsigned og = xb_add(&bar[XB_TOP], 1u);
            const unsigned tg = og / nx;
            if (og + 1u == (tg + 1u) * nx) xb_add(&bar[XB_TOPGEN], 1u);
            else XB_SPIN(xb_ld(&bar[XB_TOPGEN]) == tg, bar);
            __builtin_amdgcn_fence(__ATOMIC_ACQUIRE, "agent");
            asm volatile("s_waitcnt vmcnt(0)" ::: "memory");
        } else {
            XB_SPIN(xb_ld(&bar[XB_TOPGEN]) == gen, bar);
            __builtin_amdgcn_fence(__ATOMIC_ACQUIRE, "agent");
            asm volatile("s_waitcnt vmcnt(0)" ::: "memory");
        }
    }
    __syncthreads();
}

#define GSYNC() xcd_barrier(bar, F.wave_s)
#define MODS ((float*)(F.ws + WS_MODS))
#define DT ((float*)(F.ws + WS_DT))
#define XC ((float*)(F.ws + WS_XC))
#define MIX ((bf16_t*)(F.ws + WS_RC))
#define WIN ((const bf16_t*)(F.ws + WS_WIN))
#define WBR ((const bf16_t*)(F.ws + WS_WBR))
#define WOUT ((const bf16_t*)(F.ws + WS_WOUT))
#define WUP ((const bf16_t*)(F.ws + WS_WUP))
#define WDN ((const bf16_t*)(F.ws + WS_WDN))
#define SLABS ((bf16_t*)(F.ws + WS_RC + (size_t)94 * MiB))
template <int l> __device__ __forceinline__ void layer_body(Frame& F, const XcdBarrier& bar) {
        constexpr bool last = (l == DEPTH - 1);
#define H ((bf16_t*)(F.ws + WS_RA))
#define BR ((bf16_t*)(F.ws + WS_RB))
#define mods_l (MODS + (size_t)l * 5 * 6144)
        constexpr int Mpost = last ? MLAT : MALL;
#define xlat (l == 0 ? FIN(0) : ((float*)(F.a->out)))
#define xctx (l == 0 ? FIN(2) : XC)

        { pg8::Gemm g{H, WIN, MALL, NMIX}; pg8::StaticOrder S; S.init(MALL, NMIX, F.G, F.bid);
          pg8::EpiStoreFG E{MIX, NMIX, l == 1 ? FIN(7) : (const float*)nullptr}; pg8::gemm_phase<pg8::EpiStoreFG, DM, DM, DM, 0, 0>(F.lds, g, S, E, tid_from_lds(F.lds, F.wave_s)); }
        GSYNC();
        prep_phase(F, l);
        conv_to_lds(F, l);
        GSYNC();
        conv_from_lds(F);
        GSYNC();
        mixers_phase<0>(F, l, BR);
        GSYNC();
        scan_carry(F);
        GSYNC();
        mixers_phase<2>(F, l, BR);
        GSYNC();
        combine_phase(F, l, BR, Mpost);
        if constexpr (last) convert_weights<1>(F, l);
        GSYNC();
        { pg8::Gemm g{H, WIN + (size_t)NMIX * DM, Mpost, 4096}; pg8::StaticOrder S; S.init(Mpost, 4096, F.G, F.bid);
          pg8::EpiGateStore E{MIX}; pg8::gemm_phase<pg8::EpiGateStore, DM, DM, DM, 0, 0>(F.lds, g, S, E, tid_from_lds(F.lds, F.wave_s)); }
        if constexpr (!last) convert_weights<1>(F, l, 64, F.G - 64);
        GSYNC();
        { pg8::Gemm g{BR, WBR, Mpost, DM}; pg8::StaticOrder S; S.init(Mpost, DM, F.G, F.bid);
          pg8::EpiHorner E{MIX, H}; pg8::gemm_phase<pg8::EpiHorner, DM, DM, DM, 0, 0, pg8::StaticOrder, 256, false>(F.lds, g, S, E, tid_from_lds(F.lds, F.wave_s)); }
        GSYNC();
        { pg8::Gemm g{H, WOUT, Mpost, DM}; pg8::StaticOrder S; S.init(Mpost, DM, F.G, F.bid);
          pg8::EpiStore E{BR, DM}; pg8::gemm_phase<pg8::EpiStore, DM, DM, DM, 0, 0, pg8::StaticOrder, 0, false>(F.lds, g, S, E, tid_from_lds(F.lds, F.wave_s)); }
        GSYNC();
        {
            RowOp R{}; R.nrows = Mpost; R.xlat_in = xlat; R.xctx_in = xctx; R.post = true; R.Y = BR; R.gate_chunk = 2; R.lng = FIN(20) + l * DM; R.lnb = FIN(21) + l * DM; R.mods_post = mods_l;
            R.xlat_out = ((float*)(F.a->out)); R.xctx_out = XC; R.domod = true; R.mods_mod = mods_l; R.shift_chunk = 3; R.scale_chunk = 4; R.Hout = H; R.dodt = false; R.DTout = DT;
            row_pass(F, R, FIN(6));
        }
        GSYNC();
        { pg8::Gemm g{H, WUP, Mpost, 2 * FFH}; pg8::StaticOrder S; S.init(Mpost, 2 * FFH, F.G, F.bid);
          pg8::EpiSwiGLU E{MIX, FFH}; pg8::gemm_phase<pg8::EpiSwiGLU, DM, DM, DM, 0, 0>(F.lds, g, S, E, tid_from_lds(F.lds, F.wave_s)); }
        GSYNC();
        { pg8::Gemm g{MIX, WDN, MLAT, DM}; pg8::StaticOrder S; S.init(MLAT, DM, F.G, F.bid);
          pg8::EpiStore E{BR, DM}; pg8::gemm_phase<pg8::EpiStore, FFH, FFH, FFH, 0, 0, pg8::StaticOrder, 0, false>(F.lds, g, S, E, tid_from_lds(F.lds, F.wave_s)); }
        if (!last) {
          pg8::Gemm g{MIX, WDN, MALL, DM}; pg8::SplitOrder S; S.init(MCTX / 256, DM / 256, FFH / 256, MLAT / 256, F.G, F.bid);
          pg8::EpiSlab E{SLABS, MLAT / 256, MCTX}; pg8::gemm_phase<pg8::EpiSlab, 256, FFH, FFH, 0, 0, pg8::SplitOrder>(F.lds, g, S, E, tid_from_lds(F.lds, F.wave_s)); }
        GSYNC();
        {
            RowOp R{}; R.nrows = Mpost; R.xlat_in = ((float*)(F.a->out)); R.xctx_in = XC; R.post = true; R.Y = BR; R.slabs = SLABS; R.nslab = last ? 0 : FFH / 256; R.slab_row0 = MLAT; R.gate_chunk = 5; R.lng = FIN(24) + l * DM; R.lnb = FIN(25) + l * DM; R.mods_post = mods_l;
            R.xlat_out = ((float*)(F.a->out)); R.xctx_out = XC; R.domod = !last; R.mods_mod = MODS + (size_t)(l + 1) * 5 * 6144; R.shift_chunk = 0; R.scale_chunk = 1; R.Hout = H; R.dodt = !last; R.DTout = DT;
            row_pass(F, R, FIN(6) + (size_t)(last ? l : l + 1) * DM * INC);
            if (!last) { convert_weights<0>(F, l + 1); GSYNC(); }
        }
}

__global__ void __launch_bounds__(NTHREADS, 2) fwd_megakernel(Args args) {
    extern __shared__ __attribute__((aligned(16))) unsigned char lds_raw[];
    Frame F;
    F.lds = (LAS unsigned char*)lds_raw;
    F.G = gridDim.x; F.bid = blockIdx.x; F.a = &args; F.ws = args.ws; F.ws0 = args.ws;
    { const int t0 = threadIdx.x; F.wave_s = __builtin_amdgcn_readfirstlane(t0 >> 6);
      *(LAS int*)(F.lds + TIDTAB_OFF + t0 * 4) = t0;
      volatile LAS unsigned* bst0 = (volatile LAS unsigned*)(F.lds + 8 * WLDS); if (t0 < 2) bst0[t0] = 0u; }
    __syncthreads();
    refresh(F);
    volatile LAS unsigned* bst = (volatile LAS unsigned*)(F.lds + 8 * WLDS);
    const XcdBarrier bar = xcd_barrier_post((unsigned*)(F.ws + WS_CTL), bst, F.tid == 0);

    mods_phase(F);
    convert_weights<0>(F, 0);
    GSYNC();
    {
        RowOp R{}; R.nrows = MALL; R.xlat_in = FIN(0); R.xctx_in = FIN(2); R.post = false; R.domod = true; R.mods_mod = MODS; R.shift_chunk = 0; R.scale_chunk = 1;
        R.Hout = (bf16_t*)(F.ws + WS_RA); R.dodt = true; R.DTout = DT;
        row_pass(F, R, FIN(6));
    }
    GSYNC();

    layer_body<0>(F, bar);
    layer_body<1>(F, bar);
}

extern "C" void kernel_launch(void* const* d_in, const int* in_sizes, int n_in, void* d_out, int out_size, void* d_ws, size_t ws_size, hipStream_t stream) {
    static int grid = 0;
    if (grid == 0) {
        if (n_in != 26 || out_size != MLAT * DM || ws_size < WS_END) { fprintf(stderr, "kernel_launch: unexpected shapes (n_in %d out %d ws %zu)\n", n_in, out_size, ws_size); grid = -1; return; }
        int dev = 0, cus = 0, per_cu = 0;
        hipGetDevice(&dev); hipDeviceGetAttribute(&cus, hipDeviceAttributeMultiprocessorCount, dev);
        hipFuncSetAttribute((const void*)fwd_megakernel, hipFuncAttributeMaxDynamicSharedMemorySize, LDS_BYTES);
        hipOccupancyMaxActiveBlocksPerMultiprocessor(&per_cu, (const void*)fwd_megakernel, NTHREADS, LDS_BYTES);
        if (per_cu < 1) { fprintf(stderr, "kernel_launch: occupancy query says %d\n", per_cu); per_cu = 1; }
        (void)hipGetLastError();
        grid = cus * 1;
    }
    if (grid < 0) return;
    if (hipMemsetAsync((char*)d_ws + WS_CTL, 0, CTL_ZERO_BYTES, stream) != hipSuccess) { fprintf(stderr, "kernel_launch: memset failed\n"); return; }
    Args a{};
    for (int i = 0; i < 26; ++i) a.in[i] = (GAS const float*)d_in[i];
    a.out = (GAS float*)d_out; a.ws = (GAS unsigned char*)d_ws;
    hipLaunchKernelGGL(fwd_megakernel, dim3(grid), dim3(NTHREADS), LDS_BYTES, stream, a);
    hipError_t e = hipPeekAtLastError();
    if (e != hipSuccess) fprintf(stderr, "launch failed: %s (grid %d)\n", hipGetErrorString(e), grid);
}
```

```cpp
#include <hip/hip_runtime.h>
#include <cstdio>
#include <cstdint>

#define LAS __attribute__((address_space(3)))
typedef unsigned short bf16_t;
typedef short bf16x8 __attribute__((ext_vector_type(8)));
typedef float f32x4 __attribute__((ext_vector_type(4)));
typedef unsigned u32x4 __attribute__((ext_vector_type(4)));
typedef unsigned u32x2 __attribute__((ext_vector_type(2)));

constexpr int DM = 1024, NB = 4, SEQ = 4096, CTXL = 256, DEPTH = 2;
constexpr int MLAT = NB * SEQ;
constexpr int MCTX = NB * CTXL;
constexpr int MALL = MLAT + MCTX;
constexpr int INC = 7688;
constexpr int NMIX = 3584;
constexpr int FFH = 2816;
constexpr float LN_EPS = 1e-6f;
constexpr float ALPHA = 1.4142135623730951f;
constexpr int C_AQ = 0, C_AFF = 256, C_AFB = 512, C_AV = 768, C_AG = 1024, C_BZ = 1280, C_BX = 1536, C_BB = 1792, C_BC = 2048,
              C_CQ = 2304, C_CK = 2560, C_CV = 2816, C_DQ = 3072, C_DK = 3328, C_DV = 3456;

constexpr size_t MiB = 1u << 20;
constexpr size_t WS_CTL = 0, CTL_ZERO_BYTES = 16384;
constexpr size_t WS_MODS = 1 * MiB;
constexpr size_t WS_DT = 2 * MiB;
constexpr size_t WS_XC = 3 * MiB;
constexpr size_t WS_WIN = 8 * MiB;
constexpr size_t WS_WBR = 23 * MiB;
constexpr size_t WS_WOUT = 25 * MiB;
constexpr size_t WS_WUP = 33 * MiB;
constexpr size_t WS_WDN = 44 * MiB;
constexpr size_t WS_RA = 50 * MiB;
constexpr size_t WS_RB = 84 * MiB;
constexpr size_t WS_RC = 118 * MiB;
constexpr size_t WS_OBA = WS_RC + 119 * MiB;
constexpr size_t WS_OBB = WS_OBA + 17 * MiB / 2;
constexpr size_t WS_END = 254 * MiB;
constexpr size_t WS_STA = 33 * MiB;
constexpr size_t WS_STB = WS_STA + (size_t)32 * 17 * 4096 * 2;
constexpr size_t WS_DLA = 46 * MiB;
constexpr size_t WS_DLB = 47 * MiB;
static_assert(WS_STB + (size_t)64 * 17 * 4096 * 2 <= WS_DLA, "scan state map");

constexpr int NWAVES = 8, NTHREADS = 512;
constexpr int LDS_BYTES = 155648 + 64 + 2048;
constexpr int WLDS = 19456;

__device__ __forceinline__ float bf2f(unsigned u) { return __uint_as_float(u << 16); }
__device__ __forceinline__ float bflo(unsigned w) { return __uint_as_float(w << 16); }
__device__ __forceinline__ float bfhi(unsigned w) { return __uint_as_float(w & 0xffff0000u); }
__device__ __forceinline__ unsigned f2bf(float f) { unsigned u = __float_as_uint(f); return (u + 0x7fffu + ((u >> 16) & 1u)) >> 16; }
__device__ __forceinline__ unsigned pk2(float lo, float hi) { return f2bf(lo) | (f2bf(hi) << 16); }
__device__ __forceinline__ float sigmoidf_(float x) { return __builtin_amdgcn_rcpf(1.f + __expf(-x)); }
__device__ __forceinline__ float siluf_(float x) { return x * sigmoidf_(x); }
template <int CTRL, int RMASK, bool BC> __device__ __forceinline__ float dppf_(float v) { return __int_as_float(__builtin_amdgcn_update_dpp(0, __float_as_int(v), CTRL, RMASK, 0xF, BC)); }
__device__ __forceinline__ float wave_sum(float v) {
    v += dppf_<0xB1, 0xF, true>(v);
    v += dppf_<0x4E, 0xF, true>(v);
    v += dppf_<0x141, 0xF, true>(v);
    v += dppf_<0x140, 0xF, true>(v);
    v += dppf_<0x142, 0xA, false>(v);
    v += dppf_<0x143, 0xC, false>(v);
    return __int_as_float(__builtin_amdgcn_readlane(__float_as_int(v), 63));
}
#define LDS_WAIT() asm volatile("s_waitcnt lgkmcnt(0)" ::: "memory")

__device__ __forceinline__ void wt8a(void* p, u32x2 v) { __hip_atomic_store((unsigned long long*)p, ((unsigned long long)v.y << 32) | v.x, __ATOMIC_RELAXED, __HIP_MEMORY_SCOPE_AGENT); }

namespace pg8 {
constexpr int BM = 256, BK = 64, HALF = 128, HTB = HALF * BK * 2, STAGE_BYTES = 8 * HTB, NXCD = 8, WGM = 8;
__host__ __device__ __forceinline__ int lds_byte(int r, int c) { const int st = (r >> 4) * 2 + (c >> 5), rr = r & 15, cc = c & 31, ob = rr * 64 + cc * 2; return st * 1024 + (ob ^ (((ob >> 9) & 1) << 5)); }
__host__ __device__ __forceinline__ void stage_rc(int b, int& R, int& C) { const int st = b / 1024, sb = b % 1024, swz = sb ^ (((sb >> 9) & 1) << 5); R = (st >> 1) * 16 + swz / 64; C = (st & 1) * 32 + (swz % 64) / 2; }
__host__ __device__ __forceinline__ int perm32(int rho) { const int n = rho >> 4, i = rho & 15; return 8 * (i >> 2) + 4 * n + (i & 3); }

struct Unit { int pm, pn, kc; };
struct Gemm { const bf16_t* A; const bf16_t* Bt; int M, N; };

__device__ __forceinline__ void st16_wt(void* p, u32x4 v) { asm volatile("global_store_dwordx4 %0, %1, off sc1\n\ts_nop 1" :: "v"(p), "v"(v) : "memory"); }
struct StaticOrder {
    int nM, nN, nwg, G, c;
    __device__ void init(int M, int N, int G_, int c_) { nM = M / BM; nN = N / BM; nwg = nM * nN; G = G_; c = c_; }
    __device__ bool next(int i, Unit& u) const {
        const long L = (long)i * G + c; if (L >= nwg) return false;
        int wgid = (int)L; { const int q = nwg / NXCD, r = nwg % NXCD, xcd = wgid % NXCD, off = wgid / NXCD; wgid = (xcd < r ? xcd * (q + 1) : r * (q + 1) + (xcd - r) * q) + off; }
        const int nig = WGM * nN, gid = wgid / nig, fm = gid * WGM, gsz = (nM - fm) < WGM ? (nM - fm) : WGM;
        u.pm = fm + ((wgid % nig) % gsz); u.pn = (wgid % nig) / gsz; u.kc = 0; return true;
    }
};

struct SplitOrder {
    int nsub, G, c, nkc, nn, pm0;
    __device__ void init(int ntiles_m, int nn_, int nkc_, int pm0_, int G_, int c_) { nn = nn_; nkc = nkc_; pm0 = pm0_; nsub = ntiles_m * nn_ * nkc_; G = G_; c = c_; }
    __device__ bool next(int i, Unit& u) const { const int L = i * G + c; if (L >= nsub) return false; const int tile = L / nkc; u.kc = L % nkc; u.pm = pm0 + tile / nn; u.pn = tile % nn; return true; }
};
struct GroupOrder {
    int ngrp, G, c;
    __device__ void init(int M, int G_, int c_) { ngrp = (M / BM) * 4; G = G_; c = c_; }
    __device__ bool next(int i, Unit& u) const { const int grp = (i >> 2) * G + c; if (grp >= ngrp) return false; u.pm = grp >> 2; u.pn = 4 * (i & 3) + (grp & 3); u.kc = 0; return true; }
};
typedef float f32x2c_t __attribute__((ext_vector_type(2))); typedef __bf16 bf16x2c_t __attribute__((ext_vector_type(2)));
__device__ __forceinline__ unsigned cvt_pk_bf16(float lo, float hi) { f32x2c_t v = {lo, hi}; bf16x2c_t b = __builtin_convertvector(v, bf16x2c_t); return __builtin_bit_cast(unsigned, b); }

struct EpiStore {
    bf16_t* O; int ldc;
    __device__ __forceinline__ void operator()(const f32x4 (&acc)[2][2][4][2], const Unit& u, int wr, int wc, int fr, int fq) const {
        const int row0 = u.pm * BM + wr * 64 + fr; const int col0 = u.pn * BM + wc * 32 + 8 * fq;
#pragma unroll
        for (int ai = 0; ai < 2; ++ai)
#pragma unroll
            for (int m = 0; m < 4; ++m) { bf16_t* rowp = O + (size_t)(row0 + ai * HALF + m * 16) * ldc + col0;
#pragma unroll
                for (int bj = 0; bj < 2; ++bj) { const f32x4 v0 = acc[ai][bj][m][0], v1 = acc[ai][bj][m][1];
                    u32x4 w; w.x = cvt_pk_bf16(v0[0], v0[1]); w.y = cvt_pk_bf16(v0[2], v0[3]); w.z = cvt_pk_bf16(v1[0], v1[1]); w.w = cvt_pk_bf16(v1[2], v1[3]);
                    st16_wt((rowp + bj * HALF), w); } }
    }
};
struct EpiStoreFG {
    bf16_t* O; int ldc; const float* lbp;
    __device__ __forceinline__ void operator()(const f32x4 (&acc)[2][2][4][2], const Unit& u, int wr, int wc, int fr, int fq) const {
        const int row0 = u.pm * BM + wr * 64 + fr; const int col0 = u.pn * BM + wc * 32 + 8 * fq;
        const bool isg = (u.pn == 1) || (u.pn == 2);
        float lb[2][8];
#pragma unroll
        for (int bj = 0; bj < 2; ++bj)
#pragma unroll
            for (int j = 0; j < 8; ++j) lb[bj][j] = 0.f;
        if (isg && lbp) { const float* p = lbp + (u.pn - 1) * 512 + wc * 32 + 8 * fq;
#pragma unroll
            for (int bj = 0; bj < 2; ++bj)
#pragma unroll
                for (int j = 0; j < 8; ++j) lb[bj][j] = __builtin_amdgcn_rcpf(1.f + __expf(p[bj * HALF + j] - p[256 + bj * HALF + j])); }
#pragma unroll
        for (int ai = 0; ai < 2; ++ai)
#pragma unroll
            for (int m = 0; m < 4; ++m) { bf16_t* rowp = O + (size_t)(row0 + ai * HALF + m * 16) * ldc + col0;
#pragma unroll
                for (int bj = 0; bj < 2; ++bj) { f32x4 v0 = acc[ai][bj][m][0], v1 = acc[ai][bj][m][1];
                    if (isg) {
#pragma unroll
                        for (int j = 0; j < 4; ++j) { v0[j] = fmaxf(__log2f(lb[bj][j] + (1.f - lb[bj][j]) * sigmoidf_(v0[j])), -126.f); v1[j] = fmaxf(__log2f(lb[bj][4 + j] + (1.f - lb[bj][4 + j]) * sigmoidf_(v1[j])), -126.f); } }
                    u32x4 w; w.x = cvt_pk_bf16(v0[0], v0[1]); w.y = cvt_pk_bf16(v0[2], v0[3]); w.z = cvt_pk_bf16(v1[0], v1[1]); w.w = cvt_pk_bf16(v1[2], v1[3]);
                    st16_wt((rowp + bj * HALF), w); } }
    }
};
struct EpiGateMul {
    bf16_t* O; int ldc;
    __device__ __forceinline__ void operator()(const f32x4 (&acc)[2][2][4][2], const Unit& u, int wr, int wc, int fr, int fq) const {
        const int row0 = u.pm * BM + wr * 64 + fr; const int col0 = u.pn * BM + wc * 32 + 8 * fq;
#pragma unroll
        for (int ai = 0; ai < 2; ++ai)
#pragma unroll
            for (int m = 0; m < 4; ++m) { bf16_t* rowp = O + (size_t)(row0 + ai * HALF + m * 16) * ldc + col0;
#pragma unroll
                for (int bj = 0; bj < 2; ++bj) { const f32x4 v0 = acc[ai][bj][m][0], v1 = acc[ai][bj][m][1];
                    const u32x4 g = *(const u32x4*)(rowp + bj * HALF);
                    u32x4 w;
                    w.x = cvt_pk_bf16(v0[0] * sigmoidf_(bflo(g.x)), v0[1] * sigmoidf_(bfhi(g.x)));
                    w.y = cvt_pk_bf16(v0[2] * sigmoidf_(bflo(g.y)), v0[3] * sigmoidf_(bfhi(g.y)));
                    w.z = cvt_pk_bf16(v1[0] * sigmoidf_(bflo(g.z)), v1[1] * sigmoidf_(bfhi(g.z)));
                    w.w = cvt_pk_bf16(v1[2] * sigmoidf_(bflo(g.w)), v1[3] * sigmoidf_(bfhi(g.w)));
                    st16_wt((rowp + bj * HALF), w); } }
    }
};
__device__ __forceinline__ size_t gate_frag_off(int pm, int pn16, int ai, int m, int bj, int tid) { return ((size_t)(pm * 16 + pn16) << 16) + (size_t)((((ai * 4 + m) * 2 + bj) * 512 + tid) * 8); }
struct EpiGateStore {
    bf16_t* G;
    __device__ __forceinline__ void operator()(const f32x4 (&acc)[2][2][4][2], const Unit& u, int wr, int wc, int fr, int fq) const {
        const int tid = (wr * 4 + wc) * 64 + fq * 16 + fr;
#pragma unroll
        for (int ai = 0; ai < 2; ++ai)
#pragma unroll
            for (int m = 0; m < 4; ++m)
#pragma unroll
                for (int bj = 0; bj < 2; ++bj) { const f32x4 v0 = acc[ai][bj][m][0], v1 = acc[ai][bj][m][1];
                    u32x4 w; w.x = cvt_pk_bf16(sigmoidf_(v0[0]), sigmoidf_(v0[1])); w.y = cvt_pk_bf16(sigmoidf_(v0[2]), sigmoidf_(v0[3]));
                    w.z = cvt_pk_bf16(sigmoidf_(v1[0]), sigmoidf_(v1[1])); w.w = cvt_pk_bf16(sigmoidf_(v1[2]), sigmoidf_(v1[3]));
                    st16_wt((G + gate_frag_off(u.pm, u.pn, ai, m, bj, tid)), w); }
    }
};
struct EpiGateAcc {
    const bf16_t* GATE; bf16_t* O;
    __device__ __forceinline__ void operator()(const f32x4 (&acc)[2][2][4][2], const Unit& u, int wr, int wc, int fr, int fq) const {
        const int row0 = u.pm * BM + wr * 64 + fr; const int colo = (u.pn & 3) * BM + wc * 32 + 8 * fq; const bool first = (u.pn < 4); const int tid = (wr * 4 + wc) * 64 + fq * 16 + fr;
#pragma unroll
        for (int ai = 0; ai < 2; ++ai)
#pragma unroll
            for (int m = 0; m < 4; ++m) { const size_t r = (size_t)(row0 + ai * HALF + m * 16); bf16_t* op = O + r * 1024 + colo;
#pragma unroll
                for (int bj = 0; bj < 2; ++bj) { const f32x4 v0 = acc[ai][bj][m][0], v1 = acc[ai][bj][m][1];
                    const u32x4 g = *(const u32x4*)(GATE + gate_frag_off(u.pm, u.pn, ai, m, bj, tid));
                    u32x4 p = (u32x4){0u, 0u, 0u, 0u}; if (!first) p = *(const u32x4*)(op + bj * HALF);
                    u32x4 w;
                    w.x = cvt_pk_bf16(bflo(p.x) + v0[0] * bflo(g.x), bfhi(p.x) + v0[1] * bfhi(g.x));
                    w.y = cvt_pk_bf16(bflo(p.y) + v0[2] * bflo(g.y), bfhi(p.y) + v0[3] * bfhi(g.y));
                    w.z = cvt_pk_bf16(bflo(p.z) + v1[0] * bflo(g.z), bfhi(p.z) + v1[1] * bfhi(g.z));
                    w.w = cvt_pk_bf16(bflo(p.w) + v1[2] * bflo(g.w), bfhi(p.w) + v1[3] * bfhi(g.w));
                    st16_wt((op + bj * HALF), w); } }
    }
};
struct EpiHorner {
    const bf16_t* GATE; bf16_t* O;
    static __device__ __forceinline__ float ratio_(float ga, float gb) { return ga * __builtin_amdgcn_rcpf(fmaxf(gb, 1e-30f)); }
    __device__ __forceinline__ void mid(f32x4 (&acc)[2][2][4][2], const Unit& u, int wr, int wc, int fr, int fq, int nb) const {
        const int tid = (wr * 4 + wc) * 64 + fq * 16 + fr;
        typedef __attribute__((address_space(1))) const u32x4 gu32x4;
        const gu32x4* ga = (const gu32x4*)(GATE + gate_frag_off(u.pm, nb * 4 + u.pn, 0, 0, 0, tid));
        const gu32x4* gb = (const gu32x4*)(GATE + gate_frag_off(u.pm, (nb + 1) * 4 + u.pn, 0, 0, 0, tid));
#pragma unroll
        for (int ai = 0; ai < 2; ++ai) {
            u32x4 a[8], b[8];
#pragma unroll
            for (int p = 0; p < 8; ++p) { a[p] = __builtin_nontemporal_load(ga + (ai * 8 + p) * 512); b[p] = gb[(ai * 8 + p) * 512]; }
            asm volatile("" ::: "memory");
#pragma unroll
            for (int m = 0; m < 4; ++m)
#pragma unroll
                for (int bj = 0; bj < 2; ++bj) { const u32x4 av = a[m * 2 + bj], bv = b[m * 2 + bj];
                    f32x4& v0 = acc[ai][bj][m][0]; f32x4& v1 = acc[ai][bj][m][1];
                    v0[0] *= ratio_(bflo(av.x), bflo(bv.x)); v0[1] *= ratio_(bfhi(av.x), bfhi(bv.x)); v0[2] *= ratio_(bflo(av.y), bflo(bv.y)); v0[3] *= ratio_(bfhi(av.y), bfhi(bv.y));
                    v1[0] *= ratio_(bflo(av.z), bflo(bv.z)); v1[1] *= ratio_(bfhi(av.z), bfhi(bv.z)); v1[2] *= ratio_(bflo(av.w), bflo(bv.w)); v1[3] *= ratio_(bfhi(av.w), bfhi(bv.w)); }
        }
    }
    __device__ __forceinline__ void operator()(const f32x4 (&acc)[2][2][4][2], const Unit& u, int wr, int wc, int fr, int fq) const {
        const int row0 = u.pm * BM + wr * 64 + fr; const int col0 = u.pn * BM + wc * 32 + 8 * fq; const int tid = (wr * 4 + wc) * 64 + fq * 16 + fr;
        typedef __attribute__((address_space(1))) const u32x4 gu32x4;
        const gu32x4* gg = (const gu32x4*)(GATE + gate_frag_off(u.pm, 12 + u.pn, 0, 0, 0, tid));
#pragma unroll
        for (int ai = 0; ai < 2; ++ai) {
            u32x4 g[8];
#pragma unroll
            for (int p = 0; p < 8; ++p) g[p] = __builtin_nontemporal_load(gg + (ai * 8 + p) * 512);
            asm volatile("" ::: "memory");
#pragma unroll
            for (int m = 0; m < 4; ++m) { bf16_t* op = O + (size_t)(row0 + ai * HALF + m * 16) * 1024 + col0;
#pragma unroll
                for (int bj = 0; bj < 2; ++bj) { const f32x4 v0 = acc[ai][bj][m][0], v1 = acc[ai][bj][m][1]; const u32x4 gv = g[m * 2 + bj];
                    u32x4 w;
                    w.x = cvt_pk_bf16(v0[0] * bflo(gv.x), v0[1] * bfhi(gv.x)); w.y = cvt_pk_bf16(v0[2] * bflo(gv.y), v0[3] * bfhi(gv.y));
                    w.z = cvt_pk_bf16(v1[0] * bflo(gv.z), v1[1] * bfhi(gv.z)); w.w = cvt_pk_bf16(v1[2] * bflo(gv.w), v1[3] * bfhi(gv.w));
                    st16_wt((op + bj * HALF), w); } }
        }
    }
};
struct EpiSlab {
    bf16_t* S; int pm0, rows;
    __device__ __forceinline__ void operator()(const f32x4 (&acc)[2][2][4][2], const Unit& u, int wr, int wc, int fr, int fq) const {
        const int row0 = (u.pm - pm0) * BM + wr * 64 + fr; const int col0 = u.pn * BM + wc * 32 + 8 * fq; bf16_t* base = S + (size_t)u.kc * rows * 1024;
#pragma unroll
        for (int ai = 0; ai < 2; ++ai)
#pragma unroll
            for (int m = 0; m < 4; ++m) { bf16_t* rowp = base + (size_t)(row0 + ai * HALF + m * 16) * 1024 + col0;
#pragma unroll
                for (int bj = 0; bj < 2; ++bj) { const f32x4 v0 = acc[ai][bj][m][0], v1 = acc[ai][bj][m][1];
                    u32x4 w; w.x = cvt_pk_bf16(v0[0], v0[1]); w.y = cvt_pk_bf16(v0[2], v0[3]); w.z = cvt_pk_bf16(v1[0], v1[1]); w.w = cvt_pk_bf16(v1[2], v1[3]);
                    st16_wt((rowp + bj * HALF), w); } }
    }
};
struct EpiSwiGLU {
    bf16_t* O; int ldc;
    __device__ __forceinline__ void operator()(const f32x4 (&acc)[2][2][4][2], const Unit& u, int wr, int wc, int fr, int fq) const {
        const int row0 = u.pm * BM + wr * 64 + fr; const int col0 = u.pn * HALF + wc * 32 + 8 * fq;
#pragma unroll
        for (int ai = 0; ai < 2; ++ai)
#pragma unroll
            for (int m = 0; m < 4; ++m) { bf16_t* rowp = O + (size_t)(row0 + ai * HALF + m * 16) * ldc + col0;
                const f32x4 g0 = acc[ai][0][m][0], g1 = acc[ai][0][m][1], u0 = acc[ai][1][m][0], u1 = acc[ai][1][m][1];
                u32x4 w;
                w.x = cvt_pk_bf16(siluf_(g0[0]) * u0[0], siluf_(g0[1]) * u0[1]); w.y = cvt_pk_bf16(siluf_(g0[2]) * u0[2], siluf_(g0[3]) * u0[3]);
                w.z = cvt_pk_bf16(siluf_(g1[0]) * u1[0], siluf_(g1[1]) * u1[1]); w.w = cvt_pk_bf16(siluf_(g1[2]) * u1[2], siluf_(g1[3]) * u1[3]);
                st16_wt(rowp, w); }
    }
};

template <class Epi, int K, int LDA, int LDB, int ADIV, int ACOLS, class Sched = StaticOrder, int MIDK = 0, bool ALIGN_EPI = true>
__device__ __forceinline__ void gemm_phase(LAS unsigned char* lds, const Gemm g, const Sched& S, const Epi& E, int tid_) {
    const int tid = tid_, wid = __builtin_amdgcn_readfirstlane(tid >> 6), lane = tid & 63, wr = wid >> 2, wc = wid & 3, fr = lane & 15, fq = lane >> 4;
    constexpr int nt = K / BK;
    unsigned voffA, voffB;
    { int R, C; stage_rc(tid * 16, R, C); const int Rb = (R & ~31) + perm32(R & 31); voffA = (unsigned)(R * LDA + C) * 2u; voffB = (unsigned)(Rb * LDB + C) * 2u; }
    constexpr size_t p1offA = (size_t)64 * LDA * 2, p1offB = (size_t)64 * LDB * 2;
    constexpr size_t kstep = (size_t)(BK * 2);
    constexpr size_t hstepA = (size_t)HALF * LDA * 2, hstepB = (size_t)HALF * LDB * 2;
    constexpr size_t tstepA = 2 * hstepA, tstepB = 2 * hstepB;
    const unsigned ldsw = (unsigned)wid * 1024u;
    const int aoff = lds_byte(wr * 64 + fr, fq * 8), boff = lds_byte(wc * 32 + fr, fq * 8);
#define PG8_SA(b, h) (((b) * 2 + (h)) * HTB)
#define PG8_SB(b, h) ((4 + (b) * 2 + (h)) * HTB)
#define PG8_STAGE(bufoff, gbase, voff) do { _Pragma("unroll") for (int _i = 0; _i < 2; ++_i) \
        __builtin_amdgcn_global_load_lds((const unsigned*)((const char*)(gbase) + _i * p1##voff + (v##voff)), (LAS unsigned*)(lds + (bufoff) + ldsw + _i * 8192), 16, 0, 0); } while (0)
#define PG8_LDA(dst, b, h) do { _Pragma("unroll") for (int m = 0; m < 4; ++m) _Pragma("unroll") for (int k = 0; k < 2; ++k) dst[m][k] = *(const LAS bf16x8*)(lds + PG8_SA(b, h) + aoff + m * 2048 + k * 1024); } while (0)
#define PG8_LDB(dst, b, h) do { _Pragma("unroll") for (int n = 0; n < 2; ++n) _Pragma("unroll") for (int k = 0; k < 2; ++k) dst[n][k] = *(const LAS bf16x8*)(lds + PG8_SB(b, h) + boff + n * 2048 + k * 1024); } while (0)
#define PG8_MMA(ai, bj, At, Bt) do { __builtin_amdgcn_s_setprio(1); _Pragma("unroll") for (int m = 0; m < 4; ++m) _Pragma("unroll") for (int n = 0; n < 2; ++n) _Pragma("unroll") for (int k = 0; k < 2; ++k) \
        acc[ai][bj][m][n] = __builtin_amdgcn_mfma_f32_16x16x32_bf16(Bt[n][k], At[m][k], acc[ai][bj][m][n], 0, 0, 0); __builtin_amdgcn_s_setprio(0); } while (0)
#define PG8_WAIT_V(n) asm volatile("s_waitcnt vmcnt(" #n ")" ::: "memory")
#define PG8_WAIT_L(n) asm volatile("s_waitcnt lgkmcnt(" #n ")" ::: "memory")
#define PG8_BAR __builtin_amdgcn_s_barrier()
#define PG8_SCHED __builtin_amdgcn_sched_barrier(0)
#define PG8_ACOL(pn) (ADIV ? (size_t)(((pn) / (ADIV ? ADIV : 1)) * ACOLS) * 2 : (size_t)0)
    Unit cur, nxt; int ui = 0;
    if (!S.next(0, cur)) return;
    f32x4 acc[2][2][4][2];
#pragma unroll
    for (int a = 0; a < 2; ++a)
#pragma unroll
        for (int b = 0; b < 2; ++b)
#pragma unroll
            for (int m = 0; m < 4; ++m)
#pragma unroll
                for (int n = 0; n < 2; ++n) acc[a][b][m][n] = (f32x4){0.f, 0.f, 0.f, 0.f};
    bf16x8 At[4][2], B0[2][2], B1[2][2];
    const char* cA = (const char*)g.A + (size_t)cur.pm * tstepA + PG8_ACOL(cur.pn) + (size_t)cur.kc * (K * 2); const char* cB = (const char*)g.Bt + (size_t)cur.pn * tstepB + (size_t)cur.kc * (K * 2);
    PG8_STAGE(PG8_SB(0, 0), cB, offB); PG8_STAGE(PG8_SB(0, 1), cB + hstepB, offB); PG8_STAGE(PG8_SA(0, 0), cA, offA); PG8_STAGE(PG8_SA(0, 1), cA + hstepA, offA);
    if (wr == 1) PG8_BAR;
    PG8_WAIT_V(2); PG8_BAR;
    PG8_STAGE(PG8_SB(1, 0), cB + kstep, offB); PG8_STAGE(PG8_SA(1, 0), cA + kstep, offA); PG8_STAGE(PG8_SB(1, 1), cB + hstepB + kstep, offB);
    PG8_WAIT_V(6); PG8_BAR;
    for (;;) {
        const bool has_next = S.next(ui + 1, nxt);
        const char* nA = has_next ? (const char*)g.A + (size_t)nxt.pm * tstepA + PG8_ACOL(nxt.pn) + (size_t)nxt.kc * (K * 2) : cA; const char* nB = has_next ? (const char*)g.Bt + (size_t)nxt.pn * tstepB + (size_t)nxt.kc * (K * 2) : cB;
#pragma unroll 1
        for (int t = 0; t < nt; t += 2) {
            const bool last = (t == nt - 2);
            const char* a1 = cA + (size_t)(t + 1) * kstep;
            const char* a2 = last ? nA : cA + (size_t)(t + 2) * kstep; const char* b2 = last ? nB : cB + (size_t)(t + 2) * kstep;
            const char* a3 = a2 + kstep; const char* b3 = b2 + kstep;
            PG8_LDB(B0, 0, 0); PG8_LDB(B1, 0, 1); PG8_SCHED; PG8_LDA(At, 0, 0); PG8_STAGE(PG8_SA(1, 1), a1 + hstepA, offA);
            PG8_WAIT_V(8); PG8_WAIT_L(0); PG8_BAR; PG8_MMA(0, 0, At, B0); PG8_MMA(0, 1, At, B1); PG8_BAR; PG8_SCHED;
            PG8_LDA(At, 0, 1); PG8_STAGE(PG8_SB(0, 0), b2, offB); PG8_STAGE(PG8_SB(0, 1), b2 + hstepB, offB); PG8_STAGE(PG8_SA(0, 0), a2, offA);
            PG8_WAIT_V(8); PG8_WAIT_L(0); PG8_BAR; PG8_MMA(1, 0, At, B0); PG8_MMA(1, 1, At, B1); PG8_BAR; PG8_SCHED;
            PG8_LDB(B0, 1, 0); PG8_LDB(B1, 1, 1); PG8_SCHED; PG8_LDA(At, 1, 0); PG8_STAGE(PG8_SA(0, 1), a2 + hstepA, offA);
            PG8_WAIT_V(8); PG8_WAIT_L(0); PG8_BAR; PG8_MMA(0, 0, At, B0); PG8_MMA(0, 1, At, B1); PG8_BAR; PG8_SCHED;
            PG8_LDA(At, 1, 1); PG8_STAGE(PG8_SB(1, 0), b3, offB); PG8_STAGE(PG8_SB(1, 1), b3 + hstepB, offB); PG8_STAGE(PG8_SA(1, 0), a3, offA);
            PG8_WAIT_V(8); PG8_WAIT_L(0); PG8_BAR; PG8_MMA(1, 0, At, B0); PG8_MMA(1, 1, At, B1); PG8_BAR; PG8_SCHED;
            if constexpr (MIDK > 0) {
                constexpr int seg = MIDK / BK; if (((t + 2) % seg) == 0 && t + 2 < nt) E.mid(acc, cur, wr, wc, fr, fq, (t + 2) / seg - 1); }
        }
        if constexpr (ALIGN_EPI) { if (wr == 0) PG8_BAR; }
        E(acc, cur, wr, wc, fr, fq);
        if (!has_next) break;
#pragma unroll
        for (int a = 0; a < 2; ++a)
#pragma unroll
            for (int b = 0; b < 2; ++b)
#pragma unroll
                for (int m = 0; m < 4; ++m)
#pragma unroll
                    for (int n = 0; n < 2; ++n) acc[a][b][m][n] = (f32x4){0.f, 0.f, 0.f, 0.f};
        cur = nxt; cA = nA; cB = nB; ++ui;
        if constexpr (ALIGN_EPI) { if (wr == 1) PG8_BAR; }
    }
    PG8_WAIT_V(0);
    if constexpr (!ALIGN_EPI) { if (wr == 0) PG8_BAR; }
    PG8_BAR;
#undef PG8_SA
#undef PG8_SB
#undef PG8_STAGE
#undef PG8_LDA
#undef PG8_LDB
#undef PG8_MMA
#undef PG8_WAIT_V
#undef PG8_WAIT_L
#undef PG8_BAR
#undef PG8_SCHED
#undef PG8_ACOL
}
}

#define GAS __attribute__((address_space(1)))
struct Args { GAS const float* in[26]; GAS float* out; GAS unsigned char* ws; };

struct Frame {
    LAS unsigned char* lds;
    int tid, lane, wave, G, bid, wave_s;
    const Args* a; GAS unsigned char* ws; GAS unsigned char* ws0;
};
constexpr int TIDTAB_OFF = 8 * 19456 + 64;
__device__ __forceinline__ int tid_from_lds(LAS unsigned char* lds, int wave_s) {
    int ln; asm volatile("v_mbcnt_lo_u32_b32 %0, -1, 0\n\tv_mbcnt_hi_u32_b32 %0, -1, %0" : "=v"(ln));
    const int t = *(const volatile LAS int*)(lds + TIDTAB_OFF + (wave_s * 64 + ln) * 4);
    __builtin_assume(t >= 0 && t < 512);
    return t;
}
#define FIN(i) ((const float*)(F.a->in[i]))
__device__ __forceinline__ void refresh(Frame& F) { const int t = tid_from_lds(F.lds, F.wave_s); F.tid = t; F.lane = t & 63; F.wave = __builtin_amdgcn_readfirstlane(t >> 6);
    GAS unsigned char* w = F.ws0; asm volatile("" : "+s"(w)); F.ws = w; }

__device__ __forceinline__ void transpose_item(const float* W, int ldw, int k0, int nsrc0, bf16_t* WT, int ldt, int drow0, int dcol0, int nrep, int drep, LAS float* scr, int lane) {
    float tv[32];
#pragma unroll
    for (int i = 0; i < 32; ++i) { const int kk = 2 * i + (lane >> 5); tv[i] = __builtin_nontemporal_load(W + (size_t)(k0 + kk) * ldw + nsrc0 + (lane & 31)); }
#pragma unroll
    for (int i = 0; i < 32; ++i) { const int kk = 2 * i + (lane >> 5); scr[kk * 33 + (lane & 31)] = tv[i]; }
    LDS_WAIT(); asm volatile("" ::: "memory");
    const int c = lane & 7;
#pragma unroll
    for (int j = 0; j < 4; ++j) { const int n = (lane >> 3) + 8 * j; const LAS float* s = scr + (8 * c) * 33 + n;
        u32x4 o; o.x = pk2(s[0 * 33], s[1 * 33]); o.y = pk2(s[2 * 33], s[3 * 33]); o.z = pk2(s[4 * 33], s[5 * 33]); o.w = pk2(s[6 * 33], s[7 * 33]);
        for (int r = 0; r < nrep; ++r) *(u32x4*)(WT + (size_t)(drow0 + n) * ldt + dcol0 + r * drep + k0 + 8 * c) = o; }
    LDS_WAIT(); asm volatile("" ::: "memory");
}
template <int PART>
__device__ __forceinline__ void convert_weights(Frame& F, int l, int b0 = 0, int nb = 0) {
    refresh(F);
    LAS float* scr = (LAS float*)(F.lds + F.wave * 16384);
    if (nb == 0) nb = F.G;
    if (F.bid < b0 || F.bid >= b0 + nb) return;
    const int gw = (F.bid - b0) * NWAVES + F.wave, NGW = nb * NWAVES;
    const float* w_in = FIN(6) + (size_t)l * DM * INC;
    const float* w_br = FIN(18) + (size_t)l * 4 * 256 * DM;
    const float* w_out = FIN(19) + (size_t)l * DM * DM;
    const float* w_up = FIN(22) + (size_t)l * DM * 2 * FFH;
    const float* w_dn = FIN(23) + (size_t)l * FFH * DM;
    bf16_t* WIN = (bf16_t*)(F.ws + WS_WIN); bf16_t* WBR = (bf16_t*)(F.ws + WS_WBR); bf16_t* WOUT = (bf16_t*)(F.ws + WS_WOUT);
    bf16_t* WUP = (bf16_t*)(F.ws + WS_WUP); bf16_t* WDN = (bf16_t*)(F.ws + WS_WDN);
    constexpr int I_IN = 16 * 240, I_BR = 4 * 4 * 32, I_OUT = 16 * 32, I_UP = 16 * 176, I_DN = 44 * 32;
    if (PART == 0) {
        for (int it = gw; it < I_IN + I_BR + I_OUT; it += NGW) {
            int r = it;
            if (r < I_IN) { const int kb = r / 240, nb = r % 240, d0 = nb * 32; const int s0 = d0 < 2304 ? d0 : d0 + 8;
                transpose_item(w_in, INC, kb * 64, s0, WIN, DM, d0, 0, 1, 0, scr, F.lane); continue; } r -= I_IN;
            if (r < I_BR) { const int n = r / 128, rr = r % 128, kb = rr / 32, nb = rr % 32;
                transpose_item(w_br + (size_t)n * 256 * DM, DM, kb * 64, nb * 32, WBR, DM, nb * 32, n * 256, 1, 0, scr, F.lane); continue; } r -= I_BR;
            { const int kb = r / 32, nb = r % 32; transpose_item(w_out, DM, kb * 64, nb * 32, WOUT, DM, nb * 32, 0, 1, 0, scr, F.lane); }
        }
    } else {
        for (int it = gw; it < I_UP + I_DN; it += NGW) {
            int r = it;
            if (r < I_UP) { const int kb = r / 176, nb = r % 176, d0 = nb * 32, tile = d0 >> 8, within = d0 & 255;
                const int s0 = within < 128 ? tile * 128 + within : FFH + tile * 128 + (within - 128);
                transpose_item(w_up, 2 * FFH, kb * 64, s0, WUP, DM, d0, 0, 1, 0, scr, F.lane); continue; } r -= I_UP;
            { const int kb = r / 32, nb = r % 32; transpose_item(w_dn, DM, kb * 64, nb * 32, WDN, FFH, nb * 32, 0, 1, 0, scr, F.lane); }
        }
    }
}

__device__ __forceinline__ void mods_phase(Frame& F) {
    refresh(F);
    LAS float* sil = (LAS float*)(F.lds);
    LAS float* part = sil + 5 * 1024;
    if (F.bid >= 192) return;
    const int l = F.bid / 96, cgp = F.bid % 96;
    for (int i = F.tid; i < 5 * 1024; i += NTHREADS) { const int r = i >> 10, k = i & 1023; const float cv = r < 4 ? FIN(1)[r * 1024 + k] : FIN(3)[k]; sil[i] = siluf_(cv); }
    __syncthreads();
    const float* aw = FIN(4) + (size_t)l * DM * 6144 + cgp * 64 + F.lane;
    float a0 = 0.f, a1 = 0.f, a2 = 0.f, a3 = 0.f, a4 = 0.f;
    const int kb = F.wave * 128;
#pragma unroll 32
    for (int k = 0; k < 128; ++k) { const float w = __builtin_nontemporal_load(aw + (size_t)(kb + k) * 6144);
        a0 += sil[kb + k] * w; a1 += sil[1024 + kb + k] * w; a2 += sil[2048 + kb + k] * w; a3 += sil[3072 + kb + k] * w; a4 += sil[4096 + kb + k] * w; }
    part[(F.wave * 5 + 0) * 64 + F.lane] = a0; part[(F.wave * 5 + 1) * 64 + F.lane] = a1; part[(F.wave * 5 + 2) * 64 + F.lane] = a2;
    part[(F.wave * 5 + 3) * 64 + F.lane] = a3; part[(F.wave * 5 + 4) * 64 + F.lane] = a4;
    __syncthreads();
    if (F.wave < 5) { float s = FIN(5)[l * 6144 + cgp * 64 + F.lane];
#pragma unroll
        for (int w = 0; w < 8; ++w) s += part[(w * 5 + F.wave) * 64 + F.lane];
        ((float*)(F.ws + WS_MODS))[(size_t)(l * 5 + F.wave) * 6144 + cgp * 64 + F.lane] = s; }
    __syncthreads();
}

struct RowOp {
    int nrows;
    const float* xlat_in; const float* xctx_in;
    bool post;
    const bf16_t* Y; const bf16_t* slabs; int nslab; int slab_row0;
    int gate_chunk; const float* lng; const float* lnb; const float* mods_post;
    float* xlat_out; float* xctx_out;
    bool domod;
    const float* mods_mod; int shift_chunk, scale_chunk; bf16_t* Hout;
    bool dodt; float* DTout;
};
__device__ __forceinline__ void row_pass(Frame& F, const RowOp& R, const float* w_in_l) {
    refresh(F);
    LAS float* wdt = (LAS float*)F.lds;
    if (R.dodt) {
        for (int i = F.tid; i < 8192; i += NTHREADS) { const int c = i >> 10, k = i & 1023; wdt[i] = w_in_l[(size_t)k * INC + 2304 + c]; }
    }
    __syncthreads();
    const int gw = F.bid * NWAVES + F.wave, NGW = F.G * NWAVES;
    const int m0 = gw, m1 = R.nrows;
    const int lane = F.lane;
    f32x4 lg[4], lb[4], gt4[4], sh4[4], sc4[4];
    if (R.post) {
#pragma unroll
        for (int j = 0; j < 4; ++j) { lg[j] = *(const f32x4*)(R.lng + 4 * (lane + 64 * j)); lb[j] = *(const f32x4*)(R.lnb + 4 * (lane + 64 * j)); }
    }
    int cur_r5 = -1;
    f32x4 xn[4]; u32x2 yn[4];
#define RP_LOAD(M) do { const int m_ = (M); const float* xr_ = m_ < MLAT ? R.xlat_in + (size_t)m_ * DM : R.xctx_in + (size_t)(m_ - MLAT) * DM; \
        _Pragma("unroll") for (int j = 0; j < 4; ++j) xn[j] = __builtin_nontemporal_load((const f32x4*)(xr_ + 4 * (lane + 64 * j))); \
        if (R.post && !(R.nslab > 0 && m_ >= R.slab_row0)) { const bf16_t* yr_ = R.Y + (size_t)m_ * DM; _Pragma("unroll") for (int j = 0; j < 4; ++j) yn[j] = __builtin_nontemporal_load((const u32x2*)(yr_ + 4 * (lane + 64 * j))); } } while (0)
    if (m0 < m1) RP_LOAD(m0);
#pragma unroll 1
    for (int m = m0; m < m1; m += NGW) {
        const int r5 = m < MLAT ? (m >> 12) : 4;
        if (r5 != cur_r5) { cur_r5 = r5;
            if (R.post) { const float* gt = R.mods_post + (size_t)r5 * 6144 + R.gate_chunk * 1024;
#pragma unroll
                for (int j = 0; j < 4; ++j) gt4[j] = *(const f32x4*)(gt + 4 * (lane + 64 * j)); }
            if (R.domod) { const float* sh = R.mods_mod + (size_t)r5 * 6144 + R.shift_chunk * 1024; const float* sc = R.mods_mod + (size_t)r5 * 6144 + R.scale_chunk * 1024;
#pragma unroll
                for (int j = 0; j < 4; ++j) { sh4[j] = *(const f32x4*)(sh + 4 * (lane + 64 * j)); sc4[j] = *(const f32x4*)(sc + 4 * (lane + 64 * j)); } }
        }
        f32x4 v[4]; u32x2 yv[4];
#pragma unroll
        for (int j = 0; j < 4; ++j) { v[j] = xn[j]; yv[j] = yn[j]; }
        const bool slabrow = R.post && R.nslab > 0 && m >= R.slab_row0;
        float ys[4][4];
        if (slabrow) {
#pragma unroll
            for (int j = 0; j < 4; ++j) { const int c = 4 * (lane + 64 * j); ys[j][0] = ys[j][1] = ys[j][2] = ys[j][3] = 0.f; const bf16_t* sp = R.slabs + (size_t)(m - R.slab_row0) * 1024 + c;
                for (int sidx = 0; sidx < R.nslab; ++sidx) { const u32x2 yw = *(const u32x2*)(sp + (size_t)sidx * (MALL - R.slab_row0) * 1024); ys[j][0] += bflo(yw.x); ys[j][1] += bfhi(yw.x); ys[j][2] += bflo(yw.y); ys[j][3] += bfhi(yw.y); } }
        }
        if (m + NGW < m1) RP_LOAD(m + NGW);
        if (R.post) {
#pragma unroll
            for (int j = 0; j < 4; ++j) { const f32x4 g4 = gt4[j];
                const float y0 = slabrow ? ys[j][0] : bflo(yv[j].x), y1 = slabrow ? ys[j][1] : bfhi(yv[j].x), y2 = slabrow ? ys[j][2] : bflo(yv[j].y), y3 = slabrow ? ys[j][3] : bfhi(yv[j].y);
                v[j].x = ALPHA * v[j].x + g4.x * y0; v[j].y = ALPHA * v[j].y + g4.y * y1;
                v[j].z = ALPHA * v[j].z + g4.z * y2; v[j].w = ALPHA * v[j].w + g4.w * y3; }
            float s = 0.f;
#pragma unroll
            for (int j = 0; j < 4; ++j) s += (v[j].x + v[j].y) + (v[j].z + v[j].w);
            const float mean = wave_sum(s) * (1.f / DM); float s2 = 0.f;
#pragma unroll
            for (int j = 0; j < 4; ++j) { v[j] = v[j] - mean; s2 += (v[j].x * v[j].x + v[j].y * v[j].y) + (v[j].z * v[j].z + v[j].w * v[j].w); }
            const float rstd = 1.f / sqrtf(wave_sum(s2) * (1.f / DM) + LN_EPS);
            float* xo = m < MLAT ? R.xlat_out + (size_t)m * DM : R.xctx_out + (size_t)(m - MLAT) * DM;
#pragma unroll
            for (int j = 0; j < 4; ++j) { const int c = 4 * (lane + 64 * j); v[j] = v[j] * rstd * lg[j] + lb[j]; __builtin_nontemporal_store(v[j], (f32x4*)(xo + c)); }
        }
        if (R.domod) {
            float s = 0.f;
#pragma unroll
            for (int j = 0; j < 4; ++j) s += (v[j].x + v[j].y) + (v[j].z + v[j].w);
            const float mean = wave_sum(s) * (1.f / DM); float s2 = 0.f;
#pragma unroll
            for (int j = 0; j < 4; ++j) { v[j] = v[j] - mean; s2 += (v[j].x * v[j].x + v[j].y * v[j].y) + (v[j].z * v[j].z + v[j].w * v[j].w); }
            const float rstd = 1.f / sqrtf(wave_sum(s2) * (1.f / DM) + LN_EPS);
            bf16_t* hr = R.Hout + (size_t)m * DM;
#pragma unroll
            for (int j = 0; j < 4; ++j) { const int c = 4 * (lane + 64 * j);
                v[j] = v[j] * rstd * (sc4[j] + 1.f) + sh4[j];
                u32x2 w; w.x = pk2(v[j].x, v[j].y); w.y = pk2(v[j].z, v[j].w); *(u32x2*)(hr + c) = w; }
            if (R.dodt) {
                float d[8];
#pragma unroll
                for (int c = 0; c < 8; ++c) { float a = 0.f;
                    asm volatile("" ::: "memory");
#pragma unroll
                    for (int j = 0; j < 4; ++j) { const f32x4 w4 = *(const LAS f32x4*)(wdt + c * 1024 + 4 * (lane + 64 * j)); a += (v[j].x * w4.x + v[j].y * w4.y) + (v[j].z * w4.z + v[j].w * w4.w); }
                    d[c] = wave_sum(a); }
                if (lane == 0) { *(f32x4*)(R.DTout + (size_t)m * 8) = (f32x4){d[0], d[1], d[2], d[3]}; *(f32x4*)(R.DTout + (size_t)m * 8 + 4) = (f32x4){d[4], d[5], d[6], d[7]}; }
            }
        }
    }
#undef RP_LOAD
    __syncthreads();
}

__device__ __forceinline__ void prep_phase(Frame& F, int l) {
    refresh(F);
    bf16_t* MIX = (bf16_t*)(F.ws + WS_RC);
    const float* qn = FIN(16) + l * 64; const float* kn = FIN(17) + l * 64;
    const int gt = F.bid * NTHREADS + F.tid, NGT = F.G * NTHREADS;
    for (int it = gt; it < MALL * 6; it += NGT) {
        const int m = it / 6, slot = it % 6;
        bf16_t* p = MIX + (size_t)m * NMIX + (slot < 4 ? C_DQ + 64 * slot : C_DK + 64 * (slot - 4));
        const float* nw = slot < 4 ? qn : kn;
        float x[64];
#pragma unroll
        for (int w = 0; w < 8; ++w) { const u32x4 u = *(const u32x4*)(p + 8 * w);
            x[8 * w + 0] = bflo(u.x); x[8 * w + 1] = bfhi(u.x); x[8 * w + 2] = bflo(u.y); x[8 * w + 3] = bfhi(u.y);
            x[8 * w + 4] = bflo(u.z); x[8 * w + 5] = bfhi(u.z); x[8 * w + 6] = bflo(u.w); x[8 * w + 7] = bfhi(u.w); }
        float ss = 0.f;
#pragma unroll
        for (int d = 0; d < 64; ++d) ss += x[d] * x[d];
        const float rs = 1.f / sqrtf(ss * (1.f / 64.f) + LN_EPS);
#pragma unroll
        for (int d = 0; d < 64; ++d) x[d] = x[d] * rs * nw[d];
        if (m < MLAT && slot < 4) {
#pragma unroll
            for (int d = 0; d < 64; ++d) x[d] *= 0.125f * 1.4426950408889634f; }
        if (m < MLAT) {
            const int t = m & 4095; const float prow = (float)(t >> 6), pcol = (float)(t & 63);
#pragma unroll
            for (int i = 0; i < 16; ++i) {
                const float inv = expf(-(float)i * (9.210340371976184f / 16.f));
                const float ar = prow * inv, ac = pcol * inv;
                const float sr = __sinf(ar), cr = __cosf(ar), sc = __sinf(ac), cc = __cosf(ac);
                const float a1 = x[i], a2 = x[16 + i]; x[i] = a1 * cr - a2 * sr; x[16 + i] = a2 * cr + a1 * sr;
                const float b1 = x[32 + i], b2 = x[48 + i]; x[32 + i] = b1 * cc - b2 * sc; x[48 + i] = b2 * cc + b1 * sc;
            }
        }
#pragma unroll
        for (int w = 0; w < 8; ++w) { u32x4 u; u.x = pk2(x[8 * w], x[8 * w + 1]); u.y = pk2(x[8 * w + 2], x[8 * w + 3]); u.z = pk2(x[8 * w + 4], x[8 * w + 5]); u.w = pk2(x[8 * w + 6], x[8 * w + 7]);
            *(u32x4*)(p + 8 * w) = u; }
    }
}

__device__ __forceinline__ void conv_to_lds(Frame& F, int l) {
    refresh(F);
    const bf16_t* MIX = (const bf16_t*)(F.ws + WS_RC);
    const float* cw = FIN(9) + (size_t)l * 5 * 768; const float* cb = FIN(10) + l * 768;
    LAS unsigned* cv = (LAS unsigned*)F.lds;
    if (F.tid < 384) {
        const int c = 2 * F.tid, r0 = 68 * F.bid;
        float w0[5], w1[5];
#pragma unroll
        for (int j = 0; j < 5; ++j) { w0[j] = cw[j * 768 + c]; w1[j] = cw[j * 768 + c + 1]; }
        const float b0 = cb[c], b1 = cb[c + 1];
        unsigned win[72];
#pragma unroll
        for (int j = 0; j < 72; ++j) { const int mm = r0 - 2 + j; win[j] = (mm >= 0 && mm < MALL) ? *(const unsigned*)(MIX + (size_t)mm * NMIX + C_BX + c) : 0u; }
#pragma unroll
        for (int r = 0; r < 68; ++r) {
            const int m = r0 + r;
            const int lo = m < MLAT ? (m & ~4095) : MLAT + ((m - MLAT) & ~255), hi = lo + (m < MLAT ? SEQ : CTXL);
            float a0 = b0, a1 = b1;
#pragma unroll
            for (int j = 0; j < 5; ++j) { const int mm = m + j - 2; const bool ok = (mm >= lo) && (mm < hi); a0 += ok ? w0[j] * bflo(win[r + j]) : 0.f; a1 += ok ? w1[j] * bfhi(win[r + j]) : 0.f; }
            cv[r * 384 + F.tid] = pk2(siluf_(a0), siluf_(a1));
        }
    }
}
__device__ __forceinline__ void conv_from_lds(Frame& F) {
    refresh(F);
    bf16_t* MIX = (bf16_t*)(F.ws + WS_RC);
    const LAS unsigned* cv = (const LAS unsigned*)F.lds;
    if (F.tid < 384) { const int r0 = 68 * F.bid;
        for (int r = 0; r < 68; ++r) *(unsigned*)(MIX + (size_t)(r0 + r) * NMIX + C_BX + 2 * F.tid) = cv[r * 384 + F.tid]; }
}

typedef short s16x4 __attribute__((ext_vector_type(4)));
typedef float f32x16 __attribute__((ext_vector_type(16)));
typedef float f32x2_t __attribute__((ext_vector_type(2))); typedef __bf16 bf16x2_t __attribute__((ext_vector_type(2)));
#define MFMA32(a, b, c) __builtin_amdgcn_mfma_f32_32x32x16_bf16((a), (b), (c), 0, 0, 0)
__device__ __forceinline__ unsigned cvtpk(float lo, float hi) { f32x2_t v = {lo, hi}; bf16x2_t b = __builtin_convertvector(v, bf16x2_t); return __builtin_bit_cast(unsigned, b); }
__device__ __forceinline__ int crow(int reg, int h) { return (reg & 3) + 8 * (reg >> 2) + 4 * h; }
template <int S_> __device__ __forceinline__ bf16x8 pack8(const f32x16& x) {
    u32x4 p; p.x = cvtpk(x[8 * S_], x[8 * S_ + 1]); p.y = cvtpk(x[8 * S_ + 2], x[8 * S_ + 3]); p.z = cvtpk(x[8 * S_ + 4], x[8 * S_ + 5]); p.w = cvtpk(x[8 * S_ + 6], x[8 * S_ + 7]);
    return __builtin_bit_cast(bf16x8, p);
}
__device__ __forceinline__ bf16x8 ld_row8(const LAS unsigned char* tb, int P, int r, int c0) { return *(const LAS bf16x8*)(tb + r * P + c0 * 2); }
__device__ __forceinline__ bf16x8 ld_row8_perm(const LAS unsigned char* tb, int P, int r, int c0, int h) {
    const s16x4 lo = *(const LAS s16x4*)(tb + r * P + (c0 + 4 * h) * 2), hi = *(const LAS s16x4*)(tb + r * P + (c0 + 8 + 4 * h) * 2);
    return __builtin_shufflevector(lo, hi, 0, 1, 2, 3, 4, 5, 6, 7);
}
__device__ __forceinline__ s16x4 tr4(const LAS unsigned char* tb, int P, int row0, int col0, int lane) {
    const int q = (lane & 15) >> 2, p = lane & 3, blk = (lane >> 4) & 1;
    return __builtin_bit_cast(s16x4, __builtin_amdgcn_ds_read_tr16_b64_v4i16((LAS s16x4*)(tb + (row0 + q) * P + (col0 + 16 * blk + 4 * p) * 2)));
}
__device__ __forceinline__ bf16x8 ld_tr8(const LAS unsigned char* tb, int P, int row_lo, int row_hi, int col0, int lane) {
    const s16x4 lo = tr4(tb, P, row_lo, col0, lane), hi = tr4(tb, P, row_hi, col0, lane);
    return __builtin_shufflevector(lo, hi, 0, 1, 2, 3, 4, 5, 6, 7);
}
__device__ __forceinline__ float bperm_(float v, int src_lane) { return __int_as_float(__builtin_amdgcn_ds_bpermute(src_lane * 4, __float_as_int(v))); }
__device__ __forceinline__ float softplusf_(float x) { return fmaxf(x, 0.f) + __logf(1.f + __expf(-fabsf(x))); }
constexpr int NCH = 17;
constexpr int TP64 = 144, TP32 = 80;

template <int NC> __device__ __forceinline__ void stage_tile(LAS unsigned char* tb, const bf16_t* MIX, int R0, int dir, int I, int col, int lane) {
    constexpr int CPR = NC / 8, NP = 32 * CPR / 64, P = NC == 64 ? TP64 : TP32;
#pragma unroll
    for (int t = 0; t < NP; ++t) { const int id = lane + 64 * t, r = id / CPR, ck = id % CPR; const int i = 32 * I + r; const int m = dir ? R0 + 255 - i : R0 + i;
        *(LAS u32x4*)(tb + r * P + ck * 16) = *(const u32x4*)(MIX + (size_t)m * NMIX + col + ck * 8); }
}

template <int NC> __device__ __forceinline__ void tile_load(u32x4 (&rg)[NC / 16], const bf16_t* MIX, int R0, int dir, int I, int col, int lane) {
    constexpr int CPR = NC / 8, NP = NC / 16;
#pragma unroll
    for (int t = 0; t < NP; ++t) { const int id = lane + 64 * t, r = id / CPR, ck = id % CPR; const int i = 32 * I + r; const int m = dir ? R0 + 255 - i : R0 + i;
        const unsigned off = (unsigned)m * (unsigned)(NMIX * 2) + (unsigned)((col + ck * 8) * 2);
        rg[t] = *(const u32x4*)((const char*)MIX + off); }
}
template <int NC> __device__ __forceinline__ void tile_store(LAS unsigned char* tb, const u32x4 (&rg)[NC / 16], int lane) {
    constexpr int CPR = NC / 8, NP = NC / 16, P = NC == 64 ? TP64 : TP32;
#pragma unroll
    for (int t = 0; t < NP; ++t) { const int id = lane + 64 * t, r = id / CPR, ck = id % CPR; *(LAS u32x4*)(tb + r * P + ck * 16) = rg[t]; }
}

template <bool PASS_C>
__device__ __forceinline__ void hgrn_task(Frame& F, int l, int seq, int pc, bf16_t* OUT, int ldo) {
    const bf16_t* MIX = (const bf16_t*)(F.ws + WS_RC);
    const int lane_ = tid_from_lds(F.lds, F.wave_s) & 63;
    const int lane = lane_, h = lane >> 5, c31 = lane & 31;
    const int dir = seq >> 4, b = (seq >> 2) & 3, head = seq & 3;
    LAS unsigned char* wl = F.lds + F.wave * WLDS;
    LAS unsigned char* TQ = wl; LAS unsigned char* TK = wl + 4608; LAS unsigned char* TH = wl + 9216; LAS unsigned char* TV = wl + 13824; LAS float* Dv = (LAS float*)(wl + 18432);
    const int R0 = pc == 0 ? MLAT + b * CTXL : b * SEQ + (dir ? 16 - pc : pc - 1) * 256;
    const int fcol = (dir ? C_AFB : C_AFF) + head * 64;
    bf16_t* ST = (bf16_t*)(F.ws + WS_STA) + ((size_t)seq * NCH + pc) * 4096;
    f32x16 S[2][2];
#pragma unroll
    for (int kb = 0; kb < 2; ++kb)
#pragma unroll
        for (int vb = 0; vb < 2; ++vb) {
            if (PASS_C) {
#pragma unroll
                for (int q4 = 0; q4 < 2; ++q4) { const u32x4 w = *(const u32x4*)(ST + lane * 64 + (kb * 2 + vb) * 16 + q4 * 8);
                    S[kb][vb][8 * q4 + 0] = bflo(w.x); S[kb][vb][8 * q4 + 1] = bfhi(w.x); S[kb][vb][8 * q4 + 2] = bflo(w.y); S[kb][vb][8 * q4 + 3] = bfhi(w.y);
                    S[kb][vb][8 * q4 + 4] = bflo(w.z); S[kb][vb][8 * q4 + 5] = bfhi(w.z); S[kb][vb][8 * q4 + 6] = bflo(w.w); S[kb][vb][8 * q4 + 7] = bfhi(w.w); }
            } else {
#pragma unroll
                for (int reg = 0; reg < 16; ++reg) S[kb][vb][reg] = 0.f; } }
    float gtot = 0.f;
    u32x4 pg[4], pq[4], pv[4];
    tile_load<64>(pg, MIX, R0, dir, 0, fcol, lane); if (PASS_C) tile_load<64>(pq, MIX, R0, dir, 0, C_AQ + head * 64, lane); tile_load<64>(pv, MIX, R0, dir, 0, C_AV + head * 64, lane);
#pragma unroll 1
    for (int I = 0; I < 8; ++I) {
        tile_store<64>(TH, pg, lane); if (PASS_C) tile_store<64>(TQ, pq, lane); tile_store<64>(TV, pv, lane);
        LDS_WAIT();
        if (I + 1 < 8) { tile_load<64>(pg, MIX, R0, dir, I + 1, fcol, lane); if (PASS_C) tile_load<64>(pq, MIX, R0, dir, I + 1, C_AQ + head * 64, lane); tile_load<64>(pv, MIX, R0, dir, I + 1, C_AV + head * 64, lane); }
        float br[32], kkv[32];
        float run = 0.f;
#pragma unroll
        for (int r = 0; r < 32; ++r) {
            if ((r & 7) == 0) asm volatile("" ::: "memory");
            const float g2 = bf2f(*(const LAS bf16_t*)(TH + r * TP64 + lane * 2));
            run += g2; br[r] = run; const float kk = 1.f - __builtin_amdgcn_exp2f(g2); kkv[r] = kk;
            if (PASS_C) { const float e = __builtin_amdgcn_exp2f(fmaxf(run, -120.f)); const float q = bf2f(*(const LAS bf16_t*)(TQ + r * TP64 + lane * 2));
                const unsigned w = cvtpk(q * e, kk * __builtin_amdgcn_rcpf(e));
                *(LAS bf16_t*)(TQ + r * TP64 + lane * 2) = (bf16_t)w; *(LAS bf16_t*)(TK + r * TP64 + lane * 2) = (bf16_t)(w >> 16); }
        }
        const float total = run; gtot += total;
#pragma unroll
        for (int r = 0; r < 32; r += 2) { const unsigned w = cvtpk(kkv[r] * __builtin_amdgcn_exp2f(total - br[r]), kkv[r + 1] * __builtin_amdgcn_exp2f(total - br[r + 1]));
            *(LAS bf16_t*)(TH + r * TP64 + lane * 2) = (bf16_t)w; *(LAS bf16_t*)(TH + (r + 1) * TP64 + lane * 2) = (bf16_t)(w >> 16); }
        Dv[lane] = __builtin_amdgcn_exp2f(total);
        LDS_WAIT();
        if (PASS_C) {
            f32x16 P;
#pragma unroll
            for (int reg = 0; reg < 16; ++reg) P[reg] = 0.f;
#pragma unroll
            for (int s = 0; s < 4; ++s) P = MFMA32(ld_row8(TK, TP64, c31, 16 * s + 8 * h), ld_row8(TQ, TP64, c31, 16 * s + 8 * h), P);
#pragma unroll
            for (int reg = 0; reg < 16; ++reg) if (crow(reg, h) > c31) P[reg] = 0.f;
            const bf16x8 pa0 = pack8<0>(P), pa1 = pack8<1>(P);
#pragma unroll
            for (int vb = 0; vb < 2; ++vb) {
                f32x16 o;
#pragma unroll
                for (int reg = 0; reg < 16; ++reg) o[reg] = 0.f;
                o = MFMA32(pa0, ld_tr8(TV, TP64, 4 * h, 8 + 4 * h, 32 * vb, lane), o);
                o = MFMA32(pa1, ld_tr8(TV, TP64, 16 + 4 * h, 24 + 4 * h, 32 * vb, lane), o);
#pragma unroll
                for (int kb = 0; kb < 2; ++kb) {
                    o = MFMA32(ld_row8_perm(TQ, TP64, c31, 32 * kb, h), pack8<0>(S[kb][vb]), o);
                    o = MFMA32(ld_row8_perm(TQ, TP64, c31, 32 * kb + 16, h), pack8<1>(S[kb][vb]), o);
                }
#pragma unroll
                for (int reg = 0; reg < 16; reg += 2) { const unsigned w0 = cvtpk(o[reg], o[reg + 1]);
                    *(LAS bf16_t*)(TK + crow(reg, h) * TP64 + (32 * vb + c31) * 2) = (bf16_t)w0; *(LAS bf16_t*)(TK + crow(reg + 1, h) * TP64 + (32 * vb + c31) * 2) = (bf16_t)(w0 >> 16); }
            }
            LDS_WAIT();
#pragma unroll
            for (int t = 0; t < 4; ++t) { const int id = lane + 64 * t, r = id >> 3, ck = id & 7; const int i = 32 * I + r; const int m = dir ? R0 + 255 - i : R0 + i;
                __builtin_nontemporal_store(*(const LAS u32x4*)(TK + r * TP64 + ck * 16), (u32x4*)((char*)OUT + ((unsigned)m * (unsigned)ldo + (unsigned)(head * 64 + ck * 8)) * 2u)); }
        }
#pragma unroll
        for (int kb = 0; kb < 2; ++kb) {
            float dr[16];
#pragma unroll
            for (int g = 0; g < 4; ++g) { const f32x4 d4 = *(const LAS f32x4*)(Dv + 32 * kb + 8 * g + 4 * h); dr[4 * g] = d4.x; dr[4 * g + 1] = d4.y; dr[4 * g + 2] = d4.z; dr[4 * g + 3] = d4.w; }
#pragma unroll
            for (int vb = 0; vb < 2; ++vb)
#pragma unroll
                for (int reg = 0; reg < 16; ++reg) S[kb][vb][reg] *= dr[reg];
#pragma unroll
            for (int s = 0; s < 2; ++s) { const bf16x8 a = ld_tr8(TH, TP64, 16 * s + 8 * h, 16 * s + 8 * h + 4, 32 * kb, lane);
#pragma unroll
                for (int vb = 0; vb < 2; ++vb) S[kb][vb] = MFMA32(a, ld_tr8(TV, TP64, 16 * s + 8 * h, 16 * s + 8 * h + 4, 32 * vb, lane), S[kb][vb]); }
        }
        LDS_WAIT();
    }
    if (!PASS_C) {
#pragma unroll
        for (int kb = 0; kb < 2; ++kb)
#pragma unroll
            for (int vb = 0; vb < 2; ++vb)
#pragma unroll
                for (int q4 = 0; q4 < 2; ++q4) { const f32x16& T = S[kb][vb]; u32x4 w; w.x = cvtpk(T[8 * q4], T[8 * q4 + 1]); w.y = cvtpk(T[8 * q4 + 2], T[8 * q4 + 3]); w.z = cvtpk(T[8 * q4 + 4], T[8 * q4 + 5]); w.w = cvtpk(T[8 * q4 + 6], T[8 * q4 + 7]);
                    *(u32x4*)(ST + lane * 64 + (kb * 2 + vb) * 16 + q4 * 8) = w; }
        ((float*)(F.ws + WS_DLA))[((size_t)seq * NCH + pc) * 64 + lane] = gtot;
    }
}

template <bool PASS_C>
__device__ __forceinline__ void ssd_task(Frame& F, int l, int seq2, int pc, bf16_t* OUT, int ldo) {
    const bf16_t* MIX = (const bf16_t*)(F.ws + WS_RC);
    const float* DT = (const float*)(F.ws + WS_DT);
    const int lane_ = tid_from_lds(F.lds, F.wave_s) & 63;
    const int lane = lane_, h = lane >> 5, c31 = lane & 31;
    const int seq = seq2 >> 1, vb = seq2 & 1, dir = seq >> 4, b = (seq >> 2) & 3, head = seq & 3, g = head >> 1;
    LAS unsigned char* wl = F.lds + F.wave * WLDS;
    LAS unsigned char* TC = wl; LAS unsigned char* TB = wl + 4608; LAS unsigned char* TX = wl + 9216; LAS unsigned char* TXh = wl + 11776;
    LAS float* brn = (LAS float*)(wl + 18432); LAS float* dtv = brn + 32;
    const int R0 = pc == 0 ? MLAT + b * CTXL : b * SEQ + (dir ? 16 - pc : pc - 1) * 256;
    const float Aneg = -expf(FIN(12)[(l * 2 + dir) * 4 + head]); const float dtb = FIN(11)[(l * 2 + dir) * 4 + head];
    bf16_t* ST = (bf16_t*)(F.ws + WS_STB) + ((size_t)seq2 * NCH + pc) * 4096;
    f32x16 S[4];
#pragma unroll
    for (int kb = 0; kb < 4; ++kb) {
        if (PASS_C) {
#pragma unroll
            for (int q4 = 0; q4 < 2; ++q4) { const u32x4 w = *(const u32x4*)(ST + lane * 64 + kb * 16 + q4 * 8);
                S[kb][8 * q4 + 0] = bflo(w.x); S[kb][8 * q4 + 1] = bfhi(w.x); S[kb][8 * q4 + 2] = bflo(w.y); S[kb][8 * q4 + 3] = bfhi(w.y);
                S[kb][8 * q4 + 4] = bflo(w.z); S[kb][8 * q4 + 5] = bfhi(w.z); S[kb][8 * q4 + 6] = bflo(w.w); S[kb][8 * q4 + 7] = bfhi(w.w); }
        } else {
#pragma unroll
            for (int reg = 0; reg < 16; ++reg) S[kb][reg] = 0.f; } }
    float gtot = 0.f;
    u32x4 pxx[2], pcq[4], pbb[4]; float dtraw;
    const int xcol = C_BX + head * 64 + vb * 32, ccol = C_BC + g * 128, bcol = C_BB + g * 128;
    { const int i_o = c31; const int m_o = dir ? R0 + 255 - i_o : R0 + i_o; dtraw = DT[(size_t)m_o * 8 + dir * 4 + head]; }
    if (PASS_C) tile_load<64>(pcq, MIX, R0, dir, 0, ccol, lane); tile_load<64>(pbb, MIX, R0, dir, 0, bcol, lane);
#pragma unroll 1
    for (int I = 0; I < 8; ++I) {
        tile_load<32>(pxx, MIX, R0, dir, I, xcol, lane);
        const float dt = softplusf_(dtraw + dtb);
        float run = dt * Aneg;
#pragma unroll
        for (int off = 1; off < 32; off <<= 1) { const float t = bperm_(run, (lane - off) & 63); if (c31 >= off) run += t; }
        const float total = bperm_(run, (lane & 32) | 31); gtot += total;
        const float wown = dt * __expf(total - run);
        if (lane < 32) { brn[c31] = run; dtv[c31] = dt; }
        tile_store<32>(TX, pxx, lane);
#pragma unroll
        for (int t = 0; t < 2; ++t) { const int id = lane + 64 * t, r = id >> 2, ck = id & 3;
            const u32x4 x4 = pxx[t];
            const float w = bperm_(wown, r);
            u32x4 y; y.x = cvtpk(bflo(x4.x) * w, bfhi(x4.x) * w); y.y = cvtpk(bflo(x4.y) * w, bfhi(x4.y) * w); y.z = cvtpk(bflo(x4.z) * w, bfhi(x4.z) * w); y.w = cvtpk(bflo(x4.w) * w, bfhi(x4.w) * w);
            *(LAS u32x4*)(TXh + r * TP32 + ck * 16) = y; }
        const float dsub = __expf(total);
        f32x16 P, oi;
#pragma unroll
        for (int reg = 0; reg < 16; ++reg) { P[reg] = 0.f; oi[reg] = 0.f; }
#pragma unroll
        for (int nh = 0; nh < 2; ++nh) {
            if (PASS_C) tile_store<64>(TC, pcq, lane);
            tile_store<64>(TB, pbb, lane);
            LDS_WAIT();
            if (nh == 0) { if (PASS_C) tile_load<64>(pcq, MIX, R0, dir, I, ccol + 64, lane); tile_load<64>(pbb, MIX, R0, dir, I, bcol + 64, lane); }
            else if (I + 1 < 8) { if (PASS_C) tile_load<64>(pcq, MIX, R0, dir, I + 1, ccol, lane); tile_load<64>(pbb, MIX, R0, dir, I + 1, bcol, lane);
                const int i_o = 32 * (I + 1) + c31; const int m_o = dir ? R0 + 255 - i_o : R0 + i_o; dtraw = DT[(size_t)m_o * 8 + dir * 4 + head]; }
            if (PASS_C) {
#pragma unroll
                for (int s = 0; s < 4; ++s) P = MFMA32(ld_row8(TB, TP64, c31, 16 * s + 8 * h), ld_row8(TC, TP64, c31, 16 * s + 8 * h), P);
#pragma unroll
                for (int kk = 0; kk < 2; ++kk) {
                    oi = MFMA32(ld_row8_perm(TC, TP64, c31, 32 * kk, h), pack8<0>(S[2 * nh + kk]), oi);
                    oi = MFMA32(ld_row8_perm(TC, TP64, c31, 32 * kk + 16, h), pack8<1>(S[2 * nh + kk]), oi);
                }
            }
#pragma unroll
            for (int kk = 0; kk < 2; ++kk) {
#pragma unroll
                for (int reg = 0; reg < 16; ++reg) S[2 * nh + kk][reg] *= dsub;
#pragma unroll
                for (int s = 0; s < 2; ++s)
                    S[2 * nh + kk] = MFMA32(ld_tr8(TB, TP64, 16 * s + 8 * h, 16 * s + 8 * h + 4, 32 * kk, lane), ld_tr8(TXh, TP32, 16 * s + 8 * h, 16 * s + 8 * h + 4, 0, lane), S[2 * nh + kk]);
            }
            LDS_WAIT();
        }
        if (PASS_C) {
            float bj[16], dj[16];
#pragma unroll
            for (int gq = 0; gq < 4; ++gq) { const f32x4 b4 = *(const LAS f32x4*)(brn + 8 * gq + 4 * h), d4 = *(const LAS f32x4*)(dtv + 8 * gq + 4 * h);
                bj[4 * gq] = b4.x; bj[4 * gq + 1] = b4.y; bj[4 * gq + 2] = b4.z; bj[4 * gq + 3] = b4.w; dj[4 * gq] = d4.x; dj[4 * gq + 1] = d4.y; dj[4 * gq + 2] = d4.z; dj[4 * gq + 3] = d4.w; }
#pragma unroll
            for (int reg = 0; reg < 16; ++reg) P[reg] = (crow(reg, h) <= c31) ? P[reg] * dj[reg] * __expf(run - bj[reg]) : 0.f;
#pragma unroll
            for (int reg = 0; reg < 16; ++reg) oi[reg] = oi[reg] * __expf(bj[reg]);
            oi = MFMA32(pack8<0>(P), ld_tr8(TX, TP32, 4 * h, 8 + 4 * h, 0, lane), oi);
            oi = MFMA32(pack8<1>(P), ld_tr8(TX, TP32, 16 + 4 * h, 24 + 4 * h, 0, lane), oi);
#pragma unroll
            for (int reg = 0; reg < 16; reg += 2) { const unsigned w0 = cvtpk(oi[reg], oi[reg + 1]);
                *(LAS bf16_t*)(TXh + crow(reg, h) * TP32 + c31 * 2) = (bf16_t)w0; *(LAS bf16_t*)(TXh + crow(reg + 1, h) * TP32 + c31 * 2) = (bf16_t)(w0 >> 16); }
            LDS_WAIT();
#pragma unroll
            for (int t = 0; t < 2; ++t) { const int id = lane + 64 * t, r = id >> 2, ck = id & 3; const int i = 32 * I + r; const int m = dir ? R0 + 255 - i : R0 + i;
                __builtin_nontemporal_store(*(const LAS u32x4*)(TXh + r * TP32 + ck * 16), (u32x4*)((char*)OUT + ((unsigned)m * (unsigned)ldo + (unsigned)(head * 64 + 32 * vb + ck * 8)) * 2u)); }
        }
        LDS_WAIT();
    }
    if (!PASS_C) {
#pragma unroll
        for (int kb = 0; kb < 4; ++kb)
#pragma unroll
            for (int q4 = 0; q4 < 2; ++q4) { const f32x16& T = S[kb]; u32x4 w; w.x = cvtpk(T[8 * q4], T[8 * q4 + 1]); w.y = cvtpk(T[8 * q4 + 2], T[8 * q4 + 3]); w.z = cvtpk(T[8 * q4 + 4], T[8 * q4 + 5]); w.w = cvtpk(T[8 * q4 + 6], T[8 * q4 + 7]);
                *(u32x4*)(ST + lane * 64 + kb * 16 + q4 * 8) = w; }
        if (vb == 0 && lane == 0) ((float*)(F.ws + WS_DLB))[seq * NCH + pc] = gtot;
    }
}

constexpr int NA_GQA = 2048, NA_NA = 2048, NA_CTX = 256;
template <int TYPE> __device__ __forceinline__ void attn_task(Frame& F, int l, int u, bf16_t* BR) {
    const bf16_t* MIX = (const bf16_t*)(F.ws + WS_RC);
    const int lane_ = tid_from_lds(F.lds, F.wave_s) & 63;
    const int lane = lane_, h = lane >> 5, c31 = lane & 31;
    LAS unsigned char* wl = F.lds + F.wave * WLDS; LAS unsigned char* TV = wl; LAS float* al = (LAS float*)(wl + 4608);
    int qrow0, qcol, kcol, vcol, ocol, b, ntiles, r = 0, c0 = 0, hh = 0;
    if (TYPE == 0) { b = u >> 9; const int hq = (u >> 7) & 3, tb = u & 127; qrow0 = b * SEQ + tb * 32; qcol = C_DQ + hq * 64; kcol = C_DK + (hq >> 1) * 64; vcol = C_DV + (hq >> 1) * 64; ocol = 768 + hq * 64; ntiles = 8 + 128; }
    else if (TYPE == 1) { b = u >> 9; hh = (u >> 7) & 3; r = (u >> 1) & 63; c0 = (u & 1) * 32; qrow0 = b * SEQ + r * 64 + c0; qcol = C_CQ + hh * 64; kcol = C_CK + hh * 64; vcol = C_CV + hh * 64; ocol = 512 + hh * 64; ntiles = 8 + 16; }
    else { b = u >> 6; const int h8 = (u >> 3) & 7, tb = u & 7; qrow0 = MLAT + b * CTXL + tb * 32; ntiles = 8;
        if (h8 < 4) { qcol = C_CQ + h8 * 64; kcol = C_CK + h8 * 64; vcol = C_CV + h8 * 64; ocol = 512 + h8 * 64; } else { const int hq = h8 - 4; qcol = C_DQ + hq * 64; kcol = C_DK + (hq >> 1) * 64; vcol = C_DV + (hq >> 1) * 64; ocol = 768 + hq * 64; } }
    const int rs = min(max(r - 4, 0), 56);
    const float* rpb = FIN(15) + (size_t)(l * 4 + hh) * 15 * 31;
    const int cq = c0 + c31, cs = min(max(cq - 8, 0), 48);
#define TILE_ROW(t) ((t) < 8 ? MLAT + b * CTXL + 32 * (t) : (TYPE == 1 ? b * SEQ + (rs + (((t) - 8) >> 1)) * 64 + 32 * (((t) - 8) & 1) : b * SEQ + 32 * ((t) - 8)))
    bf16x8 qf[4];
#pragma unroll
    for (int s = 0; s < 4; ++s) qf[s] = *(const bf16x8*)(MIX + (size_t)(qrow0 + c31) * NMIX + qcol + 16 * s + 8 * h);
    f32x16 O0, O1;
#pragma unroll
    for (int reg = 0; reg < 16; ++reg) { O0[reg] = 0.f; O1[reg] = 0.f; }
    float m_run = -1e30f, l_run = 0.f;
    bf16x8 kf[4]; u32x4 vr[4];
    { const int kr0 = TILE_ROW(0);
#pragma unroll
      for (int s = 0; s < 4; ++s) kf[s] = *(const bf16x8*)(MIX + (size_t)(kr0 + c31) * NMIX + kcol + 16 * s + 8 * h);
#pragma unroll
      for (int t4 = 0; t4 < 4; ++t4) { const int id = lane + 64 * t4; vr[t4] = *(const u32x4*)(MIX + (size_t)(kr0 + (id >> 3)) * NMIX + vcol + (id & 7) * 8); } }
#pragma unroll 1
    for (int t = 0; t < ntiles; ++t) {
#pragma unroll
        for (int t4 = 0; t4 < 4; ++t4) { const int id = lane + 64 * t4; *(LAS u32x4*)(TV + (id >> 3) * TP64 + (id & 7) * 16) = vr[t4]; }
        asm volatile("" ::: "memory");
        f32x16 S;
#pragma unroll
        for (int reg = 0; reg < 16; ++reg) S[reg] = 0.f;
#pragma unroll
        for (int s = 0; s < 4; ++s) S = MFMA32(kf[s], qf[s], S);
        if (t + 1 < ntiles) { const int kr1 = TILE_ROW(t + 1);
#pragma unroll
            for (int s = 0; s < 4; ++s) kf[s] = *(const bf16x8*)(MIX + (size_t)(kr1 + c31) * NMIX + kcol + 16 * s + 8 * h);
#pragma unroll
            for (int t4 = 0; t4 < 4; ++t4) { const int id = lane + 64 * t4; vr[t4] = *(const u32x4*)(MIX + (size_t)(kr1 + (id >> 3)) * NMIX + vcol + (id & 7) * 8); } }
        if (TYPE == 1 && t >= 8) {
            const int kr = rs + ((t - 8) >> 1), kc0 = 32 * ((t - 8) & 1); const float* rb = rpb + (kr - r + 7) * 31 + (15 - cq);
#pragma unroll
            for (int reg = 0; reg < 16; ++reg) { const int kc = kc0 + crow(reg, h); const bool ok = (kc >= cs) && (kc < cs + 16);
                const float bias = ok ? rb[kc] : 0.f; S[reg] = ok ? S[reg] * 0.125f + bias : -1e30f; }
        } else {
#pragma unroll
            for (int reg = 0; reg < 16; ++reg) S[reg] *= 0.125f;
        }
        float mloc = fmaxf(fmaxf(fmaxf(S[0], S[1]), fmaxf(S[2], S[3])), fmaxf(fmaxf(S[4], S[5]), fmaxf(S[6], S[7])));
        mloc = fmaxf(mloc, fmaxf(fmaxf(fmaxf(S[8], S[9]), fmaxf(S[10], S[11])), fmaxf(fmaxf(S[12], S[13]), fmaxf(S[14], S[15]))));
        mloc = fmaxf(mloc, bperm_(mloc, lane ^ 32));
        const float m_new = fmaxf(m_run, mloc);
        const float alpha = __expf(m_run - m_new);
        m_run = m_new;
        float ls = 0.f;
#pragma unroll
        for (int reg = 0; reg < 16; ++reg) { const float p = __expf(S[reg] - m_new); ls += p; S[reg] = p; }
        l_run = l_run * alpha + ls;
        if (lane < 32) al[c31] = alpha;
        LDS_WAIT();
        const bf16x8 pa0 = pack8<0>(S), pa1 = pack8<1>(S);
        {
#pragma unroll
            for (int g = 0; g < 4; ++g) { const f32x4 a4 = *(const LAS f32x4*)(al + 8 * g + 4 * h);
                O0[4 * g] *= a4.x; O0[4 * g + 1] *= a4.y; O0[4 * g + 2] *= a4.z; O0[4 * g + 3] *= a4.w;
                O1[4 * g] *= a4.x; O1[4 * g + 1] *= a4.y; O1[4 * g + 2] *= a4.z; O1[4 * g + 3] *= a4.w; }
        }
        O0 = MFMA32(pa0, ld_tr8(TV, TP64, 4 * h, 8 + 4 * h, 0, lane), O0);
        O0 = MFMA32(pa1, ld_tr8(TV, TP64, 16 + 4 * h, 24 + 4 * h, 0, lane), O0);
        O1 = MFMA32(pa0, ld_tr8(TV, TP64, 4 * h, 8 + 4 * h, 32, lane), O1);
        O1 = MFMA32(pa1, ld_tr8(TV, TP64, 16 + 4 * h, 24 + 4 * h, 32, lane), O1);
    }
#undef TILE_ROW
    l_run += bperm_(l_run, lane ^ 32);
    if (lane < 32) al[c31] = 1.f / l_run;
    LDS_WAIT();
#pragma unroll
    for (int g = 0; g < 4; ++g) { const f32x4 a4 = *(const LAS f32x4*)(al + 8 * g + 4 * h);
        O0[4 * g] *= a4.x; O0[4 * g + 1] *= a4.y; O0[4 * g + 2] *= a4.z; O0[4 * g + 3] *= a4.w;
        O1[4 * g] *= a4.x; O1[4 * g + 1] *= a4.y; O1[4 * g + 2] *= a4.z; O1[4 * g + 3] *= a4.w; }
#pragma unroll
    for (int reg = 0; reg < 16; ++reg) { bf16_t* op = BR + (size_t)(qrow0 + crow(reg, h)) * DM + ocol + c31; op[0] = (bf16_t)f2bf(O0[reg]); op[32] = (bf16_t)f2bf(O1[reg]); }
    LDS_WAIT();
}

constexpr int AB_TILE = 9216;
constexpr int AB_AL = 4 * AB_TILE;
template <int TYPE>
__device__ __forceinline__ void attn_block_task(Frame& F, int l, int u, bf16_t* BR) {
    const bf16_t* MIX = (const bf16_t*)(F.ws + WS_RC);
    const int lane_ = tid_from_lds(F.lds, F.wave_s) & 63;
    const int lane = lane_, h = lane >> 5, c31 = lane & 31, tid = F.wave * 64 + lane;
    int b, qrow0, qcol, kcol, vcol, ocol, ntile, r = 0, c0 = 0, hh = 0, r0 = 0;
    if (TYPE == 0) { b = u >> 6; const int hq = (u >> 4) & 3, qblk = u & 15; qrow0 = b * SEQ + qblk * 256 + F.wave * 32; qcol = C_DQ + hq * 64; kcol = C_DK + (hq >> 1) * 64; vcol = C_DV + (hq >> 1) * 64; ocol = 768 + hq * 64; ntile = 4 + 64; }
    else { b = u >> 6; hh = (u >> 4) & 3; r0 = (u & 15) * 4; r = r0 + (F.wave >> 1); c0 = (F.wave & 1) * 32; qrow0 = b * SEQ + r * 64 + c0; qcol = C_CQ + hh * 64; kcol = C_CK + hh * 64; vcol = C_CV + hh * 64; ocol = 512 + hh * 64;
           ntile = 4 + (min(max(r0 + 3 - 4, 0), 56) - min(max(r0 - 4, 0), 56) + 8); }
    const int rs_blk = min(max(r0 - 4, 0), 56), rs = min(max(r - 4, 0), 56);
    const float* rpb = FIN(15) + (size_t)(l * 4 + hh) * 15 * 31;
    const int cq = c0 + c31, cs = min(max(cq - 8, 0), 48);
    LAS unsigned char* lds = F.lds; LAS float* al = (LAS float*)(lds + AB_AL + F.wave * 128);
    LAS float* rpbL = (LAS float*)(lds + AB_AL + 1024);
    if (TYPE == 1) { if (tid < 465) rpbL[tid] = rpb[tid]; }
    const int prow = tid >> 3, pck = tid & 7;
    const unsigned pdst = prow * TP64 + pck * 16;
    const int NTILE = ntile;
#define AB_TROW(t) ((t) < 4 ? MLAT + b * CTXL + 64 * (t) : (TYPE == 0 ? b * SEQ + 64 * ((t) - 4) : b * SEQ + 64 * (rs_blk + (t) - 4)))
    bf16x8 qf[4];
#pragma unroll
    for (int s = 0; s < 4; ++s) qf[s] = *(const bf16x8*)(MIX + (size_t)(qrow0 + c31) * NMIX + qcol + 16 * s + 8 * h);
    f32x16 O0, O1;
#pragma unroll
    for (int reg = 0; reg < 16; ++reg) { O0[reg] = 0.f; O1[reg] = 0.f; }
    float m_run = -1e30f, l_run = 0.f;
    constexpr float SC2 = 0.125f * 1.4426950408889634f;
    constexpr float L2E = 1.4426950408889634f;
    u32x4 kr0, vr0, kr1, vr1, kr2, vr2;
#define AB_LOAD(T, KR, VR) do { const size_t ro_ = (size_t)(AB_TROW(T) + prow) * NMIX + pck * 8; KR = *(const u32x4*)(MIX + ro_ + kcol); VR = *(const u32x4*)(MIX + ro_ + vcol); } while (0)
    AB_LOAD(0, kr0, vr0);
    *(LAS u32x4*)(lds + pdst) = kr0; *(LAS u32x4*)(lds + AB_TILE + pdst) = vr0;
    AB_LOAD(1, kr0, vr0); AB_LOAD(2, kr1, vr1); AB_LOAD(3, kr2, vr2);
    __syncthreads();
#define AB_BODY(T, KR, VR) do { \
        LAS unsigned char* KB = lds + ((T) & 1) * 2 * AB_TILE; LAS unsigned char* VB = KB + AB_TILE; \
        const int kr_ = rs_blk + (T) - 4;                                  \
        if (TYPE == 0 || (T) < 4 || (kr_ >= rs && kr_ < rs + 8)) {         \
        f32x16 S0, S1; \
        _Pragma("unroll") for (int reg = 0; reg < 16; ++reg) { S0[reg] = 0.f; S1[reg] = 0.f; } \
        _Pragma("unroll") for (int s = 0; s < 4; ++s) { S0 = MFMA32(ld_row8(KB, TP64, c31, 16 * s + 8 * h), qf[s], S0); S1 = MFMA32(ld_row8(KB, TP64, 32 + c31, 16 * s + 8 * h), qf[s], S1); } \
        if (TYPE == 1 && (T) >= 4) {                                       \
            const LAS float* rbl = rpbL + (kr_ - r + 7) * 31; \
            _Pragma("unroll") for (int reg = 0; reg < 16; ++reg) { const int kc = crow(reg, h); \
                const bool ok0 = (kc >= cs) && (kc < cs + 16), ok1 = (kc + 32 >= cs) && (kc + 32 < cs + 16); \
                const float b0 = rbl[min(max(kc - cq + 15, 0), 30)], b1 = rbl[min(max(kc + 32 - cq + 15, 0), 30)];     \
                S0[reg] = ok0 ? fmaf(S0[reg], SC2, b0 * L2E) : -1e30f; S1[reg] = ok1 ? fmaf(S1[reg], SC2, b1 * L2E) : -1e30f; } \
        } \
        const bool pre = (TYPE == 1 && (T) >= 4);                  \
        float mloc = fmaxf(fmaxf(fmaxf(S0[0], S0[1]), fmaxf(S0[2], S0[3])), fmaxf(fmaxf(S0[4], S0[5]), fmaxf(S0[6], S0[7]))); \
        mloc = fmaxf(mloc, fmaxf(fmaxf(fmaxf(S0[8], S0[9]), fmaxf(S0[10], S0[11])), fmaxf(fmaxf(S0[12], S0[13]), fmaxf(S0[14], S0[15])))); \
        mloc = fmaxf(mloc, fmaxf(fmaxf(fmaxf(S1[0], S1[1]), fmaxf(S1[2], S1[3])), fmaxf(fmaxf(S1[4], S1[5]), fmaxf(S1[6], S1[7])))); \
        mloc = fmaxf(mloc, fmaxf(fmaxf(fmaxf(S1[8], S1[9]), fmaxf(S1[10], S1[11])), fmaxf(fmaxf(S1[12], S1[13]), fmaxf(S1[14], S1[15])))); \
        if (!pre) mloc *= SC2; \
        { const auto rr_ = __builtin_amdgcn_permlane32_swap(__float_as_uint(mloc), __float_as_uint(mloc), false, false); mloc = fmaxf(__uint_as_float(rr_[0]), __uint_as_float(rr_[1])); } \
        if (__any(mloc > m_run + 8.f)) {                         \
            const float m_new = fmaxf(m_run, mloc); \
            const float alpha = __builtin_amdgcn_exp2f(m_run - m_new); \
            m_run = m_new; l_run *= alpha; \
            if (lane < 32) al[c31] = alpha; \
            LDS_WAIT(); \
            _Pragma("unroll") for (int g = 0; g < 4; ++g) { const f32x4 a4 = *(const LAS f32x4*)(al + 8 * g + 4 * h); \
                O0[4 * g] *= a4.x; O0[4 * g + 1] *= a4.y; O0[4 * g + 2] *= a4.z; O0[4 * g + 3] *= a4.w; \
                O1[4 * g] *= a4.x; O1[4 * g + 1] *= a4.y; O1[4 * g + 2] *= a4.z; O1[4 * g + 3] *= a4.w; } \
            LDS_WAIT(); \
        } \
        float ls = 0.f; \
        if (pre) { _Pragma("unroll") for (int reg = 0; reg < 16; ++reg) { const float p0 = __builtin_amdgcn_exp2f(S0[reg] - m_run), p1 = __builtin_amdgcn_exp2f(S1[reg] - m_run); ls += p0 + p1; S0[reg] = p0; S1[reg] = p1; } } \
        else     { _Pragma("unroll") for (int reg = 0; reg < 16; ++reg) { const float p0 = __builtin_amdgcn_exp2f(fmaf(S0[reg], SC2, -m_run)), p1 = __builtin_amdgcn_exp2f(fmaf(S1[reg], SC2, -m_run)); ls += p0 + p1; S0[reg] = p0; S1[reg] = p1; } } \
        l_run += ls; \
        const bf16x8 pa0 = pack8<0>(S0), pa1 = pack8<1>(S0), pa2 = pack8<0>(S1), pa3 = pack8<1>(S1); \
        O0 = MFMA32(pa0, ld_tr8(VB, TP64, 4 * h, 8 + 4 * h, 0, lane), O0); \
        O1 = MFMA32(pa0, ld_tr8(VB, TP64, 4 * h, 8 + 4 * h, 32, lane), O1); \
        O0 = MFMA32(pa1, ld_tr8(VB, TP64, 16 + 4 * h, 24 + 4 * h, 0, lane), O0); \
        O1 = MFMA32(pa1, ld_tr8(VB, TP64, 16 + 4 * h, 24 + 4 * h, 32, lane), O1); \
        O0 = MFMA32(pa2, ld_tr8(VB, TP64, 32 + 4 * h, 40 + 4 * h, 0, lane), O0); \
        O1 = MFMA32(pa2, ld_tr8(VB, TP64, 32 + 4 * h, 40 + 4 * h, 32, lane), O1); \
        O0 = MFMA32(pa3, ld_tr8(VB, TP64, 48 + 4 * h, 56 + 4 * h, 0, lane), O0); \
        O1 = MFMA32(pa3, ld_tr8(VB, TP64, 48 + 4 * h, 56 + 4 * h, 32, lane), O1); \
        } \
        if ((T) + 1 < NTILE) { LAS unsigned char* KN = lds + (((T) + 1) & 1) * 2 * AB_TILE; *(LAS u32x4*)(KN + pdst) = KR; *(LAS u32x4*)(KN + AB_TILE + pdst) = VR; } \
        if ((T) + 4 < NTILE) AB_LOAD((T) + 4, KR, VR); \
        __syncthreads(); \
    } while (0)
#pragma unroll 1
    for (int t = 0; t < NTILE; t += 3) {
        AB_BODY(t, kr0, vr0);
        if (t + 1 < NTILE) AB_BODY(t + 1, kr1, vr1);
        if (t + 2 < NTILE) AB_BODY(t + 2, kr2, vr2);
    }
#undef AB_BODY
#undef AB_LOAD
#undef AB_TROW
    l_run += bperm_(l_run, lane ^ 32);
    if (lane < 32) al[c31] = 1.f / l_run;
    LDS_WAIT();
#pragma unroll
    for (int g = 0; g < 4; ++g) { const f32x4 a4 = *(const LAS f32x4*)(al + 8 * g + 4 * h);
        O0[4 * g] *= a4.x; O0[4 * g + 1] *= a4.y; O0[4 * g + 2] *= a4.z; O0[4 * g + 3] *= a4.w;
        O1[4 * g] *= a4.x; O1[4 * g + 1] *= a4.y; O1[4 * g + 2] *= a4.z; O1[4 * g + 3] *= a4.w; }
#pragma unroll
    for (int reg = 0; reg < 16; ++reg) { bf16_t* op = BR + (size_t)(qrow0 + crow(reg, h)) * DM + ocol + c31; op[0] = (bf16_t)f2bf(O0[reg]); op[32] = (bf16_t)f2bf(O1[reg]); }
    __syncthreads();
}


namespace gx {
constexpr int NSLOT = 3, SLOTB = 8192, KVBLK = 64;
constexpr int LDS_K = 0, LDS_V = NSLOT * SLOTB, LDS_WS = 2 * NSLOT * SLOTB, LDS_OST = LDS_WS + 8 * 64 * 4, LDS_BYTES_GX = LDS_OST + 8 * 4096;
typedef LAS const char* lds_cptr;
typedef short v4i16_t __attribute__((ext_vector_type(4)));
#define GX_SBAR() __builtin_amdgcn_sched_barrier(0)
__device__ __forceinline__ void glds16(const void* gsrc, unsigned lds_dst) { unsigned keep;
    asm volatile("s_mov_b32 %0, m0\n\ts_mov_b32 m0, %2\n\ts_nop 0\n\tglobal_load_lds_dwordx4 %1, off\n\ts_mov_b32 m0, %0" : "=&s"(keep) : "v"(gsrc), "s"(lds_dst) : "memory"); }
__device__ __forceinline__ float max3f(float a, float b, float c) { float r; asm("v_max3_f32 %0, %1, %2, %3" : "=v"(r) : "v"(a), "v"(b), "v"(c)); return r; }
__device__ __forceinline__ float max2f(float a, float b) { float r; asm("v_max_f32_e32 %0, %1, %2" : "=v"(r) : "v"(a), "v"(b)); return r; }
__device__ __forceinline__ float fadd_s(float a, float b) { float r; asm("v_add_f32_e32 %0, %1, %2" : "=v"(r) : "v"(a), "v"(b)); return r; }
__device__ __forceinline__ float fsub_s(float a, float b) { float r; asm("v_sub_f32_e32 %0, %1, %2" : "=v"(r) : "v"(a), "v"(b)); return r; }
__device__ __forceinline__ unsigned cvtpk_s(float lo, float hi) { f32x2_t v = {lo, hi}; bf16x2_t b = __builtin_convertvector(v, bf16x2_t); return __builtin_bit_cast(unsigned, b); }
#define GX_WAIT_BAR(N) asm volatile("s_waitcnt vmcnt(" #N ") lgkmcnt(0)\n\ts_barrier" ::: "memory")
__device__ __forceinline__ void qkt(f32x16& p0, f32x16& p1, lds_cptr Kslot, const bf16x8* qr, const f32x16& negm, int r32, int hi) {
    lds_cptr kb = Kslot + hi * 1024 + r32 * 16;
#pragma unroll
    for (int d0 = 0; d0 < 4; ++d0) {
        const bf16x8 b0 = *(const LAS bf16x8*)(kb + d0 * 2048);
        const bf16x8 b1 = *(const LAS bf16x8*)(kb + d0 * 2048 + 512);
        if (d0 == 0) { p0 = __builtin_amdgcn_mfma_f32_32x32x16_bf16(b0, qr[0], negm, 0, 0, 0); p1 = __builtin_amdgcn_mfma_f32_32x32x16_bf16(b1, qr[0], negm, 0, 0, 0); }
        else { p0 = __builtin_amdgcn_mfma_f32_32x32x16_bf16(b0, qr[d0], p0, 0, 0, 0); p1 = __builtin_amdgcn_mfma_f32_32x32x16_bf16(b1, qr[d0], p1, 0, 0, 0); } }
}
__device__ __forceinline__ void kload8(bf16x8* kf, lds_cptr kp) {
    kf[0] = *(const LAS bf16x8*)(kp);        kf[1] = *(const LAS bf16x8*)(kp + 512);
    kf[2] = *(const LAS bf16x8*)(kp + 2048); kf[3] = *(const LAS bf16x8*)(kp + 2560);
    kf[4] = *(const LAS bf16x8*)(kp + 4096); kf[5] = *(const LAS bf16x8*)(kp + 4608);
    kf[6] = *(const LAS bf16x8*)(kp + 6144); kf[7] = *(const LAS bf16x8*)(kp + 6656);
}
__device__ __forceinline__ void kload2(bf16x8* kf, lds_cptr kp, int j) { kf[2 * j] = *(const LAS bf16x8*)(kp + j * 2048); kf[2 * j + 1] = *(const LAS bf16x8*)(kp + j * 2048 + 512); }
__device__ __forceinline__ s16x4 vtr(lds_cptr p) { return __builtin_bit_cast(s16x4, __builtin_amdgcn_ds_read_tr16_b64_v4i16((LAS v4i16_t*)p)); }
__device__ __forceinline__ float rowmax(const f32x16& p0, const f32x16& p1) {
    float a = max3f(p0[0], p0[1], p1[0]), b = max3f(p0[2], p0[3], p1[1]); a = max3f(a, p1[2], p1[3]);
#pragma unroll
    for (int r = 4; r < 16; r += 4) { a = max3f(a, p0[r], p0[r + 1]); b = max3f(b, p0[r + 2], p0[r + 3]); a = max3f(a, p1[r], p1[r + 1]); b = max3f(b, p1[r + 2], p1[r + 3]); }
    const float m = max2f(a, b);
    auto rr = __builtin_amdgcn_permlane32_swap(__float_as_uint(m), __float_as_uint(m), false, false);
    return max2f(__uint_as_float(rr[0]), __uint_as_float(rr[1]));
}
__device__ __forceinline__ void pv(f32x16* o, int vb, bf16x8 pa0, bf16x8 pa1, bf16x8 pa2, bf16x8 pa3) {
#pragma unroll
    for (int d0 = 0; d0 < 2; ++d0) { s16x4 lo[4], hi[4];
#pragma unroll
        for (int ks = 0; ks < 4; ++ks) {
            asm volatile("ds_read_b64_tr_b16 %0,%1 offset:%c2" : "=&v"(lo[ks]) : "v"(vb), "i"(d0 * 4096 + ks * 1024) : "memory");
            asm volatile("ds_read_b64_tr_b16 %0,%1 offset:%c2" : "=&v"(hi[ks]) : "v"(vb), "i"(d0 * 4096 + ks * 1024 + 512) : "memory"); }
        asm volatile("s_waitcnt lgkmcnt(0)" ::: "memory"); GX_SBAR();
#define GX_PK(k) (bf16x8){lo[k][0], lo[k][1], lo[k][2], lo[k][3], hi[k][0], hi[k][1], hi[k][2], hi[k][3]}
        o[d0] = __builtin_amdgcn_mfma_f32_32x32x16_bf16(pa0, GX_PK(0), o[d0], 0, 0, 0);
        o[d0] = __builtin_amdgcn_mfma_f32_32x32x16_bf16(pa1, GX_PK(1), o[d0], 0, 0, 0);
        o[d0] = __builtin_amdgcn_mfma_f32_32x32x16_bf16(pa2, GX_PK(2), o[d0], 0, 0, 0);
        o[d0] = __builtin_amdgcn_mfma_f32_32x32x16_bf16(pa3, GX_PK(3), o[d0], 0, 0, 0);
#undef GX_PK
    }
}
template <int THRL> __device__ __forceinline__ void gqa_unit(Frame& F, int u, bf16_t* BR) {
    const bf16_t* MIX = (const bf16_t*)(F.ws + WS_RC);
    const int lane_ = tid_from_lds(F.lds, F.wave_s) & 63;
    const int lane = lane_, r32 = lane & 31, hi = lane >> 5, wid = F.wave;
    const int ux = u & 7, uj = u >> 3;
    const int b = ux >> 1, hq = 2 * (ux & 1) + (uj >> 4), qblk = uj & 15;
    const int qrow0 = b * SEQ + qblk * 256 + wid * 32, qcol = C_DQ + hq * 64, kcol = C_DK + (hq >> 1) * 64, vcol = C_DV + (hq >> 1) * 64, ocol = 768 + hq * 64;
    constexpr int NT = 64 + 4;
#define GX_TROW(t) ((t) < 64 ? b * SEQ + 64 * (t) : MLAT + b * CTXL + 64 * ((t) - 64))
    const bf16_t* Qw = MIX + (size_t)qrow0 * NMIX + qcol;
    LAS unsigned char* shm = F.lds;
    const unsigned lds0 = 0u;
    LAS float* wsf = (LAS float*)(shm + LDS_WS) + wid * 64;
    const bf16_t* ksrc = MIX + (size_t)lane * NMIX + kcol + wid * 8;
    const bf16_t* vsrc = MIX + (size_t)(16 * (wid & 3) + (lane >> 2)) * NMIX + vcol + (wid >> 2) * 32 + (lane & 3) * 8;
    const unsigned kdst = lds0 + LDS_K + wid * 1024, vdst = lds0 + LDS_V + wid * 1024;
#define GX_DMA_K(t, slot) glds16(ksrc + (size_t)GX_TROW(t) * NMIX, (unsigned)__builtin_amdgcn_readfirstlane(kdst + (slot)))
#define GX_DMA_V(t, slot) glds16(vsrc + (size_t)GX_TROW(t) * NMIX, (unsigned)__builtin_amdgcn_readfirstlane(vdst + (slot)))
    const int vb0 = (int)(lds0 + LDS_V) + ((lane >> 4) & 1) * 32 + (lane & 3) * 8 + (4 * hi + ((lane & 15) >> 2)) * 64;
    bf16x8 kf[8];
    const lds_cptr shm3 = (lds_cptr)shm; const lds_cptr kp0 = shm3 + LDS_K + hi * 1024 + r32 * 16; const lds_cptr vp0 = shm3 + LDS_V + ((lane >> 4) & 1) * 32 + (lane & 3) * 8 + (4 * hi + ((lane & 15) >> 2)) * 64;
    GX_DMA_K(0, 0); GX_DMA_V(0, 0); GX_DMA_K(1, SLOTB);
    bf16x8 qr[4];
#pragma unroll
    for (int d0 = 0; d0 < 4; ++d0) qr[d0] = *(const bf16x8*)(Qw + (size_t)r32 * NMIX + d0 * 16 + hi * 8);
    float mhat = 0.f, l_reg = 0.f; f32x16 o[2]; o[0] = f32x16{}; o[1] = f32x16{}; f32x16 negm = f32x16{}; asm volatile("" : "+v"(negm));
    bool resc = false;
#define GX_START(P0, P1) do { const float rm = rowmax(P0, P1); resc = false; \
    { const float dl = rm; mhat = fadd_s(mhat, dl); \
      _Pragma("unroll") for (int r = 0; r < 16; ++r) { P0[r] = fsub_s(P0[r], dl); P1[r] = fsub_s(P1[r], dl); } \
      _Pragma("unroll") for (int r = 0; r < 16; ++r) negm[r] = -mhat; asm volatile("" : "+v"(negm)); } \
    _Pragma("unroll") for (int r = 0; r < 16; ++r) P0[r] = __builtin_amdgcn_exp2f(P0[r]); } while (0)
#define GX_RESC() do { if (resc) { asm volatile("s_waitcnt lgkmcnt(0)" ::: "memory"); \
      _Pragma("unroll") for (int d_ = 0; d_ < 2; ++d_) _Pragma("unroll") for (int r = 0; r < 16; ++r) o[d_][r] *= wsf[crow(r, hi)]; } } while (0)
    f32x16 pA0, pA1, pB0, pB1;
    int sl_prev = 0, sl_cur = 0, sl_next = SLOTB;
#define GX_ROT() do { sl_prev = sl_cur; sl_cur = sl_next; sl_next = (sl_next == (NSLOT - 1) * SLOTB) ? 0 : sl_next + SLOTB; } while (0)
    GX_DMA_K(2, 2 * SLOTB);
    GX_WAIT_BAR(3);
    qkt(pA0, pA1, shm3 + LDS_K, qr, negm, r32, hi); asm volatile("s_nop 15\n\ts_nop 7" : "+v"(pA0), "+v"(pA1));
    GX_START(pA0, pA1);
    _Pragma("unroll") for (int r = 0; r < 16; ++r) pA1[r] = __builtin_amdgcn_exp2f(pA1[r]);
    GX_WAIT_BAR(0);
    GX_DMA_K(3, 0); GX_DMA_V(1, SLOTB);
    GX_ROT();
    kload8(kf, kp0 + sl_cur);
    GX_WAIT_BAR(2);
    s16x4 vlo[8], vhi[8]; u32x4 pw0, pw1, pw2, pw3;
#define GX_PKW(P, B) cvtpk_s(P[B], P[B + 1])
#define GX_PAF(k) __builtin_bit_cast(bf16x8, pw##k)
#define GX_VFR(i) (bf16x8){vlo[i][0], vlo[i][1], vlo[i][2], vlo[i][3], vhi[i][0], vhi[i][1], vhi[i][2], vhi[i][3]}
#define GX_PIN(x) asm volatile("" : "+v"(x))
#define GX_MX3(a, b, c) __builtin_fmaxf(__builtin_fmaxf((a), (b)), (c))
#define GX_GAPA(MF, A0, A1, A2, A3, W0, W1, PW) do { MF; sacc += A0; sacc += A1; sacc += A2; sacc += A3; GX_PIN(sacc); W0; W1; GX_PIN(PW); GX_SBAR(); } while (0)
#define GX_EX(v) __builtin_amdgcn_exp2f(v)
#define GX_GAPB(MF, X, B) do { MF; X[B] = GX_EX(X[B]); X[B + 1] = GX_EX(X[B + 1]); X[B + 2] = GX_EX(X[B + 2]); X[B + 3] = GX_EX(X[B + 3]); GX_PIN(X); GX_SBAR(); } while (0)
#define GX_VRD(i) do { vlo[i] = vtr(vp_ + (((i) >> 2) * 4096 + ((i) & 3) * 1024)); vhi[i] = vtr(vp_ + (((i) >> 2) * 4096 + ((i) & 3) * 1024 + 512)); } while (0)
#define GX_KRD(G, j) do { if (G) { kload2(kf, kp0 + sl_next, j); GX_SBAR(); } } while (0)
#define GX_MFMA __builtin_amdgcn_mfma_f32_32x32x16_bf16
#define GX_STEP(C0, C1, P0, P1, t, GK, GV, GL) do { GX_SBAR(); \
    const lds_cptr vp_ = vp0 + sl_prev; \
    GX_VRD(0); GX_SBAR(); float sacc = (P0[0] + P0[1]); \
    GX_GAPA(C0 = GX_MFMA(kf[0], qr[0], negm, 0, 0, 0), P0[2], P0[3], P0[4], P0[5],     pw0[0] = GX_PKW(P0, 0), pw0[1] = GX_PKW(P0, 2), pw0); \
    GX_VRD(4); GX_SBAR(); GX_GAPA(C1 = GX_MFMA(kf[1], qr[0], negm, 0, 0, 0), P0[6], P0[7], P0[8], P0[9],     pw0[2] = GX_PKW(P0, 4), pw0[3] = GX_PKW(P0, 6), pw0); \
    GX_VRD(1); GX_SBAR(); GX_GAPA(C0 = GX_MFMA(kf[2], qr[1], C0, 0, 0, 0),   P0[10], P0[11], P0[12], P0[13], pw1[0] = GX_PKW(P0, 8), pw1[1] = GX_PKW(P0, 10), pw1); \
    GX_VRD(5); GX_SBAR(); GX_GAPA(C1 = GX_MFMA(kf[3], qr[1], C1, 0, 0, 0),   P0[14], P0[15], P1[0], P1[1],   pw1[2] = GX_PKW(P0, 12), pw1[3] = GX_PKW(P0, 14), pw1); \
    GX_VRD(2); GX_SBAR(); GX_GAPA(C0 = GX_MFMA(kf[4], qr[2], C0, 0, 0, 0),   P1[2], P1[3], P1[4], P1[5],     pw2[0] = GX_PKW(P1, 0), pw2[1] = GX_PKW(P1, 2), pw2); \
    GX_VRD(6); GX_SBAR(); GX_GAPA(C1 = GX_MFMA(kf[5], qr[2], C1, 0, 0, 0),   P1[6], P1[7], P1[8], P1[9],     pw2[2] = GX_PKW(P1, 4), pw2[3] = GX_PKW(P1, 6), pw2); \
    GX_VRD(3); GX_SBAR(); GX_GAPA(C0 = GX_MFMA(kf[6], qr[3], C0, 0, 0, 0),   P1[10], P1[11], P1[12], P1[13], pw3[0] = GX_PKW(P1, 8), pw3[1] = GX_PKW(P1, 10), pw3); \
    GX_VRD(7); GX_SBAR(); GX_GAPA(C1 = GX_MFMA(kf[7], qr[3], C1, 0, 0, 0),   P1[14], P1[15], 0.f, 0.f,       pw3[2] = GX_PKW(P1, 12), pw3[3] = GX_PKW(P1, 14), pw3); \
    l_reg += sacc; \
    if (GK) { GX_DMA_K((t) + 3, sl_cur); } if (GV) { GX_DMA_V((t) + 1, sl_next); } \
    { float a = GX_MX3(C0[0], C0[1], C1[0]), b_ = GX_MX3(C0[2], C0[3], C1[1]); a = GX_MX3(a, C1[2], C1[3]); \
      _Pragma("unroll") for (int r = 4; r < 16; r += 4) { a = GX_MX3(a, C0[r], C0[r + 1]); b_ = GX_MX3(b_, C0[r + 2], C0[r + 3]); a = GX_MX3(a, C1[r], C1[r + 1]); b_ = GX_MX3(b_, C1[r + 2], C1[r + 3]); } \
      float rm = __builtin_fmaxf(a, b_); { auto rr = __builtin_amdgcn_permlane32_swap(__float_as_uint(rm), __float_as_uint(rm), false, false); rm = __builtin_fmaxf(__uint_as_float(rr[0]), __uint_as_float(rr[1])); } \
      resc = false; \
      if (__builtin_expect(__any(rm > (float)THRL), 0)) { const float dl = __builtin_fmaxf(rm, 0.f); mhat += dl; \
        _Pragma("unroll") for (int r = 0; r < 16; ++r) { C0[r] -= dl; C1[r] -= dl; } \
        _Pragma("unroll") for (int r = 0; r < 16; ++r) negm[r] = -mhat; asm volatile("" : "+v"(negm)); \
        const float f = __builtin_amdgcn_exp2f(-dl); l_reg *= f; if (hi == 0) wsf[r32] = f; resc = true; } } \
    GX_SBAR(); \
    GX_GAPB(o[0] = GX_MFMA(GX_PAF(0), GX_VFR(0), o[0], 0, 0, 0), C0, 0); \
    GX_GAPB(o[1] = GX_MFMA(GX_PAF(0), GX_VFR(4), o[1], 0, 0, 0), C0, 4); \
    GX_KRD(GL, 0); GX_GAPB(o[0] = GX_MFMA(GX_PAF(1), GX_VFR(1), o[0], 0, 0, 0), C0, 8); \
    GX_KRD(GL, 1); GX_GAPB(o[1] = GX_MFMA(GX_PAF(1), GX_VFR(5), o[1], 0, 0, 0), C0, 12); \
    GX_KRD(GL, 2); GX_GAPB(o[0] = GX_MFMA(GX_PAF(2), GX_VFR(2), o[0], 0, 0, 0), C1, 0); \
    GX_KRD(GL, 3); GX_GAPB(o[1] = GX_MFMA(GX_PAF(2), GX_VFR(6), o[1], 0, 0, 0), C1, 4); \
    GX_GAPB(o[0] = GX_MFMA(GX_PAF(3), GX_VFR(3), o[0], 0, 0, 0), C1, 8); \
    GX_GAPB(o[1] = GX_MFMA(GX_PAF(3), GX_VFR(7), o[1], 0, 0, 0), C1, 12); \
    } while (0)
    int t = 1;
#pragma unroll 1
    for (; t + 5 < NT; t += 2) {
        GX_STEP(pB0, pB1, pA0, pA1, t, true, true, true);     GX_WAIT_BAR(2); GX_RESC(); GX_ROT();
        GX_STEP(pA0, pA1, pB0, pB1, t + 1, true, true, true); GX_WAIT_BAR(2); GX_RESC(); GX_ROT();
    }
#define GX_ENDW(tt) do { if ((tt) + 3 < NT) { GX_WAIT_BAR(2); } else if ((tt) + 2 < NT) { GX_WAIT_BAR(1); } else { GX_WAIT_BAR(0); } } while (0)
#pragma unroll 1
    for (; t + 1 < NT; t += 2) {
        GX_STEP(pB0, pB1, pA0, pA1, t, (t + 3 < NT), (t + 1 < NT), (t + 1 < NT));         GX_ENDW(t);     GX_RESC(); GX_ROT();
        GX_STEP(pA0, pA1, pB0, pB1, t + 1, (t + 4 < NT), (t + 2 < NT), (t + 2 < NT));     GX_ENDW(t + 1); GX_RESC(); GX_ROT();
    }
    GX_STEP(pB0, pB1, pA0, pA1, NT - 1, false, false, false); GX_RESC();
    { float sacc = pB0[0] + pB0[1]; _Pragma("unroll") for (int r = 2; r < 16; ++r) sacc += pB0[r]; _Pragma("unroll") for (int r = 0; r < 16; ++r) sacc += pB1[r]; l_reg += sacc;
      pw0 = (u32x4){GX_PKW(pB0, 0), GX_PKW(pB0, 2), GX_PKW(pB0, 4), GX_PKW(pB0, 6)}; pw1 = (u32x4){GX_PKW(pB0, 8), GX_PKW(pB0, 10), GX_PKW(pB0, 12), GX_PKW(pB0, 14)};
      pw2 = (u32x4){GX_PKW(pB1, 0), GX_PKW(pB1, 2), GX_PKW(pB1, 4), GX_PKW(pB1, 6)}; pw3 = (u32x4){GX_PKW(pB1, 8), GX_PKW(pB1, 10), GX_PKW(pB1, 12), GX_PKW(pB1, 14)};
      GX_SBAR(); pv(o, vb0 + sl_cur, GX_PAF(0), GX_PAF(1), GX_PAF(2), GX_PAF(3)); }
    { auto rr = __builtin_amdgcn_permlane32_swap(__float_as_uint(l_reg), __float_as_uint(l_reg), false, false); l_reg = __uint_as_float(rr[0]) + __uint_as_float(rr[1]); }
    if (hi == 0) wsf[32 + r32] = l_reg; asm volatile("s_waitcnt lgkmcnt(0)" ::: "memory");
    float rli[16];
#pragma unroll
    for (int r = 0; r < 16; ++r) rli[r] = __builtin_amdgcn_rcpf(wsf[32 + crow(r, hi)]);
    bf16_t* Ow = BR + (size_t)qrow0 * DM + ocol;
    { LAS bf16_t* stg = (LAS bf16_t*)(shm + LDS_OST) + wid * 2048;
#pragma unroll
      for (int r = 0; r < 16; ++r) { const int orow = crow(r, hi);
#pragma unroll
        for (int d0 = 0; d0 < 2; ++d0) stg[orow * 64 + d0 * 32 + r32] = (bf16_t)f2bf(o[d0][r] * rli[r]); }
      asm volatile("s_waitcnt lgkmcnt(0)" ::: "memory");
#pragma unroll
      for (int i = 0; i < 4; ++i) { const int row = i * 8 + (lane >> 3), ch = lane & 7; const u32x4 v = *(const LAS u32x4*)(stg + row * 64 + ch * 8); pg8::st16_wt(Ow + (size_t)row * DM + ch * 8, v); } }
    asm volatile("s_waitcnt lgkmcnt(0)\n\ts_barrier" ::: "memory");
#undef GX_TROW
#undef GX_DMA_K
#undef GX_DMA_V
#undef GX_START
#undef GX_RESC
#undef GX_ROT
#undef GX_PKW
#undef GX_PAF
#undef GX_VFR
#undef GX_PIN
#undef GX_MX3
#undef GX_GAPA
#undef GX_EX
#undef GX_GAPB
#undef GX_VRD
#undef GX_KRD
#undef GX_MFMA
#undef GX_STEP
#undef GX_ENDW
}
}

constexpr int NT_HGRN = 32 * NCH, NT_SSD = 64 * NCH, NT_SCAN = NT_HGRN + NT_SSD;
template <bool PASS_C> __device__ __forceinline__ void scan_tasks(Frame& F, int l, bf16_t* BR) {
    bf16_t* OBA = (bf16_t*)(F.ws + WS_OBA); bf16_t* OBB = (bf16_t*)(F.ws + WS_OBB);
    const int slot = F.wave * F.G + F.bid, nslots = NWAVES * F.G;
#pragma unroll 1
    for (int t = slot; t < NT_SCAN; t += nslots) {
        if (t < NT_HGRN) { const int seq = t / NCH, pc = t % NCH; if (PASS_C && l == 1 && pc == 0) continue;
            hgrn_task<PASS_C>(F, l, seq, pc, seq < 16 ? BR : OBA, seq < 16 ? DM : 256);
        } else { const int t2 = t - NT_HGRN, seq2 = t2 / NCH, pc = t2 % NCH; if (PASS_C && l == 1 && pc == 0) continue;
            ssd_task<PASS_C>(F, l, seq2, pc, seq2 < 32 ? BR + 256 : OBB, seq2 < 32 ? DM : 256);
        }
    }
}
__device__ __forceinline__ void scan_carry(Frame& F) {
    refresh(F);
    bf16_t* STA = (bf16_t*)(F.ws + WS_STA); bf16_t* STB = (bf16_t*)(F.ws + WS_STB);
    const float* DLA = (const float*)(F.ws + WS_DLA); const float* DLB = (const float*)(F.ws + WS_DLB);
    const int gt = F.bid * NTHREADS + F.tid, NGT = F.G * NTHREADS;
    for (int e = gt; e < (32 * 4096 + 64 * 4096) / 2; e += NGT) {
        unsigned kvw[NCH]; float d0[NCH], d1[NCH];
        const bool isA = e < 32 * 2048;
        bf16_t* base;
        if (isA) { const int seq = e >> 11, idx = (e & 2047) * 2; base = STA + (size_t)seq * NCH * 4096 + idx;
            const int k = 32 * (((idx >> 4) & 3) >> 1) + crow(idx & 15, idx >> 11);
#pragma unroll
            for (int pc = 0; pc < NCH; ++pc) { kvw[pc] = *(const unsigned*)(base + (size_t)pc * 4096); const float* dl = DLA + ((size_t)seq * NCH + pc) * 64 + k; d0[pc] = dl[0]; d1[pc] = dl[1]; }
        } else { const int e2 = e - 32 * 2048, seq2 = e2 >> 11, idx = (e2 & 2047) * 2; base = STB + (size_t)seq2 * NCH * 4096 + idx;
#pragma unroll
            for (int pc = 0; pc < NCH; ++pc) { kvw[pc] = *(const unsigned*)(base + (size_t)pc * 4096); d0[pc] = d1[pc] = DLB[(seq2 >> 1) * NCH + pc] * 1.4426950408889634f; }
        }
        float S0 = 0.f, S1 = 0.f;
#pragma unroll
        for (int pc = 0; pc < NCH; ++pc) { const unsigned out = cvtpk(S0, S1);
            S0 = __builtin_amdgcn_exp2f(d0[pc]) * S0 + bflo(kvw[pc]); S1 = __builtin_amdgcn_exp2f(d1[pc]) * S1 + bfhi(kvw[pc]); kvw[pc] = out; }
#pragma unroll
        for (int pc = 0; pc < NCH; ++pc) *(unsigned*)(base + (size_t)pc * 4096) = kvw[pc];
    }
}

template <int STAGE> __device__ __forceinline__ void mixers_phase(Frame& F, int l, bf16_t* BR) {
    refresh(F);
    scan_tasks<STAGE == 2>(F, l, BR);
    refresh(F);
    const int slot = F.wave * F.G + F.bid, nslots = NWAVES * F.G;
    if (STAGE == 0) {
        if (l == 0) {
#pragma unroll 1
            for (int u = nslots - 1 - slot; u < NA_CTX; u += nslots) attn_task<2>(F, l, u, BR); }
        __syncthreads();
#pragma unroll 1
        for (int u = F.bid; u < 256; u += F.G) attn_block_task<1>(F, l, u, BR);
    } else {
        __syncthreads();
#pragma unroll 1
        for (int u = F.bid; u < 256; u += F.G) gx::gqa_unit<8>(F, u, BR);
    }
}

__device__ __forceinline__ void combine_phase(Frame& F, int l, bf16_t* BR, int nrows) {
    refresh(F);
    const bf16_t* MIX = (const bf16_t*)(F.ws + WS_RC);
    const bf16_t* OBA = (const bf16_t*)(F.ws + WS_OBA); const bf16_t* OBB = (const bf16_t*)(F.ws + WS_OBB);
    const int gw = F.bid * NWAVES + F.wave, NGW = F.G * NWAVES;
    const int m0 = gw, m1 = nrows;
    const int c0 = 4 * F.lane, head = F.lane >> 4;
    const f32x4 hw4 = *(const f32x4*)(FIN(8) + l * 256 + c0), sw4 = *(const f32x4*)(FIN(14) + l * 256 + c0); const float dk = FIN(13)[l * 4 + head];
    u32x2 n_of, n_ob, n_ag, n_sf, n_sb, n_zz, n_xc;
#define CB_LOAD(M) do { const size_t m_ = (size_t)(M); const bf16_t* br_ = BR + m_ * DM; const bf16_t* mx_ = MIX + m_ * NMIX; \
        n_of = __builtin_nontemporal_load((const u32x2*)(br_ + c0)); n_ob = __builtin_nontemporal_load((const u32x2*)(OBA + m_ * 256 + c0)); n_ag = __builtin_nontemporal_load((const u32x2*)(mx_ + C_AG + c0)); \
        n_sf = __builtin_nontemporal_load((const u32x2*)(br_ + 256 + c0)); n_sb = __builtin_nontemporal_load((const u32x2*)(OBB + m_ * 256 + c0)); n_zz = __builtin_nontemporal_load((const u32x2*)(mx_ + C_BZ + c0)); n_xc = __builtin_nontemporal_load((const u32x2*)(mx_ + C_BX + c0)); } while (0)
    if (m0 < m1) CB_LOAD(m0);
#pragma unroll 1
    for (int m = m0; m < m1; m += NGW) {
        const u32x2 of = n_of, ob = n_ob, ag = n_ag, sf = n_sf, sb = n_sb, zz = n_zz, xc = n_xc;
        if (m + NGW < m1) CB_LOAD(m + NGW);
        bf16_t* br = BR + (size_t)m * DM;
        { float t0 = bflo(of.x) + bflo(ob.x), t1 = bfhi(of.x) + bfhi(ob.x), t2 = bflo(of.y) + bflo(ob.y), t3 = bfhi(of.y) + bfhi(ob.y);
          float ss = (t0 * t0 + t1 * t1) + (t2 * t2 + t3 * t3);
          ss += dppf_<0xB1, 0xF, true>(ss); ss += dppf_<0x4E, 0xF, true>(ss); ss += dppf_<0x141, 0xF, true>(ss); ss += dppf_<0x140, 0xF, true>(ss);
          const float rs = 1.f / sqrtf(ss * (1.f / 64.f) + LN_EPS);
          u32x2 w; w.x = pk2(t0 * rs * hw4.x * siluf_(bflo(ag.x)), t1 * rs * hw4.y * siluf_(bfhi(ag.x)));
          w.y = pk2(t2 * rs * hw4.z * siluf_(bflo(ag.y)), t3 * rs * hw4.w * siluf_(bfhi(ag.y)));
          wt8a(br + c0, w); }
        { float y0 = (bflo(sf.x) + bflo(sb.x) + bflo(xc.x) * dk) * siluf_(bflo(zz.x));
          float y1 = (bfhi(sf.x) + bfhi(sb.x) + bfhi(xc.x) * dk) * siluf_(bfhi(zz.x));
          float y2 = (bflo(sf.y) + bflo(sb.y) + bflo(xc.y) * dk) * siluf_(bflo(zz.y));
          float y3 = (bfhi(sf.y) + bfhi(sb.y) + bfhi(xc.y) * dk) * siluf_(bfhi(zz.y));
          const float ss = wave_sum((y0 * y0 + y1 * y1) + (y2 * y2 + y3 * y3));
          const float rs = 1.f / sqrtf(ss * (1.f / 256.f) + LN_EPS);
          u32x2 w; w.x = pk2(y0 * rs * sw4.x, y1 * rs * sw4.y); w.y = pk2(y2 * rs * sw4.z, y3 * rs * sw4.w);
          wt8a(br + 256 + c0, w); }
    }
#undef CB_LOAD
}

#define XB_TMO      128
#define XB_XCNT(j)  (256  + 64 * (j))
#define XB_XSUB(j)  (1280 + 64 * (j))
#define XB_XGEN(j)  (2304 + 64 * (j))
#define XB_TOP      3328
#define XB_TOPGEN   3392
#define XCD_BAR_WORDS 3456
#define XB_SPIN_CAP (1u << 18)
__device__ __forceinline__ unsigned xb_ld(unsigned* p)              { return __hip_atomic_load(p, __ATOMIC_RELAXED, __HIP_MEMORY_SCOPE_AGENT); }
__device__ __forceinline__ unsigned xb_add(unsigned* p, unsigned v) { return __hip_atomic_fetch_add(p, v, __ATOMIC_RELAXED, __HIP_MEMORY_SCOPE_AGENT); }
__device__ __forceinline__ unsigned xb_xcc_id() { return (unsigned)__builtin_amdgcn_s_getreg((3 << 11) | 20) & 0xFu; }
#define XB_SPIN(cond, bar) do { unsigned _sp = 0; while (cond) { __builtin_amdgcn_s_sleep(1); \
    if ((++_sp & 255u) == 0u) { if (xb_ld(&(bar)[XB_TMO])) break; if (_sp > XB_SPIN_CAP) { atomicAdd(&(bar)[XB_TMO], 1u); break; } } } } while (0)
struct XcdBarrier { unsigned* bar; unsigned x; volatile LAS unsigned* st; };
__device__ __forceinline__ XcdBarrier xcd_barrier_post(unsigned* bar, volatile LAS unsigned* st, bool t0) {
    XcdBarrier b; b.bar = bar; b.x = xb_xcc_id(); b.st = st;
    if (t0) (void)xb_add(&bar[XB_XCNT(b.x)], 1u);
    return b;
}
__device__ __forceinline__ void xcd_barrier_complete(unsigned* bar, unsigned x, unsigned& nloc, unsigned& nx) {
    const unsigned G = gridDim.x * gridDim.y * gridDim.z;
    unsigned sum, cnt, mine, sp = 0u;
    for (;;) {
        sum = 0u; cnt = 0u; mine = 0u;
#pragma unroll
        for (unsigned j = 0; j < 16; ++j) { const unsigned c = xb_ld(&bar[XB_XCNT(j)]); sum += c; cnt += (c > 0u) ? 1u : 0u; mine = (j == x) ? c : mine; }
        if (sum == G) break;
        __builtin_amdgcn_s_sleep(1);
        if ((++sp & 255u) == 0u) { if (xb_ld(&bar[XB_TMO])) break; if (sp > XB_SPIN_CAP) { atomicAdd(&bar[XB_TMO], 1u); break; } }
    }
    nloc = mine > 0u ? mine : 1u; nx = cnt > 0u ? cnt : 1u;
}
__device__ __forceinline__ void xcd_barrier(const XcdBarrier& b, int wave_s) {
    asm volatile("s_waitcnt vmcnt(0)" ::: "memory");
    __syncthreads();
    int ln_; asm volatile("v_mbcnt_lo_u32_b32 %0, -1, 0\n\tv_mbcnt_hi_u32_b32 %0, -1, %0" : "=v"(ln_));
    if (wave_s == 0 && ln_ == 0) {
        unsigned* bar = b.bar;
        __builtin_amdgcn_s_waitcnt(0);
        unsigned nloc = b.st[0], nx = b.st[1];
        if (nloc == 0u) { xcd_barrier_complete(bar, b.x, nloc, nx); b.st[0] = nloc; b.st[1] = nx; }
        const unsigned old = xb_add(&bar[XB_XSUB(b.x)], 1u);
        const unsigned gen = old / nloc;
        if (old + 1u == (gen + 1u) * nloc) {
            __builtin_amdgcn_fence(__ATOMIC_RELEASE, "agent");
            asm volatile("s_waitcnt vmcnt(0)" ::: "memory");
            const unsigned og = xb_add(&bar[XB_TOP], 1u);
            const unsigned tg = og / nx;
            if (og + 1u == (tg + 1u) * nx) xb_add(&bar[XB_TOPGEN], 1u);
            else XB_SPIN(xb_ld(&bar[XB_TOPGEN]) == tg, bar);
            __builtin_amdgcn_fence(__ATOMIC_ACQUIRE, "agent");
            asm volatile("s_waitcnt vmcnt(0)" ::: "memory");
        } else {
            XB_SPIN(xb_ld(&bar[XB_TOPGEN]) == gen, bar);
            __builtin_amdgcn_fence(__ATOMIC_ACQUIRE, "agent");
            asm volatile("s_waitcnt vmcnt(0)" ::: "memory");
        }
    }
    __syncthreads();
}

#define GSYNC() xcd_barrier(bar, F.wave_s)
#define MODS ((float*)(F.ws + WS_MODS))
#define DT ((float*)(F.ws + WS_DT))
#define XC ((float*)(F.ws + WS_XC))
#define MIX ((bf16_t*)(F.ws + WS_RC))
#define WIN ((const bf16_t*)(F.ws + WS_WIN))
#define WBR ((const bf16_t*)(F.ws + WS_WBR))
#define WOUT ((const bf16_t*)(F.ws + WS_WOUT))
#define WUP ((const bf16_t*)(F.ws + WS_WUP))
#define WDN ((const bf16_t*)(F.ws + WS_WDN))
#define SLABS ((bf16_t*)(F.ws + WS_RC + (size_t)94 * MiB))
template <int l> __device__ __forceinline__ void layer_body(Frame& F, const XcdBarrier& bar) {
        constexpr bool last = (l == DEPTH - 1);
#define H ((bf16_t*)(F.ws + WS_RA))
#define BR ((bf16_t*)(F.ws + WS_RB))
#define mods_l (MODS + (size_t)l * 5 * 6144)
        constexpr int Mpost = last ? MLAT : MALL;
#define xlat (l == 0 ? FIN(0) : ((float*)(F.a->out)))
#define xctx (l == 0 ? FIN(2) : XC)

        { pg8::Gemm g{H, WIN, MALL, NMIX}; pg8::StaticOrder S; S.init(MALL, NMIX, F.G, F.bid);
          pg8::EpiStoreFG E{MIX, NMIX, l == 1 ? FIN(7) : (const float*)nullptr}; pg8::gemm_phase<pg8::EpiStoreFG, DM, DM, DM, 0, 0>(F.lds, g, S, E, tid_from_lds(F.lds, F.wave_s)); }
        GSYNC();
        prep_phase(F, l);
        conv_to_lds(F, l);
        GSYNC();
        conv_from_lds(F);
        GSYNC();
        mixers_phase<0>(F, l, BR);
        GSYNC();
        scan_carry(F);
        GSYNC();
        mixers_phase<2>(F, l, BR);
        GSYNC();
        combine_phase(F, l, BR, Mpost);
        if constexpr (last) convert_weights<1>(F, l);
        GSYNC();
        { pg8::Gemm g{H, WIN + (size_t)NMIX * DM, Mpost, 4096}; pg8::StaticOrder S; S.init(Mpost, 4096, F.G, F.bid);
          pg8::EpiGateStore E{MIX}; pg8::gemm_phase<pg8::EpiGateStore, DM, DM, DM, 0, 0>(F.lds, g, S, E, tid_from_lds(F.lds, F.wave_s)); }
        if constexpr (!last) convert_weights<1>(F, l, 64, F.G - 64);
        GSYNC();
        { pg8::Gemm g{BR, WBR, Mpost, DM}; pg8::StaticOrder S; S.init(Mpost, DM, F.G, F.bid);
          pg8::EpiHorner E{MIX, H}; pg8::gemm_phase<pg8::EpiHorner, DM, DM, DM, 0, 0, pg8::StaticOrder, 256>(F.lds, g, S, E, tid_from_lds(F.lds, F.wave_s)); }
        GSYNC();
        { pg8::Gemm g{H, WOUT, Mpost, DM}; pg8::StaticOrder S; S.init(Mpost, DM, F.G, F.bid);
          pg8::EpiStore E{BR, DM}; pg8::gemm_phase<pg8::EpiStore, DM, DM, DM, 0, 0>(F.lds, g, S, E, tid_from_lds(F.lds, F.wave_s)); }
        GSYNC();
        {
            RowOp R{}; R.nrows = Mpost; R.xlat_in = xlat; R.xctx_in = xctx; R.post = true; R.Y = BR; R.gate_chunk = 2; R.lng = FIN(20) + l * DM; R.lnb = FIN(21) + l * DM; R.mods_post = mods_l;
            R.xlat_out = ((float*)(F.a->out)); R.xctx_out = XC; R.domod = true; R.mods_mod = mods_l; R.shift_chunk = 3; R.scale_chunk = 4; R.Hout = H; R.dodt = false; R.DTout = DT;
            row_pass(F, R, FIN(6));
        }
        GSYNC();
        { pg8::Gemm g{H, WUP, Mpost, 2 * FFH}; pg8::StaticOrder S; S.init(Mpost, 2 * FFH, F.G, F.bid);
          pg8::EpiSwiGLU E{MIX, FFH}; pg8::gemm_phase<pg8::EpiSwiGLU, DM, DM, DM, 0, 0>(F.lds, g, S, E, tid_from_lds(F.lds, F.wave_s)); }
        GSYNC();
        { pg8::Gemm g{MIX, WDN, MLAT, DM}; pg8::StaticOrder S; S.init(MLAT, DM, F.G, F.bid);
          pg8::EpiStore E{BR, DM}; pg8::gemm_phase<pg8::EpiStore, FFH, FFH, FFH, 0, 0>(F.lds, g, S, E, tid_from_lds(F.lds, F.wave_s)); }
        if (!last) {
          pg8::Gemm g{MIX, WDN, MALL, DM}; pg8::SplitOrder S; S.init(MCTX / 256, DM / 256, FFH / 256, MLAT / 256, F.G, F.bid);
          pg8::EpiSlab E{SLABS, MLAT / 256, MCTX}; pg8::gemm_phase<pg8::EpiSlab, 256, FFH, FFH, 0, 0, pg8::SplitOrder>(F.lds, g, S, E, tid_from_lds(F.lds, F.wave_s)); }
        GSYNC();
        {
            RowOp R{}; R.nrows = Mpost; R.xlat_in = ((float*)(F.a->out)); R.xctx_in = XC; R.post = true; R.Y = BR; R.slabs = SLABS; R.nslab = last ? 0 : FFH / 256; R.slab_row0 = MLAT; R.gate_chunk = 5; R.lng = FIN(24) + l * DM; R.lnb = FIN(25) + l * DM; R.mods_post = mods_l;
            R.xlat_out = ((float*)(F.a->out)); R.xctx_out = XC; R.domod = !last; R.mods_mod = MODS + (size_t)(l + 1) * 5 * 6144; R.shift_chunk = 0; R.scale_chunk = 1; R.Hout = H; R.dodt = !last; R.DTout = DT;
            row_pass(F, R, FIN(6) + (size_t)(last ? l : l + 1) * DM * INC);
            if (!last) { convert_weights<0>(F, l + 1); GSYNC(); }
        }
}

__global__ void __launch_bounds__(NTHREADS, 2) fwd_megakernel(Args args) {
    extern __shared__ __attribute__((aligned(16))) unsigned char lds_raw[];
    Frame F;
    F.lds = (LAS unsigned char*)lds_raw;
    F.G = gridDim.x; F.bid = blockIdx.x; F.a = &args; F.ws = args.ws; F.ws0 = args.ws;
    { const int t0 = threadIdx.x; F.wave_s = __builtin_amdgcn_readfirstlane(t0 >> 6);
      *(LAS int*)(F.lds + TIDTAB_OFF + t0 * 4) = t0;
      volatile LAS unsigned* bst0 = (volatile LAS unsigned*)(F.lds + 8 * WLDS); if (t0 < 2) bst0[t0] = 0u; }
    __syncthreads();
    refresh(F);
    volatile LAS unsigned* bst = (volatile LAS unsigned*)(F.lds + 8 * WLDS);
    const XcdBarrier bar = xcd_barrier_post((unsigned*)(F.ws + WS_CTL), bst, F.tid == 0);

    mods_phase(F);
    convert_weights<0>(F, 0);
    GSYNC();
    {
        RowOp R{}; R.nrows = MALL; R.xlat_in = FIN(0); R.xctx_in = FIN(2); R.post = false; R.domod = true; R.mods_mod = MODS; R.shift_chunk = 0; R.scale_chunk = 1;
        R.Hout = (bf16_t*)(F.ws + WS_RA); R.dodt = true; R.DTout = DT;
        row_pass(F, R, FIN(6));
    }
    GSYNC();

    layer_body<0>(F, bar);
    layer_body<1>(F, bar);
}

extern "C" void kernel_launch(void* const* d_in, const int* in_sizes, int n_in, void* d_out, int out_size, void* d_ws, size_t ws_size, hipStream_t stream) {
    static int grid = 0;
    if (grid == 0) {
        if (n_in != 26 || out_size != MLAT * DM || ws_size < WS_END) { fprintf(stderr, "kernel_launch: unexpected shapes (n_in %d out %d ws %zu)\n", n_in, out_size, ws_size); grid = -1; return; }
        int dev = 0, cus = 0, per_cu = 0;
        hipGetDevice(&dev); hipDeviceGetAttribute(&cus, hipDeviceAttributeMultiprocessorCount, dev);
        hipFuncSetAttribute((const void*)fwd_megakernel, hipFuncAttributeMaxDynamicSharedMemorySize, LDS_BYTES);
        hipOccupancyMaxActiveBlocksPerMultiprocessor(&per_cu, (const void*)fwd_megakernel, NTHREADS, LDS_BYTES);
        if (per_cu < 1) { fprintf(stderr, "kernel_launch: occupancy query says %d\n", per_cu); per_cu = 1; }
        (void)hipGetLastError();
        grid = cus * 1;
    }
    if (grid < 0) return;
    if (hipMemsetAsync((char*)d_ws + WS_CTL, 0, CTL_ZERO_BYTES, stream) != hipSuccess) { fprintf(stderr, "kernel_launch: memset failed\n"); return; }
    Args a{};
    for (int i = 0; i < 26; ++i) a.in[i] = (GAS const float*)d_in[i];
    a.out = (GAS float*)d_out; a.ws = (GAS unsigned char*)d_ws;
    hipLaunchKernelGGL(fwd_megakernel, dim3(grid), dim3(NTHREADS), LDS_BYTES, stream, a);
    hipError_t e = hipPeekAtLastError();
    if (e != hipSuccess) fprintf(stderr, "launch failed: %s (grid %d)\n", hipGetErrorString(e), grid);
}
```

```cpp
#include <hip/hip_runtime.h>
#include <cstdio>
#include <cstdint>

#define LAS __attribute__((address_space(3)))
typedef unsigned short bf16_t;
typedef short bf16x8 __attribute__((ext_vector_type(8)));
typedef float f32x4 __attribute__((ext_vector_type(4)));
typedef unsigned u32x4 __attribute__((ext_vector_type(4)));
typedef unsigned u32x2 __attribute__((ext_vector_type(2)));

constexpr int DM = 1024, NB = 4, SEQ = 4096, CTXL = 256, DEPTH = 2;
constexpr int MLAT = NB * SEQ;
constexpr int MCTX = NB * CTXL;
constexpr int MALL = MLAT + MCTX;
constexpr int INC = 7688;
constexpr int NMIX = 3584;
constexpr int FFH = 2816;
constexpr float LN_EPS = 1e-6f;
constexpr float ALPHA = 1.4142135623730951f;
constexpr int C_AQ = 0, C_AFF = 256, C_AFB = 512, C_AV = 768, C_AG = 1024, C_BZ = 1280, C_BX = 1536, C_BB = 1792, C_BC = 2048,
              C_CQ = 2304, C_CK = 2560, C_CV = 2816, C_DQ = 3072, C_DK = 3328, C_DV = 3456;

constexpr size_t MiB = 1u << 20;
constexpr size_t WS_CTL = 0, CTL_ZERO_BYTES = 32768 + 8 * 68 * 256;
constexpr size_t WS_SEAM = 32768;
constexpr size_t WS_MODS = 1 * MiB;
constexpr size_t WS_DT = 2 * MiB;
constexpr size_t WS_XC = 3 * MiB;
constexpr size_t WS_WIN = 8 * MiB;
constexpr size_t WS_WBR = 23 * MiB;
constexpr size_t WS_WOUT = 25 * MiB;
constexpr size_t WS_WUP = 33 * MiB;
constexpr size_t WS_WDN = 44 * MiB;
constexpr size_t WS_RA = 50 * MiB;
constexpr size_t WS_RB = 84 * MiB;
constexpr size_t WS_RC = 118 * MiB;
constexpr size_t WS_OBA = WS_RC + 119 * MiB;
constexpr size_t WS_OBB = WS_OBA + 17 * MiB / 2;
constexpr size_t WS_END = 254 * MiB;
constexpr size_t WS_STA = 33 * MiB;
constexpr size_t WS_STB = WS_STA + (size_t)32 * 17 * 4096 * 2;
constexpr size_t WS_DLA = 46 * MiB;
constexpr size_t WS_DLB = 47 * MiB;
static_assert(WS_STB + (size_t)64 * 17 * 4096 * 2 <= WS_DLA, "scan state map");

constexpr int NWAVES = 8, NTHREADS = 512;
constexpr int LDS_BYTES = 155648 + 64 + 2048;
constexpr int WLDS = 19456;

__device__ __forceinline__ float bf2f(unsigned u) { return __uint_as_float(u << 16); }
__device__ __forceinline__ float bflo(unsigned w) { return __uint_as_float(w << 16); }
__device__ __forceinline__ float bfhi(unsigned w) { return __uint_as_float(w & 0xffff0000u); }
__device__ __forceinline__ unsigned f2bf(float f) { unsigned u = __float_as_uint(f); return (u + 0x7fffu + ((u >> 16) & 1u)) >> 16; }
__device__ __forceinline__ unsigned pk2(float lo, float hi) { return f2bf(lo) | (f2bf(hi) << 16); }
__device__ __forceinline__ float sigmoidf_(float x) { return __builtin_amdgcn_rcpf(1.f + __expf(-x)); }
__device__ __forceinline__ float siluf_(float x) { return x * sigmoidf_(x); }
template <int CTRL, int RMASK, bool BC> __device__ __forceinline__ float dppf_(float v) { return __int_as_float(__builtin_amdgcn_update_dpp(0, __float_as_int(v), CTRL, RMASK, 0xF, BC)); }
__device__ __forceinline__ float wave_sum(float v) {
    v += dppf_<0xB1, 0xF, true>(v);
    v += dppf_<0x4E, 0xF, true>(v);
    v += dppf_<0x141, 0xF, true>(v);
    v += dppf_<0x140, 0xF, true>(v);
    v += dppf_<0x142, 0xA, false>(v);
    v += dppf_<0x143, 0xC, false>(v);
    return __int_as_float(__builtin_amdgcn_readlane(__float_as_int(v), 63));
}
#define LDS_WAIT() asm volatile("s_waitcnt lgkmcnt(0)" ::: "memory")

__device__ __forceinline__ void wt8a(void* p, u32x2 v) { __hip_atomic_store((unsigned long long*)p, ((unsigned long long)v.y << 32) | v.x, __ATOMIC_RELAXED, __HIP_MEMORY_SCOPE_AGENT); }

namespace pg8 {
constexpr int BM = 256, BK = 64, HALF = 128, HTB = HALF * BK * 2, STAGE_BYTES = 8 * HTB, NXCD = 8, WGM = 8;
__host__ __device__ __forceinline__ int lds_byte(int r, int c) { const int st = (r >> 4) * 2 + (c >> 5), rr = r & 15, cc = c & 31, ob = rr * 64 + cc * 2; return st * 1024 + (ob ^ (((ob >> 9) & 1) << 5)); }
__host__ __device__ __forceinline__ void stage_rc(int b, int& R, int& C) { const int st = b / 1024, sb = b % 1024, swz = sb ^ (((sb >> 9) & 1) << 5); R = (st >> 1) * 16 + swz / 64; C = (st & 1) * 32 + (swz % 64) / 2; }
__host__ __device__ __forceinline__ int perm32(int rho) { const int n = rho >> 4, i = rho & 15; return 8 * (i >> 2) + 4 * n + (i & 3); }

struct Unit { int pm, pn, kc; };
struct Gemm { const bf16_t* A; const bf16_t* Bt; int M, N; };

__device__ __forceinline__ void st16_wt(void* p, u32x4 v) { asm volatile("global_store_dwordx4 %0, %1, off sc1\n\ts_nop 1" :: "v"(p), "v"(v) : "memory"); }
struct StaticOrder {
    __device__ __forceinline__ void a_ready(const Unit&, int, int) const {}
    __device__ __forceinline__ void done(const Unit&, int) const {}
    int nM, nN, nwg, G, c;
    __device__ void init(int M, int N, int G_, int c_) { nM = M / BM; nN = N / BM; nwg = nM * nN; G = G_; c = c_; }
    __device__ bool next(int i, Unit& u) const {
        const long L = (long)i * G + c; if (L >= nwg) return false;
        int wgid = (int)L; { const int q = nwg / NXCD, r = nwg % NXCD, xcd = wgid % NXCD, off = wgid / NXCD; wgid = (xcd < r ? xcd * (q + 1) : r * (q + 1) + (xcd - r) * q) + off; }
        const int nig = WGM * nN, gid = wgid / nig, fm = gid * WGM, gsz = (nM - fm) < WGM ? (nM - fm) : WGM;
        u.pm = fm + ((wgid % nig) % gsz); u.pn = (wgid % nig) / gsz; u.kc = 0; return true;
    }
};

struct SeamOrder : StaticOrder {
    const unsigned* ready; unsigned need; unsigned* pub; unsigned* tmo;
    __device__ __forceinline__ void a_ready(const Unit& u, int wid, int lane) const {
        if (ready == nullptr) return;
        if (wid == 0) {
            unsigned sp = 0u;
            while ((unsigned)__builtin_amdgcn_readfirstlane(__hip_atomic_load(ready + 64 * u.pm, __ATOMIC_RELAXED, __HIP_MEMORY_SCOPE_AGENT)) < need) {
                __builtin_amdgcn_s_sleep(2);
                if ((++sp & 255u) == 0u) { if (__builtin_amdgcn_readfirstlane(__hip_atomic_load(tmo, __ATOMIC_RELAXED, __HIP_MEMORY_SCOPE_AGENT)) != 0u) break; if (sp > (1u << 18)) { if (lane == 0) atomicAdd(tmo, 1u); break; } } }
            __builtin_amdgcn_fence(__ATOMIC_ACQUIRE, "agent");
            asm volatile("s_waitcnt vmcnt(0)" ::: "memory");
        }
        asm volatile("" ::: "memory"); __builtin_amdgcn_s_barrier(); asm volatile("" ::: "memory");
    }
    __device__ __forceinline__ void done(const Unit& u, int lane) const {
        if (pub == nullptr) return;
        asm volatile("s_waitcnt vmcnt(0)" ::: "memory");
        if (lane == 0) (void)__hip_atomic_fetch_add(pub + 64 * u.pm, 1u, __ATOMIC_RELAXED, __HIP_MEMORY_SCOPE_AGENT);
    }
};
struct SplitOrder {
    __device__ __forceinline__ void a_ready(const Unit&, int, int) const {}
    __device__ __forceinline__ void done(const Unit&, int) const {}
    int nsub, G, c, nkc, nn, pm0;
    __device__ void init(int ntiles_m, int nn_, int nkc_, int pm0_, int G_, int c_) { nn = nn_; nkc = nkc_; pm0 = pm0_; nsub = ntiles_m * nn_ * nkc_; G = G_; c = c_; }
    __device__ bool next(int i, Unit& u) const { const int L = i * G + c; if (L >= nsub) return false; const int tile = L / nkc; u.kc = L % nkc; u.pm = pm0 + tile / nn; u.pn = tile % nn; return true; }
};
struct GroupOrder {
    int ngrp, G, c;
    __device__ void init(int M, int G_, int c_) { ngrp = (M / BM) * 4; G = G_; c = c_; }
    __device__ bool next(int i, Unit& u) const { const int grp = (i >> 2) * G + c; if (grp >= ngrp) return false; u.pm = grp >> 2; u.pn = 4 * (i & 3) + (grp & 3); u.kc = 0; return true; }
};
typedef float f32x2c_t __attribute__((ext_vector_type(2))); typedef __bf16 bf16x2c_t __attribute__((ext_vector_type(2)));
__device__ __forceinline__ unsigned cvt_pk_bf16(float lo, float hi) { f32x2c_t v = {lo, hi}; bf16x2c_t b = __builtin_convertvector(v, bf16x2c_t); return __builtin_bit_cast(unsigned, b); }

struct EpiStore {
    bf16_t* O; int ldc;
    __device__ __forceinline__ void operator()(const f32x4 (&acc)[2][2][4][2], const Unit& u, int wr, int wc, int fr, int fq) const {
        const int row0 = u.pm * BM + wr * 64 + fr; const int col0 = u.pn * BM + wc * 32 + 8 * fq;
#pragma unroll
        for (int ai = 0; ai < 2; ++ai)
#pragma unroll
            for (int m = 0; m < 4; ++m) { bf16_t* rowp = O + (size_t)(row0 + ai * HALF + m * 16) * ldc + col0;
#pragma unroll
                for (int bj = 0; bj < 2; ++bj) { const f32x4 v0 = acc[ai][bj][m][0], v1 = acc[ai][bj][m][1];
                    u32x4 w; w.x = cvt_pk_bf16(v0[0], v0[1]); w.y = cvt_pk_bf16(v0[2], v0[3]); w.z = cvt_pk_bf16(v1[0], v1[1]); w.w = cvt_pk_bf16(v1[2], v1[3]);
                    st16_wt((rowp + bj * HALF), w); } }
    }
};
struct EpiStoreFG {
    bf16_t* O; int ldc; const float* lbp;
    __device__ __forceinline__ void operator()(const f32x4 (&acc)[2][2][4][2], const Unit& u, int wr, int wc, int fr, int fq) const {
        const int row0 = u.pm * BM + wr * 64 + fr; const int col0 = u.pn * BM + wc * 32 + 8 * fq;
        const bool isg = (u.pn == 1) || (u.pn == 2);
        float lb[2][8];
#pragma unroll
        for (int bj = 0; bj < 2; ++bj)
#pragma unroll
            for (int j = 0; j < 8; ++j) lb[bj][j] = 0.f;
        if (isg && lbp) { const float* p = lbp + (u.pn - 1) * 512 + wc * 32 + 8 * fq;
#pragma unroll
            for (int bj = 0; bj < 2; ++bj)
#pragma unroll
                for (int j = 0; j < 8; ++j) lb[bj][j] = __builtin_amdgcn_rcpf(1.f + __expf(p[bj * HALF + j] - p[256 + bj * HALF + j])); }
#pragma unroll
        for (int ai = 0; ai < 2; ++ai)
#pragma unroll
            for (int m = 0; m < 4; ++m) { bf16_t* rowp = O + (size_t)(row0 + ai * HALF + m * 16) * ldc + col0;
#pragma unroll
                for (int bj = 0; bj < 2; ++bj) { f32x4 v0 = acc[ai][bj][m][0], v1 = acc[ai][bj][m][1];
                    if (isg) {
#pragma unroll
                        for (int j = 0; j < 4; ++j) { v0[j] = fmaxf(__log2f(lb[bj][j] + (1.f - lb[bj][j]) * sigmoidf_(v0[j])), -126.f); v1[j] = fmaxf(__log2f(lb[bj][4 + j] + (1.f - lb[bj][4 + j]) * sigmoidf_(v1[j])), -126.f); } }
                    u32x4 w; w.x = cvt_pk_bf16(v0[0], v0[1]); w.y = cvt_pk_bf16(v0[2], v0[3]); w.z = cvt_pk_bf16(v1[0], v1[1]); w.w = cvt_pk_bf16(v1[2], v1[3]);
                    st16_wt((rowp + bj * HALF), w); } }
    }
};
struct EpiGateMul {
    bf16_t* O; int ldc;
    __device__ __forceinline__ void operator()(const f32x4 (&acc)[2][2][4][2], const Unit& u, int wr, int wc, int fr, int fq) const {
        const int row0 = u.pm * BM + wr * 64 + fr; const int col0 = u.pn * BM + wc * 32 + 8 * fq;
#pragma unroll
        for (int ai = 0; ai < 2; ++ai)
#pragma unroll
            for (int m = 0; m < 4; ++m) { bf16_t* rowp = O + (size_t)(row0 + ai * HALF + m * 16) * ldc + col0;
#pragma unroll
                for (int bj = 0; bj < 2; ++bj) { const f32x4 v0 = acc[ai][bj][m][0], v1 = acc[ai][bj][m][1];
                    const u32x4 g = *(const u32x4*)(rowp + bj * HALF);
                    u32x4 w;
                    w.x = cvt_pk_bf16(v0[0] * sigmoidf_(bflo(g.x)), v0[1] * sigmoidf_(bfhi(g.x)));
                    w.y = cvt_pk_bf16(v0[2] * sigmoidf_(bflo(g.y)), v0[3] * sigmoidf_(bfhi(g.y)));
                    w.z = cvt_pk_bf16(v1[0] * sigmoidf_(bflo(g.z)), v1[1] * sigmoidf_(bfhi(g.z)));
                    w.w = cvt_pk_bf16(v1[2] * sigmoidf_(bflo(g.w)), v1[3] * sigmoidf_(bfhi(g.w)));
                    st16_wt((rowp + bj * HALF), w); } }
    }
};
__device__ __forceinline__ size_t gate_frag_off(int pm, int pn16, int ai, int m, int bj, int tid) { return ((size_t)(pm * 16 + pn16) << 16) + (size_t)((((ai * 4 + m) * 2 + bj) * 512 + tid) * 8); }
struct EpiGateStore {
    bf16_t* G;
    __device__ __forceinline__ void operator()(const f32x4 (&acc)[2][2][4][2], const Unit& u, int wr, int wc, int fr, int fq) const {
        const int tid = (wr * 4 + wc) * 64 + fq * 16 + fr;
#pragma unroll
        for (int ai = 0; ai < 2; ++ai)
#pragma unroll
            for (int m = 0; m < 4; ++m)
#pragma unroll
                for (int bj = 0; bj < 2; ++bj) { const f32x4 v0 = acc[ai][bj][m][0], v1 = acc[ai][bj][m][1];
                    u32x4 w; w.x = cvt_pk_bf16(sigmoidf_(v0[0]), sigmoidf_(v0[1])); w.y = cvt_pk_bf16(sigmoidf_(v0[2]), sigmoidf_(v0[3]));
                    w.z = cvt_pk_bf16(sigmoidf_(v1[0]), sigmoidf_(v1[1])); w.w = cvt_pk_bf16(sigmoidf_(v1[2]), sigmoidf_(v1[3]));
                    st16_wt((G + gate_frag_off(u.pm, u.pn, ai, m, bj, tid)), w); }
    }
};
struct EpiGateAcc {
    const bf16_t* GATE; bf16_t* O;
    __device__ __forceinline__ void operator()(const f32x4 (&acc)[2][2][4][2], const Unit& u, int wr, int wc, int fr, int fq) const {
        const int row0 = u.pm * BM + wr * 64 + fr; const int colo = (u.pn & 3) * BM + wc * 32 + 8 * fq; const bool first = (u.pn < 4); const int tid = (wr * 4 + wc) * 64 + fq * 16 + fr;
#pragma unroll
        for (int ai = 0; ai < 2; ++ai)
#pragma unroll
            for (int m = 0; m < 4; ++m) { const size_t r = (size_t)(row0 + ai * HALF + m * 16); bf16_t* op = O + r * 1024 + colo;
#pragma unroll
                for (int bj = 0; bj < 2; ++bj) { const f32x4 v0 = acc[ai][bj][m][0], v1 = acc[ai][bj][m][1];
                    const u32x4 g = *(const u32x4*)(GATE + gate_frag_off(u.pm, u.pn, ai, m, bj, tid));
                    u32x4 p = (u32x4){0u, 0u, 0u, 0u}; if (!first) p = *(const u32x4*)(op + bj * HALF);
                    u32x4 w;
                    w.x = cvt_pk_bf16(bflo(p.x) + v0[0] * bflo(g.x), bfhi(p.x) + v0[1] * bfhi(g.x));
                    w.y = cvt_pk_bf16(bflo(p.y) + v0[2] * bflo(g.y), bfhi(p.y) + v0[3] * bfhi(g.y));
                    w.z = cvt_pk_bf16(bflo(p.z) + v1[0] * bflo(g.z), bfhi(p.z) + v1[1] * bfhi(g.z));
                    w.w = cvt_pk_bf16(bflo(p.w) + v1[2] * bflo(g.w), bfhi(p.w) + v1[3] * bfhi(g.w));
                    st16_wt((op + bj * HALF), w); } }
    }
};
struct EpiHorner {
    const bf16_t* GATE; bf16_t* O;
    static __device__ __forceinline__ float ratio_(float ga, float gb) { return ga * __builtin_amdgcn_rcpf(fmaxf(gb, 1e-30f)); }
    __device__ __forceinline__ void mid(f32x4 (&acc)[2][2][4][2], const Unit& u, int wr, int wc, int fr, int fq, int nb) const {
        const int tid = (wr * 4 + wc) * 64 + fq * 16 + fr;
        typedef __attribute__((address_space(1))) const u32x4 gu32x4;
        const gu32x4* ga = (const gu32x4*)(GATE + gate_frag_off(u.pm, nb * 4 + u.pn, 0, 0, 0, tid));
        const gu32x4* gb = (const gu32x4*)(GATE + gate_frag_off(u.pm, (nb + 1) * 4 + u.pn, 0, 0, 0, tid));
#pragma unroll
        for (int ai = 0; ai < 2; ++ai) {
            u32x4 a[8], b[8];
#pragma unroll
            for (int p = 0; p < 8; ++p) { a[p] = ga[(ai * 8 + p) * 512]; b[p] = gb[(ai * 8 + p) * 512]; }
            asm volatile("" ::: "memory");
#pragma unroll
            for (int m = 0; m < 4; ++m)
#pragma unroll
                for (int bj = 0; bj < 2; ++bj) { const u32x4 av = a[m * 2 + bj], bv = b[m * 2 + bj];
                    f32x4& v0 = acc[ai][bj][m][0]; f32x4& v1 = acc[ai][bj][m][1];
                    v0[0] *= ratio_(bflo(av.x), bflo(bv.x)); v0[1] *= ratio_(bfhi(av.x), bfhi(bv.x)); v0[2] *= ratio_(bflo(av.y), bflo(bv.y)); v0[3] *= ratio_(bfhi(av.y), bfhi(bv.y));
                    v1[0] *= ratio_(bflo(av.z), bflo(bv.z)); v1[1] *= ratio_(bfhi(av.z), bfhi(bv.z)); v1[2] *= ratio_(bflo(av.w), bflo(bv.w)); v1[3] *= ratio_(bfhi(av.w), bfhi(bv.w)); }
        }
    }
    __device__ __forceinline__ void operator()(const f32x4 (&acc)[2][2][4][2], const Unit& u, int wr, int wc, int fr, int fq) const {
        const int row0 = u.pm * BM + wr * 64 + fr; const int col0 = u.pn * BM + wc * 32 + 8 * fq; const int tid = (wr * 4 + wc) * 64 + fq * 16 + fr;
        typedef __attribute__((address_space(1))) const u32x4 gu32x4;
        const gu32x4* gg = (const gu32x4*)(GATE + gate_frag_off(u.pm, 12 + u.pn, 0, 0, 0, tid));
#pragma unroll
        for (int ai = 0; ai < 2; ++ai) {
            u32x4 g[8];
#pragma unroll
            for (int p = 0; p < 8; ++p) g[p] = gg[(ai * 8 + p) * 512];
            asm volatile("" ::: "memory");
#pragma unroll
            for (int m = 0; m < 4; ++m) { bf16_t* op = O + (size_t)(row0 + ai * HALF + m * 16) * 1024 + col0;
#pragma unroll
                for (int bj = 0; bj < 2; ++bj) { const f32x4 v0 = acc[ai][bj][m][0], v1 = acc[ai][bj][m][1]; const u32x4 gv = g[m * 2 + bj];
                    u32x4 w;
                    w.x = cvt_pk_bf16(v0[0] * bflo(gv.x), v0[1] * bfhi(gv.x)); w.y = cvt_pk_bf16(v0[2] * bflo(gv.y), v0[3] * bfhi(gv.y));
                    w.z = cvt_pk_bf16(v1[0] * bflo(gv.z), v1[1] * bfhi(gv.z)); w.w = cvt_pk_bf16(v1[2] * bflo(gv.w), v1[3] * bfhi(gv.w));
                    st16_wt((op + bj * HALF), w); } }
        }
    }
};
struct EpiSlab {
    bf16_t* S; int pm0, rows;
    __device__ __forceinline__ void operator()(const f32x4 (&acc)[2][2][4][2], const Unit& u, int wr, int wc, int fr, int fq) const {
        const int row0 = (u.pm - pm0) * BM + wr * 64 + fr; const int col0 = u.pn * BM + wc * 32 + 8 * fq; bf16_t* base = S + (size_t)u.kc * rows * 1024;
#pragma unroll
        for (int ai = 0; ai < 2; ++ai)
#pragma unroll
            for (int m = 0; m < 4; ++m) { bf16_t* rowp = base + (size_t)(row0 + ai * HALF + m * 16) * 1024 + col0;
#pragma unroll
                for (int bj = 0; bj < 2; ++bj) { const f32x4 v0 = acc[ai][bj][m][0], v1 = acc[ai][bj][m][1];
                    u32x4 w; w.x = cvt_pk_bf16(v0[0], v0[1]); w.y = cvt_pk_bf16(v0[2], v0[3]); w.z = cvt_pk_bf16(v1[0], v1[1]); w.w = cvt_pk_bf16(v1[2], v1[3]);
                    st16_wt((rowp + bj * HALF), w); } }
    }
};
struct EpiSwiGLU {
    bf16_t* O; int ldc;
    __device__ __forceinline__ void operator()(const f32x4 (&acc)[2][2][4][2], const Unit& u, int wr, int wc, int fr, int fq) const {
        const int row0 = u.pm * BM + wr * 64 + fr; const int col0 = u.pn * HALF + wc * 32 + 8 * fq;
#pragma unroll
        for (int ai = 0; ai < 2; ++ai)
#pragma unroll
            for (int m = 0; m < 4; ++m) { bf16_t* rowp = O + (size_t)(row0 + ai * HALF + m * 16) * ldc + col0;
                const f32x4 g0 = acc[ai][0][m][0], g1 = acc[ai][0][m][1], u0 = acc[ai][1][m][0], u1 = acc[ai][1][m][1];
                u32x4 w;
                w.x = cvt_pk_bf16(siluf_(g0[0]) * u0[0], siluf_(g0[1]) * u0[1]); w.y = cvt_pk_bf16(siluf_(g0[2]) * u0[2], siluf_(g0[3]) * u0[3]);
                w.z = cvt_pk_bf16(siluf_(g1[0]) * u1[0], siluf_(g1[1]) * u1[1]); w.w = cvt_pk_bf16(siluf_(g1[2]) * u1[2], siluf_(g1[3]) * u1[3]);
                st16_wt(rowp, w); }
    }
};

template <class Epi, int K, int LDA, int LDB, int ADIV, int ACOLS, class Sched = StaticOrder, int MIDK = 0, bool ALIGN_EPI = true>
__device__ __forceinline__ void gemm_phase(LAS unsigned char* lds, const Gemm g, const Sched& S, const Epi& E, int tid_) {
    const int tid = tid_, wid = __builtin_amdgcn_readfirstlane(tid >> 6), lane = tid & 63, wr = wid >> 2, wc = wid & 3, fr = lane & 15, fq = lane >> 4;
    constexpr int nt = K / BK;
    unsigned voffA, voffB;
    { int R, C; stage_rc(tid * 16, R, C); const int Rb = (R & ~31) + perm32(R & 31); voffA = (unsigned)(R * LDA + C) * 2u; voffB = (unsigned)(Rb * LDB + C) * 2u; }
    constexpr size_t p1offA = (size_t)64 * LDA * 2, p1offB = (size_t)64 * LDB * 2;
    constexpr size_t kstep = (size_t)(BK * 2);
    constexpr size_t hstepA = (size_t)HALF * LDA * 2, hstepB = (size_t)HALF * LDB * 2;
    constexpr size_t tstepA = 2 * hstepA, tstepB = 2 * hstepB;
    const unsigned ldsw = (unsigned)wid * 1024u;
    const int aoff = lds_byte(wr * 64 + fr, fq * 8), boff = lds_byte(wc * 32 + fr, fq * 8);
#define PG8_SA(b, h) (((b) * 2 + (h)) * HTB)
#define PG8_SB(b, h) ((4 + (b) * 2 + (h)) * HTB)
#define PG8_STAGE(bufoff, gbase, voff) do { _Pragma("unroll") for (int _i = 0; _i < 2; ++_i) \
        __builtin_amdgcn_global_load_lds((const unsigned*)((const char*)(gbase) + _i * p1##voff + (v##voff)), (LAS unsigned*)(lds + (bufoff) + ldsw + _i * 8192), 16, 0, 0); } while (0)
#define PG8_LDA(dst, b, h) do { _Pragma("unroll") for (int m = 0; m < 4; ++m) _Pragma("unroll") for (int k = 0; k < 2; ++k) dst[m][k] = *(const LAS bf16x8*)(lds + PG8_SA(b, h) + aoff + m * 2048 + k * 1024); } while (0)
#define PG8_LDB(dst, b, h) do { _Pragma("unroll") for (int n = 0; n < 2; ++n) _Pragma("unroll") for (int k = 0; k < 2; ++k) dst[n][k] = *(const LAS bf16x8*)(lds + PG8_SB(b, h) + boff + n * 2048 + k * 1024); } while (0)
#define PG8_MMA(ai, bj, At, Bt) do { __builtin_amdgcn_s_setprio(1); _Pragma("unroll") for (int m = 0; m < 4; ++m) _Pragma("unroll") for (int n = 0; n < 2; ++n) _Pragma("unroll") for (int k = 0; k < 2; ++k) \
        acc[ai][bj][m][n] = __builtin_amdgcn_mfma_f32_16x16x32_bf16(Bt[n][k], At[m][k], acc[ai][bj][m][n], 0, 0, 0); __builtin_amdgcn_s_setprio(0); } while (0)
#define PG8_WAIT_V(n) asm volatile("s_waitcnt vmcnt(" #n ")" ::: "memory")
#define PG8_WAIT_L(n) asm volatile("s_waitcnt lgkmcnt(" #n ")" ::: "memory")
#define PG8_BAR __builtin_amdgcn_s_barrier()
#define PG8_SCHED __builtin_amdgcn_sched_barrier(0)
#define PG8_ACOL(pn) (ADIV ? (size_t)(((pn) / (ADIV ? ADIV : 1)) * ACOLS) * 2 : (size_t)0)
    Unit cur, nxt; int ui = 0;
    if (!S.next(0, cur)) return;
    S.a_ready(cur, wid, lane);
    f32x4 acc[2][2][4][2];
#pragma unroll
    for (int a = 0; a < 2; ++a)
#pragma unroll
        for (int b = 0; b < 2; ++b)
#pragma unroll
            for (int m = 0; m < 4; ++m)
#pragma unroll
                for (int n = 0; n < 2; ++n) acc[a][b][m][n] = (f32x4){0.f, 0.f, 0.f, 0.f};
    bf16x8 At[4][2], B0[2][2], B1[2][2];
    const char* cA = (const char*)g.A + (size_t)cur.pm * tstepA + PG8_ACOL(cur.pn) + (size_t)cur.kc * (K * 2); const char* cB = (const char*)g.Bt + (size_t)cur.pn * tstepB + (size_t)cur.kc * (K * 2);
    PG8_STAGE(PG8_SB(0, 0), cB, offB); PG8_STAGE(PG8_SB(0, 1), cB + hstepB, offB); PG8_STAGE(PG8_SA(0, 0), cA, offA); PG8_STAGE(PG8_SA(0, 1), cA + hstepA, offA);
    if (wr == 1) PG8_BAR;
    PG8_WAIT_V(2); PG8_BAR;
    PG8_STAGE(PG8_SB(1, 0), cB + kstep, offB); PG8_STAGE(PG8_SA(1, 0), cA + kstep, offA); PG8_STAGE(PG8_SB(1, 1), cB + hstepB + kstep, offB);
    PG8_WAIT_V(6); PG8_BAR;
    for (;;) {
        const bool has_next = S.next(ui + 1, nxt);
        const char* nA = has_next ? (const char*)g.A + (size_t)nxt.pm * tstepA + PG8_ACOL(nxt.pn) + (size_t)nxt.kc * (K * 2) : cA; const char* nB = has_next ? (const char*)g.Bt + (size_t)nxt.pn * tstepB + (size_t)nxt.kc * (K * 2) : cB;
#pragma unroll 1
        for (int t = 0; t < nt; t += 2) {
            const bool last = (t == nt - 2);
            if (last && has_next) S.a_ready(nxt, wid, lane);
            const char* a1 = cA + (size_t)(t + 1) * kstep;
            const char* a2 = last ? nA : cA + (size_t)(t + 2) * kstep; const char* b2 = last ? nB : cB + (size_t)(t + 2) * kstep;
            const char* a3 = a2 + kstep; const char* b3 = b2 + kstep;
            PG8_LDB(B0, 0, 0); PG8_LDB(B1, 0, 1); PG8_SCHED; PG8_LDA(At, 0, 0); PG8_STAGE(PG8_SA(1, 1), a1 + hstepA, offA);
            PG8_WAIT_V(8); PG8_WAIT_L(0); PG8_BAR; PG8_MMA(0, 0, At, B0); PG8_MMA(0, 1, At, B1); PG8_BAR; PG8_SCHED;
            PG8_LDA(At, 0, 1); PG8_STAGE(PG8_SB(0, 0), b2, offB); PG8_STAGE(PG8_SB(0, 1), b2 + hstepB, offB); PG8_STAGE(PG8_SA(0, 0), a2, offA);
            PG8_WAIT_V(8); PG8_WAIT_L(0); PG8_BAR; PG8_MMA(1, 0, At, B0); PG8_MMA(1, 1, At, B1); PG8_BAR; PG8_SCHED;
            PG8_LDB(B0, 1, 0); PG8_LDB(B1, 1, 1); PG8_SCHED; PG8_LDA(At, 1, 0); PG8_STAGE(PG8_SA(0, 1), a2 + hstepA, offA);
            PG8_WAIT_V(8); PG8_WAIT_L(0); PG8_BAR; PG8_MMA(0, 0, At, B0); PG8_MMA(0, 1, At, B1); PG8_BAR; PG8_SCHED;
            PG8_LDA(At, 1, 1); PG8_STAGE(PG8_SB(1, 0), b3, offB); PG8_STAGE(PG8_SB(1, 1), b3 + hstepB, offB); PG8_STAGE(PG8_SA(1, 0), a3, offA);
            PG8_WAIT_V(8); PG8_WAIT_L(0); PG8_BAR; PG8_MMA(1, 0, At, B0); PG8_MMA(1, 1, At, B1); PG8_BAR; PG8_SCHED;
            if constexpr (MIDK > 0) {
                constexpr int seg = MIDK / BK; if (((t + 2) % seg) == 0 && t + 2 < nt) E.mid(acc, cur, wr, wc, fr, fq, (t + 2) / seg - 1); }
        }
        if constexpr (ALIGN_EPI) { if (wr == 0) PG8_BAR; }
        E(acc, cur, wr, wc, fr, fq); S.done(cur, lane);
        if (!has_next) break;
#pragma unroll
        for (int a = 0; a < 2; ++a)
#pragma unroll
            for (int b = 0; b < 2; ++b)
#pragma unroll
                for (int m = 0; m < 4; ++m)
#pragma unroll
                    for (int n = 0; n < 2; ++n) acc[a][b][m][n] = (f32x4){0.f, 0.f, 0.f, 0.f};
        cur = nxt; cA = nA; cB = nB; ++ui;
        if constexpr (ALIGN_EPI) { if (wr == 1) PG8_BAR; }
    }
    PG8_WAIT_V(0);
    if constexpr (!ALIGN_EPI) { if (wr == 0) PG8_BAR; }
    PG8_BAR;
#undef PG8_SA
#undef PG8_SB
#undef PG8_STAGE
#undef PG8_LDA
#undef PG8_LDB
#undef PG8_MMA
#undef PG8_WAIT_V
#undef PG8_WAIT_L
#undef PG8_BAR
#undef PG8_SCHED
#undef PG8_ACOL
}
}

#define GAS __attribute__((address_space(1)))
struct Args { GAS const float* in[26]; GAS float* out; GAS unsigned char* ws; };

struct Frame {
    LAS unsigned char* lds;
    int tid, lane, wave, G, bid, wave_s;
    const Args* a; GAS unsigned char* ws; GAS unsigned char* ws0;
};
constexpr int TIDTAB_OFF = 8 * 19456 + 64;
__device__ __forceinline__ int tid_from_lds(LAS unsigned char* lds, int wave_s) {
    int ln; asm volatile("v_mbcnt_lo_u32_b32 %0, -1, 0\n\tv_mbcnt_hi_u32_b32 %0, -1, %0" : "=v"(ln));
    const int t = *(const volatile LAS int*)(lds + TIDTAB_OFF + (wave_s * 64 + ln) * 4);
    __builtin_assume(t >= 0 && t < 512);
    return t;
}
#define FIN(i) ((const float*)(F.a->in[i]))
__device__ __forceinline__ void refresh(Frame& F) { const int t = tid_from_lds(F.lds, F.wave_s); F.tid = t; F.lane = t & 63; F.wave = __builtin_amdgcn_readfirstlane(t >> 6);
    GAS unsigned char* w = F.ws0; asm volatile("" : "+s"(w)); F.ws = w; }

__device__ __forceinline__ void transpose_item(const float* W, int ldw, int k0, int nsrc0, bf16_t* WT, int ldt, int drow0, int dcol0, int nrep, int drep, LAS float* scr, int lane) {
    float tv[32];
#pragma unroll
    for (int i = 0; i < 32; ++i) { const int kk = 2 * i + (lane >> 5); tv[i] = __builtin_nontemporal_load(W + (size_t)(k0 + kk) * ldw + nsrc0 + (lane & 31)); }
#pragma unroll
    for (int i = 0; i < 32; ++i) { const int kk = 2 * i + (lane >> 5); scr[kk * 33 + (lane & 31)] = tv[i]; }
    LDS_WAIT(); asm volatile("" ::: "memory");
    const int c = lane & 7;
#pragma unroll
    for (int j = 0; j < 4; ++j) { const int n = (lane >> 3) + 8 * j; const LAS float* s = scr + (8 * c) * 33 + n;
        u32x4 o; o.x = pk2(s[0 * 33], s[1 * 33]); o.y = pk2(s[2 * 33], s[3 * 33]); o.z = pk2(s[4 * 33], s[5 * 33]); o.w = pk2(s[6 * 33], s[7 * 33]);
        for (int r = 0; r < nrep; ++r) *(u32x4*)(WT + (size_t)(drow0 + n) * ldt + dcol0 + r * drep + k0 + 8 * c) = o; }
    LDS_WAIT(); asm volatile("" ::: "memory");
}
template <int PART>
__device__ __forceinline__ void convert_weights(Frame& F, int l, int b0 = 0, int nb = 0) {
    refresh(F);
    LAS float* scr = (LAS float*)(F.lds + F.wave * 16384);
    if (nb == 0) nb = F.G;
    if (F.bid < b0 || F.bid >= b0 + nb) return;
    const int gw = (F.bid - b0) * NWAVES + F.wave, NGW = nb * NWAVES;
    const float* w_in = FIN(6) + (size_t)l * DM * INC;
    const float* w_br = FIN(18) + (size_t)l * 4 * 256 * DM;
    const float* w_out = FIN(19) + (size_t)l * DM * DM;
    const float* w_up = FIN(22) + (size_t)l * DM * 2 * FFH;
    const float* w_dn = FIN(23) + (size_t)l * FFH * DM;
    bf16_t* WIN = (bf16_t*)(F.ws + WS_WIN); bf16_t* WBR = (bf16_t*)(F.ws + WS_WBR); bf16_t* WOUT = (bf16_t*)(F.ws + WS_WOUT);
    bf16_t* WUP = (bf16_t*)(F.ws + WS_WUP); bf16_t* WDN = (bf16_t*)(F.ws + WS_WDN);
    constexpr int I_IN = 16 * 240, I_BR = 4 * 4 * 32, I_OUT = 16 * 32, I_UP = 16 * 176, I_DN = 44 * 32;
    if (PART == 0) {
        for (int it = gw; it < I_IN + I_BR + I_OUT; it += NGW) {
            int r = it;
            if (r < I_IN) { const int kb = r / 240, nb = r % 240, d0 = nb * 32; const int s0 = d0 < 2304 ? d0 : d0 + 8;
                transpose_item(w_in, INC, kb * 64, s0, WIN, DM, d0, 0, 1, 0, scr, F.lane); continue; } r -= I_IN;
            if (r < I_BR) { const int n = r / 128, rr = r % 128, kb = rr / 32, nb = rr % 32;
                transpose_item(w_br + (size_t)n * 256 * DM, DM, kb * 64, nb * 32, WBR, DM, nb * 32, n * 256, 1, 0, scr, F.lane); continue; } r -= I_BR;
            { const int kb = r / 32, nb = r % 32; transpose_item(w_out, DM, kb * 64, nb * 32, WOUT, DM, nb * 32, 0, 1, 0, scr, F.lane); }
        }
    } else {
        for (int it = gw; it < I_UP + I_DN; it += NGW) {
            int r = it;
            if (r < I_UP) { const int kb = r / 176, nb = r % 176, d0 = nb * 32, tile = d0 >> 8, within = d0 & 255;
                const int s0 = within < 128 ? tile * 128 + within : FFH + tile * 128 + (within - 128);
                transpose_item(w_up, 2 * FFH, kb * 64, s0, WUP, DM, d0, 0, 1, 0, scr, F.lane); continue; } r -= I_UP;
            { const int kb = r / 32, nb = r % 32; transpose_item(w_dn, DM, kb * 64, nb * 32, WDN, FFH, nb * 32, 0, 1, 0, scr, F.lane); }
        }
    }
}

__device__ __forceinline__ void mods_phase(Frame& F) {
    refresh(F);
    LAS float* sil = (LAS float*)(F.lds);
    LAS float* part = sil + 5 * 1024;
    if (F.bid >= 192) return;
    const int l = F.bid / 96, cgp = F.bid % 96;
    for (int i = F.tid; i < 5 * 1024; i += NTHREADS) { const int r = i >> 10, k = i & 1023; const float cv = r < 4 ? FIN(1)[r * 1024 + k] : FIN(3)[k]; sil[i] = siluf_(cv); }
    __syncthreads();
    const float* aw = FIN(4) + (size_t)l * DM * 6144 + cgp * 64 + F.lane;
    float a0 = 0.f, a1 = 0.f, a2 = 0.f, a3 = 0.f, a4 = 0.f;
    const int kb = F.wave * 128;
#pragma unroll 32
    for (int k = 0; k < 128; ++k) { const float w = __builtin_nontemporal_load(aw + (size_t)(kb + k) * 6144);
        a0 += sil[kb + k] * w; a1 += sil[1024 + kb + k] * w; a2 += sil[2048 + kb + k] * w; a3 += sil[3072 + kb + k] * w; a4 += sil[4096 + kb + k] * w; }
    part[(F.wave * 5 + 0) * 64 + F.lane] = a0; part[(F.wave * 5 + 1) * 64 + F.lane] = a1; part[(F.wave * 5 + 2) * 64 + F.lane] = a2;
    part[(F.wave * 5 + 3) * 64 + F.lane] = a3; part[(F.wave * 5 + 4) * 64 + F.lane] = a4;
    __syncthreads();
    if (F.wave < 5) { float s = FIN(5)[l * 6144 + cgp * 64 + F.lane];
#pragma unroll
        for (int w = 0; w < 8; ++w) s += part[(w * 5 + F.wave) * 64 + F.lane];
        ((float*)(F.ws + WS_MODS))[(size_t)(l * 5 + F.wave) * 6144 + cgp * 64 + F.lane] = s; }
    __syncthreads();
}

struct RowOp {
    int nrows;
    const float* xlat_in; const float* xctx_in;
    bool post;
    const bf16_t* Y; const bf16_t* slabs; int nslab; int slab_row0;
    int gate_chunk; const float* lng; const float* lnb; const float* mods_post;
    float* xlat_out; float* xctx_out;
    bool domod;
    const float* mods_mod; int shift_chunk, scale_chunk; bf16_t* Hout;
    bool dodt; float* DTout;
};
__device__ __forceinline__ void row_pass(Frame& F, const RowOp& R, const float* w_in_l) {
    refresh(F);
    LAS float* wdt = (LAS float*)F.lds;
    if (R.dodt) {
        for (int i = F.tid; i < 8192; i += NTHREADS) { const int c = i >> 10, k = i & 1023; wdt[i] = w_in_l[(size_t)k * INC + 2304 + c]; }
    }
    __syncthreads();
    const int gw = F.bid * NWAVES + F.wave, NGW = F.G * NWAVES;
    const int m0 = gw, m1 = R.nrows;
    const int lane = F.lane;
    f32x4 lg[4], lb[4], gt4[4], sh4[4], sc4[4];
    if (R.post) {
#pragma unroll
        for (int j = 0; j < 4; ++j) { lg[j] = *(const f32x4*)(R.lng + 4 * (lane + 64 * j)); lb[j] = *(const f32x4*)(R.lnb + 4 * (lane + 64 * j)); }
    }
    int cur_r5 = -1;
    f32x4 xn[4]; u32x2 yn[4];
#define RP_LOAD(M) do { const int m_ = (M); const float* xr_ = m_ < MLAT ? R.xlat_in + (size_t)m_ * DM : R.xctx_in + (size_t)(m_ - MLAT) * DM; \
        _Pragma("unroll") for (int j = 0; j < 4; ++j) xn[j] = __builtin_nontemporal_load((const f32x4*)(xr_ + 4 * (lane + 64 * j))); \
        if (R.post && !(R.nslab > 0 && m_ >= R.slab_row0)) { const bf16_t* yr_ = R.Y + (size_t)m_ * DM; _Pragma("unroll") for (int j = 0; j < 4; ++j) yn[j] = __builtin_nontemporal_load((const u32x2*)(yr_ + 4 * (lane + 64 * j))); } } while (0)
    if (m0 < m1) RP_LOAD(m0);
#pragma unroll 1
    for (int m = m0; m < m1; m += NGW) {
        const int r5 = m < MLAT ? (m >> 12) : 4;
        if (r5 != cur_r5) { cur_r5 = r5;
            if (R.post) { const float* gt = R.mods_post + (size_t)r5 * 6144 + R.gate_chunk * 1024;
#pragma unroll
                for (int j = 0; j < 4; ++j) gt4[j] = *(const f32x4*)(gt + 4 * (lane + 64 * j)); }
            if (R.domod) { const float* sh = R.mods_mod + (size_t)r5 * 6144 + R.shift_chunk * 1024; const float* sc = R.mods_mod + (size_t)r5 * 6144 + R.scale_chunk * 1024;
#pragma unroll
                for (int j = 0; j < 4; ++j) { sh4[j] = *(const f32x4*)(sh + 4 * (lane + 64 * j)); sc4[j] = *(const f32x4*)(sc + 4 * (lane + 64 * j)); } }
        }
        f32x4 v[4]; u32x2 yv[4];
#pragma unroll
        for (int j = 0; j < 4; ++j) { v[j] = xn[j]; yv[j] = yn[j]; }
        const bool slabrow = R.post && R.nslab > 0 && m >= R.slab_row0;
        float ys[4][4];
        if (slabrow) {
#pragma unroll
            for (int j = 0; j < 4; ++j) { const int c = 4 * (lane + 64 * j); ys[j][0] = ys[j][1] = ys[j][2] = ys[j][3] = 0.f; const bf16_t* sp = R.slabs + (size_t)(m - R.slab_row0) * 1024 + c;
                for (int sidx = 0; sidx < R.nslab; ++sidx) { const u32x2 yw = *(const u32x2*)(sp + (size_t)sidx * (MALL - R.slab_row0) * 1024); ys[j][0] += bflo(yw.x); ys[j][1] += bfhi(yw.x); ys[j][2] += bflo(yw.y); ys[j][3] += bfhi(yw.y); } }
        }
        if (m + NGW < m1) RP_LOAD(m + NGW);
        if (R.post) {
#pragma unroll
            for (int j = 0; j < 4; ++j) { const f32x4 g4 = gt4[j];
                const float y0 = slabrow ? ys[j][0] : bflo(yv[j].x), y1 = slabrow ? ys[j][1] : bfhi(yv[j].x), y2 = slabrow ? ys[j][2] : bflo(yv[j].y), y3 = slabrow ? ys[j][3] : bfhi(yv[j].y);
                v[j].x = ALPHA * v[j].x + g4.x * y0; v[j].y = ALPHA * v[j].y + g4.y * y1;
                v[j].z = ALPHA * v[j].z + g4.z * y2; v[j].w = ALPHA * v[j].w + g4.w * y3; }
            float s = 0.f;
#pragma unroll
            for (int j = 0; j < 4; ++j) s += (v[j].x + v[j].y) + (v[j].z + v[j].w);
            const float mean = wave_sum(s) * (1.f / DM); float s2 = 0.f;
#pragma unroll
            for (int j = 0; j < 4; ++j) { v[j] = v[j] - mean; s2 += (v[j].x * v[j].x + v[j].y * v[j].y) + (v[j].z * v[j].z + v[j].w * v[j].w); }
            const float rstd = 1.f / sqrtf(wave_sum(s2) * (1.f / DM) + LN_EPS);
            float* xo = m < MLAT ? R.xlat_out + (size_t)m * DM : R.xctx_out + (size_t)(m - MLAT) * DM;
#pragma unroll
            for (int j = 0; j < 4; ++j) { const int c = 4 * (lane + 64 * j); v[j] = v[j] * rstd * lg[j] + lb[j]; __builtin_nontemporal_store(v[j], (f32x4*)(xo + c)); }
        }
        if (R.domod) {
            float s = 0.f;
#pragma unroll
            for (int j = 0; j < 4; ++j) s += (v[j].x + v[j].y) + (v[j].z + v[j].w);
            const float mean = wave_sum(s) * (1.f / DM); float s2 = 0.f;
#pragma unroll
            for (int j = 0; j < 4; ++j) { v[j] = v[j] - mean; s2 += (v[j].x * v[j].x + v[j].y * v[j].y) + (v[j].z * v[j].z + v[j].w * v[j].w); }
            const float rstd = 1.f / sqrtf(wave_sum(s2) * (1.f / DM) + LN_EPS);
            bf16_t* hr = R.Hout + (size_t)m * DM;
#pragma unroll
            for (int j = 0; j < 4; ++j) { const int c = 4 * (lane + 64 * j);
                v[j] = v[j] * rstd * (sc4[j] + 1.f) + sh4[j];
                u32x2 w; w.x = pk2(v[j].x, v[j].y); w.y = pk2(v[j].z, v[j].w); *(u32x2*)(hr + c) = w; }
            if (R.dodt) {
                float d[8];
#pragma unroll
                for (int c = 0; c < 8; ++c) { float a = 0.f;
                    asm volatile("" ::: "memory");
#pragma unroll
                    for (int j = 0; j < 4; ++j) { const f32x4 w4 = *(const LAS f32x4*)(wdt + c * 1024 + 4 * (lane + 64 * j)); a += (v[j].x * w4.x + v[j].y * w4.y) + (v[j].z * w4.z + v[j].w * w4.w); }
                    d[c] = wave_sum(a); }
                if (lane == 0) { *(f32x4*)(R.DTout + (size_t)m * 8) = (f32x4){d[0], d[1], d[2], d[3]}; *(f32x4*)(R.DTout + (size_t)m * 8 + 4) = (f32x4){d[4], d[5], d[6], d[7]}; }
            }
        }
    }
#undef RP_LOAD
    __syncthreads();
}

__device__ __forceinline__ void prep_phase(Frame& F, int l) {
    refresh(F);
    bf16_t* MIX = (bf16_t*)(F.ws + WS_RC);
    const float* qn = FIN(16) + l * 64; const float* kn = FIN(17) + l * 64;
    const int gt = F.bid * NTHREADS + F.tid, NGT = F.G * NTHREADS;
    for (int it = gt; it < MALL * 6; it += NGT) {
        const int m = it / 6, slot = it % 6;
        bf16_t* p = MIX + (size_t)m * NMIX + (slot < 4 ? C_DQ + 64 * slot : C_DK + 64 * (slot - 4));
        const float* nw = slot < 4 ? qn : kn;
        float x[64];
#pragma unroll
        for (int w = 0; w < 8; ++w) { const u32x4 u = *(const u32x4*)(p + 8 * w);
            x[8 * w + 0] = bflo(u.x); x[8 * w + 1] = bfhi(u.x); x[8 * w + 2] = bflo(u.y); x[8 * w + 3] = bfhi(u.y);
            x[8 * w + 4] = bflo(u.z); x[8 * w + 5] = bfhi(u.z); x[8 * w + 6] = bflo(u.w); x[8 * w + 7] = bfhi(u.w); }
        float ss = 0.f;
#pragma unroll
        for (int d = 0; d < 64; ++d) ss += x[d] * x[d];
        const float rs = 1.f / sqrtf(ss * (1.f / 64.f) + LN_EPS);
#pragma unroll
        for (int d = 0; d < 64; ++d) x[d] = x[d] * rs * nw[d];
        if (m < MLAT && slot < 4) {
#pragma unroll
            for (int d = 0; d < 64; ++d) x[d] *= 0.125f * 1.4426950408889634f; }
        if (m < MLAT) {
            const int t = m & 4095; const float prow = (float)(t >> 6), pcol = (float)(t & 63);
#pragma unroll
            for (int i = 0; i < 16; ++i) {
                const float inv = expf(-(float)i * (9.210340371976184f / 16.f));
                const float ar = prow * inv, ac = pcol * inv;
                const float sr = __sinf(ar), cr = __cosf(ar), sc = __sinf(ac), cc = __cosf(ac);
                const float a1 = x[i], a2 = x[16 + i]; x[i] = a1 * cr - a2 * sr; x[16 + i] = a2 * cr + a1 * sr;
                const float b1 = x[32 + i], b2 = x[48 + i]; x[32 + i] = b1 * cc - b2 * sc; x[48 + i] = b2 * cc + b1 * sc;
            }
        }
#pragma unroll
        for (int w = 0; w < 8; ++w) { u32x4 u; u.x = pk2(x[8 * w], x[8 * w + 1]); u.y = pk2(x[8 * w + 2], x[8 * w + 3]); u.z = pk2(x[8 * w + 4], x[8 * w + 5]); u.w = pk2(x[8 * w + 6], x[8 * w + 7]);
            *(u32x4*)(p + 8 * w) = u; }
    }
}

__device__ __forceinline__ void conv_to_lds(Frame& F, int l) {
    refresh(F);
    const bf16_t* MIX = (const bf16_t*)(F.ws + WS_RC);
    const float* cw = FIN(9) + (size_t)l * 5 * 768; const float* cb = FIN(10) + l * 768;
    LAS unsigned* cv = (LAS unsigned*)F.lds;
    if (F.tid < 384) {
        const int c = 2 * F.tid, r0 = 68 * F.bid;
        float w0[5], w1[5];
#pragma unroll
        for (int j = 0; j < 5; ++j) { w0[j] = cw[j * 768 + c]; w1[j] = cw[j * 768 + c + 1]; }
        const float b0 = cb[c], b1 = cb[c + 1];
        unsigned win[72];
#pragma unroll
        for (int j = 0; j < 72; ++j) { const int mm = r0 - 2 + j; win[j] = (mm >= 0 && mm < MALL) ? *(const unsigned*)(MIX + (size_t)mm * NMIX + C_BX + c) : 0u; }
#pragma unroll
        for (int r = 0; r < 68; ++r) {
            const int m = r0 + r;
            const int lo = m < MLAT ? (m & ~4095) : MLAT + ((m - MLAT) & ~255), hi = lo + (m < MLAT ? SEQ : CTXL);
            float a0 = b0, a1 = b1;
#pragma unroll
            for (int j = 0; j < 5; ++j) { const int mm = m + j - 2; const bool ok = (mm >= lo) && (mm < hi); a0 += ok ? w0[j] * bflo(win[r + j]) : 0.f; a1 += ok ? w1[j] * bfhi(win[r + j]) : 0.f; }
            cv[r * 384 + F.tid] = pk2(siluf_(a0), siluf_(a1));
        }
    }
}
__device__ __forceinline__ void conv_from_lds(Frame& F) {
    refresh(F);
    bf16_t* MIX = (bf16_t*)(F.ws + WS_RC);
    const LAS unsigned* cv = (const LAS unsigned*)F.lds;
    if (F.tid < 384) { const int r0 = 68 * F.bid;
        for (int r = 0; r < 68; ++r) *(unsigned*)(MIX + (size_t)(r0 + r) * NMIX + C_BX + 2 * F.tid) = cv[r * 384 + F.tid]; }
}

typedef short s16x4 __attribute__((ext_vector_type(4)));
typedef float f32x16 __attribute__((ext_vector_type(16)));
typedef float f32x2_t __attribute__((ext_vector_type(2))); typedef __bf16 bf16x2_t __attribute__((ext_vector_type(2)));
#define MFMA32(a, b, c) __builtin_amdgcn_mfma_f32_32x32x16_bf16((a), (b), (c), 0, 0, 0)
__device__ __forceinline__ unsigned cvtpk(float lo, float hi) { f32x2_t v = {lo, hi}; bf16x2_t b = __builtin_convertvector(v, bf16x2_t); return __builtin_bit_cast(unsigned, b); }
__device__ __forceinline__ int crow(int reg, int h) { return (reg & 3) + 8 * (reg >> 2) + 4 * h; }
template <int S_> __device__ __forceinline__ bf16x8 pack8(const f32x16& x) {
    u32x4 p; p.x = cvtpk(x[8 * S_], x[8 * S_ + 1]); p.y = cvtpk(x[8 * S_ + 2], x[8 * S_ + 3]); p.z = cvtpk(x[8 * S_ + 4], x[8 * S_ + 5]); p.w = cvtpk(x[8 * S_ + 6], x[8 * S_ + 7]);
    return __builtin_bit_cast(bf16x8, p);
}
__device__ __forceinline__ bf16x8 ld_row8(const LAS unsigned char* tb, int P, int r, int c0) { return *(const LAS bf16x8*)(tb + r * P + c0 * 2); }
__device__ __forceinline__ bf16x8 ld_row8_perm(const LAS unsigned char* tb, int P, int r, int c0, int h) {
    const s16x4 lo = *(const LAS s16x4*)(tb + r * P + (c0 + 4 * h) * 2), hi = *(const LAS s16x4*)(tb + r * P + (c0 + 8 + 4 * h) * 2);
    return __builtin_shufflevector(lo, hi, 0, 1, 2, 3, 4, 5, 6, 7);
}
__device__ __forceinline__ s16x4 tr4(const LAS unsigned char* tb, int P, int row0, int col0, int lane) {
    const int q = (lane & 15) >> 2, p = lane & 3, blk = (lane >> 4) & 1;
    return __builtin_bit_cast(s16x4, __builtin_amdgcn_ds_read_tr16_b64_v4i16((LAS s16x4*)(tb + (row0 + q) * P + (col0 + 16 * blk + 4 * p) * 2)));
}
__device__ __forceinline__ bf16x8 ld_tr8(const LAS unsigned char* tb, int P, int row_lo, int row_hi, int col0, int lane) {
    const s16x4 lo = tr4(tb, P, row_lo, col0, lane), hi = tr4(tb, P, row_hi, col0, lane);
    return __builtin_shufflevector(lo, hi, 0, 1, 2, 3, 4, 5, 6, 7);
}
__device__ __forceinline__ float bperm_(float v, int src_lane) { return __int_as_float(__builtin_amdgcn_ds_bpermute(src_lane * 4, __float_as_int(v))); }
__device__ __forceinline__ float softplusf_(float x) { return fmaxf(x, 0.f) + __logf(1.f + __expf(-fabsf(x))); }
constexpr int NCH = 17;
constexpr int TP64 = 144, TP32 = 80;

template <int NC> __device__ __forceinline__ void stage_tile(LAS unsigned char* tb, const bf16_t* MIX, int R0, int dir, int I, int col, int lane) {
    constexpr int CPR = NC / 8, NP = 32 * CPR / 64, P = NC == 64 ? TP64 : TP32;
#pragma unroll
    for (int t = 0; t < NP; ++t) { const int id = lane + 64 * t, r = id / CPR, ck = id % CPR; const int i = 32 * I + r; const int m = dir ? R0 + 255 - i : R0 + i;
        *(LAS u32x4*)(tb + r * P + ck * 16) = *(const u32x4*)(MIX + (size_t)m * NMIX + col + ck * 8); }
}

template <int NC> __device__ __forceinline__ void tile_load(u32x4 (&rg)[NC / 16], const bf16_t* MIX, int R0, int dir, int I, int col, int lane) {
    constexpr int CPR = NC / 8, NP = NC / 16;
#pragma unroll
    for (int t = 0; t < NP; ++t) { const int id = lane + 64 * t, r = id / CPR, ck = id % CPR; const int i = 32 * I + r; const int m = dir ? R0 + 255 - i : R0 + i;
        const unsigned off = (unsigned)m * (unsigned)(NMIX * 2) + (unsigned)((col + ck * 8) * 2);
        rg[t] = *(const u32x4*)((const char*)MIX + off); }
}
template <int NC> __device__ __forceinline__ void tile_store(LAS unsigned char* tb, const u32x4 (&rg)[NC / 16], int lane) {
    constexpr int CPR = NC / 8, NP = NC / 16, P = NC == 64 ? TP64 : TP32;
#pragma unroll
    for (int t = 0; t < NP; ++t) { const int id = lane + 64 * t, r = id / CPR, ck = id % CPR; *(LAS u32x4*)(tb + r * P + ck * 16) = rg[t]; }
}

template <bool PASS_C>
__device__ __forceinline__ void hgrn_task(Frame& F, int l, int seq, int pc, bf16_t* OUT, int ldo) {
    const bf16_t* MIX = (const bf16_t*)(F.ws + WS_RC);
    const int lane_ = tid_from_lds(F.lds, F.wave_s) & 63;
    const int lane = lane_, h = lane >> 5, c31 = lane & 31;
    const int dir = seq >> 4, b = (seq >> 2) & 3, head = seq & 3;
    LAS unsigned char* wl = F.lds + F.wave * WLDS;
    LAS unsigned char* TQ = wl; LAS unsigned char* TK = wl + 4608; LAS unsigned char* TH = wl + 9216; LAS unsigned char* TV = wl + 13824; LAS float* Dv = (LAS float*)(wl + 18432);
    const int R0 = pc == 0 ? MLAT + b * CTXL : b * SEQ + (dir ? 16 - pc : pc - 1) * 256;
    const int fcol = (dir ? C_AFB : C_AFF) + head * 64;
    bf16_t* ST = (bf16_t*)(F.ws + WS_STA) + ((size_t)seq * NCH + pc) * 4096;
    f32x16 S[2][2];
#pragma unroll
    for (int kb = 0; kb < 2; ++kb)
#pragma unroll
        for (int vb = 0; vb < 2; ++vb) {
            if (PASS_C) {
#pragma unroll
                for (int q4 = 0; q4 < 2; ++q4) { const u32x4 w = *(const u32x4*)(ST + lane * 64 + (kb * 2 + vb) * 16 + q4 * 8);
                    S[kb][vb][8 * q4 + 0] = bflo(w.x); S[kb][vb][8 * q4 + 1] = bfhi(w.x); S[kb][vb][8 * q4 + 2] = bflo(w.y); S[kb][vb][8 * q4 + 3] = bfhi(w.y);
                    S[kb][vb][8 * q4 + 4] = bflo(w.z); S[kb][vb][8 * q4 + 5] = bfhi(w.z); S[kb][vb][8 * q4 + 6] = bflo(w.w); S[kb][vb][8 * q4 + 7] = bfhi(w.w); }
            } else {
#pragma unroll
                for (int reg = 0; reg < 16; ++reg) S[kb][vb][reg] = 0.f; } }
    float gtot = 0.f;
    u32x4 pg[4], pq[4], pv[4];
    tile_load<64>(pg, MIX, R0, dir, 0, fcol, lane); if (PASS_C) tile_load<64>(pq, MIX, R0, dir, 0, C_AQ + head * 64, lane); tile_load<64>(pv, MIX, R0, dir, 0, C_AV + head * 64, lane);
#pragma unroll 1
    for (int I = 0; I < 8; ++I) {
        tile_store<64>(TH, pg, lane); if (PASS_C) tile_store<64>(TQ, pq, lane); tile_store<64>(TV, pv, lane);
        LDS_WAIT();
        if (I + 1 < 8) { tile_load<64>(pg, MIX, R0, dir, I + 1, fcol, lane); if (PASS_C) tile_load<64>(pq, MIX, R0, dir, I + 1, C_AQ + head * 64, lane); tile_load<64>(pv, MIX, R0, dir, I + 1, C_AV + head * 64, lane); }
        float br[32], kkv[32];
        float run = 0.f;
#pragma unroll
        for (int r = 0; r < 32; ++r) {
            if ((r & 7) == 0) asm volatile("" ::: "memory");
            const float g2 = bf2f(*(const LAS bf16_t*)(TH + r * TP64 + lane * 2));
            run += g2; br[r] = run; const float kk = 1.f - __builtin_amdgcn_exp2f(g2); kkv[r] = kk;
            if (PASS_C) { const float e = __builtin_amdgcn_exp2f(fmaxf(run, -120.f)); const float q = bf2f(*(const LAS bf16_t*)(TQ + r * TP64 + lane * 2));
                const unsigned w = cvtpk(q * e, kk * __builtin_amdgcn_rcpf(e));
                *(LAS bf16_t*)(TQ + r * TP64 + lane * 2) = (bf16_t)w; *(LAS bf16_t*)(TK + r * TP64 + lane * 2) = (bf16_t)(w >> 16); }
        }
        const float total = run; gtot += total;
#pragma unroll
        for (int r = 0; r < 32; r += 2) { const unsigned w = cvtpk(kkv[r] * __builtin_amdgcn_exp2f(total - br[r]), kkv[r + 1] * __builtin_amdgcn_exp2f(total - br[r + 1]));
            *(LAS bf16_t*)(TH + r * TP64 + lane * 2) = (bf16_t)w; *(LAS bf16_t*)(TH + (r + 1) * TP64 + lane * 2) = (bf16_t)(w >> 16); }
        Dv[lane] = __builtin_amdgcn_exp2f(total);
        LDS_WAIT();
        if (PASS_C) {
            f32x16 P;
#pragma unroll
            for (int reg = 0; reg < 16; ++reg) P[reg] = 0.f;
#pragma unroll
            for (int s = 0; s < 4; ++s) P = MFMA32(ld_row8(TK, TP64, c31, 16 * s + 8 * h), ld_row8(TQ, TP64, c31, 16 * s + 8 * h), P);
#pragma unroll
            for (int reg = 0; reg < 16; ++reg) if (crow(reg, h) > c31) P[reg] = 0.f;
            const bf16x8 pa0 = pack8<0>(P), pa1 = pack8<1>(P);
#pragma unroll
            for (int vb = 0; vb < 2; ++vb) {
                f32x16 o;
#pragma unroll
                for (int reg = 0; reg < 16; ++reg) o[reg] = 0.f;
                o = MFMA32(pa0, ld_tr8(TV, TP64, 4 * h, 8 + 4 * h, 32 * vb, lane), o);
                o = MFMA32(pa1, ld_tr8(TV, TP64, 16 + 4 * h, 24 + 4 * h, 32 * vb, lane), o);
#pragma unroll
                for (int kb = 0; kb < 2; ++kb) {
                    o = MFMA32(ld_row8_perm(TQ, TP64, c31, 32 * kb, h), pack8<0>(S[kb][vb]), o);
                    o = MFMA32(ld_row8_perm(TQ, TP64, c31, 32 * kb + 16, h), pack8<1>(S[kb][vb]), o);
                }
#pragma unroll
                for (int reg = 0; reg < 16; reg += 2) { const unsigned w0 = cvtpk(o[reg], o[reg + 1]);
                    *(LAS bf16_t*)(TK + crow(reg, h) * TP64 + (32 * vb + c31) * 2) = (bf16_t)w0; *(LAS bf16_t*)(TK + crow(reg + 1, h) * TP64 + (32 * vb + c31) * 2) = (bf16_t)(w0 >> 16); }
            }
            LDS_WAIT();
#pragma unroll
            for (int t = 0; t < 4; ++t) { const int id = lane + 64 * t, r = id >> 3, ck = id & 7; const int i = 32 * I + r; const int m = dir ? R0 + 255 - i : R0 + i;
                __builtin_nontemporal_store(*(const LAS u32x4*)(TK + r * TP64 + ck * 16), (u32x4*)((char*)OUT + ((unsigned)m * (unsigned)ldo + (unsigned)(head * 64 + ck * 8)) * 2u)); }
        }
#pragma unroll
        for (int kb = 0; kb < 2; ++kb) {
            float dr[16];
#pragma unroll
            for (int g = 0; g < 4; ++g) { const f32x4 d4 = *(const LAS f32x4*)(Dv + 32 * kb + 8 * g + 4 * h); dr[4 * g] = d4.x; dr[4 * g + 1] = d4.y; dr[4 * g + 2] = d4.z; dr[4 * g + 3] = d4.w; }
#pragma unroll
            for (int vb = 0; vb < 2; ++vb)
#pragma unroll
                for (int reg = 0; reg < 16; ++reg) S[kb][vb][reg] *= dr[reg];
#pragma unroll
            for (int s = 0; s < 2; ++s) { const bf16x8 a = ld_tr8(TH, TP64, 16 * s + 8 * h, 16 * s + 8 * h + 4, 32 * kb, lane);
#pragma unroll
                for (int vb = 0; vb < 2; ++vb) S[kb][vb] = MFMA32(a, ld_tr8(TV, TP64, 16 * s + 8 * h, 16 * s + 8 * h + 4, 32 * vb, lane), S[kb][vb]); }
        }
        LDS_WAIT();
    }
    if (!PASS_C) {
#pragma unroll
        for (int kb = 0; kb < 2; ++kb)
#pragma unroll
            for (int vb = 0; vb < 2; ++vb)
#pragma unroll
                for (int q4 = 0; q4 < 2; ++q4) { const f32x16& T = S[kb][vb]; u32x4 w; w.x = cvtpk(T[8 * q4], T[8 * q4 + 1]); w.y = cvtpk(T[8 * q4 + 2], T[8 * q4 + 3]); w.z = cvtpk(T[8 * q4 + 4], T[8 * q4 + 5]); w.w = cvtpk(T[8 * q4 + 6], T[8 * q4 + 7]);
                    *(u32x4*)(ST + lane * 64 + (kb * 2 + vb) * 16 + q4 * 8) = w; }
        ((float*)(F.ws + WS_DLA))[((size_t)seq * NCH + pc) * 64 + lane] = gtot;
    }
}

template <bool PASS_C>
__device__ __forceinline__ void ssd_task(Frame& F, int l, int seq2, int pc, bf16_t* OUT, int ldo) {
    const bf16_t* MIX = (const bf16_t*)(F.ws + WS_RC);
    const float* DT = (const float*)(F.ws + WS_DT);
    const int lane_ = tid_from_lds(F.lds, F.wave_s) & 63;
    const int lane = lane_, h = lane >> 5, c31 = lane & 31;
    const int seq = seq2 >> 1, vb = seq2 & 1, dir = seq >> 4, b = (seq >> 2) & 3, head = seq & 3, g = head >> 1;
    LAS unsigned char* wl = F.lds + F.wave * WLDS;
    LAS unsigned char* TC = wl; LAS unsigned char* TB = wl + 4608; LAS unsigned char* TX = wl + 9216; LAS unsigned char* TXh = wl + 11776;
    LAS float* brn = (LAS float*)(wl + 18432); LAS float* dtv = brn + 32;
    const int R0 = pc == 0 ? MLAT + b * CTXL : b * SEQ + (dir ? 16 - pc : pc - 1) * 256;
    const float Aneg = -expf(FIN(12)[(l * 2 + dir) * 4 + head]); const float dtb = FIN(11)[(l * 2 + dir) * 4 + head];
    bf16_t* ST = (bf16_t*)(F.ws + WS_STB) + ((size_t)seq2 * NCH + pc) * 4096;
    f32x16 S[4];
#pragma unroll
    for (int kb = 0; kb < 4; ++kb) {
        if (PASS_C) {
#pragma unroll
            for (int q4 = 0; q4 < 2; ++q4) { const u32x4 w = *(const u32x4*)(ST + lane * 64 + kb * 16 + q4 * 8);
                S[kb][8 * q4 + 0] = bflo(w.x); S[kb][8 * q4 + 1] = bfhi(w.x); S[kb][8 * q4 + 2] = bflo(w.y); S[kb][8 * q4 + 3] = bfhi(w.y);
                S[kb][8 * q4 + 4] = bflo(w.z); S[kb][8 * q4 + 5] = bfhi(w.z); S[kb][8 * q4 + 6] = bflo(w.w); S[kb][8 * q4 + 7] = bfhi(w.w); }
        } else {
#pragma unroll
            for (int reg = 0; reg < 16; ++reg) S[kb][reg] = 0.f; } }
    float gtot = 0.f;
    u32x4 pxx[2], pcq[4], pbb[4]; float dtraw;
    const int xcol = C_BX + head * 64 + vb * 32, ccol = C_BC + g * 128, bcol = C_BB + g * 128;
    { const int i_o = c31; const int m_o = dir ? R0 + 255 - i_o : R0 + i_o; dtraw = DT[(size_t)m_o * 8 + dir * 4 + head]; }
    if (PASS_C) tile_load<64>(pcq, MIX, R0, dir, 0, ccol, lane); tile_load<64>(pbb, MIX, R0, dir, 0, bcol, lane);
#pragma unroll 1
    for (int I = 0; I < 8; ++I) {
        tile_load<32>(pxx, MIX, R0, dir, I, xcol, lane);
        const float dt = softplusf_(dtraw + dtb);
        float run = dt * Aneg;
#pragma unroll
        for (int off = 1; off < 32; off <<= 1) { const float t = bperm_(run, (lane - off) & 63); if (c31 >= off) run += t; }
        const float total = bperm_(run, (lane & 32) | 31); gtot += total;
        const float wown = dt * __expf(total - run);
        if (lane < 32) { brn[c31] = run; dtv[c31] = dt; }
        tile_store<32>(TX, pxx, lane);
#pragma unroll
        for (int t = 0; t < 2; ++t) { const int id = lane + 64 * t, r = id >> 2, ck = id & 3;
            const u32x4 x4 = pxx[t];
            const float w = bperm_(wown, r);
            u32x4 y; y.x = cvtpk(bflo(x4.x) * w, bfhi(x4.x) * w); y.y = cvtpk(bflo(x4.y) * w, bfhi(x4.y) * w); y.z = cvtpk(bflo(x4.z) * w, bfhi(x4.z) * w); y.w = cvtpk(bflo(x4.w) * w, bfhi(x4.w) * w);
            *(LAS u32x4*)(TXh + r * TP32 + ck * 16) = y; }
        const float dsub = __expf(total);
        f32x16 P, oi;
#pragma unroll
        for (int reg = 0; reg < 16; ++reg) { P[reg] = 0.f; oi[reg] = 0.f; }
#pragma unroll
        for (int nh = 0; nh < 2; ++nh) {
            if (PASS_C) tile_store<64>(TC, pcq, lane);
            tile_store<64>(TB, pbb, lane);
            LDS_WAIT();
            if (nh == 0) { if (PASS_C) tile_load<64>(pcq, MIX, R0, dir, I, ccol + 64, lane); tile_load<64>(pbb, MIX, R0, dir, I, bcol + 64, lane); }
            else if (I + 1 < 8) { if (PASS_C) tile_load<64>(pcq, MIX, R0, dir, I + 1, ccol, lane); tile_load<64>(pbb, MIX, R0, dir, I + 1, bcol, lane);
                const int i_o = 32 * (I + 1) + c31; const int m_o = dir ? R0 + 255 - i_o : R0 + i_o; dtraw = DT[(size_t)m_o * 8 + dir * 4 + head]; }
            if (PASS_C) {
#pragma unroll
                for (int s = 0; s < 4; ++s) P = MFMA32(ld_row8(TB, TP64, c31, 16 * s + 8 * h), ld_row8(TC, TP64, c31, 16 * s + 8 * h), P);
#pragma unroll
                for (int kk = 0; kk < 2; ++kk) {
                    oi = MFMA32(ld_row8_perm(TC, TP64, c31, 32 * kk, h), pack8<0>(S[2 * nh + kk]), oi);
                    oi = MFMA32(ld_row8_perm(TC, TP64, c31, 32 * kk + 16, h), pack8<1>(S[2 * nh + kk]), oi);
                }
            }
#pragma unroll
            for (int kk = 0; kk < 2; ++kk) {
#pragma unroll
                for (int reg = 0; reg < 16; ++reg) S[2 * nh + kk][reg] *= dsub;
#pragma unroll
                for (int s = 0; s < 2; ++s)
                    S[2 * nh + kk] = MFMA32(ld_tr8(TB, TP64, 16 * s + 8 * h, 16 * s + 8 * h + 4, 32 * kk, lane), ld_tr8(TXh, TP32, 16 * s + 8 * h, 16 * s + 8 * h + 4, 0, lane), S[2 * nh + kk]);
            }
            LDS_WAIT();
        }
        if (PASS_C) {
            float bj[16], dj[16];
#pragma unroll
            for (int gq = 0; gq < 4; ++gq) { const f32x4 b4 = *(const LAS f32x4*)(brn + 8 * gq + 4 * h), d4 = *(const LAS f32x4*)(dtv + 8 * gq + 4 * h);
                bj[4 * gq] = b4.x; bj[4 * gq + 1] = b4.y; bj[4 * gq + 2] = b4.z; bj[4 * gq + 3] = b4.w; dj[4 * gq] = d4.x; dj[4 * gq + 1] = d4.y; dj[4 * gq + 2] = d4.z; dj[4 * gq + 3] = d4.w; }
#pragma unroll
            for (int reg = 0; reg < 16; ++reg) P[reg] = (crow(reg, h) <= c31) ? P[reg] * dj[reg] * __expf(run - bj[reg]) : 0.f;
#pragma unroll
            for (int reg = 0; reg < 16; ++reg) oi[reg] = oi[reg] * __expf(bj[reg]);
            oi = MFMA32(pack8<0>(P), ld_tr8(TX, TP32, 4 * h, 8 + 4 * h, 0, lane), oi);
            oi = MFMA32(pack8<1>(P), ld_tr8(TX, TP32, 16 + 4 * h, 24 + 4 * h, 0, lane), oi);
#pragma unroll
            for (int reg = 0; reg < 16; reg += 2) { const unsigned w0 = cvtpk(oi[reg], oi[reg + 1]);
                *(LAS bf16_t*)(TXh + crow(reg, h) * TP32 + c31 * 2) = (bf16_t)w0; *(LAS bf16_t*)(TXh + crow(reg + 1, h) * TP32 + c31 * 2) = (bf16_t)(w0 >> 16); }
            LDS_WAIT();
#pragma unroll
            for (int t = 0; t < 2; ++t) { const int id = lane + 64 * t, r = id >> 2, ck = id & 3; const int i = 32 * I + r; const int m = dir ? R0 + 255 - i : R0 + i;
                __builtin_nontemporal_store(*(const LAS u32x4*)(TXh + r * TP32 + ck * 16), (u32x4*)((char*)OUT + ((unsigned)m * (unsigned)ldo + (unsigned)(head * 64 + 32 * vb + ck * 8)) * 2u)); }
        }
        LDS_WAIT();
    }
    if (!PASS_C) {
#pragma unroll
        for (int kb = 0; kb < 4; ++kb)
#pragma unroll
            for (int q4 = 0; q4 < 2; ++q4) { const f32x16& T = S[kb]; u32x4 w; w.x = cvtpk(T[8 * q4], T[8 * q4 + 1]); w.y = cvtpk(T[8 * q4 + 2], T[8 * q4 + 3]); w.z = cvtpk(T[8 * q4 + 4], T[8 * q4 + 5]); w.w = cvtpk(T[8 * q4 + 6], T[8 * q4 + 7]);
                *(u32x4*)(ST + lane * 64 + kb * 16 + q4 * 8) = w; }
        if (vb == 0 && lane == 0) ((float*)(F.ws + WS_DLB))[seq * NCH + pc] = gtot;
    }
}

constexpr int NA_GQA = 2048, NA_NA = 2048, NA_CTX = 256;
template <int TYPE> __device__ __forceinline__ void attn_task(Frame& F, int l, int u, bf16_t* BR) {
    const bf16_t* MIX = (const bf16_t*)(F.ws + WS_RC);
    const int lane_ = tid_from_lds(F.lds, F.wave_s) & 63;
    const int lane = lane_, h = lane >> 5, c31 = lane & 31;
    LAS unsigned char* wl = F.lds + F.wave * WLDS; LAS unsigned char* TV = wl; LAS float* al = (LAS float*)(wl + 4608);
    int qrow0, qcol, kcol, vcol, ocol, b, ntiles, r = 0, c0 = 0, hh = 0;
    if (TYPE == 0) { b = u >> 9; const int hq = (u >> 7) & 3, tb = u & 127; qrow0 = b * SEQ + tb * 32; qcol = C_DQ + hq * 64; kcol = C_DK + (hq >> 1) * 64; vcol = C_DV + (hq >> 1) * 64; ocol = 768 + hq * 64; ntiles = 8 + 128; }
    else if (TYPE == 1) { b = u >> 9; hh = (u >> 7) & 3; r = (u >> 1) & 63; c0 = (u & 1) * 32; qrow0 = b * SEQ + r * 64 + c0; qcol = C_CQ + hh * 64; kcol = C_CK + hh * 64; vcol = C_CV + hh * 64; ocol = 512 + hh * 64; ntiles = 8 + 16; }
    else { b = u >> 6; const int h8 = (u >> 3) & 7, tb = u & 7; qrow0 = MLAT + b * CTXL + tb * 32; ntiles = 8;
        if (h8 < 4) { qcol = C_CQ + h8 * 64; kcol = C_CK + h8 * 64; vcol = C_CV + h8 * 64; ocol = 512 + h8 * 64; } else { const int hq = h8 - 4; qcol = C_DQ + hq * 64; kcol = C_DK + (hq >> 1) * 64; vcol = C_DV + (hq >> 1) * 64; ocol = 768 + hq * 64; } }
    const int rs = min(max(r - 4, 0), 56);
    const float* rpb = FIN(15) + (size_t)(l * 4 + hh) * 15 * 31;
    const int cq = c0 + c31, cs = min(max(cq - 8, 0), 48);
#define TILE_ROW(t) ((t) < 8 ? MLAT + b * CTXL + 32 * (t) : (TYPE == 1 ? b * SEQ + (rs + (((t) - 8) >> 1)) * 64 + 32 * (((t) - 8) & 1) : b * SEQ + 32 * ((t) - 8)))
    bf16x8 qf[4];
#pragma unroll
    for (int s = 0; s < 4; ++s) qf[s] = *(const bf16x8*)(MIX + (size_t)(qrow0 + c31) * NMIX + qcol + 16 * s + 8 * h);
    f32x16 O0, O1;
#pragma unroll
    for (int reg = 0; reg < 16; ++reg) { O0[reg] = 0.f; O1[reg] = 0.f; }
    float m_run = -1e30f, l_run = 0.f;
    bf16x8 kf[4]; u32x4 vr[4];
    { const int kr0 = TILE_ROW(0);
#pragma unroll
      for (int s = 0; s < 4; ++s) kf[s] = *(const bf16x8*)(MIX + (size_t)(kr0 + c31) * NMIX + kcol + 16 * s + 8 * h);
#pragma unroll
      for (int t4 = 0; t4 < 4; ++t4) { const int id = lane + 64 * t4; vr[t4] = *(const u32x4*)(MIX + (size_t)(kr0 + (id >> 3)) * NMIX + vcol + (id & 7) * 8); } }
#pragma unroll 1
    for (int t = 0; t < ntiles; ++t) {
#pragma unroll
        for (int t4 = 0; t4 < 4; ++t4) { const int id = lane + 64 * t4; *(LAS u32x4*)(TV + (id >> 3) * TP64 + (id & 7) * 16) = vr[t4]; }
        asm volatile("" ::: "memory");
        f32x16 S;
#pragma unroll
        for (int reg = 0; reg < 16; ++reg) S[reg] = 0.f;
#pragma unroll
        for (int s = 0; s < 4; ++s) S = MFMA32(kf[s], qf[s], S);
        if (t + 1 < ntiles) { const int kr1 = TILE_ROW(t + 1);
#pragma unroll
            for (int s = 0; s < 4; ++s) kf[s] = *(const bf16x8*)(MIX + (size_t)(kr1 + c31) * NMIX + kcol + 16 * s + 8 * h);
#pragma unroll
            for (int t4 = 0; t4 < 4; ++t4) { const int id = lane + 64 * t4; vr[t4] = *(const u32x4*)(MIX + (size_t)(kr1 + (id >> 3)) * NMIX + vcol + (id & 7) * 8); } }
        if (TYPE == 1 && t >= 8) {
            const int kr = rs + ((t - 8) >> 1), kc0 = 32 * ((t - 8) & 1); const float* rb = rpb + (kr - r + 7) * 31 + (15 - cq);
#pragma unroll
            for (int reg = 0; reg < 16; ++reg) { const int kc = kc0 + crow(reg, h); const bool ok = (kc >= cs) && (kc < cs + 16);
                const float bias = ok ? rb[kc] : 0.f; S[reg] = ok ? S[reg] * 0.125f + bias : -1e30f; }
        } else {
#pragma unroll
            for (int reg = 0; reg < 16; ++reg) S[reg] *= 0.125f;
        }
        float mloc = fmaxf(fmaxf(fmaxf(S[0], S[1]), fmaxf(S[2], S[3])), fmaxf(fmaxf(S[4], S[5]), fmaxf(S[6], S[7])));
        mloc = fmaxf(mloc, fmaxf(fmaxf(fmaxf(S[8], S[9]), fmaxf(S[10], S[11])), fmaxf(fmaxf(S[12], S[13]), fmaxf(S[14], S[15]))));
        mloc = fmaxf(mloc, bperm_(mloc, lane ^ 32));
        const float m_new = fmaxf(m_run, mloc);
        const float alpha = __expf(m_run - m_new);
        m_run = m_new;
        float ls = 0.f;
#pragma unroll
        for (int reg = 0; reg < 16; ++reg) { const float p = __expf(S[reg] - m_new); ls += p; S[reg] = p; }
        l_run = l_run * alpha + ls;
        if (lane < 32) al[c31] = alpha;
        LDS_WAIT();
        const bf16x8 pa0 = pack8<0>(S), pa1 = pack8<1>(S);
        {
#pragma unroll
            for (int g = 0; g < 4; ++g) { const f32x4 a4 = *(const LAS f32x4*)(al + 8 * g + 4 * h);
                O0[4 * g] *= a4.x; O0[4 * g + 1] *= a4.y; O0[4 * g + 2] *= a4.z; O0[4 * g + 3] *= a4.w;
                O1[4 * g] *= a4.x; O1[4 * g + 1] *= a4.y; O1[4 * g + 2] *= a4.z; O1[4 * g + 3] *= a4.w; }
        }
        O0 = MFMA32(pa0, ld_tr8(TV, TP64, 4 * h, 8 + 4 * h, 0, lane), O0);
        O0 = MFMA32(pa1, ld_tr8(TV, TP64, 16 + 4 * h, 24 + 4 * h, 0, lane), O0);
        O1 = MFMA32(pa0, ld_tr8(TV, TP64, 4 * h, 8 + 4 * h, 32, lane), O1);
        O1 = MFMA32(pa1, ld_tr8(TV, TP64, 16 + 4 * h, 24 + 4 * h, 32, lane), O1);
    }
#undef TILE_ROW
    l_run += bperm_(l_run, lane ^ 32);
    if (lane < 32) al[c31] = 1.f / l_run;
    LDS_WAIT();
#pragma unroll
    for (int g = 0; g < 4; ++g) { const f32x4 a4 = *(const LAS f32x4*)(al + 8 * g + 4 * h);
        O0[4 * g] *= a4.x; O0[4 * g + 1] *= a4.y; O0[4 * g + 2] *= a4.z; O0[4 * g + 3] *= a4.w;
        O1[4 * g] *= a4.x; O1[4 * g + 1] *= a4.y; O1[4 * g + 2] *= a4.z; O1[4 * g + 3] *= a4.w; }
#pragma unroll
    for (int reg = 0; reg < 16; ++reg) { bf16_t* op = BR + (size_t)(qrow0 + crow(reg, h)) * DM + ocol + c31; op[0] = (bf16_t)f2bf(O0[reg]); op[32] = (bf16_t)f2bf(O1[reg]); }
    LDS_WAIT();
}

constexpr int AB_TILE = 9216;
constexpr int AB_AL = 4 * AB_TILE;
template <int TYPE>
__device__ __forceinline__ void attn_block_task(Frame& F, int l, int u, bf16_t* BR) {
    const bf16_t* MIX = (const bf16_t*)(F.ws + WS_RC);
    const int lane_ = tid_from_lds(F.lds, F.wave_s) & 63;
    const int lane = lane_, h = lane >> 5, c31 = lane & 31, tid = F.wave * 64 + lane;
    int b, qrow0, qcol, kcol, vcol, ocol, ntile, r = 0, c0 = 0, hh = 0, r0 = 0;
    if (TYPE == 0) { b = u >> 6; const int hq = (u >> 4) & 3, qblk = u & 15; qrow0 = b * SEQ + qblk * 256 + F.wave * 32; qcol = C_DQ + hq * 64; kcol = C_DK + (hq >> 1) * 64; vcol = C_DV + (hq >> 1) * 64; ocol = 768 + hq * 64; ntile = 4 + 64; }
    else { b = u >> 6; hh = (u >> 4) & 3; r0 = (u & 15) * 4; r = r0 + (F.wave >> 1); c0 = (F.wave & 1) * 32; qrow0 = b * SEQ + r * 64 + c0; qcol = C_CQ + hh * 64; kcol = C_CK + hh * 64; vcol = C_CV + hh * 64; ocol = 512 + hh * 64;
           ntile = 4 + (min(max(r0 + 3 - 4, 0), 56) - min(max(r0 - 4, 0), 56) + 8); }
    const int rs_blk = min(max(r0 - 4, 0), 56), rs = min(max(r - 4, 0), 56);
    const float* rpb = FIN(15) + (size_t)(l * 4 + hh) * 15 * 31;
    const int cq = c0 + c31, cs = min(max(cq - 8, 0), 48);
    LAS unsigned char* lds = F.lds; LAS float* al = (LAS float*)(lds + AB_AL + F.wave * 128);
    LAS float* rpbL = (LAS float*)(lds + AB_AL + 1024);
    if (TYPE == 1) { if (tid < 465) rpbL[tid] = rpb[tid]; }
    const int prow = tid >> 3, pck = tid & 7;
    const unsigned pdst = prow * TP64 + pck * 16;
    const int NTILE = ntile;
#define AB_TROW(t) ((t) < 4 ? MLAT + b * CTXL + 64 * (t) : (TYPE == 0 ? b * SEQ + 64 * ((t) - 4) : b * SEQ + 64 * (rs_blk + (t) - 4)))
    bf16x8 qf[4];
#pragma unroll
    for (int s = 0; s < 4; ++s) qf[s] = *(const bf16x8*)(MIX + (size_t)(qrow0 + c31) * NMIX + qcol + 16 * s + 8 * h);
    f32x16 O0, O1;
#pragma unroll
    for (int reg = 0; reg < 16; ++reg) { O0[reg] = 0.f; O1[reg] = 0.f; }
    float m_run = -1e30f, l_run = 0.f;
    constexpr float SC2 = 0.125f * 1.4426950408889634f;
    constexpr float L2E = 1.4426950408889634f;
    u32x4 kr0, vr0, kr1, vr1, kr2, vr2;
#define AB_LOAD(T, KR, VR) do { const size_t ro_ = (size_t)(AB_TROW(T) + prow) * NMIX + pck * 8; KR = *(const u32x4*)(MIX + ro_ + kcol); VR = *(const u32x4*)(MIX + ro_ + vcol); } while (0)
    AB_LOAD(0, kr0, vr0);
    *(LAS u32x4*)(lds + pdst) = kr0; *(LAS u32x4*)(lds + AB_TILE + pdst) = vr0;
    AB_LOAD(1, kr0, vr0); AB_LOAD(2, kr1, vr1); AB_LOAD(3, kr2, vr2);
    __syncthreads();
#define AB_BODY(T, KR, VR) do { \
        LAS unsigned char* KB = lds + ((T) & 1) * 2 * AB_TILE; LAS unsigned char* VB = KB + AB_TILE; \
        const int kr_ = rs_blk + (T) - 4;                                  \
        if (TYPE == 0 || (T) < 4 || (kr_ >= rs && kr_ < rs + 8)) {         \
        f32x16 S0, S1; \
        _Pragma("unroll") for (int reg = 0; reg < 16; ++reg) { S0[reg] = 0.f; S1[reg] = 0.f; } \
        _Pragma("unroll") for (int s = 0; s < 4; ++s) { S0 = MFMA32(ld_row8(KB, TP64, c31, 16 * s + 8 * h), qf[s], S0); S1 = MFMA32(ld_row8(KB, TP64, 32 + c31, 16 * s + 8 * h), qf[s], S1); } \
        if (TYPE == 1 && (T) >= 4) {                                       \
            const LAS float* rbl = rpbL + (kr_ - r + 7) * 31; \
            _Pragma("unroll") for (int reg = 0; reg < 16; ++reg) { const int kc = crow(reg, h); \
                const bool ok0 = (kc >= cs) && (kc < cs + 16), ok1 = (kc + 32 >= cs) && (kc + 32 < cs + 16); \
                const float b0 = rbl[min(max(kc - cq + 15, 0), 30)], b1 = rbl[min(max(kc + 32 - cq + 15, 0), 30)];     \
                S0[reg] = ok0 ? fmaf(S0[reg], SC2, b0 * L2E) : -1e30f; S1[reg] = ok1 ? fmaf(S1[reg], SC2, b1 * L2E) : -1e30f; } \
        } \
        const bool pre = (TYPE == 1 && (T) >= 4);                  \
        float mloc = fmaxf(fmaxf(fmaxf(S0[0], S0[1]), fmaxf(S0[2], S0[3])), fmaxf(fmaxf(S0[4], S0[5]), fmaxf(S0[6], S0[7]))); \
        mloc = fmaxf(mloc, fmaxf(fmaxf(fmaxf(S0[8], S0[9]), fmaxf(S0[10], S0[11])), fmaxf(fmaxf(S0[12], S0[13]), fmaxf(S0[14], S0[15])))); \
        mloc = fmaxf(mloc, fmaxf(fmaxf(fmaxf(S1[0], S1[1]), fmaxf(S1[2], S1[3])), fmaxf(fmaxf(S1[4], S1[5]), fmaxf(S1[6], S1[7])))); \
        mloc = fmaxf(mloc, fmaxf(fmaxf(fmaxf(S1[8], S1[9]), fmaxf(S1[10], S1[11])), fmaxf(fmaxf(S1[12], S1[13]), fmaxf(S1[14], S1[15])))); \
        if (!pre) mloc *= SC2; \
        { const auto rr_ = __builtin_amdgcn_permlane32_swap(__float_as_uint(mloc), __float_as_uint(mloc), false, false); mloc = fmaxf(__uint_as_float(rr_[0]), __uint_as_float(rr_[1])); } \
        if (__any(mloc > m_run + 8.f)) {                         \
            const float m_new = fmaxf(m_run, mloc); \
            const float alpha = __builtin_amdgcn_exp2f(m_run - m_new); \
            m_run = m_new; l_run *= alpha; \
            if (lane < 32) al[c31] = alpha; \
            LDS_WAIT(); \
            _Pragma("unroll") for (int g = 0; g < 4; ++g) { const f32x4 a4 = *(const LAS f32x4*)(al + 8 * g + 4 * h); \
                O0[4 * g] *= a4.x; O0[4 * g + 1] *= a4.y; O0[4 * g + 2] *= a4.z; O0[4 * g + 3] *= a4.w; \
                O1[4 * g] *= a4.x; O1[4 * g + 1] *= a4.y; O1[4 * g + 2] *= a4.z; O1[4 * g + 3] *= a4.w; } \
            LDS_WAIT(); \
        } \
        float ls = 0.f; \
        if (pre) { _Pragma("unroll") for (int reg = 0; reg < 16; ++reg) { const float p0 = __builtin_amdgcn_exp2f(S0[reg] - m_run), p1 = __builtin_amdgcn_exp2f(S1[reg] - m_run); ls += p0 + p1; S0[reg] = p0; S1[reg] = p1; } } \
        else     { _Pragma("unroll") for (int reg = 0; reg < 16; ++reg) { const float p0 = __builtin_amdgcn_exp2f(fmaf(S0[reg], SC2, -m_run)), p1 = __builtin_amdgcn_exp2f(fmaf(S1[reg], SC2, -m_run)); ls += p0 + p1; S0[reg] = p0; S1[reg] = p1; } } \
        l_run += ls; \
        const bf16x8 pa0 = pack8<0>(S0), pa1 = pack8<1>(S0), pa2 = pack8<0>(S1), pa3 = pack8<1>(S1); \
        O0 = MFMA32(pa0, ld_tr8(VB, TP64, 4 * h, 8 + 4 * h, 0, lane), O0); \
        O1 = MFMA32(pa0, ld_tr8(VB, TP64, 4 * h, 8 + 4 * h, 32, lane), O1); \
        O0 = MFMA32(pa1, ld_tr8(VB, TP64, 16 + 4 * h, 24 + 4 * h, 0, lane), O0); \
        O1 = MFMA32(pa1, ld_tr8(VB, TP64, 16 + 4 * h, 24 + 4 * h, 32, lane), O1); \
        O0 = MFMA32(pa2, ld_tr8(VB, TP64, 32 + 4 * h, 40 + 4 * h, 0, lane), O0); \
        O1 = MFMA32(pa2, ld_tr8(VB, TP64, 32 + 4 * h, 40 + 4 * h, 32, lane), O1); \
        O0 = MFMA32(pa3, ld_tr8(VB, TP64, 48 + 4 * h, 56 + 4 * h, 0, lane), O0); \
        O1 = MFMA32(pa3, ld_tr8(VB, TP64, 48 + 4 * h, 56 + 4 * h, 32, lane), O1); \
        } \
        if ((T) + 1 < NTILE) { LAS unsigned char* KN = lds + (((T) + 1) & 1) * 2 * AB_TILE; *(LAS u32x4*)(KN + pdst) = KR; *(LAS u32x4*)(KN + AB_TILE + pdst) = VR; } \
        if ((T) + 4 < NTILE) AB_LOAD((T) + 4, KR, VR); \
        __syncthreads(); \
    } while (0)
#pragma unroll 1
    for (int t = 0; t < NTILE; t += 3) {
        AB_BODY(t, kr0, vr0);
        if (t + 1 < NTILE) AB_BODY(t + 1, kr1, vr1);
        if (t + 2 < NTILE) AB_BODY(t + 2, kr2, vr2);
    }
#undef AB_BODY
#undef AB_LOAD
#undef AB_TROW
    l_run += bperm_(l_run, lane ^ 32);
    if (lane < 32) al[c31] = 1.f / l_run;
    LDS_WAIT();
#pragma unroll
    for (int g = 0; g < 4; ++g) { const f32x4 a4 = *(const LAS f32x4*)(al + 8 * g + 4 * h);
        O0[4 * g] *= a4.x; O0[4 * g + 1] *= a4.y; O0[4 * g + 2] *= a4.z; O0[4 * g + 3] *= a4.w;
        O1[4 * g] *= a4.x; O1[4 * g + 1] *= a4.y; O1[4 * g + 2] *= a4.z; O1[4 * g + 3] *= a4.w; }
#pragma unroll
    for (int reg = 0; reg < 16; ++reg) { bf16_t* op = BR + (size_t)(qrow0 + crow(reg, h)) * DM + ocol + c31; op[0] = (bf16_t)f2bf(O0[reg]); op[32] = (bf16_t)f2bf(O1[reg]); }
    __syncthreads();
}


namespace gx {
constexpr int NSLOT = 3, SLOTB = 8192, KVBLK = 64;
constexpr int LDS_K = 0, LDS_V = NSLOT * SLOTB, LDS_WS = 2 * NSLOT * SLOTB, LDS_OST = LDS_WS + 8 * 64 * 4, LDS_BYTES_GX = LDS_OST + 8 * 4096;
typedef LAS const char* lds_cptr;
typedef short v4i16_t __attribute__((ext_vector_type(4)));
#define GX_SBAR() __builtin_amdgcn_sched_barrier(0)
__device__ __forceinline__ void glds16(const void* gsrc, unsigned lds_dst) { unsigned keep;
    asm volatile("s_mov_b32 %0, m0\n\ts_mov_b32 m0, %2\n\ts_nop 0\n\tglobal_load_lds_dwordx4 %1, off\n\ts_mov_b32 m0, %0" : "=&s"(keep) : "v"(gsrc), "s"(lds_dst) : "memory"); }
__device__ __forceinline__ float max3f(float a, float b, float c) { float r; asm("v_max3_f32 %0, %1, %2, %3" : "=v"(r) : "v"(a), "v"(b), "v"(c)); return r; }
__device__ __forceinline__ float max2f(float a, float b) { float r; asm("v_max_f32_e32 %0, %1, %2" : "=v"(r) : "v"(a), "v"(b)); return r; }
__device__ __forceinline__ float fadd_s(float a, float b) { float r; asm("v_add_f32_e32 %0, %1, %2" : "=v"(r) : "v"(a), "v"(b)); return r; }
__device__ __forceinline__ float fsub_s(float a, float b) { float r; asm("v_sub_f32_e32 %0, %1, %2" : "=v"(r) : "v"(a), "v"(b)); return r; }
__device__ __forceinline__ unsigned cvtpk_s(float lo, float hi) { f32x2_t v = {lo, hi}; bf16x2_t b = __builtin_convertvector(v, bf16x2_t); return __builtin_bit_cast(unsigned, b); }
#define GX_WAIT_BAR(N) asm volatile("s_waitcnt vmcnt(" #N ") lgkmcnt(0)\n\ts_barrier" ::: "memory")
__device__ __forceinline__ void qkt(f32x16& p0, f32x16& p1, lds_cptr Kslot, const bf16x8* qr, const f32x16& negm, int r32, int hi) {
    lds_cptr kb = Kslot + hi * 1024 + r32 * 16;
#pragma unroll
    for (int d0 = 0; d0 < 4; ++d0) {
        const bf16x8 b0 = *(const LAS bf16x8*)(kb + d0 * 2048);
        const bf16x8 b1 = *(const LAS bf16x8*)(kb + d0 * 2048 + 512);
        if (d0 == 0) { p0 = __builtin_amdgcn_mfma_f32_32x32x16_bf16(b0, qr[0], negm, 0, 0, 0); p1 = __builtin_amdgcn_mfma_f32_32x32x16_bf16(b1, qr[0], negm, 0, 0, 0); }
        else { p0 = __builtin_amdgcn_mfma_f32_32x32x16_bf16(b0, qr[d0], p0, 0, 0, 0); p1 = __builtin_amdgcn_mfma_f32_32x32x16_bf16(b1, qr[d0], p1, 0, 0, 0); } }
}
__device__ __forceinline__ void kload8(bf16x8* kf, lds_cptr kp) {
    kf[0] = *(const LAS bf16x8*)(kp);        kf[1] = *(const LAS bf16x8*)(kp + 512);
    kf[2] = *(const LAS bf16x8*)(kp + 2048); kf[3] = *(const LAS bf16x8*)(kp + 2560);
    kf[4] = *(const LAS bf16x8*)(kp + 4096); kf[5] = *(const LAS bf16x8*)(kp + 4608);
    kf[6] = *(const LAS bf16x8*)(kp + 6144); kf[7] = *(const LAS bf16x8*)(kp + 6656);
}
__device__ __forceinline__ void kload2(bf16x8* kf, lds_cptr kp, int j) { kf[2 * j] = *(const LAS bf16x8*)(kp + j * 2048); kf[2 * j + 1] = *(const LAS bf16x8*)(kp + j * 2048 + 512); }
__device__ __forceinline__ s16x4 vtr(lds_cptr p) { return __builtin_bit_cast(s16x4, __builtin_amdgcn_ds_read_tr16_b64_v4i16((LAS v4i16_t*)p)); }
__device__ __forceinline__ float rowmax(const f32x16& p0, const f32x16& p1) {
    float a = max3f(p0[0], p0[1], p1[0]), b = max3f(p0[2], p0[3], p1[1]); a = max3f(a, p1[2], p1[3]);
#pragma unroll
    for (int r = 4; r < 16; r += 4) { a = max3f(a, p0[r], p0[r + 1]); b = max3f(b, p0[r + 2], p0[r + 3]); a = max3f(a, p1[r], p1[r + 1]); b = max3f(b, p1[r + 2], p1[r + 3]); }
    const float m = max2f(a, b);
    auto rr = __builtin_amdgcn_permlane32_swap(__float_as_uint(m), __float_as_uint(m), false, false);
    return max2f(__uint_as_float(rr[0]), __uint_as_float(rr[1]));
}
__device__ __forceinline__ void pv(f32x16* o, int vb, bf16x8 pa0, bf16x8 pa1, bf16x8 pa2, bf16x8 pa3) {
#pragma unroll
    for (int d0 = 0; d0 < 2; ++d0) { s16x4 lo[4], hi[4];
#pragma unroll
        for (int ks = 0; ks < 4; ++ks) {
            asm volatile("ds_read_b64_tr_b16 %0,%1 offset:%c2" : "=&v"(lo[ks]) : "v"(vb), "i"(d0 * 4096 + ks * 1024) : "memory");
            asm volatile("ds_read_b64_tr_b16 %0,%1 offset:%c2" : "=&v"(hi[ks]) : "v"(vb), "i"(d0 * 4096 + ks * 1024 + 512) : "memory"); }
        asm volatile("s_waitcnt lgkmcnt(0)" ::: "memory"); GX_SBAR();
#define GX_PK(k) (bf16x8){lo[k][0], lo[k][1], lo[k][2], lo[k][3], hi[k][0], hi[k][1], hi[k][2], hi[k][3]}
        o[d0] = __builtin_amdgcn_mfma_f32_32x32x16_bf16(pa0, GX_PK(0), o[d0], 0, 0, 0);
        o[d0] = __builtin_amdgcn_mfma_f32_32x32x16_bf16(pa1, GX_PK(1), o[d0], 0, 0, 0);
        o[d0] = __builtin_amdgcn_mfma_f32_32x32x16_bf16(pa2, GX_PK(2), o[d0], 0, 0, 0);
        o[d0] = __builtin_amdgcn_mfma_f32_32x32x16_bf16(pa3, GX_PK(3), o[d0], 0, 0, 0);
#undef GX_PK
    }
}
template <int THRL> __device__ __forceinline__ void gqa_unit(Frame& F, int u, bf16_t* BR) {
    const bf16_t* MIX = (const bf16_t*)(F.ws + WS_RC);
    const int lane_ = tid_from_lds(F.lds, F.wave_s) & 63;
    const int lane = lane_, r32 = lane & 31, hi = lane >> 5, wid = F.wave;
    const int ux = u & 7, uj = u >> 3;
    const int b = ux >> 1, hq = 2 * (ux & 1) + (uj >> 4), qblk = uj & 15;
    const int qrow0 = b * SEQ + qblk * 256 + wid * 32, qcol = C_DQ + hq * 64, kcol = C_DK + (hq >> 1) * 64, vcol = C_DV + (hq >> 1) * 64, ocol = 768 + hq * 64;
    constexpr int NT = 64 + 4;
#define GX_TROW(t) ((t) < 64 ? b * SEQ + 64 * (t) : MLAT + b * CTXL + 64 * ((t) - 64))
    const bf16_t* Qw = MIX + (size_t)qrow0 * NMIX + qcol;
    LAS unsigned char* shm = F.lds;
    const unsigned lds0 = 0u;
    LAS float* wsf = (LAS float*)(shm + LDS_WS) + wid * 64;
    const bf16_t* ksrc = MIX + (size_t)lane * NMIX + kcol + wid * 8;
    const bf16_t* vsrc = MIX + (size_t)(16 * (wid & 3) + (lane >> 2)) * NMIX + vcol + (wid >> 2) * 32 + (lane & 3) * 8;
    const unsigned kdst = lds0 + LDS_K + wid * 1024, vdst = lds0 + LDS_V + wid * 1024;
#define GX_DMA_K(t, slot) glds16(ksrc + (size_t)GX_TROW(t) * NMIX, (unsigned)__builtin_amdgcn_readfirstlane(kdst + (slot)))
#define GX_DMA_V(t, slot) glds16(vsrc + (size_t)GX_TROW(t) * NMIX, (unsigned)__builtin_amdgcn_readfirstlane(vdst + (slot)))
    const int vb0 = (int)(lds0 + LDS_V) + ((lane >> 4) & 1) * 32 + (lane & 3) * 8 + (4 * hi + ((lane & 15) >> 2)) * 64;
    bf16x8 kf[8];
    const lds_cptr shm3 = (lds_cptr)shm; const lds_cptr kp0 = shm3 + LDS_K + hi * 1024 + r32 * 16; const lds_cptr vp0 = shm3 + LDS_V + ((lane >> 4) & 1) * 32 + (lane & 3) * 8 + (4 * hi + ((lane & 15) >> 2)) * 64;
    GX_DMA_K(0, 0); GX_DMA_V(0, 0); GX_DMA_K(1, SLOTB);
    bf16x8 qr[4];
#pragma unroll
    for (int d0 = 0; d0 < 4; ++d0) qr[d0] = *(const bf16x8*)(Qw + (size_t)r32 * NMIX + d0 * 16 + hi * 8);
    float mhat = 0.f, l_reg = 0.f; f32x16 o[2]; o[0] = f32x16{}; o[1] = f32x16{}; f32x16 negm = f32x16{}; asm volatile("" : "+v"(negm));
    bool resc = false;
#define GX_START(P0, P1) do { const float rm = rowmax(P0, P1); resc = false; \
    { const float dl = rm; mhat = fadd_s(mhat, dl); \
      _Pragma("unroll") for (int r = 0; r < 16; ++r) { P0[r] = fsub_s(P0[r], dl); P1[r] = fsub_s(P1[r], dl); } \
      _Pragma("unroll") for (int r = 0; r < 16; ++r) negm[r] = -mhat; asm volatile("" : "+v"(negm)); } \
    _Pragma("unroll") for (int r = 0; r < 16; ++r) P0[r] = __builtin_amdgcn_exp2f(P0[r]); } while (0)
#define GX_RESC() do { if (resc) { asm volatile("s_waitcnt lgkmcnt(0)" ::: "memory"); \
      _Pragma("unroll") for (int d_ = 0; d_ < 2; ++d_) _Pragma("unroll") for (int r = 0; r < 16; ++r) o[d_][r] *= wsf[crow(r, hi)]; } } while (0)
    f32x16 pA0, pA1, pB0, pB1;
    int sl_prev = 0, sl_cur = 0, sl_next = SLOTB;
#define GX_ROT() do { sl_prev = sl_cur; sl_cur = sl_next; sl_next = (sl_next == (NSLOT - 1) * SLOTB) ? 0 : sl_next + SLOTB; } while (0)
    GX_DMA_K(2, 2 * SLOTB);
    GX_WAIT_BAR(3);
    qkt(pA0, pA1, shm3 + LDS_K, qr, negm, r32, hi); asm volatile("s_nop 15\n\ts_nop 7" : "+v"(pA0), "+v"(pA1));
    GX_START(pA0, pA1);
    _Pragma("unroll") for (int r = 0; r < 16; ++r) pA1[r] = __builtin_amdgcn_exp2f(pA1[r]);
    GX_WAIT_BAR(0);
    GX_DMA_K(3, 0); GX_DMA_V(1, SLOTB);
    GX_ROT();
    kload8(kf, kp0 + sl_cur);
    GX_WAIT_BAR(2);
    s16x4 vlo[8], vhi[8]; u32x4 pw0, pw1, pw2, pw3;
#define GX_PKW(P, B) cvtpk_s(P[B], P[B + 1])
#define GX_PAF(k) __builtin_bit_cast(bf16x8, pw##k)
#define GX_VFR(i) (bf16x8){vlo[i][0], vlo[i][1], vlo[i][2], vlo[i][3], vhi[i][0], vhi[i][1], vhi[i][2], vhi[i][3]}
#define GX_PIN(x) asm volatile("" : "+v"(x))
#define GX_MX3(a, b, c) __builtin_fmaxf(__builtin_fmaxf((a), (b)), (c))
#define GX_GAPA(MF, A0, A1, A2, A3, W0, W1, PW) do { MF; sacc += A0; sacc += A1; sacc += A2; sacc += A3; GX_PIN(sacc); W0; W1; GX_PIN(PW); GX_SBAR(); } while (0)
#define GX_EX(v) __builtin_amdgcn_exp2f(v)
#define GX_GAPB(MF, X, B) do { MF; X[B] = GX_EX(X[B]); X[B + 1] = GX_EX(X[B + 1]); X[B + 2] = GX_EX(X[B + 2]); X[B + 3] = GX_EX(X[B + 3]); GX_PIN(X); GX_SBAR(); } while (0)
#define GX_VRD(i) do { vlo[i] = vtr(vp_ + (((i) >> 2) * 4096 + ((i) & 3) * 1024)); vhi[i] = vtr(vp_ + (((i) >> 2) * 4096 + ((i) & 3) * 1024 + 512)); } while (0)
#define GX_KRD(G, j) do { if (G) { kload2(kf, kp0 + sl_next, j); GX_SBAR(); } } while (0)
#define GX_MFMA __builtin_amdgcn_mfma_f32_32x32x16_bf16
#define GX_STEP(C0, C1, P0, P1, t, GK, GV, GL) do { GX_SBAR(); \
    const lds_cptr vp_ = vp0 + sl_prev; \
    GX_VRD(0); GX_SBAR(); float sacc = (P0[0] + P0[1]); \
    GX_GAPA(C0 = GX_MFMA(kf[0], qr[0], negm, 0, 0, 0), P0[2], P0[3], P0[4], P0[5],     pw0[0] = GX_PKW(P0, 0), pw0[1] = GX_PKW(P0, 2), pw0); \
    GX_VRD(4); GX_SBAR(); GX_GAPA(C1 = GX_MFMA(kf[1], qr[0], negm, 0, 0, 0), P0[6], P0[7], P0[8], P0[9],     pw0[2] = GX_PKW(P0, 4), pw0[3] = GX_PKW(P0, 6), pw0); \
    GX_VRD(1); GX_SBAR(); GX_GAPA(C0 = GX_MFMA(kf[2], qr[1], C0, 0, 0, 0),   P0[10], P0[11], P0[12], P0[13], pw1[0] = GX_PKW(P0, 8), pw1[1] = GX_PKW(P0, 10), pw1); \
    GX_VRD(5); GX_SBAR(); GX_GAPA(C1 = GX_MFMA(kf[3], qr[1], C1, 0, 0, 0),   P0[14], P0[15], P1[0], P1[1],   pw1[2] = GX_PKW(P0, 12), pw1[3] = GX_PKW(P0, 14), pw1); \
    GX_VRD(2); GX_SBAR(); GX_GAPA(C0 = GX_MFMA(kf[4], qr[2], C0, 0, 0, 0),   P1[2], P1[3], P1[4], P1[5],     pw2[0] = GX_PKW(P1, 0), pw2[1] = GX_PKW(P1, 2), pw2); \
    GX_VRD(6); GX_SBAR(); GX_GAPA(C1 = GX_MFMA(kf[5], qr[2], C1, 0, 0, 0),   P1[6], P1[7], P1[8], P1[9],     pw2[2] = GX_PKW(P1, 4), pw2[3] = GX_PKW(P1, 6), pw2); \
    GX_VRD(3); GX_SBAR(); GX_GAPA(C0 = GX_MFMA(kf[6], qr[3], C0, 0, 0, 0),   P1[10], P1[11], P1[12], P1[13], pw3[0] = GX_PKW(P1, 8), pw3[1] = GX_PKW(P1, 10), pw3); \
    GX_VRD(7); GX_SBAR(); GX_GAPA(C1 = GX_MFMA(kf[7], qr[3], C1, 0, 0, 0),   P1[14], P1[15], 0.f, 0.f,       pw3[2] = GX_PKW(P1, 12), pw3[3] = GX_PKW(P1, 14), pw3); \
    l_reg += sacc; \
    if (GK) { GX_DMA_K((t) + 3, sl_cur); } if (GV) { GX_DMA_V((t) + 1, sl_next); } \
    { float a = GX_MX3(C0[0], C0[1], C1[0]), b_ = GX_MX3(C0[2], C0[3], C1[1]); a = GX_MX3(a, C1[2], C1[3]); \
      _Pragma("unroll") for (int r = 4; r < 16; r += 4) { a = GX_MX3(a, C0[r], C0[r + 1]); b_ = GX_MX3(b_, C0[r + 2], C0[r + 3]); a = GX_MX3(a, C1[r], C1[r + 1]); b_ = GX_MX3(b_, C1[r + 2], C1[r + 3]); } \
      float rm = __builtin_fmaxf(a, b_); { auto rr = __builtin_amdgcn_permlane32_swap(__float_as_uint(rm), __float_as_uint(rm), false, false); rm = __builtin_fmaxf(__uint_as_float(rr[0]), __uint_as_float(rr[1])); } \
      resc = false; \
      if (__builtin_expect(__any(rm > (float)THRL), 0)) { const float dl = __builtin_fmaxf(rm, 0.f); mhat += dl; \
        _Pragma("unroll") for (int r = 0; r < 16; ++r) { C0[r] -= dl; C1[r] -= dl; } \
        _Pragma("unroll") for (int r = 0; r < 16; ++r) negm[r] = -mhat; asm volatile("" : "+v"(negm)); \
        const float f = __builtin_amdgcn_exp2f(-dl); l_reg *= f; if (hi == 0) wsf[r32] = f; resc = true; } } \
    GX_SBAR(); \
    GX_GAPB(o[0] = GX_MFMA(GX_PAF(0), GX_VFR(0), o[0], 0, 0, 0), C0, 0); \
    GX_GAPB(o[1] = GX_MFMA(GX_PAF(0), GX_VFR(4), o[1], 0, 0, 0), C0, 4); \
    GX_KRD(GL, 0); GX_GAPB(o[0] = GX_MFMA(GX_PAF(1), GX_VFR(1), o[0], 0, 0, 0), C0, 8); \
    GX_KRD(GL, 1); GX_GAPB(o[1] = GX_MFMA(GX_PAF(1), GX_VFR(5), o[1], 0, 0, 0), C0, 12); \
    GX_KRD(GL, 2); GX_GAPB(o[0] = GX_MFMA(GX_PAF(2), GX_VFR(2), o[0], 0, 0, 0), C1, 0); \
    GX_KRD(GL, 3); GX_GAPB(o[1] = GX_MFMA(GX_PAF(2), GX_VFR(6), o[1], 0, 0, 0), C1, 4); \
    GX_GAPB(o[0] = GX_MFMA(GX_PAF(3), GX_VFR(3), o[0], 0, 0, 0), C1, 8); \
    GX_GAPB(o[1] = GX_MFMA(GX_PAF(3), GX_VFR(7), o[1], 0, 0, 0), C1, 12); \
    } while (0)
    int t = 1;
#pragma unroll 1
    for (; t + 5 < NT; t += 2) {
        GX_STEP(pB0, pB1, pA0, pA1, t, true, true, true);     GX_WAIT_BAR(2); GX_RESC(); GX_ROT();
        GX_STEP(pA0, pA1, pB0, pB1, t + 1, true, true, true); GX_WAIT_BAR(2); GX_RESC(); GX_ROT();
    }
#define GX_ENDW(tt) do { if ((tt) + 3 < NT) { GX_WAIT_BAR(2); } else if ((tt) + 2 < NT) { GX_WAIT_BAR(1); } else { GX_WAIT_BAR(0); } } while (0)
#pragma unroll 1
    for (; t + 1 < NT; t += 2) {
        GX_STEP(pB0, pB1, pA0, pA1, t, (t + 3 < NT), (t + 1 < NT), (t + 1 < NT));         GX_ENDW(t);     GX_RESC(); GX_ROT();
        GX_STEP(pA0, pA1, pB0, pB1, t + 1, (t + 4 < NT), (t + 2 < NT), (t + 2 < NT));     GX_ENDW(t + 1); GX_RESC(); GX_ROT();
    }
    GX_STEP(pB0, pB1, pA0, pA1, NT - 1, false, false, false); GX_RESC();
    { float sacc = pB0[0] + pB0[1]; _Pragma("unroll") for (int r = 2; r < 16; ++r) sacc += pB0[r]; _Pragma("unroll") for (int r = 0; r < 16; ++r) sacc += pB1[r]; l_reg += sacc;
      pw0 = (u32x4){GX_PKW(pB0, 0), GX_PKW(pB0, 2), GX_PKW(pB0, 4), GX_PKW(pB0, 6)}; pw1 = (u32x4){GX_PKW(pB0, 8), GX_PKW(pB0, 10), GX_PKW(pB0, 12), GX_PKW(pB0, 14)};
      pw2 = (u32x4){GX_PKW(pB1, 0), GX_PKW(pB1, 2), GX_PKW(pB1, 4), GX_PKW(pB1, 6)}; pw3 = (u32x4){GX_PKW(pB1, 8), GX_PKW(pB1, 10), GX_PKW(pB1, 12), GX_PKW(pB1, 14)};
      GX_SBAR(); pv(o, vb0 + sl_cur, GX_PAF(0), GX_PAF(1), GX_PAF(2), GX_PAF(3)); }
    { auto rr = __builtin_amdgcn_permlane32_swap(__float_as_uint(l_reg), __float_as_uint(l_reg), false, false); l_reg = __uint_as_float(rr[0]) + __uint_as_float(rr[1]); }
    if (hi == 0) wsf[32 + r32] = l_reg; asm volatile("s_waitcnt lgkmcnt(0)" ::: "memory");
    float rli[16];
#pragma unroll
    for (int r = 0; r < 16; ++r) rli[r] = __builtin_amdgcn_rcpf(wsf[32 + crow(r, hi)]);
    bf16_t* Ow = BR + (size_t)qrow0 * DM + ocol;
    { LAS bf16_t* stg = (LAS bf16_t*)(shm + LDS_OST) + wid * 2048;
#pragma unroll
      for (int r = 0; r < 16; ++r) { const int orow = crow(r, hi);
#pragma unroll
        for (int d0 = 0; d0 < 2; ++d0) stg[orow * 64 + d0 * 32 + r32] = (bf16_t)f2bf(o[d0][r] * rli[r]); }
      asm volatile("s_waitcnt lgkmcnt(0)" ::: "memory");
#pragma unroll
      for (int i = 0; i < 4; ++i) { const int row = i * 8 + (lane >> 3), ch = lane & 7; const u32x4 v = *(const LAS u32x4*)(stg + row * 64 + ch * 8); pg8::st16_wt(Ow + (size_t)row * DM + ch * 8, v); } }
    asm volatile("s_waitcnt lgkmcnt(0)\n\ts_barrier" ::: "memory");
#undef GX_TROW
#undef GX_DMA_K
#undef GX_DMA_V
#undef GX_START
#undef GX_RESC
#undef GX_ROT
#undef GX_PKW
#undef GX_PAF
#undef GX_VFR
#undef GX_PIN
#undef GX_MX3
#undef GX_GAPA
#undef GX_EX
#undef GX_GAPB
#undef GX_VRD
#undef GX_KRD
#undef GX_MFMA
#undef GX_STEP
#undef GX_ENDW
}
}

constexpr int NT_HGRN = 32 * NCH, NT_SSD = 64 * NCH, NT_SCAN = NT_HGRN + NT_SSD;
template <bool PASS_C> __device__ __forceinline__ void scan_tasks(Frame& F, int l, bf16_t* BR) {
    bf16_t* OBA = (bf16_t*)(F.ws + WS_OBA); bf16_t* OBB = (bf16_t*)(F.ws + WS_OBB);
    const int slot = F.wave * F.G + F.bid, nslots = NWAVES * F.G;
#pragma unroll 1
    for (int t = slot; t < NT_SCAN; t += nslots) {
        if (t < NT_HGRN) { const int seq = t / NCH, pc = t % NCH; if (PASS_C && l == 1 && pc == 0) continue;
            hgrn_task<PASS_C>(F, l, seq, pc, seq < 16 ? BR : OBA, seq < 16 ? DM : 256);
        } else { const int t2 = t - NT_HGRN, seq2 = t2 / NCH, pc = t2 % NCH; if (PASS_C && l == 1 && pc == 0) continue;
            ssd_task<PASS_C>(F, l, seq2, pc, seq2 < 32 ? BR + 256 : OBB, seq2 < 32 ? DM : 256);
        }
    }
}
__device__ __forceinline__ void scan_carry(Frame& F) {
    refresh(F);
    bf16_t* STA = (bf16_t*)(F.ws + WS_STA); bf16_t* STB = (bf16_t*)(F.ws + WS_STB);
    const float* DLA = (const float*)(F.ws + WS_DLA); const float* DLB = (const float*)(F.ws + WS_DLB);
    const int gt = F.bid * NTHREADS + F.tid, NGT = F.G * NTHREADS;
    for (int e = gt; e < (32 * 4096 + 64 * 4096) / 2; e += NGT) {
        unsigned kvw[NCH]; float d0[NCH], d1[NCH];
        const bool isA = e < 32 * 2048;
        bf16_t* base;
        if (isA) { const int seq = e >> 11, idx = (e & 2047) * 2; base = STA + (size_t)seq * NCH * 4096 + idx;
            const int k = 32 * (((idx >> 4) & 3) >> 1) + crow(idx & 15, idx >> 11);
#pragma unroll
            for (int pc = 0; pc < NCH; ++pc) { kvw[pc] = *(const unsigned*)(base + (size_t)pc * 4096); const float* dl = DLA + ((size_t)seq * NCH + pc) * 64 + k; d0[pc] = dl[0]; d1[pc] = dl[1]; }
        } else { const int e2 = e - 32 * 2048, seq2 = e2 >> 11, idx = (e2 & 2047) * 2; base = STB + (size_t)seq2 * NCH * 4096 + idx;
#pragma unroll
            for (int pc = 0; pc < NCH; ++pc) { kvw[pc] = *(const unsigned*)(base + (size_t)pc * 4096); d0[pc] = d1[pc] = DLB[(seq2 >> 1) * NCH + pc] * 1.4426950408889634f; }
        }
        float S0 = 0.f, S1 = 0.f;
#pragma unroll
        for (int pc = 0; pc < NCH; ++pc) { const unsigned out = cvtpk(S0, S1);
            S0 = __builtin_amdgcn_exp2f(d0[pc]) * S0 + bflo(kvw[pc]); S1 = __builtin_amdgcn_exp2f(d1[pc]) * S1 + bfhi(kvw[pc]); kvw[pc] = out; }
#pragma unroll
        for (int pc = 0; pc < NCH; ++pc) *(unsigned*)(base + (size_t)pc * 4096) = kvw[pc];
    }
}

template <int STAGE> __device__ __forceinline__ void mixers_phase(Frame& F, int l, bf16_t* BR) {
    refresh(F);
    scan_tasks<STAGE == 2>(F, l, BR);
    refresh(F);
    const int slot = F.wave * F.G + F.bid, nslots = NWAVES * F.G;
    if (STAGE == 0) {
        if (l == 0) {
#pragma unroll 1
            for (int u = nslots - 1 - slot; u < NA_CTX; u += nslots) attn_task<2>(F, l, u, BR); }
        __syncthreads();
#pragma unroll 1
        for (int u = F.bid; u < 256; u += F.G) attn_block_task<1>(F, l, u, BR);
    } else {
        __syncthreads();
#pragma unroll 1
        for (int u = F.bid; u < 256; u += F.G) gx::gqa_unit<8>(F, u, BR);
    }
}

__device__ __forceinline__ void combine_phase(Frame& F, int l, bf16_t* BR, int nrows) {
    refresh(F);
    const bf16_t* MIX = (const bf16_t*)(F.ws + WS_RC);
    const bf16_t* OBA = (const bf16_t*)(F.ws + WS_OBA); const bf16_t* OBB = (const bf16_t*)(F.ws + WS_OBB);
    const int gw = F.bid * NWAVES + F.wave, NGW = F.G * NWAVES;
    const int m0 = gw, m1 = nrows;
    const int c0 = 4 * F.lane, head = F.lane >> 4;
    const f32x4 hw4 = *(const f32x4*)(FIN(8) + l * 256 + c0), sw4 = *(const f32x4*)(FIN(14) + l * 256 + c0); const float dk = FIN(13)[l * 4 + head];
    u32x2 n_of, n_ob, n_ag, n_sf, n_sb, n_zz, n_xc;
#define CB_LOAD(M) do { const size_t m_ = (size_t)(M); const bf16_t* br_ = BR + m_ * DM; const bf16_t* mx_ = MIX + m_ * NMIX; \
        n_of = __builtin_nontemporal_load((const u32x2*)(br_ + c0)); n_ob = __builtin_nontemporal_load((const u32x2*)(OBA + m_ * 256 + c0)); n_ag = __builtin_nontemporal_load((const u32x2*)(mx_ + C_AG + c0)); \
        n_sf = __builtin_nontemporal_load((const u32x2*)(br_ + 256 + c0)); n_sb = __builtin_nontemporal_load((const u32x2*)(OBB + m_ * 256 + c0)); n_zz = __builtin_nontemporal_load((const u32x2*)(mx_ + C_BZ + c0)); n_xc = __builtin_nontemporal_load((const u32x2*)(mx_ + C_BX + c0)); } while (0)
    if (m0 < m1) CB_LOAD(m0);
#pragma unroll 1
    for (int m = m0; m < m1; m += NGW) {
        const u32x2 of = n_of, ob = n_ob, ag = n_ag, sf = n_sf, sb = n_sb, zz = n_zz, xc = n_xc;
        if (m + NGW < m1) CB_LOAD(m + NGW);
        bf16_t* br = BR + (size_t)m * DM;
        { float t0 = bflo(of.x) + bflo(ob.x), t1 = bfhi(of.x) + bfhi(ob.x), t2 = bflo(of.y) + bflo(ob.y), t3 = bfhi(of.y) + bfhi(ob.y);
          float ss = (t0 * t0 + t1 * t1) + (t2 * t2 + t3 * t3);
          ss += dppf_<0xB1, 0xF, true>(ss); ss += dppf_<0x4E, 0xF, true>(ss); ss += dppf_<0x141, 0xF, true>(ss); ss += dppf_<0x140, 0xF, true>(ss);
          const float rs = 1.f / sqrtf(ss * (1.f / 64.f) + LN_EPS);
          u32x2 w; w.x = pk2(t0 * rs * hw4.x * siluf_(bflo(ag.x)), t1 * rs * hw4.y * siluf_(bfhi(ag.x)));
          w.y = pk2(t2 * rs * hw4.z * siluf_(bflo(ag.y)), t3 * rs * hw4.w * siluf_(bfhi(ag.y)));
          wt8a(br + c0, w); }
        { float y0 = (bflo(sf.x) + bflo(sb.x) + bflo(xc.x) * dk) * siluf_(bflo(zz.x));
          float y1 = (bfhi(sf.x) + bfhi(sb.x) + bfhi(xc.x) * dk) * siluf_(bfhi(zz.x));
          float y2 = (bflo(sf.y) + bflo(sb.y) + bflo(xc.y) * dk) * siluf_(bflo(zz.y));
          float y3 = (bfhi(sf.y) + bfhi(sb.y) + bfhi(xc.y) * dk) * siluf_(bfhi(zz.y));
          const float ss = wave_sum((y0 * y0 + y1 * y1) + (y2 * y2 + y3 * y3));
          const float rs = 1.f / sqrtf(ss * (1.f / 256.f) + LN_EPS);
          u32x2 w; w.x = pk2(y0 * rs * sw4.x, y1 * rs * sw4.y); w.y = pk2(y2 * rs * sw4.z, y3 * rs * sw4.w);
          wt8a(br + 256 + c0, w); }
    }
#undef CB_LOAD
}

#define XB_TMO      128
#define XB_XCNT(j)  (256  + 64 * (j))
#define XB_XSUB(j)  (1280 + 64 * (j))
#define XB_XGEN(j)  (2304 + 64 * (j))
#define XB_TOP      3328
#define XB_TOPGEN   3392
#define XCD_BAR_WORDS 3456
#define XB_SPIN_CAP (1u << 18)
__device__ __forceinline__ unsigned xb_ld(unsigned* p)              { return __hip_atomic_load(p, __ATOMIC_RELAXED, __HIP_MEMORY_SCOPE_AGENT); }
__device__ __forceinline__ unsigned xb_add(unsigned* p, unsigned v) { return __hip_atomic_fetch_add(p, v, __ATOMIC_RELAXED, __HIP_MEMORY_SCOPE_AGENT); }
__device__ __forceinline__ unsigned xb_xcc_id() { return (unsigned)__builtin_amdgcn_s_getreg((3 << 11) | 20) & 0xFu; }
#define XB_SPIN(cond, bar) do { unsigned _sp = 0; while (cond) { __builtin_amdgcn_s_sleep(1); \
    if ((++_sp & 255u) == 0u) { if (xb_ld(&(bar)[XB_TMO])) break; if (_sp > XB_SPIN_CAP) { atomicAdd(&(bar)[XB_TMO], 1u); break; } } } } while (0)
struct XcdBarrier { unsigned* bar; unsigned x; volatile LAS unsigned* st; };
__device__ __forceinline__ XcdBarrier xcd_barrier_post(unsigned* bar, volatile LAS unsigned* st, bool t0) {
    XcdBarrier b; b.bar = bar; b.x = xb_xcc_id(); b.st = st;
    if (t0) (void)xb_add(&bar[XB_XCNT(b.x)], 1u);
    return b;
}
__device__ __forceinline__ void xcd_barrier_complete(unsigned* bar, unsigned x, unsigned& nloc, unsigned& nx) {
    const unsigned G = gridDim.x * gridDim.y * gridDim.z;
    unsigned sum, cnt, mine, sp = 0u;
    for (;;) {
        sum = 0u; cnt = 0u; mine = 0u;
#pragma unroll
        for (unsigned j = 0; j < 16; ++j) { const unsigned c = xb_ld(&bar[XB_XCNT(j)]); sum += c; cnt += (c > 0u) ? 1u : 0u; mine = (j == x) ? c : mine; }
        if (sum == G) break;
        __builtin_amdgcn_s_sleep(1);
        if ((++sp & 255u) == 0u) { if (xb_ld(&bar[XB_TMO])) break; if (sp > XB_SPIN_CAP) { atomicAdd(&bar[XB_TMO], 1u); break; } }
    }
    nloc = mine > 0u ? mine : 1u; nx = cnt > 0u ? cnt : 1u;
}
__device__ __forceinline__ void xcd_barrier(const XcdBarrier& b, int wave_s) {
    asm volatile("s_waitcnt vmcnt(0)" ::: "memory");
    __syncthreads();
    int ln_; asm volatile("v_mbcnt_lo_u32_b32 %0, -1, 0\n\tv_mbcnt_hi_u32_b32 %0, -1, %0" : "=v"(ln_));
    if (wave_s == 0 && ln_ == 0) {
        unsigned* bar = b.bar;
        __builtin_amdgcn_s_waitcnt(0);
        unsigned nloc = b.st[0], nx = b.st[1];
        if (nloc == 0u) { xcd_barrier_complete(bar, b.x, nloc, nx); b.st[0] = nloc; b.st[1] = nx; }
        const unsigned old = xb_add(&bar[XB_XSUB(b.x)], 1u);
        const unsigned gen = old / nloc;
        if (old + 1u == (gen + 1u) * nloc) {
            __builtin_amdgcn_fence(__ATOMIC_RELEASE, "agent");
            asm volatile("s_waitcnt vmcnt(0)" ::: "memory");
            const unsigned og = xb_add(&bar[XB_TOP], 1u);
            const unsigned tg = og / nx;
            if (og + 1u == (tg + 1u) * nx) xb_add(&bar[XB_TOPGEN], 1u);
            else XB_SPIN(xb_ld(&bar[XB_TOPGEN]) == tg, bar);
            __builtin_amdgcn_fence(__ATOMIC_ACQUIRE, "agent");
            asm volatile("s_waitcnt vmcnt(0)" ::: "memory");
        } else {
            XB_SPIN(xb_ld(&bar[XB_TOPGEN]) == gen, bar);
            __builtin_amdgcn_fence(__ATOMIC_ACQUIRE, "agent");
            asm volatile("s_waitcnt vmcnt(0)" ::: "memory");
        }
    }
    __syncthreads();
}

#define GSYNC() xcd_barrier(bar, F.wave_s)
#define MODS ((float*)(F.ws + WS_MODS))
#define DT ((float*)(F.ws + WS_DT))
#define XC ((float*)(F.ws + WS_XC))
#define MIX ((bf16_t*)(F.ws + WS_RC))
#define WIN ((const bf16_t*)(F.ws + WS_WIN))
#define WBR ((const bf16_t*)(F.ws + WS_WBR))
#define WOUT ((const bf16_t*)(F.ws + WS_WOUT))
#define WUP ((const bf16_t*)(F.ws + WS_WUP))
#define WDN ((const bf16_t*)(F.ws + WS_WDN))
#define SLABS ((bf16_t*)(F.ws + WS_RC + (size_t)94 * MiB))
template <int l> __device__ __forceinline__ void layer_body(Frame& F, const XcdBarrier& bar) {
        constexpr bool last = (l == DEPTH - 1);
#define H ((bf16_t*)(F.ws + WS_RA))
#define BR ((bf16_t*)(F.ws + WS_RB))
#define mods_l (MODS + (size_t)l * 5 * 6144)
        constexpr int Mpost = last ? MLAT : MALL;
#define xlat (l == 0 ? FIN(0) : ((float*)(F.a->out)))
#define xctx (l == 0 ? FIN(2) : XC)

        { pg8::Gemm g{H, WIN, MALL, NMIX}; pg8::StaticOrder S; S.init(MALL, NMIX, F.G, F.bid);
          pg8::EpiStoreFG E{MIX, NMIX, l == 1 ? FIN(7) : (const float*)nullptr}; pg8::gemm_phase<pg8::EpiStoreFG, DM, DM, DM, 0, 0>(F.lds, g, S, E, tid_from_lds(F.lds, F.wave_s)); }
        GSYNC();
        prep_phase(F, l);
        conv_to_lds(F, l);
        GSYNC();
        conv_from_lds(F);
        GSYNC();
        mixers_phase<0>(F, l, BR);
        GSYNC();
        scan_carry(F);
        GSYNC();
        mixers_phase<2>(F, l, BR);
        GSYNC();
        combine_phase(F, l, BR, Mpost);
        if constexpr (last) convert_weights<1>(F, l);
        GSYNC();
        { pg8::Gemm g{H, WIN + (size_t)NMIX * DM, Mpost, 4096}; pg8::StaticOrder S; S.init(Mpost, 4096, F.G, F.bid);
          pg8::EpiGateStore E{MIX}; pg8::gemm_phase<pg8::EpiGateStore, DM, DM, DM, 0, 0>(F.lds, g, S, E, tid_from_lds(F.lds, F.wave_s)); }
        if constexpr (!last) convert_weights<1>(F, l, 64, F.G - 64);
        GSYNC();
        unsigned* seam45 = (unsigned*)(F.ws + WS_SEAM) + (size_t)(l * 4 + 0) * 68 * 64; unsigned* btmo = (unsigned*)(F.ws + WS_CTL) + XB_TMO;
        { pg8::Gemm g{BR, WBR, Mpost, DM}; pg8::SeamOrder S; S.init(Mpost, DM, F.G, F.bid); S.ready = nullptr; S.need = 0u; S.pub = seam45; S.tmo = btmo;
          pg8::EpiHorner E{MIX, H}; pg8::gemm_phase<pg8::EpiHorner, DM, DM, DM, 0, 0, pg8::SeamOrder, 256>(F.lds, g, S, E, tid_from_lds(F.lds, F.wave_s)); }
        { pg8::Gemm g{H, WOUT, Mpost, DM}; pg8::SeamOrder S; S.init(Mpost, DM, F.G, F.bid); S.ready = seam45; S.need = 32u; S.pub = nullptr; S.tmo = btmo;
          pg8::EpiStore E{BR, DM}; pg8::gemm_phase<pg8::EpiStore, DM, DM, DM, 0, 0, pg8::SeamOrder>(F.lds, g, S, E, tid_from_lds(F.lds, F.wave_s)); }
        GSYNC();
        {
            RowOp R{}; R.nrows = Mpost; R.xlat_in = xlat; R.xctx_in = xctx; R.post = true; R.Y = BR; R.gate_chunk = 2; R.lng = FIN(20) + l * DM; R.lnb = FIN(21) + l * DM; R.mods_post = mods_l;
            R.xlat_out = ((float*)(F.a->out)); R.xctx_out = XC; R.domod = true; R.mods_mod = mods_l; R.shift_chunk = 3; R.scale_chunk = 4; R.Hout = H; R.dodt = false; R.DTout = DT;
            row_pass(F, R, FIN(6));
        }
        GSYNC();
        { pg8::Gemm g{H, WUP, Mpost, 2 * FFH}; pg8::StaticOrder S; S.init(Mpost, 2 * FFH, F.G, F.bid);
          pg8::EpiSwiGLU E{MIX, FFH}; pg8::gemm_phase<pg8::EpiSwiGLU, DM, DM, DM, 0, 0>(F.lds, g, S, E, tid_from_lds(F.lds, F.wave_s)); }
        GSYNC();
        { pg8::Gemm g{MIX, WDN, MLAT, DM}; pg8::StaticOrder S; S.init(MLAT, DM, F.G, F.bid);
          pg8::EpiStore E{BR, DM}; pg8::gemm_phase<pg8::EpiStore, FFH, FFH, FFH, 0, 0>(F.lds, g, S, E, tid_from_lds(F.lds, F.wave_s)); }
        if (!last) {
          pg8::Gemm g{MIX, WDN, MALL, DM}; pg8::SplitOrder S; S.init(MCTX / 256, DM / 256, FFH / 256, MLAT / 256, F.G, F.bid);
          pg8::EpiSlab E{SLABS, MLAT / 256, MCTX}; pg8::gemm_phase<pg8::EpiSlab, 256, FFH, FFH, 0, 0, pg8::SplitOrder>(F.lds, g, S, E, tid_from_lds(F.lds, F.wave_s)); }
        GSYNC();
        {
            RowOp R{}; R.nrows = Mpost; R.xlat_in = ((float*)(F.a->out)); R.xctx_in = XC; R.post = true; R.Y = BR; R.slabs = SLABS; R.nslab = last ? 0 : FFH / 256; R.slab_row0 = MLAT; R.gate_chunk = 5; R.lng = FIN(24) + l * DM; R.lnb = FIN(25) + l * DM; R.mods_post = mods_l;
            R.xlat_out = ((float*)(F.a->out)); R.xctx_out = XC; R.domod = !last; R.mods_mod = MODS + (size_t)(l + 1) * 5 * 6144; R.shift_chunk = 0; R.scale_chunk = 1; R.Hout = H; R.dodt = !last; R.DTout = DT;
            row_pass(F, R, FIN(6) + (size_t)(last ? l : l + 1) * DM * INC);
            if (!last) { convert_weights<0>(F, l + 1); GSYNC(); }
        }
}

__global__ void __launch_bounds__(NTHREADS, 2) fwd_megakernel(Args args) {
    extern __shared__ __attribute__((aligned(16))) unsigned char lds_raw[];
    Frame F;
    F.lds = (LAS unsigned char*)lds_raw;
    F.G = gridDim.x; F.bid = blockIdx.x; F.a = &args; F.ws = args.ws; F.ws0 = args.ws;
    { const int t0 = threadIdx.x; F.wave_s = __builtin_amdgcn_readfirstlane(t0 >> 6);
      *(LAS int*)(F.lds + TIDTAB_OFF + t0 * 4) = t0;
      volatile LAS unsigned* bst0 = (volatile LAS unsigned*)(F.lds + 8 * WLDS); if (t0 < 2) bst0[t0] = 0u; }
    __syncthreads();
    refresh(F);
    volatile LAS unsigned* bst = (volatile LAS unsigned*)(F.lds + 8 * WLDS);
    const XcdBarrier bar = xcd_barrier_post((unsigned*)(F.ws + WS_CTL), bst, F.tid == 0);

    mods_phase(F);
    convert_weights<0>(F, 0);
    GSYNC();
    {
        RowOp R{}; R.nrows = MALL; R.xlat_in = FIN(0); R.xctx_in = FIN(2); R.post = false; R.domod = true; R.mods_mod = MODS; R.shift_chunk = 0; R.scale_chunk = 1;
        R.Hout = (bf16_t*)(F.ws + WS_RA); R.dodt = true; R.DTout = DT;
        row_pass(F, R, FIN(6));
    }
    GSYNC();

    layer_body<0>(F, bar);
    layer_body<1>(F, bar);
}

extern "C" void kernel_launch(void* const* d_in, const int* in_sizes, int n_in, void* d_out, int out_size, void* d_ws, size_t ws_size, hipStream_t stream) {
    static int grid = 0;
    if (grid == 0) {
        if (n_in != 26 || out_size != MLAT * DM || ws_size < WS_END) { fprintf(stderr, "kernel_launch: unexpected shapes (n_in %d out %d ws %zu)\n", n_in, out_size, ws_size); grid = -1; return; }
        int dev = 0, cus = 0, per_cu = 0;
        hipGetDevice(&dev); hipDeviceGetAttribute(&cus, hipDeviceAttributeMultiprocessorCount, dev);
        hipFuncSetAttribute((const void*)fwd_megakernel, hipFuncAttributeMaxDynamicSharedMemorySize, LDS_BYTES);
        hipOccupancyMaxActiveBlocksPerMultiprocessor(&per_cu, (const void*)fwd_megakernel, NTHREADS, LDS_BYTES);
        if (per_cu < 1) { fprintf(stderr, "kernel_launch: occupancy query says %d\n", per_cu); per_cu = 1; }
        (void)hipGetLastError();
        grid = cus * 1;
    }
    if (grid < 0) return;
    if (hipMemsetAsync((char*)d_ws + WS_CTL, 0, CTL_ZERO_BYTES, stream) != hipSuccess) { fprintf(stderr, "kernel_launch: memset failed\n"); return; }
    Args a{};
    for (int i = 0; i < 26; ++i) a.in[i] = (GAS const float*)d_in[i];
    a.out = (GAS float*)d_out; a.ws = (GAS unsigned char*)d_ws;
    hipLaunchKernelGGL(fwd_megakernel, dim3(grid), dim3(NTHREADS), LDS_BYTES, stream, a);
    hipError_t e = hipPeekAtLastError();
    if (e != hipSuccess) fprintf(stderr, "launch failed: %s (grid %d)\n", hipGetErrorString(e), grid);
}
```

```cpp
#include <hip/hip_runtime.h>
#include <cstdio>
#include <cstdint>

#define LAS __attribute__((address_space(3)))
typedef unsigned short bf16_t;
typedef short bf16x8 __attribute__((ext_vector_type(8)));
typedef float f32x4 __attribute__((ext_vector_type(4)));
typedef unsigned u32x4 __attribute__((ext_vector_type(4)));
typedef unsigned u32x2 __attribute__((ext_vector_type(2)));

constexpr int DM = 1024, NB = 4, SEQ = 4096, CTXL = 256, DEPTH = 2;
constexpr int MLAT = NB * SEQ;
constexpr int MCTX = NB * CTXL;
constexpr int MALL = MLAT + MCTX;
constexpr int INC = 7688;
constexpr int NMIX = 3584;
constexpr int FFH = 2816;
constexpr float LN_EPS = 1e-6f;
constexpr float ALPHA = 1.4142135623730951f;
constexpr int C_AQ = 0, C_AFF = 256, C_AFB = 512, C_AV = 768, C_AG = 1024, C_BZ = 1280, C_BX = 1536, C_BB = 1792, C_BC = 2048,
              C_CQ = 2304, C_CK = 2560, C_CV = 2816, C_DQ = 3072, C_DK = 3328, C_DV = 3456;

constexpr size_t MiB = 1u << 20;
constexpr size_t WS_CTL = 0, CTL_ZERO_BYTES = 32768 + 8 * 68 * 256;
constexpr size_t WS_SEAM = 32768;
constexpr size_t WS_MODS = 1 * MiB;
constexpr size_t WS_DT = 2 * MiB;
constexpr size_t WS_XC = 3 * MiB;
constexpr size_t WS_WIN = 8 * MiB;
constexpr size_t WS_WBR = 23 * MiB;
constexpr size_t WS_WOUT = 25 * MiB;
constexpr size_t WS_WUP = 33 * MiB;
constexpr size_t WS_WDN = 44 * MiB;
constexpr size_t WS_RA = 50 * MiB;
constexpr size_t WS_RB = 84 * MiB;
constexpr size_t WS_RC = 118 * MiB;
constexpr size_t WS_OBA = WS_RC + 119 * MiB;
constexpr size_t WS_OBB = WS_OBA + 17 * MiB / 2;
constexpr size_t WS_END = 254 * MiB;
constexpr size_t WS_STA = 33 * MiB;
constexpr size_t WS_STB = WS_STA + (size_t)32 * 17 * 4096 * 2;
constexpr size_t WS_DLA = 46 * MiB;
constexpr size_t WS_DLB = 47 * MiB;
static_assert(WS_STB + (size_t)64 * 17 * 4096 * 2 <= WS_DLA, "scan state map");

constexpr int NWAVES = 8, NTHREADS = 512;
constexpr int LDS_BYTES = 155648 + 64 + 2048;
constexpr int WLDS = 19456;

__device__ __forceinline__ float bf2f(unsigned u) { return __uint_as_float(u << 16); }
__device__ __forceinline__ float bflo(unsigned w) { return __uint_as_float(w << 16); }
__device__ __forceinline__ float bfhi(unsigned w) { return __uint_as_float(w & 0xffff0000u); }
__device__ __forceinline__ unsigned f2bf(float f) { unsigned u = __float_as_uint(f); return (u + 0x7fffu + ((u >> 16) & 1u)) >> 16; }
__device__ __forceinline__ unsigned pk2(float lo, float hi) { return f2bf(lo) | (f2bf(hi) << 16); }
__device__ __forceinline__ float sigmoidf_(float x) { return __builtin_amdgcn_rcpf(1.f + __expf(-x)); }
__device__ __forceinline__ float siluf_(float x) { return x * sigmoidf_(x); }
template <int CTRL, int RMASK, bool BC> __device__ __forceinline__ float dppf_(float v) { return __int_as_float(__builtin_amdgcn_update_dpp(0, __float_as_int(v), CTRL, RMASK, 0xF, BC)); }
__device__ __forceinline__ float wave_sum(float v) {
    v += dppf_<0xB1, 0xF, true>(v);
    v += dppf_<0x4E, 0xF, true>(v);
    v += dppf_<0x141, 0xF, true>(v);
    v += dppf_<0x140, 0xF, true>(v);
    v += dppf_<0x142, 0xA, false>(v);
    v += dppf_<0x143, 0xC, false>(v);
    return __int_as_float(__builtin_amdgcn_readlane(__float_as_int(v), 63));
}
#define LDS_WAIT() asm volatile("s_waitcnt lgkmcnt(0)" ::: "memory")

__device__ __forceinline__ void wt8a(void* p, u32x2 v) { __hip_atomic_store((unsigned long long*)p, ((unsigned long long)v.y << 32) | v.x, __ATOMIC_RELAXED, __HIP_MEMORY_SCOPE_AGENT); }

namespace pg8 {
constexpr int BM = 256, BK = 64, HALF = 128, HTB = HALF * BK * 2, STAGE_BYTES = 8 * HTB, NXCD = 8, WGM = 8;
__host__ __device__ __forceinline__ int lds_byte(int r, int c) { const int st = (r >> 4) * 2 + (c >> 5), rr = r & 15, cc = c & 31, ob = rr * 64 + cc * 2; return st * 1024 + (ob ^ (((ob >> 9) & 1) << 5)); }
__host__ __device__ __forceinline__ void stage_rc(int b, int& R, int& C) { const int st = b / 1024, sb = b % 1024, swz = sb ^ (((sb >> 9) & 1) << 5); R = (st >> 1) * 16 + swz / 64; C = (st & 1) * 32 + (swz % 64) / 2; }
__host__ __device__ __forceinline__ int perm32(int rho) { const int n = rho >> 4, i = rho & 15; return 8 * (i >> 2) + 4 * n + (i & 3); }

struct Unit { int pm, pn, kc; };
struct Gemm { const bf16_t* A; const bf16_t* Bt; int M, N; };

__device__ __forceinline__ void st16_wt(void* p, u32x4 v) { asm volatile("global_store_dwordx4 %0, %1, off sc1\n\ts_nop 1" :: "v"(p), "v"(v) : "memory"); }
struct StaticOrder {
    __device__ __forceinline__ void a_ready(const Unit&, int, int) const {}
    __device__ __forceinline__ void done(const Unit&, int) const {}
    int nM, nN, nwg, G, c;
    __device__ void init(int M, int N, int G_, int c_) { nM = M / BM; nN = N / BM; nwg = nM * nN; G = G_; c = c_; }
    __device__ bool next(int i, Unit& u) const { return unit_of((long)i * G + c, u); }
    __device__ bool unit_of(long L, Unit& u) const {
        if (L >= nwg) return false;
        int wgid = (int)L; { const int q = nwg / NXCD, r = nwg % NXCD, xcd = wgid % NXCD, off = wgid / NXCD; wgid = (xcd < r ? xcd * (q + 1) : r * (q + 1) + (xcd - r) * q) + off; }
        const int nig = WGM * nN, gid = wgid / nig, fm = gid * WGM, gsz = (nM - fm) < WGM ? (nM - fm) : WGM;
        u.pm = fm + ((wgid % nig) % gsz); u.pn = (wgid % nig) / gsz; u.kc = 0; return true;
    }
};

struct SeamOrder : StaticOrder {
    const unsigned* ready; unsigned need; unsigned* pub; unsigned* tmo;
    int off1;
    __device__ bool next(int i, Unit& u) const {
        if (off1 < 0) return StaticOrder::next(i, u);
        if (i == 0) return unit_of(c, u);
        if (i > 1) return false;
        const int e = c - off1; if (e < 0 || e >= nwg - G) return false;
        return unit_of((long)G + e, u); }
    __device__ __forceinline__ void a_ready(const Unit& u, int wid, int lane) const {
        if (ready == nullptr) return;
        if (wid == 0) {
            unsigned sp = 0u;
            while ((unsigned)__builtin_amdgcn_readfirstlane(__hip_atomic_load(ready + 64 * u.pm, __ATOMIC_RELAXED, __HIP_MEMORY_SCOPE_AGENT)) < need) {
                __builtin_amdgcn_s_sleep(2);
                if ((++sp & 255u) == 0u) { if (__builtin_amdgcn_readfirstlane(__hip_atomic_load(tmo, __ATOMIC_RELAXED, __HIP_MEMORY_SCOPE_AGENT)) != 0u) break; if (sp > (1u << 18)) { if (lane == 0) atomicAdd(tmo, 1u); break; } } }
            __builtin_amdgcn_fence(__ATOMIC_ACQUIRE, "agent");
            asm volatile("s_waitcnt vmcnt(0)" ::: "memory");
        }
        asm volatile("" ::: "memory"); __builtin_amdgcn_s_barrier(); asm volatile("" ::: "memory");
    }
    __device__ __forceinline__ void done(const Unit& u, int lane) const {
        if (pub == nullptr) return;
        asm volatile("s_waitcnt vmcnt(0)" ::: "memory");
        if (lane == 0) (void)__hip_atomic_fetch_add(pub + 64 * u.pm, 1u, __ATOMIC_RELAXED, __HIP_MEMORY_SCOPE_AGENT);
    }
};
struct SplitOrder {
    __device__ __forceinline__ void a_ready(const Unit&, int, int) const {}
    __device__ __forceinline__ void done(const Unit&, int) const {}
    int nsub, G, c, nkc, nn, pm0;
    __device__ void init(int ntiles_m, int nn_, int nkc_, int pm0_, int G_, int c_) { nn = nn_; nkc = nkc_; pm0 = pm0_; nsub = ntiles_m * nn_ * nkc_; G = G_; c = c_; }
    __device__ bool next(int i, Unit& u) const { const int L = i * G + c; if (L >= nsub) return false; const int tile = L / nkc; u.kc = L % nkc; u.pm = pm0 + tile / nn; u.pn = tile % nn; return true; }
};
struct GroupOrder {
    int ngrp, G, c;
    __device__ void init(int M, int G_, int c_) { ngrp = (M / BM) * 4; G = G_; c = c_; }
    __device__ bool next(int i, Unit& u) const { const int grp = (i >> 2) * G + c; if (grp >= ngrp) return false; u.pm = grp >> 2; u.pn = 4 * (i & 3) + (grp & 3); u.kc = 0; return true; }
};
typedef float f32x2c_t __attribute__((ext_vector_type(2))); typedef __bf16 bf16x2c_t __attribute__((ext_vector_type(2)));
__device__ __forceinline__ unsigned cvt_pk_bf16(float lo, float hi) { f32x2c_t v = {lo, hi}; bf16x2c_t b = __builtin_convertvector(v, bf16x2c_t); return __builtin_bit_cast(unsigned, b); }

struct EpiStore {
    bf16_t* O; int ldc;
    __device__ __forceinline__ void operator()(const f32x4 (&acc)[2][2][4][2], const Unit& u, int wr, int wc, int fr, int fq) const {
        const int row0 = u.pm * BM + wr * 64 + fr; const int col0 = u.pn * BM + wc * 32 + 8 * fq;
#pragma unroll
        for (int ai = 0; ai < 2; ++ai)
#pragma unroll
            for (int m = 0; m < 4; ++m) { bf16_t* rowp = O + (size_t)(row0 + ai * HALF + m * 16) * ldc + col0;
#pragma unroll
                for (int bj = 0; bj < 2; ++bj) { const f32x4 v0 = acc[ai][bj][m][0], v1 = acc[ai][bj][m][1];
                    u32x4 w; w.x = cvt_pk_bf16(v0[0], v0[1]); w.y = cvt_pk_bf16(v0[2], v0[3]); w.z = cvt_pk_bf16(v1[0], v1[1]); w.w = cvt_pk_bf16(v1[2], v1[3]);
                    st16_wt((rowp + bj * HALF), w); } }
    }
};
struct EpiStoreFG {
    bf16_t* O; int ldc; const float* lbp;
    __device__ __forceinline__ void operator()(const f32x4 (&acc)[2][2][4][2], const Unit& u, int wr, int wc, int fr, int fq) const {
        const int row0 = u.pm * BM + wr * 64 + fr; const int col0 = u.pn * BM + wc * 32 + 8 * fq;
        const bool isg = (u.pn == 1) || (u.pn == 2);
        float lb[2][8];
#pragma unroll
        for (int bj = 0; bj < 2; ++bj)
#pragma unroll
            for (int j = 0; j < 8; ++j) lb[bj][j] = 0.f;
        if (isg && lbp) { const float* p = lbp + (u.pn - 1) * 512 + wc * 32 + 8 * fq;
#pragma unroll
            for (int bj = 0; bj < 2; ++bj)
#pragma unroll
                for (int j = 0; j < 8; ++j) lb[bj][j] = __builtin_amdgcn_rcpf(1.f + __expf(p[bj * HALF + j] - p[256 + bj * HALF + j])); }
#pragma unroll
        for (int ai = 0; ai < 2; ++ai)
#pragma unroll
            for (int m = 0; m < 4; ++m) { bf16_t* rowp = O + (size_t)(row0 + ai * HALF + m * 16) * ldc + col0;
#pragma unroll
                for (int bj = 0; bj < 2; ++bj) { f32x4 v0 = acc[ai][bj][m][0], v1 = acc[ai][bj][m][1];
                    if (isg) {
#pragma unroll
                        for (int j = 0; j < 4; ++j) { v0[j] = fmaxf(__log2f(lb[bj][j] + (1.f - lb[bj][j]) * sigmoidf_(v0[j])), -126.f); v1[j] = fmaxf(__log2f(lb[bj][4 + j] + (1.f - lb[bj][4 + j]) * sigmoidf_(v1[j])), -126.f); } }
                    u32x4 w; w.x = cvt_pk_bf16(v0[0], v0[1]); w.y = cvt_pk_bf16(v0[2], v0[3]); w.z = cvt_pk_bf16(v1[0], v1[1]); w.w = cvt_pk_bf16(v1[2], v1[3]);
                    st16_wt((rowp + bj * HALF), w); } }
    }
};
struct EpiGateMul {
    bf16_t* O; int ldc;
    __device__ __forceinline__ void operator()(const f32x4 (&acc)[2][2][4][2], const Unit& u, int wr, int wc, int fr, int fq) const {
        const int row0 = u.pm * BM + wr * 64 + fr; const int col0 = u.pn * BM + wc * 32 + 8 * fq;
#pragma unroll
        for (int ai = 0; ai < 2; ++ai)
#pragma unroll
            for (int m = 0; m < 4; ++m) { bf16_t* rowp = O + (size_t)(row0 + ai * HALF + m * 16) * ldc + col0;
#pragma unroll
                for (int bj = 0; bj < 2; ++bj) { const f32x4 v0 = acc[ai][bj][m][0], v1 = acc[ai][bj][m][1];
                    const u32x4 g = *(const u32x4*)(rowp + bj * HALF);
                    u32x4 w;
                    w.x = cvt_pk_bf16(v0[0] * sigmoidf_(bflo(g.x)), v0[1] * sigmoidf_(bfhi(g.x)));
                    w.y = cvt_pk_bf16(v0[2] * sigmoidf_(bflo(g.y)), v0[3] * sigmoidf_(bfhi(g.y)));
                    w.z = cvt_pk_bf16(v1[0] * sigmoidf_(bflo(g.z)), v1[1] * sigmoidf_(bfhi(g.z)));
                    w.w = cvt_pk_bf16(v1[2] * sigmoidf_(bflo(g.w)), v1[3] * sigmoidf_(bfhi(g.w)));
                    st16_wt((rowp + bj * HALF), w); } }
    }
};
__device__ __forceinline__ size_t gate_frag_off(int pm, int pn16, int ai, int m, int bj, int tid) { return ((size_t)(pm * 16 + pn16) << 16) + (size_t)((((ai * 4 + m) * 2 + bj) * 512 + tid) * 8); }
struct EpiGateStore {
    bf16_t* G;
    __device__ __forceinline__ void operator()(const f32x4 (&acc)[2][2][4][2], const Unit& u, int wr, int wc, int fr, int fq) const {
        const int tid = (wr * 4 + wc) * 64 + fq * 16 + fr;
#pragma unroll
        for (int ai = 0; ai < 2; ++ai)
#pragma unroll
            for (int m = 0; m < 4; ++m)
#pragma unroll
                for (int bj = 0; bj < 2; ++bj) { const f32x4 v0 = acc[ai][bj][m][0], v1 = acc[ai][bj][m][1];
                    u32x4 w; w.x = cvt_pk_bf16(sigmoidf_(v0[0]), sigmoidf_(v0[1])); w.y = cvt_pk_bf16(sigmoidf_(v0[2]), sigmoidf_(v0[3]));
                    w.z = cvt_pk_bf16(sigmoidf_(v1[0]), sigmoidf_(v1[1])); w.w = cvt_pk_bf16(sigmoidf_(v1[2]), sigmoidf_(v1[3]));
                    st16_wt((G + gate_frag_off(u.pm, u.pn, ai, m, bj, tid)), w); }
    }
};
struct EpiGateAcc {
    const bf16_t* GATE; bf16_t* O;
    __device__ __forceinline__ void operator()(const f32x4 (&acc)[2][2][4][2], const Unit& u, int wr, int wc, int fr, int fq) const {
        const int row0 = u.pm * BM + wr * 64 + fr; const int colo = (u.pn & 3) * BM + wc * 32 + 8 * fq; const bool first = (u.pn < 4); const int tid = (wr * 4 + wc) * 64 + fq * 16 + fr;
#pragma unroll
        for (int ai = 0; ai < 2; ++ai)
#pragma unroll
            for (int m = 0; m < 4; ++m) { const size_t r = (size_t)(row0 + ai * HALF + m * 16); bf16_t* op = O + r * 1024 + colo;
#pragma unroll
                for (int bj = 0; bj < 2; ++bj) { const f32x4 v0 = acc[ai][bj][m][0], v1 = acc[ai][bj][m][1];
                    const u32x4 g = *(const u32x4*)(GATE + gate_frag_off(u.pm, u.pn, ai, m, bj, tid));
                    u32x4 p = (u32x4){0u, 0u, 0u, 0u}; if (!first) p = *(const u32x4*)(op + bj * HALF);
                    u32x4 w;
                    w.x = cvt_pk_bf16(bflo(p.x) + v0[0] * bflo(g.x), bfhi(p.x) + v0[1] * bfhi(g.x));
                    w.y = cvt_pk_bf16(bflo(p.y) + v0[2] * bflo(g.y), bfhi(p.y) + v0[3] * bfhi(g.y));
                    w.z = cvt_pk_bf16(bflo(p.z) + v1[0] * bflo(g.z), bfhi(p.z) + v1[1] * bfhi(g.z));
                    w.w = cvt_pk_bf16(bflo(p.w) + v1[2] * bflo(g.w), bfhi(p.w) + v1[3] * bfhi(g.w));
                    st16_wt((op + bj * HALF), w); } }
    }
};
struct EpiHorner {
    const bf16_t* GATE; bf16_t* O;
    static __device__ __forceinline__ float ratio_(float ga, float gb) { return ga * __builtin_amdgcn_rcpf(fmaxf(gb, 1e-30f)); }
    __device__ __forceinline__ void mid(f32x4 (&acc)[2][2][4][2], const Unit& u, int wr, int wc, int fr, int fq, int nb) const {
        const int tid = (wr * 4 + wc) * 64 + fq * 16 + fr;
        typedef __attribute__((address_space(1))) const u32x4 gu32x4;
        const gu32x4* ga = (const gu32x4*)(GATE + gate_frag_off(u.pm, nb * 4 + u.pn, 0, 0, 0, tid));
        const gu32x4* gb = (const gu32x4*)(GATE + gate_frag_off(u.pm, (nb + 1) * 4 + u.pn, 0, 0, 0, tid));
#pragma unroll
        for (int ai = 0; ai < 2; ++ai) {
            u32x4 a[8], b[8];
#pragma unroll
            for (int p = 0; p < 8; ++p) { a[p] = ga[(ai * 8 + p) * 512]; b[p] = gb[(ai * 8 + p) * 512]; }
            asm volatile("" ::: "memory");
#pragma unroll
            for (int m = 0; m < 4; ++m)
#pragma unroll
                for (int bj = 0; bj < 2; ++bj) { const u32x4 av = a[m * 2 + bj], bv = b[m * 2 + bj];
                    f32x4& v0 = acc[ai][bj][m][0]; f32x4& v1 = acc[ai][bj][m][1];
                    v0[0] *= ratio_(bflo(av.x), bflo(bv.x)); v0[1] *= ratio_(bfhi(av.x), bfhi(bv.x)); v0[2] *= ratio_(bflo(av.y), bflo(bv.y)); v0[3] *= ratio_(bfhi(av.y), bfhi(bv.y));
                    v1[0] *= ratio_(bflo(av.z), bflo(bv.z)); v1[1] *= ratio_(bfhi(av.z), bfhi(bv.z)); v1[2] *= ratio_(bflo(av.w), bflo(bv.w)); v1[3] *= ratio_(bfhi(av.w), bfhi(bv.w)); }
        }
    }
    __device__ __forceinline__ void operator()(const f32x4 (&acc)[2][2][4][2], const Unit& u, int wr, int wc, int fr, int fq) const {
        const int row0 = u.pm * BM + wr * 64 + fr; const int col0 = u.pn * BM + wc * 32 + 8 * fq; const int tid = (wr * 4 + wc) * 64 + fq * 16 + fr;
        typedef __attribute__((address_space(1))) const u32x4 gu32x4;
        const gu32x4* gg = (const gu32x4*)(GATE + gate_frag_off(u.pm, 12 + u.pn, 0, 0, 0, tid));
#pragma unroll
        for (int ai = 0; ai < 2; ++ai) {
            u32x4 g[8];
#pragma unroll
            for (int p = 0; p < 8; ++p) g[p] = gg[(ai * 8 + p) * 512];
            asm volatile("" ::: "memory");
#pragma unroll
            for (int m = 0; m < 4; ++m) { bf16_t* op = O + (size_t)(row0 + ai * HALF + m * 16) * 1024 + col0;
#pragma unroll
                for (int bj = 0; bj < 2; ++bj) { const f32x4 v0 = acc[ai][bj][m][0], v1 = acc[ai][bj][m][1]; const u32x4 gv = g[m * 2 + bj];
                    u32x4 w;
                    w.x = cvt_pk_bf16(v0[0] * bflo(gv.x), v0[1] * bfhi(gv.x)); w.y = cvt_pk_bf16(v0[2] * bflo(gv.y), v0[3] * bfhi(gv.y));
                    w.z = cvt_pk_bf16(v1[0] * bflo(gv.z), v1[1] * bfhi(gv.z)); w.w = cvt_pk_bf16(v1[2] * bflo(gv.w), v1[3] * bfhi(gv.w));
                    st16_wt((op + bj * HALF), w); } }
        }
    }
};
struct EpiSlab {
    bf16_t* S; int pm0, rows;
    __device__ __forceinline__ void operator()(const f32x4 (&acc)[2][2][4][2], const Unit& u, int wr, int wc, int fr, int fq) const {
        const int row0 = (u.pm - pm0) * BM + wr * 64 + fr; const int col0 = u.pn * BM + wc * 32 + 8 * fq; bf16_t* base = S + (size_t)u.kc * rows * 1024;
#pragma unroll
        for (int ai = 0; ai < 2; ++ai)
#pragma unroll
            for (int m = 0; m < 4; ++m) { bf16_t* rowp = base + (size_t)(row0 + ai * HALF + m * 16) * 1024 + col0;
#pragma unroll
                for (int bj = 0; bj < 2; ++bj) { const f32x4 v0 = acc[ai][bj][m][0], v1 = acc[ai][bj][m][1];
                    u32x4 w; w.x = cvt_pk_bf16(v0[0], v0[1]); w.y = cvt_pk_bf16(v0[2], v0[3]); w.z = cvt_pk_bf16(v1[0], v1[1]); w.w = cvt_pk_bf16(v1[2], v1[3]);
                    st16_wt((rowp + bj * HALF), w); } }
    }
};
struct EpiSwiGLU {
    bf16_t* O; int ldc;
    __device__ __forceinline__ void operator()(const f32x4 (&acc)[2][2][4][2], const Unit& u, int wr, int wc, int fr, int fq) const {
        const int row0 = u.pm * BM + wr * 64 + fr; const int col0 = u.pn * HALF + wc * 32 + 8 * fq;
#pragma unroll
        for (int ai = 0; ai < 2; ++ai)
#pragma unroll
            for (int m = 0; m < 4; ++m) { bf16_t* rowp = O + (size_t)(row0 + ai * HALF + m * 16) * ldc + col0;
                const f32x4 g0 = acc[ai][0][m][0], g1 = acc[ai][0][m][1], u0 = acc[ai][1][m][0], u1 = acc[ai][1][m][1];
                u32x4 w;
                w.x = cvt_pk_bf16(siluf_(g0[0]) * u0[0], siluf_(g0[1]) * u0[1]); w.y = cvt_pk_bf16(siluf_(g0[2]) * u0[2], siluf_(g0[3]) * u0[3]);
                w.z = cvt_pk_bf16(siluf_(g1[0]) * u1[0], siluf_(g1[1]) * u1[1]); w.w = cvt_pk_bf16(siluf_(g1[2]) * u1[2], siluf_(g1[3]) * u1[3]);
                st16_wt(rowp, w); }
    }
};

template <class Epi, int K, int LDA, int LDB, int ADIV, int ACOLS, class Sched = StaticOrder, int MIDK = 0, bool ALIGN_EPI = true>
__device__ __forceinline__ void gemm_phase(LAS unsigned char* lds, const Gemm g, const Sched& S, const Epi& E, int tid_) {
    const int tid = tid_, wid = __builtin_amdgcn_readfirstlane(tid >> 6), lane = tid & 63, wr = wid >> 2, wc = wid & 3, fr = lane & 15, fq = lane >> 4;
    constexpr int nt = K / BK;
    unsigned voffA, voffB;
    { int R, C; stage_rc(tid * 16, R, C); const int Rb = (R & ~31) + perm32(R & 31); voffA = (unsigned)(R * LDA + C) * 2u; voffB = (unsigned)(Rb * LDB + C) * 2u; }
    constexpr size_t p1offA = (size_t)64 * LDA * 2, p1offB = (size_t)64 * LDB * 2;
    constexpr size_t kstep = (size_t)(BK * 2);
    constexpr size_t hstepA = (size_t)HALF * LDA * 2, hstepB = (size_t)HALF * LDB * 2;
    constexpr size_t tstepA = 2 * hstepA, tstepB = 2 * hstepB;
    const unsigned ldsw = (unsigned)wid * 1024u;
    const int aoff = lds_byte(wr * 64 + fr, fq * 8), boff = lds_byte(wc * 32 + fr, fq * 8);
#define PG8_SA(b, h) (((b) * 2 + (h)) * HTB)
#define PG8_SB(b, h) ((4 + (b) * 2 + (h)) * HTB)
#define PG8_STAGE(bufoff, gbase, voff) do { _Pragma("unroll") for (int _i = 0; _i < 2; ++_i) \
        __builtin_amdgcn_global_load_lds((const unsigned*)((const char*)(gbase) + _i * p1##voff + (v##voff)), (LAS unsigned*)(lds + (bufoff) + ldsw + _i * 8192), 16, 0, 0); } while (0)
#define PG8_LDA(dst, b, h) do { _Pragma("unroll") for (int m = 0; m < 4; ++m) _Pragma("unroll") for (int k = 0; k < 2; ++k) dst[m][k] = *(const LAS bf16x8*)(lds + PG8_SA(b, h) + aoff + m * 2048 + k * 1024); } while (0)
#define PG8_LDB(dst, b, h) do { _Pragma("unroll") for (int n = 0; n < 2; ++n) _Pragma("unroll") for (int k = 0; k < 2; ++k) dst[n][k] = *(const LAS bf16x8*)(lds + PG8_SB(b, h) + boff + n * 2048 + k * 1024); } while (0)
#define PG8_MMA(ai, bj, At, Bt) do { __builtin_amdgcn_s_setprio(1); _Pragma("unroll") for (int m = 0; m < 4; ++m) _Pragma("unroll") for (int n = 0; n < 2; ++n) _Pragma("unroll") for (int k = 0; k < 2; ++k) \
        acc[ai][bj][m][n] = __builtin_amdgcn_mfma_f32_16x16x32_bf16(Bt[n][k], At[m][k], acc[ai][bj][m][n], 0, 0, 0); __builtin_amdgcn_s_setprio(0); } while (0)
#define PG8_WAIT_V(n) asm volatile("s_waitcnt vmcnt(" #n ")" ::: "memory")
#define PG8_WAIT_L(n) asm volatile("s_waitcnt lgkmcnt(" #n ")" ::: "memory")
#define PG8_BAR __builtin_amdgcn_s_barrier()
#define PG8_SCHED __builtin_amdgcn_sched_barrier(0)
#define PG8_ACOL(pn) (ADIV ? (size_t)(((pn) / (ADIV ? ADIV : 1)) * ACOLS) * 2 : (size_t)0)
    Unit cur, nxt; int ui = 0;
    if (!S.next(0, cur)) return;
    S.a_ready(cur, wid, lane);
    f32x4 acc[2][2][4][2];
#pragma unroll
    for (int a = 0; a < 2; ++a)
#pragma unroll
        for (int b = 0; b < 2; ++b)
#pragma unroll
            for (int m = 0; m < 4; ++m)
#pragma unroll
                for (int n = 0; n < 2; ++n) acc[a][b][m][n] = (f32x4){0.f, 0.f, 0.f, 0.f};
    bf16x8 At[4][2], B0[2][2], B1[2][2];
    const char* cA = (const char*)g.A + (size_t)cur.pm * tstepA + PG8_ACOL(cur.pn) + (size_t)cur.kc * (K * 2); const char* cB = (const char*)g.Bt + (size_t)cur.pn * tstepB + (size_t)cur.kc * (K * 2);
    PG8_STAGE(PG8_SB(0, 0), cB, offB); PG8_STAGE(PG8_SB(0, 1), cB + hstepB, offB); PG8_STAGE(PG8_SA(0, 0), cA, offA); PG8_STAGE(PG8_SA(0, 1), cA + hstepA, offA);
    if (wr == 1) PG8_BAR;
    PG8_WAIT_V(2); PG8_BAR;
    PG8_STAGE(PG8_SB(1, 0), cB + kstep, offB); PG8_STAGE(PG8_SA(1, 0), cA + kstep, offA); PG8_STAGE(PG8_SB(1, 1), cB + hstepB + kstep, offB);
    PG8_WAIT_V(6); PG8_BAR;
    for (;;) {
        const bool has_next = S.next(ui + 1, nxt);
        const char* nA = has_next ? (const char*)g.A + (size_t)nxt.pm * tstepA + PG8_ACOL(nxt.pn) + (size_t)nxt.kc * (K * 2) : cA; const char* nB = has_next ? (const char*)g.Bt + (size_t)nxt.pn * tstepB + (size_t)nxt.kc * (K * 2) : cB;
#pragma unroll 1
        for (int t = 0; t < nt; t += 2) {
            const bool last = (t == nt - 2);
            if (last && has_next) S.a_ready(nxt, wid, lane);
            const char* a1 = cA + (size_t)(t + 1) * kstep;
            const char* a2 = last ? nA : cA + (size_t)(t + 2) * kstep; const char* b2 = last ? nB : cB + (size_t)(t + 2) * kstep;
            const char* a3 = a2 + kstep; const char* b3 = b2 + kstep;
            PG8_LDB(B0, 0, 0); PG8_LDB(B1, 0, 1); PG8_SCHED; PG8_LDA(At, 0, 0); PG8_STAGE(PG8_SA(1, 1), a1 + hstepA, offA);
            PG8_WAIT_V(8); PG8_WAIT_L(0); PG8_BAR; PG8_MMA(0, 0, At, B0); PG8_MMA(0, 1, At, B1); PG8_BAR; PG8_SCHED;
            PG8_LDA(At, 0, 1); PG8_STAGE(PG8_SB(0, 0), b2, offB); PG8_STAGE(PG8_SB(0, 1), b2 + hstepB, offB); PG8_STAGE(PG8_SA(0, 0), a2, offA);
            PG8_WAIT_V(8); PG8_WAIT_L(0); PG8_BAR; PG8_MMA(1, 0, At, B0); PG8_MMA(1, 1, At, B1); PG8_BAR; PG8_SCHED;
            PG8_LDB(B0, 1, 0); PG8_LDB(B1, 1, 1); PG8_SCHED; PG8_LDA(At, 1, 0); PG8_STAGE(PG8_SA(0, 1), a2 + hstepA, offA);
            PG8_WAIT_V(8); PG8_WAIT_L(0); PG8_BAR; PG8_MMA(0, 0, At, B0); PG8_MMA(0, 1, At, B1); PG8_BAR; PG8_SCHED;
            PG8_LDA(At, 1, 1); PG8_STAGE(PG8_SB(1, 0), b3, offB); PG8_STAGE(PG8_SB(1, 1), b3 + hstepB, offB); PG8_STAGE(PG8_SA(1, 0), a3, offA);
            PG8_WAIT_V(8); PG8_WAIT_L(0); PG8_BAR; PG8_MMA(1, 0, At, B0); PG8_MMA(1, 1, At, B1); PG8_BAR; PG8_SCHED;
            if constexpr (MIDK > 0) {
                constexpr int seg = MIDK / BK; if (((t + 2) % seg) == 0 && t + 2 < nt) E.mid(acc, cur, wr, wc, fr, fq, (t + 2) / seg - 1); }
        }
        if constexpr (ALIGN_EPI) { if (wr == 0) PG8_BAR; }
        E(acc, cur, wr, wc, fr, fq); S.done(cur, lane);
        if (!has_next) break;
#pragma unroll
        for (int a = 0; a < 2; ++a)
#pragma unroll
            for (int b = 0; b < 2; ++b)
#pragma unroll
                for (int m = 0; m < 4; ++m)
#pragma unroll
                    for (int n = 0; n < 2; ++n) acc[a][b][m][n] = (f32x4){0.f, 0.f, 0.f, 0.f};
        cur = nxt; cA = nA; cB = nB; ++ui;
        if constexpr (ALIGN_EPI) { if (wr == 1) PG8_BAR; }
    }
    PG8_WAIT_V(0);
    if constexpr (!ALIGN_EPI) { if (wr == 0) PG8_BAR; }
    PG8_BAR;
#undef PG8_SA
#undef PG8_SB
#undef PG8_STAGE
#undef PG8_LDA
#undef PG8_LDB
#undef PG8_MMA
#undef PG8_WAIT_V
#undef PG8_WAIT_L
#undef PG8_BAR
#undef PG8_SCHED
#undef PG8_ACOL
}
}

#define GAS __attribute__((address_space(1)))
struct Args { GAS const float* in[26]; GAS float* out; GAS unsigned char* ws; };

struct Frame {
    LAS unsigned char* lds;
    int tid, lane, wave, G, bid, wave_s;
    const Args* a; GAS unsigned char* ws; GAS unsigned char* ws0;
};
constexpr int TIDTAB_OFF = 8 * 19456 + 64;
__device__ __forceinline__ int tid_from_lds(LAS unsigned char* lds, int wave_s) {
    int ln; asm volatile("v_mbcnt_lo_u32_b32 %0, -1, 0\n\tv_mbcnt_hi_u32_b32 %0, -1, %0" : "=v"(ln));
    const int t = *(const volatile LAS int*)(lds + TIDTAB_OFF + (wave_s * 64 + ln) * 4);
    __builtin_assume(t >= 0 && t < 512);
    return t;
}
#define FIN(i) ((const float*)(F.a->in[i]))
__device__ __forceinline__ void refresh(Frame& F) { const int t = tid_from_lds(F.lds, F.wave_s); F.tid = t; F.lane = t & 63; F.wave = __builtin_amdgcn_readfirstlane(t >> 6);
    GAS unsigned char* w = F.ws0; asm volatile("" : "+s"(w)); F.ws = w; }

__device__ __forceinline__ void transpose_item(const float* W, int ldw, int k0, int nsrc0, bf16_t* WT, int ldt, int drow0, int dcol0, int nrep, int drep, LAS float* scr, int lane) {
    float tv[32];
#pragma unroll
    for (int i = 0; i < 32; ++i) { const int kk = 2 * i + (lane >> 5); tv[i] = __builtin_nontemporal_load(W + (size_t)(k0 + kk) * ldw + nsrc0 + (lane & 31)); }
#pragma unroll
    for (int i = 0; i < 32; ++i) { const int kk = 2 * i + (lane >> 5); scr[kk * 33 + (lane & 31)] = tv[i]; }
    LDS_WAIT(); asm volatile("" ::: "memory");
    const int c = lane & 7;
#pragma unroll
    for (int j = 0; j < 4; ++j) { const int n = (lane >> 3) + 8 * j; const LAS float* s = scr + (8 * c) * 33 + n;
        u32x4 o; o.x = pk2(s[0 * 33], s[1 * 33]); o.y = pk2(s[2 * 33], s[3 * 33]); o.z = pk2(s[4 * 33], s[5 * 33]); o.w = pk2(s[6 * 33], s[7 * 33]);
        for (int r = 0; r < nrep; ++r) *(u32x4*)(WT + (size_t)(drow0 + n) * ldt + dcol0 + r * drep + k0 + 8 * c) = o; }
    LDS_WAIT(); asm volatile("" ::: "memory");
}
template <int PART>
__device__ __forceinline__ void convert_weights(Frame& F, int l, int b0 = 0, int nb = 0) {
    refresh(F);
    LAS float* scr = (LAS float*)(F.lds + F.wave * 16384);
    if (nb == 0) nb = F.G;
    if (F.bid < b0 || F.bid >= b0 + nb) return;
    const int gw = (F.bid - b0) * NWAVES + F.wave, NGW = nb * NWAVES;
    const float* w_in = FIN(6) + (size_t)l * DM * INC;
    const float* w_br = FIN(18) + (size_t)l * 4 * 256 * DM;
    const float* w_out = FIN(19) + (size_t)l * DM * DM;
    const float* w_up = FIN(22) + (size_t)l * DM * 2 * FFH;
    const float* w_dn = FIN(23) + (size_t)l * FFH * DM;
    bf16_t* WIN = (bf16_t*)(F.ws + WS_WIN); bf16_t* WBR = (bf16_t*)(F.ws + WS_WBR); bf16_t* WOUT = (bf16_t*)(F.ws + WS_WOUT);
    bf16_t* WUP = (bf16_t*)(F.ws + WS_WUP); bf16_t* WDN = (bf16_t*)(F.ws + WS_WDN);
    constexpr int I_IN = 16 * 240, I_BR = 4 * 4 * 32, I_OUT = 16 * 32, I_UP = 16 * 176, I_DN = 44 * 32;
    if (PART == 0) {
        for (int it = gw; it < I_IN + I_BR + I_OUT; it += NGW) {
            int r = it;
            if (r < I_IN) { const int kb = r / 240, nb = r % 240, d0 = nb * 32; const int s0 = d0 < 2304 ? d0 : d0 + 8;
                transpose_item(w_in, INC, kb * 64, s0, WIN, DM, d0, 0, 1, 0, scr, F.lane); continue; } r -= I_IN;
            if (r < I_BR) { const int n = r / 128, rr = r % 128, kb = rr / 32, nb = rr % 32;
                transpose_item(w_br + (size_t)n * 256 * DM, DM, kb * 64, nb * 32, WBR, DM, nb * 32, n * 256, 1, 0, scr, F.lane); continue; } r -= I_BR;
            { const int kb = r / 32, nb = r % 32; transpose_item(w_out, DM, kb * 64, nb * 32, WOUT, DM, nb * 32, 0, 1, 0, scr, F.lane); }
        }
    } else {
        for (int it = gw; it < I_UP + I_DN; it += NGW) {
            int r = it;
            if (r < I_UP) { const int kb = r / 176, nb = r % 176, d0 = nb * 32, tile = d0 >> 8, within = d0 & 255;
                const int s0 = within < 128 ? tile * 128 + within : FFH + tile * 128 + (within - 128);
                transpose_item(w_up, 2 * FFH, kb * 64, s0, WUP, DM, d0, 0, 1, 0, scr, F.lane); continue; } r -= I_UP;
            { const int kb = r / 32, nb = r % 32; transpose_item(w_dn, DM, kb * 64, nb * 32, WDN, FFH, nb * 32, 0, 1, 0, scr, F.lane); }
        }
    }
}

__device__ __forceinline__ void mods_phase(Frame& F) {
    refresh(F);
    LAS float* sil = (LAS float*)(F.lds);
    LAS float* part = sil + 5 * 1024;
    if (F.bid >= 192) return;
    const int l = F.bid / 96, cgp = F.bid % 96;
    for (int i = F.tid; i < 5 * 1024; i += NTHREADS) { const int r = i >> 10, k = i & 1023; const float cv = r < 4 ? FIN(1)[r * 1024 + k] : FIN(3)[k]; sil[i] = siluf_(cv); }
    __syncthreads();
    const float* aw = FIN(4) + (size_t)l * DM * 6144 + cgp * 64 + F.lane;
    float a0 = 0.f, a1 = 0.f, a2 = 0.f, a3 = 0.f, a4 = 0.f;
    const int kb = F.wave * 128;
#pragma unroll 32
    for (int k = 0; k < 128; ++k) { const float w = __builtin_nontemporal_load(aw + (size_t)(kb + k) * 6144);
        a0 += sil[kb + k] * w; a1 += sil[1024 + kb + k] * w; a2 += sil[2048 + kb + k] * w; a3 += sil[3072 + kb + k] * w; a4 += sil[4096 + kb + k] * w; }
    part[(F.wave * 5 + 0) * 64 + F.lane] = a0; part[(F.wave * 5 + 1) * 64 + F.lane] = a1; part[(F.wave * 5 + 2) * 64 + F.lane] = a2;
    part[(F.wave * 5 + 3) * 64 + F.lane] = a3; part[(F.wave * 5 + 4) * 64 + F.lane] = a4;
    __syncthreads();
    if (F.wave < 5) { float s = FIN(5)[l * 6144 + cgp * 64 + F.lane];
#pragma unroll
        for (int w = 0; w < 8; ++w) s += part[(w * 5 + F.wave) * 64 + F.lane];
        ((float*)(F.ws + WS_MODS))[(size_t)(l * 5 + F.wave) * 6144 + cgp * 64 + F.lane] = s; }
    __syncthreads();
}

struct RowOp {
    int nrows;
    const float* xlat_in; const float* xctx_in;
    bool post;
    const bf16_t* Y; const bf16_t* slabs; int nslab; int slab_row0;
    int gate_chunk; const float* lng; const float* lnb; const float* mods_post;
    float* xlat_out; float* xctx_out;
    bool domod;
    const float* mods_mod; int shift_chunk, scale_chunk; bf16_t* Hout;
    bool dodt; float* DTout;
};
__device__ __forceinline__ void row_pass(Frame& F, const RowOp& R, const float* w_in_l) {
    refresh(F);
    LAS float* wdt = (LAS float*)F.lds;
    if (R.dodt) {
        for (int i = F.tid; i < 8192; i += NTHREADS) { const int c = i >> 10, k = i & 1023; wdt[i] = w_in_l[(size_t)k * INC + 2304 + c]; }
    }
    __syncthreads();
    const int gw = F.bid * NWAVES + F.wave, NGW = F.G * NWAVES;
    const int m0 = gw, m1 = R.nrows;
    const int lane = F.lane;
    f32x4 lg[4], lb[4], gt4[4], sh4[4], sc4[4];
    if (R.post) {
#pragma unroll
        for (int j = 0; j < 4; ++j) { lg[j] = *(const f32x4*)(R.lng + 4 * (lane + 64 * j)); lb[j] = *(const f32x4*)(R.lnb + 4 * (lane + 64 * j)); }
    }
    int cur_r5 = -1;
    f32x4 xn[4]; u32x2 yn[4];
#define RP_LOAD(M) do { const int m_ = (M); const float* xr_ = m_ < MLAT ? R.xlat_in + (size_t)m_ * DM : R.xctx_in + (size_t)(m_ - MLAT) * DM; \
        _Pragma("unroll") for (int j = 0; j < 4; ++j) xn[j] = __builtin_nontemporal_load((const f32x4*)(xr_ + 4 * (lane + 64 * j))); \
        if (R.post && !(R.nslab > 0 && m_ >= R.slab_row0)) { const bf16_t* yr_ = R.Y + (size_t)m_ * DM; _Pragma("unroll") for (int j = 0; j < 4; ++j) yn[j] = __builtin_nontemporal_load((const u32x2*)(yr_ + 4 * (lane + 64 * j))); } } while (0)
    if (m0 < m1) RP_LOAD(m0);
#pragma unroll 1
    for (int m = m0; m < m1; m += NGW) {
        const int r5 = m < MLAT ? (m >> 12) : 4;
        if (r5 != cur_r5) { cur_r5 = r5;
            if (R.post) { const float* gt = R.mods_post + (size_t)r5 * 6144 + R.gate_chunk * 1024;
#pragma unroll
                for (int j = 0; j < 4; ++j) gt4[j] = *(const f32x4*)(gt + 4 * (lane + 64 * j)); }
            if (R.domod) { const float* sh = R.mods_mod + (size_t)r5 * 6144 + R.shift_chunk * 1024; const float* sc = R.mods_mod + (size_t)r5 * 6144 + R.scale_chunk * 1024;
#pragma unroll
                for (int j = 0; j < 4; ++j) { sh4[j] = *(const f32x4*)(sh + 4 * (lane + 64 * j)); sc4[j] = *(const f32x4*)(sc + 4 * (lane + 64 * j)); } }
        }
        f32x4 v[4]; u32x2 yv[4];
#pragma unroll
        for (int j = 0; j < 4; ++j) { v[j] = xn[j]; yv[j] = yn[j]; }
        const bool slabrow = R.post && R.nslab > 0 && m >= R.slab_row0;
        float ys[4][4];
        if (slabrow) {
#pragma unroll
            for (int j = 0; j < 4; ++j) { const int c = 4 * (lane + 64 * j); ys[j][0] = ys[j][1] = ys[j][2] = ys[j][3] = 0.f; const bf16_t* sp = R.slabs + (size_t)(m - R.slab_row0) * 1024 + c;
                for (int sidx = 0; sidx < R.nslab; ++sidx) { const u32x2 yw = *(const u32x2*)(sp + (size_t)sidx * (MALL - R.slab_row0) * 1024); ys[j][0] += bflo(yw.x); ys[j][1] += bfhi(yw.x); ys[j][2] += bflo(yw.y); ys[j][3] += bfhi(yw.y); } }
        }
        if (m + NGW < m1) RP_LOAD(m + NGW);
        if (R.post) {
#pragma unroll
            for (int j = 0; j < 4; ++j) { const f32x4 g4 = gt4[j];
                const float y0 = slabrow ? ys[j][0] : bflo(yv[j].x), y1 = slabrow ? ys[j][1] : bfhi(yv[j].x), y2 = slabrow ? ys[j][2] : bflo(yv[j].y), y3 = slabrow ? ys[j][3] : bfhi(yv[j].y);
                v[j].x = ALPHA * v[j].x + g4.x * y0; v[j].y = ALPHA * v[j].y + g4.y * y1;
                v[j].z = ALPHA * v[j].z + g4.z * y2; v[j].w = ALPHA * v[j].w + g4.w * y3; }
            float s = 0.f;
#pragma unroll
            for (int j = 0; j < 4; ++j) s += (v[j].x + v[j].y) + (v[j].z + v[j].w);
            const float mean = wave_sum(s) * (1.f / DM); float s2 = 0.f;
#pragma unroll
            for (int j = 0; j < 4; ++j) { v[j] = v[j] - mean; s2 += (v[j].x * v[j].x + v[j].y * v[j].y) + (v[j].z * v[j].z + v[j].w * v[j].w); }
            const float rstd = 1.f / sqrtf(wave_sum(s2) * (1.f / DM) + LN_EPS);
            float* xo = m < MLAT ? R.xlat_out + (size_t)m * DM : R.xctx_out + (size_t)(m - MLAT) * DM;
#pragma unroll
            for (int j = 0; j < 4; ++j) { const int c = 4 * (lane + 64 * j); v[j] = v[j] * rstd * lg[j] + lb[j]; __builtin_nontemporal_store(v[j], (f32x4*)(xo + c)); }
        }
        if (R.domod) {
            float s = 0.f;
#pragma unroll
            for (int j = 0; j < 4; ++j) s += (v[j].x + v[j].y) + (v[j].z + v[j].w);
            const float mean = wave_sum(s) * (1.f / DM); float s2 = 0.f;
#pragma unroll
            for (int j = 0; j < 4; ++j) { v[j] = v[j] - mean; s2 += (v[j].x * v[j].x + v[j].y * v[j].y) + (v[j].z * v[j].z + v[j].w * v[j].w); }
            const float rstd = 1.f / sqrtf(wave_sum(s2) * (1.f / DM) + LN_EPS);
            bf16_t* hr = R.Hout + (size_t)m * DM;
#pragma unroll
            for (int j = 0; j < 4; ++j) { const int c = 4 * (lane + 64 * j);
                v[j] = v[j] * rstd * (sc4[j] + 1.f) + sh4[j];
                u32x2 w; w.x = pk2(v[j].x, v[j].y); w.y = pk2(v[j].z, v[j].w); *(u32x2*)(hr + c) = w; }
            if (R.dodt) {
                float d[8];
#pragma unroll
                for (int c = 0; c < 8; ++c) { float a = 0.f;
                    asm volatile("" ::: "memory");
#pragma unroll
                    for (int j = 0; j < 4; ++j) { const f32x4 w4 = *(const LAS f32x4*)(wdt + c * 1024 + 4 * (lane + 64 * j)); a += (v[j].x * w4.x + v[j].y * w4.y) + (v[j].z * w4.z + v[j].w * w4.w); }
                    d[c] = wave_sum(a); }
                if (lane == 0) { *(f32x4*)(R.DTout + (size_t)m * 8) = (f32x4){d[0], d[1], d[2], d[3]}; *(f32x4*)(R.DTout + (size_t)m * 8 + 4) = (f32x4){d[4], d[5], d[6], d[7]}; }
            }
        }
    }
#undef RP_LOAD
    __syncthreads();
}

__device__ __forceinline__ void prep_phase(Frame& F, int l) {
    refresh(F);
    bf16_t* MIX = (bf16_t*)(F.ws + WS_RC);
    const float* qn = FIN(16) + l * 64; const float* kn = FIN(17) + l * 64;
    const int gt = F.bid * NTHREADS + F.tid, NGT = F.G * NTHREADS;
    for (int it = gt; it < MALL * 6; it += NGT) {
        const int m = it / 6, slot = it % 6;
        bf16_t* p = MIX + (size_t)m * NMIX + (slot < 4 ? C_DQ + 64 * slot : C_DK + 64 * (slot - 4));
        const float* nw = slot < 4 ? qn : kn;
        float x[64];
#pragma unroll
        for (int w = 0; w < 8; ++w) { const u32x4 u = *(const u32x4*)(p + 8 * w);
            x[8 * w + 0] = bflo(u.x); x[8 * w + 1] = bfhi(u.x); x[8 * w + 2] = bflo(u.y); x[8 * w + 3] = bfhi(u.y);
            x[8 * w + 4] = bflo(u.z); x[8 * w + 5] = bfhi(u.z); x[8 * w + 6] = bflo(u.w); x[8 * w + 7] = bfhi(u.w); }
        float ss = 0.f;
#pragma unroll
        for (int d = 0; d < 64; ++d) ss += x[d] * x[d];
        const float rs = 1.f / sqrtf(ss * (1.f / 64.f) + LN_EPS);
#pragma unroll
        for (int d = 0; d < 64; ++d) x[d] = x[d] * rs * nw[d];
        if (m < MLAT && slot < 4) {
#pragma unroll
            for (int d = 0; d < 64; ++d) x[d] *= 0.125f * 1.4426950408889634f; }
        if (m < MLAT) {
            const int t = m & 4095; const float prow = (float)(t >> 6), pcol = (float)(t & 63);
#pragma unroll
            for (int i = 0; i < 16; ++i) {
                const float inv = expf(-(float)i * (9.210340371976184f / 16.f));
                const float ar = prow * inv, ac = pcol * inv;
                const float sr = __sinf(ar), cr = __cosf(ar), sc = __sinf(ac), cc = __cosf(ac);
                const float a1 = x[i], a2 = x[16 + i]; x[i] = a1 * cr - a2 * sr; x[16 + i] = a2 * cr + a1 * sr;
                const float b1 = x[32 + i], b2 = x[48 + i]; x[32 + i] = b1 * cc - b2 * sc; x[48 + i] = b2 * cc + b1 * sc;
            }
        }
#pragma unroll
        for (int w = 0; w < 8; ++w) { u32x4 u; u.x = pk2(x[8 * w], x[8 * w + 1]); u.y = pk2(x[8 * w + 2], x[8 * w + 3]); u.z = pk2(x[8 * w + 4], x[8 * w + 5]); u.w = pk2(x[8 * w + 6], x[8 * w + 7]);
            *(u32x4*)(p + 8 * w) = u; }
    }
}

__device__ __forceinline__ void conv_to_lds(Frame& F, int l) {
    refresh(F);
    const bf16_t* MIX = (const bf16_t*)(F.ws + WS_RC);
    const float* cw = FIN(9) + (size_t)l * 5 * 768; const float* cb = FIN(10) + l * 768;
    LAS unsigned* cv = (LAS unsigned*)F.lds;
    if (F.tid < 384) {
        const int c = 2 * F.tid, r0 = 68 * F.bid;
        float w0[5], w1[5];
#pragma unroll
        for (int j = 0; j < 5; ++j) { w0[j] = cw[j * 768 + c]; w1[j] = cw[j * 768 + c + 1]; }
        const float b0 = cb[c], b1 = cb[c + 1];
        unsigned win[72];
#pragma unroll
        for (int j = 0; j < 72; ++j) { const int mm = r0 - 2 + j; win[j] = (mm >= 0 && mm < MALL) ? *(const unsigned*)(MIX + (size_t)mm * NMIX + C_BX + c) : 0u; }
#pragma unroll
        for (int r = 0; r < 68; ++r) {
            const int m = r0 + r;
            const int lo = m < MLAT ? (m & ~4095) : MLAT + ((m - MLAT) & ~255), hi = lo + (m < MLAT ? SEQ : CTXL);
            float a0 = b0, a1 = b1;
#pragma unroll
            for (int j = 0; j < 5; ++j) { const int mm = m + j - 2; const bool ok = (mm >= lo) && (mm < hi); a0 += ok ? w0[j] * bflo(win[r + j]) : 0.f; a1 += ok ? w1[j] * bfhi(win[r + j]) : 0.f; }
            cv[r * 384 + F.tid] = pk2(siluf_(a0), siluf_(a1));
        }
    }
}
__device__ __forceinline__ void conv_from_lds(Frame& F) {
    refresh(F);
    bf16_t* MIX = (bf16_t*)(F.ws + WS_RC);
    const LAS unsigned* cv = (const LAS unsigned*)F.lds;
    if (F.tid < 384) { const int r0 = 68 * F.bid;
        for (int r = 0; r < 68; ++r) *(unsigned*)(MIX + (size_t)(r0 + r) * NMIX + C_BX + 2 * F.tid) = cv[r * 384 + F.tid]; }
}

typedef short s16x4 __attribute__((ext_vector_type(4)));
typedef float f32x16 __attribute__((ext_vector_type(16)));
typedef float f32x2_t __attribute__((ext_vector_type(2))); typedef __bf16 bf16x2_t __attribute__((ext_vector_type(2)));
#define MFMA32(a, b, c) __builtin_amdgcn_mfma_f32_32x32x16_bf16((a), (b), (c), 0, 0, 0)
__device__ __forceinline__ unsigned cvtpk(float lo, float hi) { f32x2_t v = {lo, hi}; bf16x2_t b = __builtin_convertvector(v, bf16x2_t); return __builtin_bit_cast(unsigned, b); }
__device__ __forceinline__ int crow(int reg, int h) { return (reg & 3) + 8 * (reg >> 2) + 4 * h; }
template <int S_> __device__ __forceinline__ bf16x8 pack8(const f32x16& x) {
    u32x4 p; p.x = cvtpk(x[8 * S_], x[8 * S_ + 1]); p.y = cvtpk(x[8 * S_ + 2], x[8 * S_ + 3]); p.z = cvtpk(x[8 * S_ + 4], x[8 * S_ + 5]); p.w = cvtpk(x[8 * S_ + 6], x[8 * S_ + 7]);
    return __builtin_bit_cast(bf16x8, p);
}
__device__ __forceinline__ bf16x8 ld_row8(const LAS unsigned char* tb, int P, int r, int c0) { return *(const LAS bf16x8*)(tb + r * P + c0 * 2); }
__device__ __forceinline__ bf16x8 ld_row8_perm(const LAS unsigned char* tb, int P, int r, int c0, int h) {
    const s16x4 lo = *(const LAS s16x4*)(tb + r * P + (c0 + 4 * h) * 2), hi = *(const LAS s16x4*)(tb + r * P + (c0 + 8 + 4 * h) * 2);
    return __builtin_shufflevector(lo, hi, 0, 1, 2, 3, 4, 5, 6, 7);
}
__device__ __forceinline__ s16x4 tr4(const LAS unsigned char* tb, int P, int row0, int col0, int lane) {
    const int q = (lane & 15) >> 2, p = lane & 3, blk = (lane >> 4) & 1;
    return __builtin_bit_cast(s16x4, __builtin_amdgcn_ds_read_tr16_b64_v4i16((LAS s16x4*)(tb + (row0 + q) * P + (col0 + 16 * blk + 4 * p) * 2)));
}
__device__ __forceinline__ bf16x8 ld_tr8(const LAS unsigned char* tb, int P, int row_lo, int row_hi, int col0, int lane) {
    const s16x4 lo = tr4(tb, P, row_lo, col0, lane), hi = tr4(tb, P, row_hi, col0, lane);
    return __builtin_shufflevector(lo, hi, 0, 1, 2, 3, 4, 5, 6, 7);
}
__device__ __forceinline__ float bperm_(float v, int src_lane) { return __int_as_float(__builtin_amdgcn_ds_bpermute(src_lane * 4, __float_as_int(v))); }
__device__ __forceinline__ float softplusf_(float x) { return fmaxf(x, 0.f) + __logf(1.f + __expf(-fabsf(x))); }
constexpr int NCH = 17;
constexpr int TP64 = 144, TP32 = 80;

template <int NC> __device__ __forceinline__ void stage_tile(LAS unsigned char* tb, const bf16_t* MIX, int R0, int dir, int I, int col, int lane) {
    constexpr int CPR = NC / 8, NP = 32 * CPR / 64, P = NC == 64 ? TP64 : TP32;
#pragma unroll
    for (int t = 0; t < NP; ++t) { const int id = lane + 64 * t, r = id / CPR, ck = id % CPR; const int i = 32 * I + r; const int m = dir ? R0 + 255 - i : R0 + i;
        *(LAS u32x4*)(tb + r * P + ck * 16) = *(const u32x4*)(MIX + (size_t)m * NMIX + col + ck * 8); }
}

template <int NC> __device__ __forceinline__ void tile_load(u32x4 (&rg)[NC / 16], const bf16_t* MIX, int R0, int dir, int I, int col, int lane) {
    constexpr int CPR = NC / 8, NP = NC / 16;
#pragma unroll
    for (int t = 0; t < NP; ++t) { const int id = lane + 64 * t, r = id / CPR, ck = id % CPR; const int i = 32 * I + r; const int m = dir ? R0 + 255 - i : R0 + i;
        const unsigned off = (unsigned)m * (unsigned)(NMIX * 2) + (unsigned)((col + ck * 8) * 2);
        rg[t] = *(const u32x4*)((const char*)MIX + off); }
}
template <int NC> __device__ __forceinline__ void tile_store(LAS unsigned char* tb, const u32x4 (&rg)[NC / 16], int lane) {
    constexpr int CPR = NC / 8, NP = NC / 16, P = NC == 64 ? TP64 : TP32;
#pragma unroll
    for (int t = 0; t < NP; ++t) { const int id = lane + 64 * t, r = id / CPR, ck = id % CPR; *(LAS u32x4*)(tb + r * P + ck * 16) = rg[t]; }
}

template <bool PASS_C>
__device__ __forceinline__ void hgrn_task(Frame& F, int l, int seq, int pc, bf16_t* OUT, int ldo) {
    const bf16_t* MIX = (const bf16_t*)(F.ws + WS_RC);
    const int lane_ = tid_from_lds(F.lds, F.wave_s) & 63;
    const int lane = lane_, h = lane >> 5, c31 = lane & 31;
    const int dir = seq >> 4, b = (seq >> 2) & 3, head = seq & 3;
    LAS unsigned char* wl = F.lds + F.wave * WLDS;
    LAS unsigned char* TQ = wl; LAS unsigned char* TK = wl + 4608; LAS unsigned char* TH = wl + 9216; LAS unsigned char* TV = wl + 13824; LAS float* Dv = (LAS float*)(wl + 18432);
    const int R0 = pc == 0 ? MLAT + b * CTXL : b * SEQ + (dir ? 16 - pc : pc - 1) * 256;
    const int fcol = (dir ? C_AFB : C_AFF) + head * 64;
    bf16_t* ST = (bf16_t*)(F.ws + WS_STA) + ((size_t)seq * NCH + pc) * 4096;
    f32x16 S[2][2];
#pragma unroll
    for (int kb = 0; kb < 2; ++kb)
#pragma unroll
        for (int vb = 0; vb < 2; ++vb) {
            if (PASS_C) {
#pragma unroll
                for (int q4 = 0; q4 < 2; ++q4) { const u32x4 w = *(const u32x4*)(ST + lane * 64 + (kb * 2 + vb) * 16 + q4 * 8);
                    S[kb][vb][8 * q4 + 0] = bflo(w.x); S[kb][vb][8 * q4 + 1] = bfhi(w.x); S[kb][vb][8 * q4 + 2] = bflo(w.y); S[kb][vb][8 * q4 + 3] = bfhi(w.y);
                    S[kb][vb][8 * q4 + 4] = bflo(w.z); S[kb][vb][8 * q4 + 5] = bfhi(w.z); S[kb][vb][8 * q4 + 6] = bflo(w.w); S[kb][vb][8 * q4 + 7] = bfhi(w.w); }
            } else {
#pragma unroll
                for (int reg = 0; reg < 16; ++reg) S[kb][vb][reg] = 0.f; } }
    float gtot = 0.f;
    u32x4 pg[4], pq[4], pv[4];
    tile_load<64>(pg, MIX, R0, dir, 0, fcol, lane); if (PASS_C) tile_load<64>(pq, MIX, R0, dir, 0, C_AQ + head * 64, lane); tile_load<64>(pv, MIX, R0, dir, 0, C_AV + head * 64, lane);
#pragma unroll 1
    for (int I = 0; I < 8; ++I) {
        tile_store<64>(TH, pg, lane); if (PASS_C) tile_store<64>(TQ, pq, lane); tile_store<64>(TV, pv, lane);
        LDS_WAIT();
        if (I + 1 < 8) { tile_load<64>(pg, MIX, R0, dir, I + 1, fcol, lane); if (PASS_C) tile_load<64>(pq, MIX, R0, dir, I + 1, C_AQ + head * 64, lane); tile_load<64>(pv, MIX, R0, dir, I + 1, C_AV + head * 64, lane); }
        float br[32], kkv[32];
        float run = 0.f;
#pragma unroll
        for (int r = 0; r < 32; ++r) {
            if ((r & 7) == 0) asm volatile("" ::: "memory");
            const float g2 = bf2f(*(const LAS bf16_t*)(TH + r * TP64 + lane * 2));
            run += g2; br[r] = run; const float kk = 1.f - __builtin_amdgcn_exp2f(g2); kkv[r] = kk;
            if (PASS_C) { const float e = __builtin_amdgcn_exp2f(fmaxf(run, -120.f)); const float q = bf2f(*(const LAS bf16_t*)(TQ + r * TP64 + lane * 2));
                const unsigned w = cvtpk(q * e, kk * __builtin_amdgcn_rcpf(e));
                *(LAS bf16_t*)(TQ + r * TP64 + lane * 2) = (bf16_t)w; *(LAS bf16_t*)(TK + r * TP64 + lane * 2) = (bf16_t)(w >> 16); }
        }
        const float total = run; gtot += total;
#pragma unroll
        for (int r = 0; r < 32; r += 2) { const unsigned w = cvtpk(kkv[r] * __builtin_amdgcn_exp2f(total - br[r]), kkv[r + 1] * __builtin_amdgcn_exp2f(total - br[r + 1]));
            *(LAS bf16_t*)(TH + r * TP64 + lane * 2) = (bf16_t)w; *(LAS bf16_t*)(TH + (r + 1) * TP64 + lane * 2) = (bf16_t)(w >> 16); }
        Dv[lane] = __builtin_amdgcn_exp2f(total);
        LDS_WAIT();
        if (PASS_C) {
            f32x16 P;
#pragma unroll
            for (int reg = 0; reg < 16; ++reg) P[reg] = 0.f;
#pragma unroll
            for (int s = 0; s < 4; ++s) P = MFMA32(ld_row8(TK, TP64, c31, 16 * s + 8 * h), ld_row8(TQ, TP64, c31, 16 * s + 8 * h), P);
#pragma unroll
            for (int reg = 0; reg < 16; ++reg) if (crow(reg, h) > c31) P[reg] = 0.f;
            const bf16x8 pa0 = pack8<0>(P), pa1 = pack8<1>(P);
#pragma unroll
            for (int vb = 0; vb < 2; ++vb) {
                f32x16 o;
#pragma unroll
                for (int reg = 0; reg < 16; ++reg) o[reg] = 0.f;
                o = MFMA32(pa0, ld_tr8(TV, TP64, 4 * h, 8 + 4 * h, 32 * vb, lane), o);
                o = MFMA32(pa1, ld_tr8(TV, TP64, 16 + 4 * h, 24 + 4 * h, 32 * vb, lane), o);
#pragma unroll
                for (int kb = 0; kb < 2; ++kb) {
                    o = MFMA32(ld_row8_perm(TQ, TP64, c31, 32 * kb, h), pack8<0>(S[kb][vb]), o);
                    o = MFMA32(ld_row8_perm(TQ, TP64, c31, 32 * kb + 16, h), pack8<1>(S[kb][vb]), o);
                }
#pragma unroll
                for (int reg = 0; reg < 16; reg += 2) { const unsigned w0 = cvtpk(o[reg], o[reg + 1]);
                    *(LAS bf16_t*)(TK + crow(reg, h) * TP64 + (32 * vb + c31) * 2) = (bf16_t)w0; *(LAS bf16_t*)(TK + crow(reg + 1, h) * TP64 + (32 * vb + c31) * 2) = (bf16_t)(w0 >> 16); }
            }
            LDS_WAIT();
#pragma unroll
            for (int t = 0; t < 4; ++t) { const int id = lane + 64 * t, r = id >> 3, ck = id & 7; const int i = 32 * I + r; const int m = dir ? R0 + 255 - i : R0 + i;
                __builtin_nontemporal_store(*(const LAS u32x4*)(TK + r * TP64 + ck * 16), (u32x4*)((char*)OUT + ((unsigned)m * (unsigned)ldo + (unsigned)(head * 64 + ck * 8)) * 2u)); }
        }
#pragma unroll
        for (int kb = 0; kb < 2; ++kb) {
            float dr[16];
#pragma unroll
            for (int g = 0; g < 4; ++g) { const f32x4 d4 = *(const LAS f32x4*)(Dv + 32 * kb + 8 * g + 4 * h); dr[4 * g] = d4.x; dr[4 * g + 1] = d4.y; dr[4 * g + 2] = d4.z; dr[4 * g + 3] = d4.w; }
#pragma unroll
            for (int vb = 0; vb < 2; ++vb)
#pragma unroll
                for (int reg = 0; reg < 16; ++reg) S[kb][vb][reg] *= dr[reg];
#pragma unroll
            for (int s = 0; s < 2; ++s) { const bf16x8 a = ld_tr8(TH, TP64, 16 * s + 8 * h, 16 * s + 8 * h + 4, 32 * kb, lane);
#pragma unroll
                for (int vb = 0; vb < 2; ++vb) S[kb][vb] = MFMA32(a, ld_tr8(TV, TP64, 16 * s + 8 * h, 16 * s + 8 * h + 4, 32 * vb, lane), S[kb][vb]); }
        }
        LDS_WAIT();
    }
    if (!PASS_C) {
#pragma unroll
        for (int kb = 0; kb < 2; ++kb)
#pragma unroll
            for (int vb = 0; vb < 2; ++vb)
#pragma unroll
                for (int q4 = 0; q4 < 2; ++q4) { const f32x16& T = S[kb][vb]; u32x4 w; w.x = cvtpk(T[8 * q4], T[8 * q4 + 1]); w.y = cvtpk(T[8 * q4 + 2], T[8 * q4 + 3]); w.z = cvtpk(T[8 * q4 + 4], T[8 * q4 + 5]); w.w = cvtpk(T[8 * q4 + 6], T[8 * q4 + 7]);
                    *(u32x4*)(ST + lane * 64 + (kb * 2 + vb) * 16 + q4 * 8) = w; }
        ((float*)(F.ws + WS_DLA))[((size_t)seq * NCH + pc) * 64 + lane] = gtot;
    }
}

template <bool PASS_C>
__device__ __forceinline__ void ssd_task(Frame& F, int l, int seq2, int pc, bf16_t* OUT, int ldo) {
    const bf16_t* MIX = (const bf16_t*)(F.ws + WS_RC);
    const float* DT = (const float*)(F.ws + WS_DT);
    const int lane_ = tid_from_lds(F.lds, F.wave_s) & 63;
    const int lane = lane_, h = lane >> 5, c31 = lane & 31;
    const int seq = seq2 >> 1, vb = seq2 & 1, dir = seq >> 4, b = (seq >> 2) & 3, head = seq & 3, g = head >> 1;
    LAS unsigned char* wl = F.lds + F.wave * WLDS;
    LAS unsigned char* TC = wl; LAS unsigned char* TB = wl + 4608; LAS unsigned char* TX = wl + 9216; LAS unsigned char* TXh = wl + 11776;
    LAS float* brn = (LAS float*)(wl + 18432); LAS float* dtv = brn + 32;
    const int R0 = pc == 0 ? MLAT + b * CTXL : b * SEQ + (dir ? 16 - pc : pc - 1) * 256;
    const float Aneg = -expf(FIN(12)[(l * 2 + dir) * 4 + head]); const float dtb = FIN(11)[(l * 2 + dir) * 4 + head];
    bf16_t* ST = (bf16_t*)(F.ws + WS_STB) + ((size_t)seq2 * NCH + pc) * 4096;
    f32x16 S[4];
#pragma unroll
    for (int kb = 0; kb < 4; ++kb) {
        if (PASS_C) {
#pragma unroll
            for (int q4 = 0; q4 < 2; ++q4) { const u32x4 w = *(const u32x4*)(ST + lane * 64 + kb * 16 + q4 * 8);
                S[kb][8 * q4 + 0] = bflo(w.x); S[kb][8 * q4 + 1] = bfhi(w.x); S[kb][8 * q4 + 2] = bflo(w.y); S[kb][8 * q4 + 3] = bfhi(w.y);
                S[kb][8 * q4 + 4] = bflo(w.z); S[kb][8 * q4 + 5] = bfhi(w.z); S[kb][8 * q4 + 6] = bflo(w.w); S[kb][8 * q4 + 7] = bfhi(w.w); }
        } else {
#pragma unroll
            for (int reg = 0; reg < 16; ++reg) S[kb][reg] = 0.f; } }
    float gtot = 0.f;
    u32x4 pxx[2], pcq[4], pbb[4]; float dtraw;
    const int xcol = C_BX + head * 64 + vb * 32, ccol = C_BC + g * 128, bcol = C_BB + g * 128;
    { const int i_o = c31; const int m_o = dir ? R0 + 255 - i_o : R0 + i_o; dtraw = DT[(size_t)m_o * 8 + dir * 4 + head]; }
    if (PASS_C) tile_load<64>(pcq, MIX, R0, dir, 0, ccol, lane); tile_load<64>(pbb, MIX, R0, dir, 0, bcol, lane);
#pragma unroll 1
    for (int I = 0; I < 8; ++I) {
        tile_load<32>(pxx, MIX, R0, dir, I, xcol, lane);
        const float dt = softplusf_(dtraw + dtb);
        float run = dt * Aneg;
#pragma unroll
        for (int off = 1; off < 32; off <<= 1) { const float t = bperm_(run, (lane - off) & 63); if (c31 >= off) run += t; }
        const float total = bperm_(run, (lane & 32) | 31); gtot += total;
        const float wown = dt * __expf(total - run);
        if (lane < 32) { brn[c31] = run; dtv[c31] = dt; }
        tile_store<32>(TX, pxx, lane);
#pragma unroll
        for (int t = 0; t < 2; ++t) { const int id = lane + 64 * t, r = id >> 2, ck = id & 3;
            const u32x4 x4 = pxx[t];
            const float w = bperm_(wown, r);
            u32x4 y; y.x = cvtpk(bflo(x4.x) * w, bfhi(x4.x) * w); y.y = cvtpk(bflo(x4.y) * w, bfhi(x4.y) * w); y.z = cvtpk(bflo(x4.z) * w, bfhi(x4.z) * w); y.w = cvtpk(bflo(x4.w) * w, bfhi(x4.w) * w);
            *(LAS u32x4*)(TXh + r * TP32 + ck * 16) = y; }
        const float dsub = __expf(total);
        f32x16 P, oi;
#pragma unroll
        for (int reg = 0; reg < 16; ++reg) { P[reg] = 0.f; oi[reg] = 0.f; }
#pragma unroll
        for (int nh = 0; nh < 2; ++nh) {
            if (PASS_C) tile_store<64>(TC, pcq, lane);
            tile_store<64>(TB, pbb, lane);
            LDS_WAIT();
            if (nh == 0) { if (PASS_C) tile_load<64>(pcq, MIX, R0, dir, I, ccol + 64, lane); tile_load<64>(pbb, MIX, R0, dir, I, bcol + 64, lane); }
            else if (I + 1 < 8) { if (PASS_C) tile_load<64>(pcq, MIX, R0, dir, I + 1, ccol, lane); tile_load<64>(pbb, MIX, R0, dir, I + 1, bcol, lane);
                const int i_o = 32 * (I + 1) + c31; const int m_o = dir ? R0 + 255 - i_o : R0 + i_o; dtraw = DT[(size_t)m_o * 8 + dir * 4 + head]; }
            if (PASS_C) {
#pragma unroll
                for (int s = 0; s < 4; ++s) P = MFMA32(ld_row8(TB, TP64, c31, 16 * s + 8 * h), ld_row8(TC, TP64, c31, 16 * s + 8 * h), P);
#pragma unroll
                for (int kk = 0; kk < 2; ++kk) {
                    oi = MFMA32(ld_row8_perm(TC, TP64, c31, 32 * kk, h), pack8<0>(S[2 * nh + kk]), oi);
                    oi = MFMA32(ld_row8_perm(TC, TP64, c31, 32 * kk + 16, h), pack8<1>(S[2 * nh + kk]), oi);
                }
            }
#pragma unroll
            for (int kk = 0; kk < 2; ++kk) {
#pragma unroll
                for (int reg = 0; reg < 16; ++reg) S[2 * nh + kk][reg] *= dsub;
#pragma unroll
                for (int s = 0; s < 2; ++s)
                    S[2 * nh + kk] = MFMA32(ld_tr8(TB, TP64, 16 * s + 8 * h, 16 * s + 8 * h + 4, 32 * kk, lane), ld_tr8(TXh, TP32, 16 * s + 8 * h, 16 * s + 8 * h + 4, 0, lane), S[2 * nh + kk]);
            }
            LDS_WAIT();
        }
        if (PASS_C) {
            float bj[16], dj[16];
#pragma unroll
            for (int gq = 0; gq < 4; ++gq) { const f32x4 b4 = *(const LAS f32x4*)(brn + 8 * gq + 4 * h), d4 = *(const LAS f32x4*)(dtv + 8 * gq + 4 * h);
                bj[4 * gq] = b4.x; bj[4 * gq + 1] = b4.y; bj[4 * gq + 2] = b4.z; bj[4 * gq + 3] = b4.w; dj[4 * gq] = d4.x; dj[4 * gq + 1] = d4.y; dj[4 * gq + 2] = d4.z; dj[4 * gq + 3] = d4.w; }
#pragma unroll
            for (int reg = 0; reg < 16; ++reg) P[reg] = (crow(reg, h) <= c31) ? P[reg] * dj[reg] * __expf(run - bj[reg]) : 0.f;
#pragma unroll
            for (int reg = 0; reg < 16; ++reg) oi[reg] = oi[reg] * __expf(bj[reg]);
            oi = MFMA32(pack8<0>(P), ld_tr8(TX, TP32, 4 * h, 8 + 4 * h, 0, lane), oi);
            oi = MFMA32(pack8<1>(P), ld_tr8(TX, TP32, 16 + 4 * h, 24 + 4 * h, 0, lane), oi);
#pragma unroll
            for (int reg = 0; reg < 16; reg += 2) { const unsigned w0 = cvtpk(oi[reg], oi[reg + 1]);
                *(LAS bf16_t*)(TXh + crow(reg, h) * TP32 + c31 * 2) = (bf16_t)w0; *(LAS bf16_t*)(TXh + crow(reg + 1, h) * TP32 + c31 * 2) = (bf16_t)(w0 >> 16); }
            LDS_WAIT();
#pragma unroll
            for (int t = 0; t < 2; ++t) { const int id = lane + 64 * t, r = id >> 2, ck = id & 3; const int i = 32 * I + r; const int m = dir ? R0 + 255 - i : R0 + i;
                __builtin_nontemporal_store(*(const LAS u32x4*)(TXh + r * TP32 + ck * 16), (u32x4*)((char*)OUT + ((unsigned)m * (unsigned)ldo + (unsigned)(head * 64 + 32 * vb + ck * 8)) * 2u)); }
        }
        LDS_WAIT();
    }
    if (!PASS_C) {
#pragma unroll
        for (int kb = 0; kb < 4; ++kb)
#pragma unroll
            for (int q4 = 0; q4 < 2; ++q4) { const f32x16& T = S[kb]; u32x4 w; w.x = cvtpk(T[8 * q4], T[8 * q4 + 1]); w.y = cvtpk(T[8 * q4 + 2], T[8 * q4 + 3]); w.z = cvtpk(T[8 * q4 + 4], T[8 * q4 + 5]); w.w = cvtpk(T[8 * q4 + 6], T[8 * q4 + 7]);
                *(u32x4*)(ST + lane * 64 + kb * 16 + q4 * 8) = w; }
        if (vb == 0 && lane == 0) ((float*)(F.ws + WS_DLB))[seq * NCH + pc] = gtot;
    }
}

constexpr int NA_GQA = 2048, NA_NA = 2048, NA_CTX = 256;
template <int TYPE> __device__ __forceinline__ void attn_task(Frame& F, int l, int u, bf16_t* BR) {
    const bf16_t* MIX = (const bf16_t*)(F.ws + WS_RC);
    const int lane_ = tid_from_lds(F.lds, F.wave_s) & 63;
    const int lane = lane_, h = lane >> 5, c31 = lane & 31;
    LAS unsigned char* wl = F.lds + F.wave * WLDS; LAS unsigned char* TV = wl; LAS float* al = (LAS float*)(wl + 4608);
    int qrow0, qcol, kcol, vcol, ocol, b, ntiles, r = 0, c0 = 0, hh = 0;
    if (TYPE == 0) { b = u >> 9; const int hq = (u >> 7) & 3, tb = u & 127; qrow0 = b * SEQ + tb * 32; qcol = C_DQ + hq * 64; kcol = C_DK + (hq >> 1) * 64; vcol = C_DV + (hq >> 1) * 64; ocol = 768 + hq * 64; ntiles = 8 + 128; }
    else if (TYPE == 1) { b = u >> 9; hh = (u >> 7) & 3; r = (u >> 1) & 63; c0 = (u & 1) * 32; qrow0 = b * SEQ + r * 64 + c0; qcol = C_CQ + hh * 64; kcol = C_CK + hh * 64; vcol = C_CV + hh * 64; ocol = 512 + hh * 64; ntiles = 8 + 16; }
    else { b = u >> 6; const int h8 = (u >> 3) & 7, tb = u & 7; qrow0 = MLAT + b * CTXL + tb * 32; ntiles = 8;
        if (h8 < 4) { qcol = C_CQ + h8 * 64; kcol = C_CK + h8 * 64; vcol = C_CV + h8 * 64; ocol = 512 + h8 * 64; } else { const int hq = h8 - 4; qcol = C_DQ + hq * 64; kcol = C_DK + (hq >> 1) * 64; vcol = C_DV + (hq >> 1) * 64; ocol = 768 + hq * 64; } }
    const int rs = min(max(r - 4, 0), 56);
    const float* rpb = FIN(15) + (size_t)(l * 4 + hh) * 15 * 31;
    const int cq = c0 + c31, cs = min(max(cq - 8, 0), 48);
#define TILE_ROW(t) ((t) < 8 ? MLAT + b * CTXL + 32 * (t) : (TYPE == 1 ? b * SEQ + (rs + (((t) - 8) >> 1)) * 64 + 32 * (((t) - 8) & 1) : b * SEQ + 32 * ((t) - 8)))
    bf16x8 qf[4];
#pragma unroll
    for (int s = 0; s < 4; ++s) qf[s] = *(const bf16x8*)(MIX + (size_t)(qrow0 + c31) * NMIX + qcol + 16 * s + 8 * h);
    f32x16 O0, O1;
#pragma unroll
    for (int reg = 0; reg < 16; ++reg) { O0[reg] = 0.f; O1[reg] = 0.f; }
    float m_run = -1e30f, l_run = 0.f;
    bf16x8 kf[4]; u32x4 vr[4];
    { const int kr0 = TILE_ROW(0);
#pragma unroll
      for (int s = 0; s < 4; ++s) kf[s] = *(const bf16x8*)(MIX + (size_t)(kr0 + c31) * NMIX + kcol + 16 * s + 8 * h);
#pragma unroll
      for (int t4 = 0; t4 < 4; ++t4) { const int id = lane + 64 * t4; vr[t4] = *(const u32x4*)(MIX + (size_t)(kr0 + (id >> 3)) * NMIX + vcol + (id & 7) * 8); } }
#pragma unroll 1
    for (int t = 0; t < ntiles; ++t) {
#pragma unroll
        for (int t4 = 0; t4 < 4; ++t4) { const int id = lane + 64 * t4; *(LAS u32x4*)(TV + (id >> 3) * TP64 + (id & 7) * 16) = vr[t4]; }
        asm volatile("" ::: "memory");
        f32x16 S;
#pragma unroll
        for (int reg = 0; reg < 16; ++reg) S[reg] = 0.f;
#pragma unroll
        for (int s = 0; s < 4; ++s) S = MFMA32(kf[s], qf[s], S);
        if (t + 1 < ntiles) { const int kr1 = TILE_ROW(t + 1);
#pragma unroll
            for (int s = 0; s < 4; ++s) kf[s] = *(const bf16x8*)(MIX + (size_t)(kr1 + c31) * NMIX + kcol + 16 * s + 8 * h);
#pragma unroll
            for (int t4 = 0; t4 < 4; ++t4) { const int id = lane + 64 * t4; vr[t4] = *(const u32x4*)(MIX + (size_t)(kr1 + (id >> 3)) * NMIX + vcol + (id & 7) * 8); } }
        if (TYPE == 1 && t >= 8) {
            const int kr = rs + ((t - 8) >> 1), kc0 = 32 * ((t - 8) & 1); const float* rb = rpb + (kr - r + 7) * 31 + (15 - cq);
#pragma unroll
            for (int reg = 0; reg < 16; ++reg) { const int kc = kc0 + crow(reg, h); const bool ok = (kc >= cs) && (kc < cs + 16);
                const float bias = ok ? rb[kc] : 0.f; S[reg] = ok ? S[reg] * 0.125f + bias : -1e30f; }
        } else {
#pragma unroll
            for (int reg = 0; reg < 16; ++reg) S[reg] *= 0.125f;
        }
        float mloc = fmaxf(fmaxf(fmaxf(S[0], S[1]), fmaxf(S[2], S[3])), fmaxf(fmaxf(S[4], S[5]), fmaxf(S[6], S[7])));
        mloc = fmaxf(mloc, fmaxf(fmaxf(fmaxf(S[8], S[9]), fmaxf(S[10], S[11])), fmaxf(fmaxf(S[12], S[13]), fmaxf(S[14], S[15]))));
        mloc = fmaxf(mloc, bperm_(mloc, lane ^ 32));
        const float m_new = fmaxf(m_run, mloc);
        const float alpha = __expf(m_run - m_new);
        m_run = m_new;
        float ls = 0.f;
#pragma unroll
        for (int reg = 0; reg < 16; ++reg) { const float p = __expf(S[reg] - m_new); ls += p; S[reg] = p; }
        l_run = l_run * alpha + ls;
        if (lane < 32) al[c31] = alpha;
        LDS_WAIT();
        const bf16x8 pa0 = pack8<0>(S), pa1 = pack8<1>(S);
        {
#pragma unroll
            for (int g = 0; g < 4; ++g) { const f32x4 a4 = *(const LAS f32x4*)(al + 8 * g + 4 * h);
                O0[4 * g] *= a4.x; O0[4 * g + 1] *= a4.y; O0[4 * g + 2] *= a4.z; O0[4 * g + 3] *= a4.w;
                O1[4 * g] *= a4.x; O1[4 * g + 1] *= a4.y; O1[4 * g + 2] *= a4.z; O1[4 * g + 3] *= a4.w; }
        }
        O0 = MFMA32(pa0, ld_tr8(TV, TP64, 4 * h, 8 + 4 * h, 0, lane), O0);
        O0 = MFMA32(pa1, ld_tr8(TV, TP64, 16 + 4 * h, 24 + 4 * h, 0, lane), O0);
        O1 = MFMA32(pa0, ld_tr8(TV, TP64, 4 * h, 8 + 4 * h, 32, lane), O1);
        O1 = MFMA32(pa1, ld_tr8(TV, TP64, 16 + 4 * h, 24 + 4 * h, 32, lane), O1);
    }
#undef TILE_ROW
    l_run += bperm_(l_run, lane ^ 32);
    if (lane < 32) al[c31] = 1.f / l_run;
    LDS_WAIT();
#pragma unroll
    for (int g = 0; g < 4; ++g) { const f32x4 a4 = *(const LAS f32x4*)(al + 8 * g + 4 * h);
        O0[4 * g] *= a4.x; O0[4 * g + 1] *= a4.y; O0[4 * g + 2] *= a4.z; O0[4 * g + 3] *= a4.w;
        O1[4 * g] *= a4.x; O1[4 * g + 1] *= a4.y; O1[4 * g + 2] *= a4.z; O1[4 * g + 3] *= a4.w; }
#pragma unroll
    for (int reg = 0; reg < 16; ++reg) { bf16_t* op = BR + (size_t)(qrow0 + crow(reg, h)) * DM + ocol + c31; op[0] = (bf16_t)f2bf(O0[reg]); op[32] = (bf16_t)f2bf(O1[reg]); }
    LDS_WAIT();
}

constexpr int AB_TILE = 9216;
constexpr int AB_AL = 4 * AB_TILE;
template <int TYPE>
__device__ __forceinline__ void attn_block_task(Frame& F, int l, int u, bf16_t* BR) {
    const bf16_t* MIX = (const bf16_t*)(F.ws + WS_RC);
    const int lane_ = tid_from_lds(F.lds, F.wave_s) & 63;
    const int lane = lane_, h = lane >> 5, c31 = lane & 31, tid = F.wave * 64 + lane;
    int b, qrow0, qcol, kcol, vcol, ocol, ntile, r = 0, c0 = 0, hh = 0, r0 = 0;
    if (TYPE == 0) { b = u >> 6; const int hq = (u >> 4) & 3, qblk = u & 15; qrow0 = b * SEQ + qblk * 256 + F.wave * 32; qcol = C_DQ + hq * 64; kcol = C_DK + (hq >> 1) * 64; vcol = C_DV + (hq >> 1) * 64; ocol = 768 + hq * 64; ntile = 4 + 64; }
    else { b = u >> 6; hh = (u >> 4) & 3; r0 = (u & 15) * 4; r = r0 + (F.wave >> 1); c0 = (F.wave & 1) * 32; qrow0 = b * SEQ + r * 64 + c0; qcol = C_CQ + hh * 64; kcol = C_CK + hh * 64; vcol = C_CV + hh * 64; ocol = 512 + hh * 64;
           ntile = 4 + (min(max(r0 + 3 - 4, 0), 56) - min(max(r0 - 4, 0), 56) + 8); }
    const int rs_blk = min(max(r0 - 4, 0), 56), rs = min(max(r - 4, 0), 56);
    const float* rpb = FIN(15) + (size_t)(l * 4 + hh) * 15 * 31;
    const int cq = c0 + c31, cs = min(max(cq - 8, 0), 48);
    LAS unsigned char* lds = F.lds; LAS float* al = (LAS float*)(lds + AB_AL + F.wave * 128);
    LAS float* rpbL = (LAS float*)(lds + AB_AL + 1024);
    if (TYPE == 1) { if (tid < 465) rpbL[tid] = rpb[tid]; }
    const int prow = tid >> 3, pck = tid & 7;
    const unsigned pdst = prow * TP64 + pck * 16;
    const int NTILE = ntile;
#define AB_TROW(t) ((t) < 4 ? MLAT + b * CTXL + 64 * (t) : (TYPE == 0 ? b * SEQ + 64 * ((t) - 4) : b * SEQ + 64 * (rs_blk + (t) - 4)))
    bf16x8 qf[4];
#pragma unroll
    for (int s = 0; s < 4; ++s) qf[s] = *(const bf16x8*)(MIX + (size_t)(qrow0 + c31) * NMIX + qcol + 16 * s + 8 * h);
    f32x16 O0, O1;
#pragma unroll
    for (int reg = 0; reg < 16; ++reg) { O0[reg] = 0.f; O1[reg] = 0.f; }
    float m_run = -1e30f, l_run = 0.f;
    constexpr float SC2 = 0.125f * 1.4426950408889634f;
    constexpr float L2E = 1.4426950408889634f;
    u32x4 kr0, vr0, kr1, vr1, kr2, vr2;
#define AB_LOAD(T, KR, VR) do { const size_t ro_ = (size_t)(AB_TROW(T) + prow) * NMIX + pck * 8; KR = *(const u32x4*)(MIX + ro_ + kcol); VR = *(const u32x4*)(MIX + ro_ + vcol); } while (0)
    AB_LOAD(0, kr0, vr0);
    *(LAS u32x4*)(lds + pdst) = kr0; *(LAS u32x4*)(lds + AB_TILE + pdst) = vr0;
    AB_LOAD(1, kr0, vr0); AB_LOAD(2, kr1, vr1); AB_LOAD(3, kr2, vr2);
    __syncthreads();
#define AB_BODY(T, KR, VR) do { \
        LAS unsigned char* KB = lds + ((T) & 1) * 2 * AB_TILE; LAS unsigned char* VB = KB + AB_TILE; \
        const int kr_ = rs_blk + (T) - 4;                                  \
        if (TYPE == 0 || (T) < 4 || (kr_ >= rs && kr_ < rs + 8)) {         \
        f32x16 S0, S1; \
        _Pragma("unroll") for (int reg = 0; reg < 16; ++reg) { S0[reg] = 0.f; S1[reg] = 0.f; } \
        _Pragma("unroll") for (int s = 0; s < 4; ++s) { S0 = MFMA32(ld_row8(KB, TP64, c31, 16 * s + 8 * h), qf[s], S0); S1 = MFMA32(ld_row8(KB, TP64, 32 + c31, 16 * s + 8 * h), qf[s], S1); } \
        if (TYPE == 1 && (T) >= 4) {                                       \
            const LAS float* rbl = rpbL + (kr_ - r + 7) * 31; \
            _Pragma("unroll") for (int reg = 0; reg < 16; ++reg) { const int kc = crow(reg, h); \
                const bool ok0 = (kc >= cs) && (kc < cs + 16), ok1 = (kc + 32 >= cs) && (kc + 32 < cs + 16); \
                const float b0 = rbl[min(max(kc - cq + 15, 0), 30)], b1 = rbl[min(max(kc + 32 - cq + 15, 0), 30)];     \
                S0[reg] = ok0 ? fmaf(S0[reg], SC2, b0 * L2E) : -1e30f; S1[reg] = ok1 ? fmaf(S1[reg], SC2, b1 * L2E) : -1e30f; } \
        } \
        const bool pre = (TYPE == 1 && (T) >= 4);                  \
        float mloc = fmaxf(fmaxf(fmaxf(S0[0], S0[1]), fmaxf(S0[2], S0[3])), fmaxf(fmaxf(S0[4], S0[5]), fmaxf(S0[6], S0[7]))); \
        mloc = fmaxf(mloc, fmaxf(fmaxf(fmaxf(S0[8], S0[9]), fmaxf(S0[10], S0[11])), fmaxf(fmaxf(S0[12], S0[13]), fmaxf(S0[14], S0[15])))); \
        mloc = fmaxf(mloc, fmaxf(fmaxf(fmaxf(S1[0], S1[1]), fmaxf(S1[2], S1[3])), fmaxf(fmaxf(S1[4], S1[5]), fmaxf(S1[6], S1[7])))); \
        mloc = fmaxf(mloc, fmaxf(fmaxf(fmaxf(S1[8], S1[9]), fmaxf(S1[10], S1[11])), fmaxf(fmaxf(S1[12], S1[13]), fmaxf(S1[14], S1[15])))); \
        if (!pre) mloc *= SC2; \
        { const auto rr_ = __builtin_amdgcn_permlane32_swap(__float_as_uint(mloc), __float_as_uint(mloc), false, false); mloc = fmaxf(__uint_as_float(rr_[0]), __uint_as_float(rr_[1])); } \
        if (__any(mloc > m_run + 8.f)) {                         \
            const float m_new = fmaxf(m_run, mloc); \
            const float alpha = __builtin_amdgcn_exp2f(m_run - m_new); \
            m_run = m_new; l_run *= alpha; \
            if (lane < 32) al[c31] = alpha; \
            LDS_WAIT(); \
            _Pragma("unroll") for (int g = 0; g < 4; ++g) { const f32x4 a4 = *(const LAS f32x4*)(al + 8 * g + 4 * h); \
                O0[4 * g] *= a4.x; O0[4 * g + 1] *= a4.y; O0[4 * g + 2] *= a4.z; O0[4 * g + 3] *= a4.w; \
                O1[4 * g] *= a4.x; O1[4 * g + 1] *= a4.y; O1[4 * g + 2] *= a4.z; O1[4 * g + 3] *= a4.w; } \
            LDS_WAIT(); \
        } \
        float ls = 0.f; \
        if (pre) { _Pragma("unroll") for (int reg = 0; reg < 16; ++reg) { const float p0 = __builtin_amdgcn_exp2f(S0[reg] - m_run), p1 = __builtin_amdgcn_exp2f(S1[reg] - m_run); ls += p0 + p1; S0[reg] = p0; S1[reg] = p1; } } \
        else     { _Pragma("unroll") for (int reg = 0; reg < 16; ++reg) { const float p0 = __builtin_amdgcn_exp2f(fmaf(S0[reg], SC2, -m_run)), p1 = __builtin_amdgcn_exp2f(fmaf(S1[reg], SC2, -m_run)); ls += p0 + p1; S0[reg] = p0; S1[reg] = p1; } } \
        l_run += ls; \
        const bf16x8 pa0 = pack8<0>(S0), pa1 = pack8<1>(S0), pa2 = pack8<0>(S1), pa3 = pack8<1>(S1); \
        O0 = MFMA32(pa0, ld_tr8(VB, TP64, 4 * h, 8 + 4 * h, 0, lane), O0); \
        O1 = MFMA32(pa0, ld_tr8(VB, TP64, 4 * h, 8 + 4 * h, 32, lane), O1); \
        O0 = MFMA32(pa1, ld_tr8(VB, TP64, 16 + 4 * h, 24 + 4 * h, 0, lane), O0); \
        O1 = MFMA32(pa1, ld_tr8(VB, TP64, 16 + 4 * h, 24 + 4 * h, 32, lane), O1); \
        O0 = MFMA32(pa2, ld_tr8(VB, TP64, 32 + 4 * h, 40 + 4 * h, 0, lane), O0); \
        O1 = MFMA32(pa2, ld_tr8(VB, TP64, 32 + 4 * h, 40 + 4 * h, 32, lane), O1); \
        O0 = MFMA32(pa3, ld_tr8(VB, TP64, 48 + 4 * h, 56 + 4 * h, 0, lane), O0); \
        O1 = MFMA32(pa3, ld_tr8(VB, TP64, 48 + 4 * h, 56 + 4 * h, 32, lane), O1); \
        } \
        if ((T) + 1 < NTILE) { LAS unsigned char* KN = lds + (((T) + 1) & 1) * 2 * AB_TILE; *(LAS u32x4*)(KN + pdst) = KR; *(LAS u32x4*)(KN + AB_TILE + pdst) = VR; } \
        if ((T) + 4 < NTILE) AB_LOAD((T) + 4, KR, VR); \
        __syncthreads(); \
    } while (0)
#pragma unroll 1
    for (int t = 0; t < NTILE; t += 3) {
        AB_BODY(t, kr0, vr0);
        if (t + 1 < NTILE) AB_BODY(t + 1, kr1, vr1);
        if (t + 2 < NTILE) AB_BODY(t + 2, kr2, vr2);
    }
#undef AB_BODY
#undef AB_LOAD
#undef AB_TROW
    l_run += bperm_(l_run, lane ^ 32);
    if (lane < 32) al[c31] = 1.f / l_run;
    LDS_WAIT();
#pragma unroll
    for (int g = 0; g < 4; ++g) { const f32x4 a4 = *(const LAS f32x4*)(al + 8 * g + 4 * h);
        O0[4 * g] *= a4.x; O0[4 * g + 1] *= a4.y; O0[4 * g + 2] *= a4.z; O0[4 * g + 3] *= a4.w;
        O1[4 * g] *= a4.x; O1[4 * g + 1] *= a4.y; O1[4 * g + 2] *= a4.z; O1[4 * g + 3] *= a4.w; }
#pragma unroll
    for (int reg = 0; reg < 16; ++reg) { bf16_t* op = BR + (size_t)(qrow0 + crow(reg, h)) * DM + ocol + c31; op[0] = (bf16_t)f2bf(O0[reg]); op[32] = (bf16_t)f2bf(O1[reg]); }
    __syncthreads();
}


namespace gx {
constexpr int NSLOT = 3, SLOTB = 8192, KVBLK = 64;
constexpr int LDS_K = 0, LDS_V = NSLOT * SLOTB, LDS_WS = 2 * NSLOT * SLOTB, LDS_OST = LDS_WS + 8 * 64 * 4, LDS_BYTES_GX = LDS_OST + 8 * 4096;
typedef LAS const char* lds_cptr;
typedef short v4i16_t __attribute__((ext_vector_type(4)));
#define GX_SBAR() __builtin_amdgcn_sched_barrier(0)
__device__ __forceinline__ void glds16(const void* gsrc, unsigned lds_dst) { unsigned keep;
    asm volatile("s_mov_b32 %0, m0\n\ts_mov_b32 m0, %2\n\ts_nop 0\n\tglobal_load_lds_dwordx4 %1, off\n\ts_mov_b32 m0, %0" : "=&s"(keep) : "v"(gsrc), "s"(lds_dst) : "memory"); }
__device__ __forceinline__ float max3f(float a, float b, float c) { float r; asm("v_max3_f32 %0, %1, %2, %3" : "=v"(r) : "v"(a), "v"(b), "v"(c)); return r; }
__device__ __forceinline__ float max2f(float a, float b) { float r; asm("v_max_f32_e32 %0, %1, %2" : "=v"(r) : "v"(a), "v"(b)); return r; }
__device__ __forceinline__ float fadd_s(float a, float b) { float r; asm("v_add_f32_e32 %0, %1, %2" : "=v"(r) : "v"(a), "v"(b)); return r; }
__device__ __forceinline__ float fsub_s(float a, float b) { float r; asm("v_sub_f32_e32 %0, %1, %2" : "=v"(r) : "v"(a), "v"(b)); return r; }
__device__ __forceinline__ unsigned cvtpk_s(float lo, float hi) { f32x2_t v = {lo, hi}; bf16x2_t b = __builtin_convertvector(v, bf16x2_t); return __builtin_bit_cast(unsigned, b); }
#define GX_WAIT_BAR(N) asm volatile("s_waitcnt vmcnt(" #N ") lgkmcnt(0)\n\ts_barrier" ::: "memory")
__device__ __forceinline__ void qkt(f32x16& p0, f32x16& p1, lds_cptr Kslot, const bf16x8* qr, const f32x16& negm, int r32, int hi) {
    lds_cptr kb = Kslot + hi * 1024 + r32 * 16;
#pragma unroll
    for (int d0 = 0; d0 < 4; ++d0) {
        const bf16x8 b0 = *(const LAS bf16x8*)(kb + d0 * 2048);
        const bf16x8 b1 = *(const LAS bf16x8*)(kb + d0 * 2048 + 512);
        if (d0 == 0) { p0 = __builtin_amdgcn_mfma_f32_32x32x16_bf16(b0, qr[0], negm, 0, 0, 0); p1 = __builtin_amdgcn_mfma_f32_32x32x16_bf16(b1, qr[0], negm, 0, 0, 0); }
        else { p0 = __builtin_amdgcn_mfma_f32_32x32x16_bf16(b0, qr[d0], p0, 0, 0, 0); p1 = __builtin_amdgcn_mfma_f32_32x32x16_bf16(b1, qr[d0], p1, 0, 0, 0); } }
}
__device__ __forceinline__ void kload8(bf16x8* kf, lds_cptr kp) {
    kf[0] = *(const LAS bf16x8*)(kp);        kf[1] = *(const LAS bf16x8*)(kp + 512);
    kf[2] = *(const LAS bf16x8*)(kp + 2048); kf[3] = *(const LAS bf16x8*)(kp + 2560);
    kf[4] = *(const LAS bf16x8*)(kp + 4096); kf[5] = *(const LAS bf16x8*)(kp + 4608);
    kf[6] = *(const LAS bf16x8*)(kp + 6144); kf[7] = *(const LAS bf16x8*)(kp + 6656);
}
__device__ __forceinline__ void kload2(bf16x8* kf, lds_cptr kp, int j) { kf[2 * j] = *(const LAS bf16x8*)(kp + j * 2048); kf[2 * j + 1] = *(const LAS bf16x8*)(kp + j * 2048 + 512); }
__device__ __forceinline__ s16x4 vtr(lds_cptr p) { return __builtin_bit_cast(s16x4, __builtin_amdgcn_ds_read_tr16_b64_v4i16((LAS v4i16_t*)p)); }
__device__ __forceinline__ float rowmax(const f32x16& p0, const f32x16& p1) {
    float a = max3f(p0[0], p0[1], p1[0]), b = max3f(p0[2], p0[3], p1[1]); a = max3f(a, p1[2], p1[3]);
#pragma unroll
    for (int r = 4; r < 16; r += 4) { a = max3f(a, p0[r], p0[r + 1]); b = max3f(b, p0[r + 2], p0[r + 3]); a = max3f(a, p1[r], p1[r + 1]); b = max3f(b, p1[r + 2], p1[r + 3]); }
    const float m = max2f(a, b);
    auto rr = __builtin_amdgcn_permlane32_swap(__float_as_uint(m), __float_as_uint(m), false, false);
    return max2f(__uint_as_float(rr[0]), __uint_as_float(rr[1]));
}
__device__ __forceinline__ void pv(f32x16* o, int vb, bf16x8 pa0, bf16x8 pa1, bf16x8 pa2, bf16x8 pa3) {
#pragma unroll
    for (int d0 = 0; d0 < 2; ++d0) { s16x4 lo[4], hi[4];
#pragma unroll
        for (int ks = 0; ks < 4; ++ks) {
            asm volatile("ds_read_b64_tr_b16 %0,%1 offset:%c2" : "=&v"(lo[ks]) : "v"(vb), "i"(d0 * 4096 + ks * 1024) : "memory");
            asm volatile("ds_read_b64_tr_b16 %0,%1 offset:%c2" : "=&v"(hi[ks]) : "v"(vb), "i"(d0 * 4096 + ks * 1024 + 512) : "memory"); }
        asm volatile("s_waitcnt lgkmcnt(0)" ::: "memory"); GX_SBAR();
#define GX_PK(k) (bf16x8){lo[k][0], lo[k][1], lo[k][2], lo[k][3], hi[k][0], hi[k][1], hi[k][2], hi[k][3]}
        o[d0] = __builtin_amdgcn_mfma_f32_32x32x16_bf16(pa0, GX_PK(0), o[d0], 0, 0, 0);
        o[d0] = __builtin_amdgcn_mfma_f32_32x32x16_bf16(pa1, GX_PK(1), o[d0], 0, 0, 0);
        o[d0] = __builtin_amdgcn_mfma_f32_32x32x16_bf16(pa2, GX_PK(2), o[d0], 0, 0, 0);
        o[d0] = __builtin_amdgcn_mfma_f32_32x32x16_bf16(pa3, GX_PK(3), o[d0], 0, 0, 0);
#undef GX_PK
    }
}
template <int THRL> __device__ __forceinline__ void gqa_unit(Frame& F, int u, bf16_t* BR) {
    const bf16_t* MIX = (const bf16_t*)(F.ws + WS_RC);
    const int lane_ = tid_from_lds(F.lds, F.wave_s) & 63;
    const int lane = lane_, r32 = lane & 31, hi = lane >> 5, wid = F.wave;
    const int ux = u & 7, uj = u >> 3;
    const int b = ux >> 1, hq = 2 * (ux & 1) + (uj >> 4), qblk = uj & 15;
    const int qrow0 = b * SEQ + qblk * 256 + wid * 32, qcol = C_DQ + hq * 64, kcol = C_DK + (hq >> 1) * 64, vcol = C_DV + (hq >> 1) * 64, ocol = 768 + hq * 64;
    constexpr int NT = 64 + 4;
#define GX_TROW(t) ((t) < 64 ? b * SEQ + 64 * (t) : MLAT + b * CTXL + 64 * ((t) - 64))
    const bf16_t* Qw = MIX + (size_t)qrow0 * NMIX + qcol;
    LAS unsigned char* shm = F.lds;
    const unsigned lds0 = 0u;
    LAS float* wsf = (LAS float*)(shm + LDS_WS) + wid * 64;
    const bf16_t* ksrc = MIX + (size_t)lane * NMIX + kcol + wid * 8;
    const bf16_t* vsrc = MIX + (size_t)(16 * (wid & 3) + (lane >> 2)) * NMIX + vcol + (wid >> 2) * 32 + (lane & 3) * 8;
    const unsigned kdst = lds0 + LDS_K + wid * 1024, vdst = lds0 + LDS_V + wid * 1024;
#define GX_DMA_K(t, slot) glds16(ksrc + (size_t)GX_TROW(t) * NMIX, (unsigned)__builtin_amdgcn_readfirstlane(kdst + (slot)))
#define GX_DMA_V(t, slot) glds16(vsrc + (size_t)GX_TROW(t) * NMIX, (unsigned)__builtin_amdgcn_readfirstlane(vdst + (slot)))
    const int vb0 = (int)(lds0 + LDS_V) + ((lane >> 4) & 1) * 32 + (lane & 3) * 8 + (4 * hi + ((lane & 15) >> 2)) * 64;
    bf16x8 kf[8];
    const lds_cptr shm3 = (lds_cptr)shm; const lds_cptr kp0 = shm3 + LDS_K + hi * 1024 + r32 * 16; const lds_cptr vp0 = shm3 + LDS_V + ((lane >> 4) & 1) * 32 + (lane & 3) * 8 + (4 * hi + ((lane & 15) >> 2)) * 64;
    GX_DMA_K(0, 0); GX_DMA_V(0, 0); GX_DMA_K(1, SLOTB);
    bf16x8 qr[4];
#pragma unroll
    for (int d0 = 0; d0 < 4; ++d0) qr[d0] = *(const bf16x8*)(Qw + (size_t)r32 * NMIX + d0 * 16 + hi * 8);
    float mhat = 0.f, l_reg = 0.f; f32x16 o[2]; o[0] = f32x16{}; o[1] = f32x16{}; f32x16 negm = f32x16{}; asm volatile("" : "+v"(negm));
    bool resc = false;
#define GX_START(P0, P1) do { const float rm = rowmax(P0, P1); resc = false; \
    { const float dl = rm; mhat = fadd_s(mhat, dl); \
      _Pragma("unroll") for (int r = 0; r < 16; ++r) { P0[r] = fsub_s(P0[r], dl); P1[r] = fsub_s(P1[r], dl); } \
      _Pragma("unroll") for (int r = 0; r < 16; ++r) negm[r] = -mhat; asm volatile("" : "+v"(negm)); } \
    _Pragma("unroll") for (int r = 0; r < 16; ++r) P0[r] = __builtin_amdgcn_exp2f(P0[r]); } while (0)
#define GX_RESC() do { if (resc) { asm volatile("s_waitcnt lgkmcnt(0)" ::: "memory"); \
      _Pragma("unroll") for (int d_ = 0; d_ < 2; ++d_) _Pragma("unroll") for (int r = 0; r < 16; ++r) o[d_][r] *= wsf[crow(r, hi)]; } } while (0)
    f32x16 pA0, pA1, pB0, pB1;
    int sl_prev = 0, sl_cur = 0, sl_next = SLOTB;
#define GX_ROT() do { sl_prev = sl_cur; sl_cur = sl_next; sl_next = (sl_next == (NSLOT - 1) * SLOTB) ? 0 : sl_next + SLOTB; } while (0)
    GX_DMA_K(2, 2 * SLOTB);
    GX_WAIT_BAR(3);
    qkt(pA0, pA1, shm3 + LDS_K, qr, negm, r32, hi); asm volatile("s_nop 15\n\ts_nop 7" : "+v"(pA0), "+v"(pA1));
    GX_START(pA0, pA1);
    _Pragma("unroll") for (int r = 0; r < 16; ++r) pA1[r] = __builtin_amdgcn_exp2f(pA1[r]);
    GX_WAIT_BAR(0);
    GX_DMA_K(3, 0); GX_DMA_V(1, SLOTB);
    GX_ROT();
    kload8(kf, kp0 + sl_cur);
    GX_WAIT_BAR(2);
    s16x4 vlo[8], vhi[8]; u32x4 pw0, pw1, pw2, pw3;
#define GX_PKW(P, B) cvtpk_s(P[B], P[B + 1])
#define GX_PAF(k) __builtin_bit_cast(bf16x8, pw##k)
#define GX_VFR(i) (bf16x8){vlo[i][0], vlo[i][1], vlo[i][2], vlo[i][3], vhi[i][0], vhi[i][1], vhi[i][2], vhi[i][3]}
#define GX_PIN(x) asm volatile("" : "+v"(x))
#define GX_MX3(a, b, c) __builtin_fmaxf(__builtin_fmaxf((a), (b)), (c))
#define GX_GAPA(MF, A0, A1, A2, A3, W0, W1, PW) do { MF; sacc += A0; sacc += A1; sacc += A2; sacc += A3; GX_PIN(sacc); W0; W1; GX_PIN(PW); GX_SBAR(); } while (0)
#define GX_EX(v) __builtin_amdgcn_exp2f(v)
#define GX_GAPB(MF, X, B) do { MF; X[B] = GX_EX(X[B]); X[B + 1] = GX_EX(X[B + 1]); X[B + 2] = GX_EX(X[B + 2]); X[B + 3] = GX_EX(X[B + 3]); GX_PIN(X); GX_SBAR(); } while (0)
#define GX_VRD(i) do { vlo[i] = vtr(vp_ + (((i) >> 2) * 4096 + ((i) & 3) * 1024)); vhi[i] = vtr(vp_ + (((i) >> 2) * 4096 + ((i) & 3) * 1024 + 512)); } while (0)
#define GX_KRD(G, j) do { if (G) { kload2(kf, kp0 + sl_next, j); GX_SBAR(); } } while (0)
#define GX_MFMA __builtin_amdgcn_mfma_f32_32x32x16_bf16
#define GX_STEP(C0, C1, P0, P1, t, GK, GV, GL) do { GX_SBAR(); \
    const lds_cptr vp_ = vp0 + sl_prev; \
    GX_VRD(0); GX_SBAR(); float sacc = (P0[0] + P0[1]); \
    GX_GAPA(C0 = GX_MFMA(kf[0], qr[0], negm, 0, 0, 0), P0[2], P0[3], P0[4], P0[5],     pw0[0] = GX_PKW(P0, 0), pw0[1] = GX_PKW(P0, 2), pw0); \
    GX_VRD(4); GX_SBAR(); GX_GAPA(C1 = GX_MFMA(kf[1], qr[0], negm, 0, 0, 0), P0[6], P0[7], P0[8], P0[9],     pw0[2] = GX_PKW(P0, 4), pw0[3] = GX_PKW(P0, 6), pw0); \
    GX_VRD(1); GX_SBAR(); GX_GAPA(C0 = GX_MFMA(kf[2], qr[1], C0, 0, 0, 0),   P0[10], P0[11], P0[12], P0[13], pw1[0] = GX_PKW(P0, 8), pw1[1] = GX_PKW(P0, 10), pw1); \
    GX_VRD(5); GX_SBAR(); GX_GAPA(C1 = GX_MFMA(kf[3], qr[1], C1, 0, 0, 0),   P0[14], P0[15], P1[0], P1[1],   pw1[2] = GX_PKW(P0, 12), pw1[3] = GX_PKW(P0, 14), pw1); \
    GX_VRD(2); GX_SBAR(); GX_GAPA(C0 = GX_MFMA(kf[4], qr[2], C0, 0, 0, 0),   P1[2], P1[3], P1[4], P1[5],     pw2[0] = GX_PKW(P1, 0), pw2[1] = GX_PKW(P1, 2), pw2); \
    GX_VRD(6); GX_SBAR(); GX_GAPA(C1 = GX_MFMA(kf[5], qr[2], C1, 0, 0, 0),   P1[6], P1[7], P1[8], P1[9],     pw2[2] = GX_PKW(P1, 4), pw2[3] = GX_PKW(P1, 6), pw2); \
    GX_VRD(3); GX_SBAR(); GX_GAPA(C0 = GX_MFMA(kf[6], qr[3], C0, 0, 0, 0),   P1[10], P1[11], P1[12], P1[13], pw3[0] = GX_PKW(P1, 8), pw3[1] = GX_PKW(P1, 10), pw3); \
    GX_VRD(7); GX_SBAR(); GX_GAPA(C1 = GX_MFMA(kf[7], qr[3], C1, 0, 0, 0),   P1[14], P1[15], 0.f, 0.f,       pw3[2] = GX_PKW(P1, 12), pw3[3] = GX_PKW(P1, 14), pw3); \
    l_reg += sacc; \
    if (GK) { GX_DMA_K((t) + 3, sl_cur); } if (GV) { GX_DMA_V((t) + 1, sl_next); } \
    { float a = GX_MX3(C0[0], C0[1], C1[0]), b_ = GX_MX3(C0[2], C0[3], C1[1]); a = GX_MX3(a, C1[2], C1[3]); \
      _Pragma("unroll") for (int r = 4; r < 16; r += 4) { a = GX_MX3(a, C0[r], C0[r + 1]); b_ = GX_MX3(b_, C0[r + 2], C0[r + 3]); a = GX_MX3(a, C1[r], C1[r + 1]); b_ = GX_MX3(b_, C1[r + 2], C1[r + 3]); } \
      float rm = __builtin_fmaxf(a, b_); { auto rr = __builtin_amdgcn_permlane32_swap(__float_as_uint(rm), __float_as_uint(rm), false, false); rm = __builtin_fmaxf(__uint_as_float(rr[0]), __uint_as_float(rr[1])); } \
      resc = false; \
      if (__builtin_expect(__any(rm > (float)THRL), 0)) { const float dl = __builtin_fmaxf(rm, 0.f); mhat += dl; \
        _Pragma("unroll") for (int r = 0; r < 16; ++r) { C0[r] -= dl; C1[r] -= dl; } \
        _Pragma("unroll") for (int r = 0; r < 16; ++r) negm[r] = -mhat; asm volatile("" : "+v"(negm)); \
        const float f = __builtin_amdgcn_exp2f(-dl); l_reg *= f; if (hi == 0) wsf[r32] = f; resc = true; } } \
    GX_SBAR(); \
    GX_GAPB(o[0] = GX_MFMA(GX_PAF(0), GX_VFR(0), o[0], 0, 0, 0), C0, 0); \
    GX_GAPB(o[1] = GX_MFMA(GX_PAF(0), GX_VFR(4), o[1], 0, 0, 0), C0, 4); \
    GX_KRD(GL, 0); GX_GAPB(o[0] = GX_MFMA(GX_PAF(1), GX_VFR(1), o[0], 0, 0, 0), C0, 8); \
    GX_KRD(GL, 1); GX_GAPB(o[1] = GX_MFMA(GX_PAF(1), GX_VFR(5), o[1], 0, 0, 0), C0, 12); \
    GX_KRD(GL, 2); GX_GAPB(o[0] = GX_MFMA(GX_PAF(2), GX_VFR(2), o[0], 0, 0, 0), C1, 0); \
    GX_KRD(GL, 3); GX_GAPB(o[1] = GX_MFMA(GX_PAF(2), GX_VFR(6), o[1], 0, 0, 0), C1, 4); \
    GX_GAPB(o[0] = GX_MFMA(GX_PAF(3), GX_VFR(3), o[0], 0, 0, 0), C1, 8); \
    GX_GAPB(o[1] = GX_MFMA(GX_PAF(3), GX_VFR(7), o[1], 0, 0, 0), C1, 12); \
    } while (0)
    int t = 1;
#pragma unroll 1
    for (; t + 5 < NT; t += 2) {
        GX_STEP(pB0, pB1, pA0, pA1, t, true, true, true);     GX_WAIT_BAR(2); GX_RESC(); GX_ROT();
        GX_STEP(pA0, pA1, pB0, pB1, t + 1, true, true, true); GX_WAIT_BAR(2); GX_RESC(); GX_ROT();
    }
#define GX_ENDW(tt) do { if ((tt) + 3 < NT) { GX_WAIT_BAR(2); } else if ((tt) + 2 < NT) { GX_WAIT_BAR(1); } else { GX_WAIT_BAR(0); } } while (0)
#pragma unroll 1
    for (; t + 1 < NT; t += 2) {
        GX_STEP(pB0, pB1, pA0, pA1, t, (t + 3 < NT), (t + 1 < NT), (t + 1 < NT));         GX_ENDW(t);     GX_RESC(); GX_ROT();
        GX_STEP(pA0, pA1, pB0, pB1, t + 1, (t + 4 < NT), (t + 2 < NT), (t + 2 < NT));     GX_ENDW(t + 1); GX_RESC(); GX_ROT();
    }
    GX_STEP(pB0, pB1, pA0, pA1, NT - 1, false, false, false); GX_RESC();
    { float sacc = pB0[0] + pB0[1]; _Pragma("unroll") for (int r = 2; r < 16; ++r) sacc += pB0[r]; _Pragma("unroll") for (int r = 0; r < 16; ++r) sacc += pB1[r]; l_reg += sacc;
      pw0 = (u32x4){GX_PKW(pB0, 0), GX_PKW(pB0, 2), GX_PKW(pB0, 4), GX_PKW(pB0, 6)}; pw1 = (u32x4){GX_PKW(pB0, 8), GX_PKW(pB0, 10), GX_PKW(pB0, 12), GX_PKW(pB0, 14)};
      pw2 = (u32x4){GX_PKW(pB1, 0), GX_PKW(pB1, 2), GX_PKW(pB1, 4), GX_PKW(pB1, 6)}; pw3 = (u32x4){GX_PKW(pB1, 8), GX_PKW(pB1, 10), GX_PKW(pB1, 12), GX_PKW(pB1, 14)};
      GX_SBAR(); pv(o, vb0 + sl_cur, GX_PAF(0), GX_PAF(1), GX_PAF(2), GX_PAF(3)); }
    { auto rr = __builtin_amdgcn_permlane32_swap(__float_as_uint(l_reg), __float_as_uint(l_reg), false, false); l_reg = __uint_as_float(rr[0]) + __uint_as_float(rr[1]); }
    if (hi == 0) wsf[32 + r32] = l_reg; asm volatile("s_waitcnt lgkmcnt(0)" ::: "memory");
    float rli[16];
#pragma unroll
    for (int r = 0; r < 16; ++r) rli[r] = __builtin_amdgcn_rcpf(wsf[32 + crow(r, hi)]);
    bf16_t* Ow = BR + (size_t)qrow0 * DM + ocol;
    { LAS bf16_t* stg = (LAS bf16_t*)(shm + LDS_OST) + wid * 2048;
#pragma unroll
      for (int r = 0; r < 16; ++r) { const int orow = crow(r, hi);
#pragma unroll
        for (int d0 = 0; d0 < 2; ++d0) stg[orow * 64 + d0 * 32 + r32] = (bf16_t)f2bf(o[d0][r] * rli[r]); }
      asm volatile("s_waitcnt lgkmcnt(0)" ::: "memory");
#pragma unroll
      for (int i = 0; i < 4; ++i) { const int row = i * 8 + (lane >> 3), ch = lane & 7; const u32x4 v = *(const LAS u32x4*)(stg + row * 64 + ch * 8); pg8::st16_wt(Ow + (size_t)row * DM + ch * 8, v); } }
    asm volatile("s_waitcnt lgkmcnt(0)\n\ts_barrier" ::: "memory");
#undef GX_TROW
#undef GX_DMA_K
#undef GX_DMA_V
#undef GX_START
#undef GX_RESC
#undef GX_ROT
#undef GX_PKW
#undef GX_PAF
#undef GX_VFR
#undef GX_PIN
#undef GX_MX3
#undef GX_GAPA
#undef GX_EX
#undef GX_GAPB
#undef GX_VRD
#undef GX_KRD
#undef GX_MFMA
#undef GX_STEP
#undef GX_ENDW
}
}

constexpr int NT_HGRN = 32 * NCH, NT_SSD = 64 * NCH, NT_SCAN = NT_HGRN + NT_SSD;
template <bool PASS_C> __device__ __forceinline__ void scan_tasks(Frame& F, int l, bf16_t* BR) {
    bf16_t* OBA = (bf16_t*)(F.ws + WS_OBA); bf16_t* OBB = (bf16_t*)(F.ws + WS_OBB);
    const int slot = F.wave * F.G + F.bid, nslots = NWAVES * F.G;
#pragma unroll 1
    for (int t = slot; t < NT_SCAN; t += nslots) {
        if (t < NT_HGRN) { const int seq = t / NCH, pc = t % NCH; if (PASS_C && l == 1 && pc == 0) continue;
            hgrn_task<PASS_C>(F, l, seq, pc, seq < 16 ? BR : OBA, seq < 16 ? DM : 256);
        } else { const int t2 = t - NT_HGRN, seq2 = t2 / NCH, pc = t2 % NCH; if (PASS_C && l == 1 && pc == 0) continue;
            ssd_task<PASS_C>(F, l, seq2, pc, seq2 < 32 ? BR + 256 : OBB, seq2 < 32 ? DM : 256);
        }
    }
}
__device__ __forceinline__ void scan_carry(Frame& F) {
    refresh(F);
    bf16_t* STA = (bf16_t*)(F.ws + WS_STA); bf16_t* STB = (bf16_t*)(F.ws + WS_STB);
    const float* DLA = (const float*)(F.ws + WS_DLA); const float* DLB = (const float*)(F.ws + WS_DLB);
    const int gt = F.bid * NTHREADS + F.tid, NGT = F.G * NTHREADS;
    for (int e = gt; e < (32 * 4096 + 64 * 4096) / 2; e += NGT) {
        unsigned kvw[NCH]; float d0[NCH], d1[NCH];
        const bool isA = e < 32 * 2048;
        bf16_t* base;
        if (isA) { const int seq = e >> 11, idx = (e & 2047) * 2; base = STA + (size_t)seq * NCH * 4096 + idx;
            const int k = 32 * (((idx >> 4) & 3) >> 1) + crow(idx & 15, idx >> 11);
#pragma unroll
            for (int pc = 0; pc < NCH; ++pc) { kvw[pc] = *(const unsigned*)(base + (size_t)pc * 4096); const float* dl = DLA + ((size_t)seq * NCH + pc) * 64 + k; d0[pc] = dl[0]; d1[pc] = dl[1]; }
        } else { const int e2 = e - 32 * 2048, seq2 = e2 >> 11, idx = (e2 & 2047) * 2; base = STB + (size_t)seq2 * NCH * 4096 + idx;
#pragma unroll
            for (int pc = 0; pc < NCH; ++pc) { kvw[pc] = *(const unsigned*)(base + (size_t)pc * 4096); d0[pc] = d1[pc] = DLB[(seq2 >> 1) * NCH + pc] * 1.4426950408889634f; }
        }
        float S0 = 0.f, S1 = 0.f;
#pragma unroll
        for (int pc = 0; pc < NCH; ++pc) { const unsigned out = cvtpk(S0, S1);
            S0 = __builtin_amdgcn_exp2f(d0[pc]) * S0 + bflo(kvw[pc]); S1 = __builtin_amdgcn_exp2f(d1[pc]) * S1 + bfhi(kvw[pc]); kvw[pc] = out; }
#pragma unroll
        for (int pc = 0; pc < NCH; ++pc) *(unsigned*)(base + (size_t)pc * 4096) = kvw[pc];
    }
}

template <int STAGE> __device__ __forceinline__ void mixers_phase(Frame& F, int l, bf16_t* BR) {
    refresh(F);
    scan_tasks<STAGE == 2>(F, l, BR);
    refresh(F);
    const int slot = F.wave * F.G + F.bid, nslots = NWAVES * F.G;
    if (STAGE == 0) {
        if (l == 0) {
#pragma unroll 1
            for (int u = nslots - 1 - slot; u < NA_CTX; u += nslots) attn_task<2>(F, l, u, BR); }
        __syncthreads();
#pragma unroll 1
        for (int u = F.bid; u < 256; u += F.G) attn_block_task<1>(F, l, u, BR);
    } else {
        __syncthreads();
#pragma unroll 1
        for (int u = F.bid; u < 256; u += F.G) gx::gqa_unit<8>(F, u, BR);
    }
}

__device__ __forceinline__ void combine_phase(Frame& F, int l, bf16_t* BR, int nrows) {
    refresh(F);
    const bf16_t* MIX = (const bf16_t*)(F.ws + WS_RC);
    const bf16_t* OBA = (const bf16_t*)(F.ws + WS_OBA); const bf16_t* OBB = (const bf16_t*)(F.ws + WS_OBB);
    const int gw = F.bid * NWAVES + F.wave, NGW = F.G * NWAVES;
    const int m0 = gw, m1 = nrows;
    const int c0 = 4 * F.lane, head = F.lane >> 4;
    const f32x4 hw4 = *(const f32x4*)(FIN(8) + l * 256 + c0), sw4 = *(const f32x4*)(FIN(14) + l * 256 + c0); const float dk = FIN(13)[l * 4 + head];
    u32x2 n_of, n_ob, n_ag, n_sf, n_sb, n_zz, n_xc;
#define CB_LOAD(M) do { const size_t m_ = (size_t)(M); const bf16_t* br_ = BR + m_ * DM; const bf16_t* mx_ = MIX + m_ * NMIX; \
        n_of = __builtin_nontemporal_load((const u32x2*)(br_ + c0)); n_ob = __builtin_nontemporal_load((const u32x2*)(OBA + m_ * 256 + c0)); n_ag = __builtin_nontemporal_load((const u32x2*)(mx_ + C_AG + c0)); \
        n_sf = __builtin_nontemporal_load((const u32x2*)(br_ + 256 + c0)); n_sb = __builtin_nontemporal_load((const u32x2*)(OBB + m_ * 256 + c0)); n_zz = __builtin_nontemporal_load((const u32x2*)(mx_ + C_BZ + c0)); n_xc = __builtin_nontemporal_load((const u32x2*)(mx_ + C_BX + c0)); } while (0)
    if (m0 < m1) CB_LOAD(m0);
#pragma unroll 1
    for (int m = m0; m < m1; m += NGW) {
        const u32x2 of = n_of, ob = n_ob, ag = n_ag, sf = n_sf, sb = n_sb, zz = n_zz, xc = n_xc;
        if (m + NGW < m1) CB_LOAD(m + NGW);
        bf16_t* br = BR + (size_t)m * DM;
        { float t0 = bflo(of.x) + bflo(ob.x), t1 = bfhi(of.x) + bfhi(ob.x), t2 = bflo(of.y) + bflo(ob.y), t3 = bfhi(of.y) + bfhi(ob.y);
          float ss = (t0 * t0 + t1 * t1) + (t2 * t2 + t3 * t3);
          ss += dppf_<0xB1, 0xF, true>(ss); ss += dppf_<0x4E, 0xF, true>(ss); ss += dppf_<0x141, 0xF, true>(ss); ss += dppf_<0x140, 0xF, true>(ss);
          const float rs = 1.f / sqrtf(ss * (1.f / 64.f) + LN_EPS);
          u32x2 w; w.x = pk2(t0 * rs * hw4.x * siluf_(bflo(ag.x)), t1 * rs * hw4.y * siluf_(bfhi(ag.x)));
          w.y = pk2(t2 * rs * hw4.z * siluf_(bflo(ag.y)), t3 * rs * hw4.w * siluf_(bfhi(ag.y)));
          wt8a(br + c0, w); }
        { float y0 = (bflo(sf.x) + bflo(sb.x) + bflo(xc.x) * dk) * siluf_(bflo(zz.x));
          float y1 = (bfhi(sf.x) + bfhi(sb.x) + bfhi(xc.x) * dk) * siluf_(bfhi(zz.x));
          float y2 = (bflo(sf.y) + bflo(sb.y) + bflo(xc.y) * dk) * siluf_(bflo(zz.y));
          float y3 = (bfhi(sf.y) + bfhi(sb.y) + bfhi(xc.y) * dk) * siluf_(bfhi(zz.y));
          const float ss = wave_sum((y0 * y0 + y1 * y1) + (y2 * y2 + y3 * y3));
          const float rs = 1.f / sqrtf(ss * (1.f / 256.f) + LN_EPS);
          u32x2 w; w.x = pk2(y0 * rs * sw4.x, y1 * rs * sw4.y); w.y = pk2(y2 * rs * sw4.z, y3 * rs * sw4.w);
          wt8a(br + 256 + c0, w); }
    }
#undef CB_LOAD
}

#define XB_TMO      128
#define XB_XCNT(j)  (256  + 64 * (j))
#define XB_XSUB(j)  (1280 + 64 * (j))
#define XB_XGEN(j)  (2304 + 64 * (j))
#define XB_TOP      3328
#define XB_TOPGEN   3392
#define XCD_BAR_WORDS 3456
#define XB_SPIN_CAP (1u << 18)
__device__ __forceinline__ unsigned xb_ld(unsigned* p)              { return __hip_atomic_load(p, __ATOMIC_RELAXED, __HIP_MEMORY_SCOPE_AGENT); }
__device__ __forceinline__ unsigned xb_add(unsigned* p, unsigned v) { return __hip_atomic_fetch_add(p, v, __ATOMIC_RELAXED, __HIP_MEMORY_SCOPE_AGENT); }
__device__ __forceinline__ unsigned xb_xcc_id() { return (unsigned)__builtin_amdgcn_s_getreg((3 << 11) | 20) & 0xFu; }
#define XB_SPIN(cond, bar) do { unsigned _sp = 0; while (cond) { __builtin_amdgcn_s_sleep(1); \
    if ((++_sp & 255u) == 0u) { if (xb_ld(&(bar)[XB_TMO])) break; if (_sp > XB_SPIN_CAP) { atomicAdd(&(bar)[XB_TMO], 1u); break; } } } } while (0)
struct XcdBarrier { unsigned* bar; unsigned x; volatile LAS unsigned* st; };
__device__ __forceinline__ XcdBarrier xcd_barrier_post(unsigned* bar, volatile LAS unsigned* st, bool t0) {
    XcdBarrier b; b.bar = bar; b.x = xb_xcc_id(); b.st = st;
    if (t0) (void)xb_add(&bar[XB_XCNT(b.x)], 1u);
    return b;
}
__device__ __forceinline__ void xcd_barrier_complete(unsigned* bar, unsigned x, unsigned& nloc, unsigned& nx) {
    const unsigned G = gridDim.x * gridDim.y * gridDim.z;
    unsigned sum, cnt, mine, sp = 0u;
    for (;;) {
        sum = 0u; cnt = 0u; mine = 0u;
#pragma unroll
        for (unsigned j = 0; j < 16; ++j) { const unsigned c = xb_ld(&bar[XB_XCNT(j)]); sum += c; cnt += (c > 0u) ? 1u : 0u; mine = (j == x) ? c : mine; }
        if (sum == G) break;
        __builtin_amdgcn_s_sleep(1);
        if ((++sp & 255u) == 0u) { if (xb_ld(&bar[XB_TMO])) break; if (sp > XB_SPIN_CAP) { atomicAdd(&bar[XB_TMO], 1u); break; } }
    }
    nloc = mine > 0u ? mine : 1u; nx = cnt > 0u ? cnt : 1u;
}
__device__ __forceinline__ void xcd_barrier(const XcdBarrier& b, int wave_s) {
    asm volatile("s_waitcnt vmcnt(0)" ::: "memory");
    __syncthreads();
    int ln_; asm volatile("v_mbcnt_lo_u32_b32 %0, -1, 0\n\tv_mbcnt_hi_u32_b32 %0, -1, %0" : "=v"(ln_));
    if (wave_s == 0 && ln_ == 0) {
        unsigned* bar = b.bar;
        __builtin_amdgcn_s_waitcnt(0);
        unsigned nloc = b.st[0], nx = b.st[1];
        if (nloc == 0u) { xcd_barrier_complete(bar, b.x, nloc, nx); b.st[0] = nloc; b.st[1] = nx; }
        const unsigned old = xb_add(&bar[XB_XSUB(b.x)], 1u);
        const unsigned gen = old / nloc;
        if (old + 1u == (gen + 1u) * nloc) {
            __builtin_amdgcn_fence(__ATOMIC_RELEASE, "agent");
            asm volatile("s_waitcnt vmcnt(0)" ::: "memory");
            const unsigned og = xb_add(&bar[XB_TOP], 1u);
            const unsigned tg = og / nx;
            if (og + 1u == (tg + 1u) * nx) xb_add(&bar[XB_TOPGEN], 1u);
            else XB_SPIN(xb_ld(&bar[XB_TOPGEN]) == tg, bar);
            __builtin_amdgcn_fence(__ATOMIC_ACQUIRE, "agent");
            asm volatile("s_waitcnt vmcnt(0)" ::: "memory");
        } else {
            XB_SPIN(xb_ld(&bar[XB_TOPGEN]) == gen, bar);
            __builtin_amdgcn_fence(__ATOMIC_ACQUIRE, "agent");
            asm volatile("s_waitcnt vmcnt(0)" ::: "memory");
        }
    }
    __syncthreads();
}

#define GSYNC() xcd_barrier(bar, F.wave_s)
#define MODS ((float*)(F.ws + WS_MODS))
#define DT ((float*)(F.ws + WS_DT))
#define XC ((float*)(F.ws + WS_XC))
#define MIX ((bf16_t*)(F.ws + WS_RC))
#define WIN ((const bf16_t*)(F.ws + WS_WIN))
#define WBR ((const bf16_t*)(F.ws + WS_WBR))
#define WOUT ((const bf16_t*)(F.ws + WS_WOUT))
#define WUP ((const bf16_t*)(F.ws + WS_WUP))
#define WDN ((const bf16_t*)(F.ws + WS_WDN))
#define SLABS ((bf16_t*)(F.ws + WS_RC + (size_t)94 * MiB))
template <int l> __device__ __forceinline__ void layer_body(Frame& F, const XcdBarrier& bar) {
        constexpr bool last = (l == DEPTH - 1);
#define H ((bf16_t*)(F.ws + WS_RA))
#define BR ((bf16_t*)(F.ws + WS_RB))
#define mods_l (MODS + (size_t)l * 5 * 6144)
        constexpr int Mpost = last ? MLAT : MALL;
#define xlat (l == 0 ? FIN(0) : ((float*)(F.a->out)))
#define xctx (l == 0 ? FIN(2) : XC)

        { pg8::Gemm g{H, WIN, MALL, NMIX}; pg8::StaticOrder S; S.init(MALL, NMIX, F.G, F.bid);
          pg8::EpiStoreFG E{MIX, NMIX, l == 1 ? FIN(7) : (const float*)nullptr}; pg8::gemm_phase<pg8::EpiStoreFG, DM, DM, DM, 0, 0>(F.lds, g, S, E, tid_from_lds(F.lds, F.wave_s)); }
        GSYNC();
        prep_phase(F, l);
        conv_to_lds(F, l);
        GSYNC();
        conv_from_lds(F);
        GSYNC();
        mixers_phase<0>(F, l, BR);
        GSYNC();
        scan_carry(F);
        GSYNC();
        mixers_phase<2>(F, l, BR);
        GSYNC();
        combine_phase(F, l, BR, Mpost);
        if constexpr (last) convert_weights<1>(F, l);
        GSYNC();
        unsigned* seam34 = (unsigned*)(F.ws + WS_SEAM) + (size_t)(l * 4 + 1) * 68 * 64;
        unsigned* seam45 = (unsigned*)(F.ws + WS_SEAM) + (size_t)(l * 4 + 0) * 68 * 64; unsigned* btmo = (unsigned*)(F.ws + WS_CTL) + XB_TMO;
        { pg8::Gemm g{H, WIN + (size_t)NMIX * DM, Mpost, 4096}; pg8::SeamOrder S; S.init(Mpost, 4096, F.G, F.bid); S.ready = nullptr; S.need = 0u; S.pub = seam34; S.tmo = btmo; S.off1 = -1;
          pg8::EpiGateStore E{MIX}; pg8::gemm_phase<pg8::EpiGateStore, DM, DM, DM, 0, 0, pg8::SeamOrder>(F.lds, g, S, E, tid_from_lds(F.lds, F.wave_s)); }
        if constexpr (!last) convert_weights<1>(F, l, 96, F.G - 96);
        { pg8::Gemm g{BR, WBR, Mpost, DM}; pg8::SeamOrder S; S.init(Mpost, DM, F.G, F.bid); S.ready = seam34; S.need = 128u; S.pub = seam45; S.tmo = btmo; S.off1 = last ? -1 : 64;
          pg8::EpiHorner E{MIX, H}; pg8::gemm_phase<pg8::EpiHorner, DM, DM, DM, 0, 0, pg8::SeamOrder, 256>(F.lds, g, S, E, tid_from_lds(F.lds, F.wave_s)); }
        { pg8::Gemm g{H, WOUT, Mpost, DM}; pg8::SeamOrder S; S.init(Mpost, DM, F.G, F.bid); S.ready = seam45; S.need = 32u; S.pub = nullptr; S.tmo = btmo; S.off1 = last ? -1 : 80;
          pg8::EpiStore E{BR, DM}; pg8::gemm_phase<pg8::EpiStore, DM, DM, DM, 0, 0, pg8::SeamOrder>(F.lds, g, S, E, tid_from_lds(F.lds, F.wave_s)); }
        GSYNC();
        {
            RowOp R{}; R.nrows = Mpost; R.xlat_in = xlat; R.xctx_in = xctx; R.post = true; R.Y = BR; R.gate_chunk = 2; R.lng = FIN(20) + l * DM; R.lnb = FIN(21) + l * DM; R.mods_post = mods_l;
            R.xlat_out = ((float*)(F.a->out)); R.xctx_out = XC; R.domod = true; R.mods_mod = mods_l; R.shift_chunk = 3; R.scale_chunk = 4; R.Hout = H; R.dodt = false; R.DTout = DT;
            row_pass(F, R, FIN(6));
        }
        GSYNC();
        { pg8::Gemm g{H, WUP, Mpost, 2 * FFH}; pg8::StaticOrder S; S.init(Mpost, 2 * FFH, F.G, F.bid);
          pg8::EpiSwiGLU E{MIX, FFH}; pg8::gemm_phase<pg8::EpiSwiGLU, DM, DM, DM, 0, 0>(F.lds, g, S, E, tid_from_lds(F.lds, F.wave_s)); }
        GSYNC();
        { pg8::Gemm g{MIX, WDN, MLAT, DM}; pg8::StaticOrder S; S.init(MLAT, DM, F.G, F.bid);
          pg8::EpiStore E{BR, DM}; pg8::gemm_phase<pg8::EpiStore, FFH, FFH, FFH, 0, 0>(F.lds, g, S, E, tid_from_lds(F.lds, F.wave_s)); }
        if (!last) {
          pg8::Gemm g{MIX, WDN, MALL, DM}; pg8::SplitOrder S; S.init(MCTX / 256, DM / 256, FFH / 256, MLAT / 256, F.G, F.bid);
          pg8::EpiSlab E{SLABS, MLAT / 256, MCTX}; pg8::gemm_phase<pg8::EpiSlab, 256, FFH, FFH, 0, 0, pg8::SplitOrder>(F.lds, g, S, E, tid_from_lds(F.lds, F.wave_s)); }
        GSYNC();
        {
            RowOp R{}; R.nrows = Mpost; R.xlat_in = ((float*)(F.a->out)); R.xctx_in = XC; R.post = true; R.Y = BR; R.slabs = SLABS; R.nslab = last ? 0 : FFH / 256; R.slab_row0 = MLAT; R.gate_chunk = 5; R.lng = FIN(24) + l * DM; R.lnb = FIN(25) + l * DM; R.mods_post = mods_l;
            R.xlat_out = ((float*)(F.a->out)); R.xctx_out = XC; R.domod = !last; R.mods_mod = MODS + (size_t)(l + 1) * 5 * 6144; R.shift_chunk = 0; R.scale_chunk = 1; R.Hout = H; R.dodt = !last; R.DTout = DT;
            row_pass(F, R, FIN(6) + (size_t)(last ? l : l + 1) * DM * INC);
            if (!last) { convert_weights<0>(F, l + 1); GSYNC(); }
        }
}

__global__ void __launch_bounds__(NTHREADS, 2) fwd_megakernel(Args args) {
    extern __shared__ __attribute__((aligned(16))) unsigned char lds_raw[];
    Frame F;
    F.lds = (LAS unsigned char*)lds_raw;
    F.G = gridDim.x; F.bid = blockIdx.x; F.a = &args; F.ws = args.ws; F.ws0 = args.ws;
    { const int t0 = threadIdx.x; F.wave_s = __builtin_amdgcn_readfirstlane(t0 >> 6);
      *(LAS int*)(F.lds + TIDTAB_OFF + t0 * 4) = t0;
      volatile LAS unsigned* bst0 = (volatile LAS unsigned*)(F.lds + 8 * WLDS); if (t0 < 2) bst0[t0] = 0u; }
    __syncthreads();
    refresh(F);
    volatile LAS unsigned* bst = (volatile LAS unsigned*)(F.lds + 8 * WLDS);
    const XcdBarrier bar = xcd_barrier_post((unsigned*)(F.ws + WS_CTL), bst, F.tid == 0);

    mods_phase(F);
    convert_weights<0>(F, 0);
    GSYNC();
    {
        RowOp R{}; R.nrows = MALL; R.xlat_in = FIN(0); R.xctx_in = FIN(2); R.post = false; R.domod = true; R.mods_mod = MODS; R.shift_chunk = 0; R.scale_chunk = 1;
        R.Hout = (bf16_t*)(F.ws + WS_RA); R.dodt = true; R.DTout = DT;
        row_pass(F, R, FIN(6));
    }
    GSYNC();

    layer_body<0>(F, bar);
    layer_body<1>(F, bar);
}

extern "C" void kernel_launch(void* const* d_in, const int* in_sizes, int n_in, void* d_out, int out_size, void* d_ws, size_t ws_size, hipStream_t stream) {
    static int grid = 0;
    if (grid == 0) {
        if (n_in != 26 || out_size != MLAT * DM || ws_size < WS_END) { fprintf(stderr, "kernel_launch: unexpected shapes (n_in %d out %d ws %zu)\n", n_in, out_size, ws_size); grid = -1; return; }
        int dev = 0, cus = 0, per_cu = 0;
        hipGetDevice(&dev); hipDeviceGetAttribute(&cus, hipDeviceAttributeMultiprocessorCount, dev);
        hipFuncSetAttribute((const void*)fwd_megakernel, hipFuncAttributeMaxDynamicSharedMemorySize, LDS_BYTES);
        hipOccupancyMaxActiveBlocksPerMultiprocessor(&per_cu, (const void*)fwd_megakernel, NTHREADS, LDS_BYTES);
        if (per_cu < 1) { fprintf(stderr, "kernel_launch: occupancy query says %d\n", per_cu); per_cu = 1; }
        (void)hipGetLastError();
        grid = cus * 1;
    }
    if (grid < 0) return;
    if (hipMemsetAsync((char*)d_ws + WS_CTL, 0, CTL_ZERO_BYTES, stream) != hipSuccess) { fprintf(stderr, "kernel_launch: memset failed\n"); return; }
    Args a{};
    for (int i = 0; i < 26; ++i) a.in[i] = (GAS const float*)d_in[i];
    a.out = (GAS float*)d_out; a.ws = (GAS unsigned char*)d_ws;
    hipLaunchKernelGGL(fwd_megakernel, dim3(grid), dim3(NTHREADS), LDS_BYTES, stream, a);
    hipError_t e = hipPeekAtLastError();
    if (e != hipSuccess) fprintf(stderr, "launch failed: %s (grid %d)\n", hipGetErrorString(e), grid);
}
```

```cpp
#include <hip/hip_runtime.h>
#include <cstdio>
#include <cstdint>

#define LAS __attribute__((address_space(3)))
typedef unsigned short bf16_t;
typedef short bf16x8 __attribute__((ext_vector_type(8)));
typedef float f32x4 __attribute__((ext_vector_type(4)));
typedef unsigned u32x4 __attribute__((ext_vector_type(4)));
typedef unsigned u32x2 __attribute__((ext_vector_type(2)));

constexpr int DM = 1024, NB = 4, SEQ = 4096, CTXL = 256, DEPTH = 2;
constexpr int MLAT = NB * SEQ;
constexpr int MCTX = NB * CTXL;
constexpr int MALL = MLAT + MCTX;
constexpr int INC = 7688;
constexpr int NMIX = 3584;
constexpr int FFH = 2816;
constexpr float LN_EPS = 1e-6f;
constexpr float ALPHA = 1.4142135623730951f;
constexpr int C_AQ = 0, C_AFF = 256, C_AFB = 512, C_AV = 768, C_AG = 1024, C_BZ = 1280, C_BX = 1536, C_BB = 1792, C_BC = 2048,
              C_CQ = 2304, C_CK = 2560, C_CV = 2816, C_DQ = 3072, C_DK = 3328, C_DV = 3456;

constexpr size_t MiB = 1u << 20;
constexpr size_t WS_CTL = 0, CTL_ZERO_BYTES = 32768 + 8 * 68 * 256;
constexpr size_t WS_SEAM = 32768;
constexpr size_t WS_MODS = 1 * MiB;
constexpr size_t WS_DT = 2 * MiB;
constexpr size_t WS_XC = 3 * MiB;
constexpr size_t WS_WIN = 8 * MiB;
constexpr size_t WS_WBR = 23 * MiB;
constexpr size_t WS_WOUT = 25 * MiB;
constexpr size_t WS_WUP = 33 * MiB;
constexpr size_t WS_WDN = 44 * MiB;
constexpr size_t WS_RA = 50 * MiB;
constexpr size_t WS_RB = 84 * MiB;
constexpr size_t WS_RC = 118 * MiB;
constexpr size_t WS_OBA = WS_RC + 119 * MiB;
constexpr size_t WS_OBB = WS_OBA + 17 * MiB / 2;
constexpr size_t WS_END = 254 * MiB;
constexpr size_t WS_STA = 33 * MiB;
constexpr size_t WS_STB = WS_STA + (size_t)32 * 17 * 4096 * 2;
constexpr size_t WS_DLA = 46 * MiB;
constexpr size_t WS_DLB = 47 * MiB;
static_assert(WS_STB + (size_t)64 * 17 * 4096 * 2 <= WS_DLA, "scan state map");

constexpr int NWAVES = 8, NTHREADS = 512;
constexpr int LDS_BYTES = 155648 + 64 + 2048;
constexpr int WLDS = 19456;

__device__ __forceinline__ float bf2f(unsigned u) { return __uint_as_float(u << 16); }
__device__ __forceinline__ float bflo(unsigned w) { return __uint_as_float(w << 16); }
__device__ __forceinline__ float bfhi(unsigned w) { return __uint_as_float(w & 0xffff0000u); }
__device__ __forceinline__ unsigned f2bf(float f) { unsigned u = __float_as_uint(f); return (u + 0x7fffu + ((u >> 16) & 1u)) >> 16; }
__device__ __forceinline__ unsigned pk2(float lo, float hi) { return f2bf(lo) | (f2bf(hi) << 16); }
__device__ __forceinline__ float sigmoidf_(float x) { return __builtin_amdgcn_rcpf(1.f + __expf(-x)); }
__device__ __forceinline__ float siluf_(float x) { return x * sigmoidf_(x); }
template <int CTRL, int RMASK, bool BC> __device__ __forceinline__ float dppf_(float v) { return __int_as_float(__builtin_amdgcn_update_dpp(0, __float_as_int(v), CTRL, RMASK, 0xF, BC)); }
__device__ __forceinline__ float wave_sum(float v) {
    v += dppf_<0xB1, 0xF, true>(v);
    v += dppf_<0x4E, 0xF, true>(v);
    v += dppf_<0x141, 0xF, true>(v);
    v += dppf_<0x140, 0xF, true>(v);
    v += dppf_<0x142, 0xA, false>(v);
    v += dppf_<0x143, 0xC, false>(v);
    return __int_as_float(__builtin_amdgcn_readlane(__float_as_int(v), 63));
}
#define LDS_WAIT() asm volatile("s_waitcnt lgkmcnt(0)" ::: "memory")

__device__ __forceinline__ void wt8a(void* p, u32x2 v) { __hip_atomic_store((unsigned long long*)p, ((unsigned long long)v.y << 32) | v.x, __ATOMIC_RELAXED, __HIP_MEMORY_SCOPE_AGENT); }

namespace pg8 {
constexpr int BM = 256, BK = 64, HALF = 128, HTB = HALF * BK * 2, STAGE_BYTES = 8 * HTB, NXCD = 8, WGM = 8;
__host__ __device__ __forceinline__ int lds_byte(int r, int c) { const int st = (r >> 4) * 2 + (c >> 5), rr = r & 15, cc = c & 31, ob = rr * 64 + cc * 2; return st * 1024 + (ob ^ (((ob >> 9) & 1) << 5)); }
__host__ __device__ __forceinline__ void stage_rc(int b, int& R, int& C) { const int st = b / 1024, sb = b % 1024, swz = sb ^ (((sb >> 9) & 1) << 5); R = (st >> 1) * 16 + swz / 64; C = (st & 1) * 32 + (swz % 64) / 2; }
__host__ __device__ __forceinline__ int perm32(int rho) { const int n = rho >> 4, i = rho & 15; return 8 * (i >> 2) + 4 * n + (i & 3); }

struct Unit { int pm, pn, kc; };
struct Gemm { const bf16_t* A; const bf16_t* Bt; int M, N; };

__device__ __forceinline__ void st16_wt(void* p, u32x4 v) { asm volatile("global_store_dwordx4 %0, %1, off sc1\n\ts_nop 1" :: "v"(p), "v"(v) : "memory"); }
struct StaticOrder {
    __device__ __forceinline__ void a_ready(const Unit&, int, int) const {}
    __device__ __forceinline__ void done(const Unit&, int) const {}
    int nM, nN, nwg, G, c;
    __device__ void init(int M, int N, int G_, int c_) { nM = M / BM; nN = N / BM; nwg = nM * nN; G = G_; c = c_; }
    __device__ bool next(int i, Unit& u) const { return unit_of((long)i * G + c, u); }
    __device__ bool unit_of(long L, Unit& u) const {
        if (L >= nwg) return false;
        int wgid = (int)L; { const int q = nwg / NXCD, r = nwg % NXCD, xcd = wgid % NXCD, off = wgid / NXCD; wgid = (xcd < r ? xcd * (q + 1) : r * (q + 1) + (xcd - r) * q) + off; }
        const int nig = WGM * nN, gid = wgid / nig, fm = gid * WGM, gsz = (nM - fm) < WGM ? (nM - fm) : WGM;
        u.pm = fm + ((wgid % nig) % gsz); u.pn = (wgid % nig) / gsz; u.kc = 0; return true;
    }
};

struct SeamOrder : StaticOrder {
    const unsigned* ready; unsigned need; unsigned* pub; unsigned* tmo;
    int off1;
    __device__ bool next(int i, Unit& u) const {
        if (off1 < 0) return StaticOrder::next(i, u);
        if (i == 0) return unit_of(c, u);
        if (i > 1) return false;
        const int e = c - off1; if (e < 0 || e >= nwg - G) return false;
        return unit_of((long)G + e, u); }
    __device__ __forceinline__ void a_ready(const Unit& u, int wid, int lane) const {
        if (ready == nullptr) return;
        if (wid == 0) {
            unsigned sp = 0u;
            while ((unsigned)__builtin_amdgcn_readfirstlane(__hip_atomic_load(ready + 64 * u.pm, __ATOMIC_RELAXED, __HIP_MEMORY_SCOPE_AGENT)) < need) {
                __builtin_amdgcn_s_sleep(2);
                if ((++sp & 255u) == 0u) { if (__builtin_amdgcn_readfirstlane(__hip_atomic_load(tmo, __ATOMIC_RELAXED, __HIP_MEMORY_SCOPE_AGENT)) != 0u) break; if (sp > (1u << 18)) { if (lane == 0) atomicAdd(tmo, 1u); break; } } }
            __builtin_amdgcn_fence(__ATOMIC_ACQUIRE, "agent");
            asm volatile("s_waitcnt vmcnt(0)" ::: "memory");
        }
        asm volatile("" ::: "memory"); __builtin_amdgcn_s_barrier(); asm volatile("" ::: "memory");
    }
    __device__ __forceinline__ void done(const Unit& u, int lane) const {
        if (pub == nullptr) return;
        asm volatile("s_waitcnt vmcnt(0)" ::: "memory");
        if (lane == 0) (void)__hip_atomic_fetch_add(pub + 64 * u.pm, 1u, __ATOMIC_RELAXED, __HIP_MEMORY_SCOPE_AGENT);
    }
};
struct SplitOrder {
    __device__ __forceinline__ void a_ready(const Unit&, int, int) const {}
    __device__ __forceinline__ void done(const Unit&, int) const {}
    int nsub, G, c, nkc, nn, pm0;
    __device__ void init(int ntiles_m, int nn_, int nkc_, int pm0_, int G_, int c_) { nn = nn_; nkc = nkc_; pm0 = pm0_; nsub = ntiles_m * nn_ * nkc_; G = G_; c = c_; }
    __device__ bool next(int i, Unit& u) const { const int L = i * G + c; if (L >= nsub) return false; const int tile = L / nkc; u.kc = L % nkc; u.pm = pm0 + tile / nn; u.pn = tile % nn; return true; }
};
struct GroupOrder {
    int ngrp, G, c;
    __device__ void init(int M, int G_, int c_) { ngrp = (M / BM) * 4; G = G_; c = c_; }
    __device__ bool next(int i, Unit& u) const { const int grp = (i >> 2) * G + c; if (grp >= ngrp) return false; u.pm = grp >> 2; u.pn = 4 * (i & 3) + (grp & 3); u.kc = 0; return true; }
};
typedef float f32x2c_t __attribute__((ext_vector_type(2))); typedef __bf16 bf16x2c_t __attribute__((ext_vector_type(2)));
__device__ __forceinline__ unsigned cvt_pk_bf16(float lo, float hi) { f32x2c_t v = {lo, hi}; bf16x2c_t b = __builtin_convertvector(v, bf16x2c_t); return __builtin_bit_cast(unsigned, b); }

struct EpiStore {
    bf16_t* O; int ldc;
    __device__ __forceinline__ void operator()(const f32x4 (&acc)[2][2][4][2], const Unit& u, int wr, int wc, int fr, int fq) const {
        const int row0 = u.pm * BM + wr * 64 + fr; const int col0 = u.pn * BM + wc * 32 + 8 * fq;
#pragma unroll
        for (int ai = 0; ai < 2; ++ai)
#pragma unroll
            for (int m = 0; m < 4; ++m) { bf16_t* rowp = O + (size_t)(row0 + ai * HALF + m * 16) * ldc + col0;
#pragma unroll
                for (int bj = 0; bj < 2; ++bj) { const f32x4 v0 = acc[ai][bj][m][0], v1 = acc[ai][bj][m][1];
                    u32x4 w; w.x = cvt_pk_bf16(v0[0], v0[1]); w.y = cvt_pk_bf16(v0[2], v0[3]); w.z = cvt_pk_bf16(v1[0], v1[1]); w.w = cvt_pk_bf16(v1[2], v1[3]);
                    st16_wt((rowp + bj * HALF), w); } }
    }
};
struct EpiStoreFG {
    bf16_t* O; int ldc; const float* lbp;
    __device__ __forceinline__ void operator()(const f32x4 (&acc)[2][2][4][2], const Unit& u, int wr, int wc, int fr, int fq) const {
        const int row0 = u.pm * BM + wr * 64 + fr; const int col0 = u.pn * BM + wc * 32 + 8 * fq;
        const bool isg = (u.pn == 1) || (u.pn == 2);
        float lb[2][8];
#pragma unroll
        for (int bj = 0; bj < 2; ++bj)
#pragma unroll
            for (int j = 0; j < 8; ++j) lb[bj][j] = 0.f;
        if (isg && lbp) { const float* p = lbp + (u.pn - 1) * 512 + wc * 32 + 8 * fq;
#pragma unroll
            for (int bj = 0; bj < 2; ++bj)
#pragma unroll
                for (int j = 0; j < 8; ++j) lb[bj][j] = __builtin_amdgcn_rcpf(1.f + __expf(p[bj * HALF + j] - p[256 + bj * HALF + j])); }
#pragma unroll
        for (int ai = 0; ai < 2; ++ai)
#pragma unroll
            for (int m = 0; m < 4; ++m) { bf16_t* rowp = O + (size_t)(row0 + ai * HALF + m * 16) * ldc + col0;
#pragma unroll
                for (int bj = 0; bj < 2; ++bj) { f32x4 v0 = acc[ai][bj][m][0], v1 = acc[ai][bj][m][1];
                    if (isg) {
#pragma unroll
                        for (int j = 0; j < 4; ++j) { v0[j] = fmaxf(__log2f(lb[bj][j] + (1.f - lb[bj][j]) * sigmoidf_(v0[j])), -126.f); v1[j] = fmaxf(__log2f(lb[bj][4 + j] + (1.f - lb[bj][4 + j]) * sigmoidf_(v1[j])), -126.f); } }
                    u32x4 w; w.x = cvt_pk_bf16(v0[0], v0[1]); w.y = cvt_pk_bf16(v0[2], v0[3]); w.z = cvt_pk_bf16(v1[0], v1[1]); w.w = cvt_pk_bf16(v1[2], v1[3]);
                    st16_wt((rowp + bj * HALF), w); } }
    }
};
struct EpiGateMul {
    bf16_t* O; int ldc;
    __device__ __forceinline__ void operator()(const f32x4 (&acc)[2][2][4][2], const Unit& u, int wr, int wc, int fr, int fq) const {
        const int row0 = u.pm * BM + wr * 64 + fr; const int col0 = u.pn * BM + wc * 32 + 8 * fq;
#pragma unroll
        for (int ai = 0; ai < 2; ++ai)
#pragma unroll
            for (int m = 0; m < 4; ++m) { bf16_t* rowp = O + (size_t)(row0 + ai * HALF + m * 16) * ldc + col0;
#pragma unroll
                for (int bj = 0; bj < 2; ++bj) { const f32x4 v0 = acc[ai][bj][m][0], v1 = acc[ai][bj][m][1];
                    const u32x4 g = *(const u32x4*)(rowp + bj * HALF);
                    u32x4 w;
                    w.x = cvt_pk_bf16(v0[0] * sigmoidf_(bflo(g.x)), v0[1] * sigmoidf_(bfhi(g.x)));
                    w.y = cvt_pk_bf16(v0[2] * sigmoidf_(bflo(g.y)), v0[3] * sigmoidf_(bfhi(g.y)));
                    w.z = cvt_pk_bf16(v1[0] * sigmoidf_(bflo(g.z)), v1[1] * sigmoidf_(bfhi(g.z)));
                    w.w = cvt_pk_bf16(v1[2] * sigmoidf_(bflo(g.w)), v1[3] * sigmoidf_(bfhi(g.w)));
                    st16_wt((rowp + bj * HALF), w); } }
    }
};
__device__ __forceinline__ size_t gate_frag_off(int pm, int pn16, int ai, int m, int bj, int tid) { return ((size_t)(pm * 16 + pn16) << 16) + (size_t)((((ai * 4 + m) * 2 + bj) * 512 + tid) * 8); }
struct EpiGateStore {
    bf16_t* G;
    __device__ __forceinline__ void operator()(const f32x4 (&acc)[2][2][4][2], const Unit& u, int wr, int wc, int fr, int fq) const {
        const int tid = (wr * 4 + wc) * 64 + fq * 16 + fr;
#pragma unroll
        for (int ai = 0; ai < 2; ++ai)
#pragma unroll
            for (int m = 0; m < 4; ++m)
#pragma unroll
                for (int bj = 0; bj < 2; ++bj) { const f32x4 v0 = acc[ai][bj][m][0], v1 = acc[ai][bj][m][1];
                    u32x4 w; w.x = cvt_pk_bf16(sigmoidf_(v0[0]), sigmoidf_(v0[1])); w.y = cvt_pk_bf16(sigmoidf_(v0[2]), sigmoidf_(v0[3]));
                    w.z = cvt_pk_bf16(sigmoidf_(v1[0]), sigmoidf_(v1[1])); w.w = cvt_pk_bf16(sigmoidf_(v1[2]), sigmoidf_(v1[3]));
                    st16_wt((G + gate_frag_off(u.pm, u.pn, ai, m, bj, tid)), w); }
    }
};
struct EpiGateAcc {
    const bf16_t* GATE; bf16_t* O;
    __device__ __forceinline__ void operator()(const f32x4 (&acc)[2][2][4][2], const Unit& u, int wr, int wc, int fr, int fq) const {
        const int row0 = u.pm * BM + wr * 64 + fr; const int colo = (u.pn & 3) * BM + wc * 32 + 8 * fq; const bool first = (u.pn < 4); const int tid = (wr * 4 + wc) * 64 + fq * 16 + fr;
#pragma unroll
        for (int ai = 0; ai < 2; ++ai)
#pragma unroll
            for (int m = 0; m < 4; ++m) { const size_t r = (size_t)(row0 + ai * HALF + m * 16); bf16_t* op = O + r * 1024 + colo;
#pragma unroll
                for (int bj = 0; bj < 2; ++bj) { const f32x4 v0 = acc[ai][bj][m][0], v1 = acc[ai][bj][m][1];
                    const u32x4 g = *(const u32x4*)(GATE + gate_frag_off(u.pm, u.pn, ai, m, bj, tid));
                    u32x4 p = (u32x4){0u, 0u, 0u, 0u}; if (!first) p = *(const u32x4*)(op + bj * HALF);
                    u32x4 w;
                    w.x = cvt_pk_bf16(bflo(p.x) + v0[0] * bflo(g.x), bfhi(p.x) + v0[1] * bfhi(g.x));
                    w.y = cvt_pk_bf16(bflo(p.y) + v0[2] * bflo(g.y), bfhi(p.y) + v0[3] * bfhi(g.y));
                    w.z = cvt_pk_bf16(bflo(p.z) + v1[0] * bflo(g.z), bfhi(p.z) + v1[1] * bfhi(g.z));
                    w.w = cvt_pk_bf16(bflo(p.w) + v1[2] * bflo(g.w), bfhi(p.w) + v1[3] * bfhi(g.w));
                    st16_wt((op + bj * HALF), w); } }
    }
};
struct EpiHorner {
    const bf16_t* GATE; bf16_t* O;
    static __device__ __forceinline__ float ratio_(float ga, float gb) { return ga * __builtin_amdgcn_rcpf(fmaxf(gb, 1e-30f)); }
    __device__ __forceinline__ void mid(f32x4 (&acc)[2][2][4][2], const Unit& u, int wr, int wc, int fr, int fq, int nb) const {
        const int tid = (wr * 4 + wc) * 64 + fq * 16 + fr;
        typedef __attribute__((address_space(1))) const u32x4 gu32x4;
        const gu32x4* ga = (const gu32x4*)(GATE + gate_frag_off(u.pm, nb * 4 + u.pn, 0, 0, 0, tid));
        const gu32x4* gb = (const gu32x4*)(GATE + gate_frag_off(u.pm, (nb + 1) * 4 + u.pn, 0, 0, 0, tid));
#pragma unroll
        for (int ai = 0; ai < 2; ++ai) {
            u32x4 a[8], b[8];
#pragma unroll
            for (int p = 0; p < 8; ++p) { a[p] = ga[(ai * 8 + p) * 512]; b[p] = gb[(ai * 8 + p) * 512]; }
            asm volatile("" ::: "memory");
#pragma unroll
            for (int m = 0; m < 4; ++m)
#pragma unroll
                for (int bj = 0; bj < 2; ++bj) { const u32x4 av = a[m * 2 + bj], bv = b[m * 2 + bj];
                    f32x4& v0 = acc[ai][bj][m][0]; f32x4& v1 = acc[ai][bj][m][1];
                    v0[0] *= ratio_(bflo(av.x), bflo(bv.x)); v0[1] *= ratio_(bfhi(av.x), bfhi(bv.x)); v0[2] *= ratio_(bflo(av.y), bflo(bv.y)); v0[3] *= ratio_(bfhi(av.y), bfhi(bv.y));
                    v1[0] *= ratio_(bflo(av.z), bflo(bv.z)); v1[1] *= ratio_(bfhi(av.z), bfhi(bv.z)); v1[2] *= ratio_(bflo(av.w), bflo(bv.w)); v1[3] *= ratio_(bfhi(av.w), bfhi(bv.w)); }
        }
    }
    __device__ __forceinline__ void operator()(const f32x4 (&acc)[2][2][4][2], const Unit& u, int wr, int wc, int fr, int fq) const {
        const int row0 = u.pm * BM + wr * 64 + fr; const int col0 = u.pn * BM + wc * 32 + 8 * fq; const int tid = (wr * 4 + wc) * 64 + fq * 16 + fr;
        typedef __attribute__((address_space(1))) const u32x4 gu32x4;
        const gu32x4* gg = (const gu32x4*)(GATE + gate_frag_off(u.pm, 12 + u.pn, 0, 0, 0, tid));
#pragma unroll
        for (int ai = 0; ai < 2; ++ai) {
            u32x4 g[8];
#pragma unroll
            for (int p = 0; p < 8; ++p) g[p] = gg[(ai * 8 + p) * 512];
            asm volatile("" ::: "memory");
#pragma unroll
            for (int m = 0; m < 4; ++m) { bf16_t* op = O + (size_t)(row0 + ai * HALF + m * 16) * 1024 + col0;
#pragma unroll
                for (int bj = 0; bj < 2; ++bj) { const f32x4 v0 = acc[ai][bj][m][0], v1 = acc[ai][bj][m][1]; const u32x4 gv = g[m * 2 + bj];
                    u32x4 w;
                    w.x = cvt_pk_bf16(v0[0] * bflo(gv.x), v0[1] * bfhi(gv.x)); w.y = cvt_pk_bf16(v0[2] * bflo(gv.y), v0[3] * bfhi(gv.y));
                    w.z = cvt_pk_bf16(v1[0] * bflo(gv.z), v1[1] * bfhi(gv.z)); w.w = cvt_pk_bf16(v1[2] * bflo(gv.w), v1[3] * bfhi(gv.w));
                    st16_wt((op + bj * HALF), w); } }
        }
    }
};
struct EpiSlab {
    bf16_t* S; int pm0, rows;
    __device__ __forceinline__ void operator()(const f32x4 (&acc)[2][2][4][2], const Unit& u, int wr, int wc, int fr, int fq) const {
        const int row0 = (u.pm - pm0) * BM + wr * 64 + fr; const int col0 = u.pn * BM + wc * 32 + 8 * fq; bf16_t* base = S + (size_t)u.kc * rows * 1024;
#pragma unroll
        for (int ai = 0; ai < 2; ++ai)
#pragma unroll
            for (int m = 0; m < 4; ++m) { bf16_t* rowp = base + (size_t)(row0 + ai * HALF + m * 16) * 1024 + col0;
#pragma unroll
                for (int bj = 0; bj < 2; ++bj) { const f32x4 v0 = acc[ai][bj][m][0], v1 = acc[ai][bj][m][1];
                    u32x4 w; w.x = cvt_pk_bf16(v0[0], v0[1]); w.y = cvt_pk_bf16(v0[2], v0[3]); w.z = cvt_pk_bf16(v1[0], v1[1]); w.w = cvt_pk_bf16(v1[2], v1[3]);
                    st16_wt((rowp + bj * HALF), w); } }
    }
};
struct EpiSwiGLU {
    bf16_t* O; int ldc;
    __device__ __forceinline__ void operator()(const f32x4 (&acc)[2][2][4][2], const Unit& u, int wr, int wc, int fr, int fq) const {
        const int row0 = u.pm * BM + wr * 64 + fr; const int col0 = u.pn * HALF + wc * 32 + 8 * fq;
#pragma unroll
        for (int ai = 0; ai < 2; ++ai)
#pragma unroll
            for (int m = 0; m < 4; ++m) { bf16_t* rowp = O + (size_t)(row0 + ai * HALF + m * 16) * ldc + col0;
                const f32x4 g0 = acc[ai][0][m][0], g1 = acc[ai][0][m][1], u0 = acc[ai][1][m][0], u1 = acc[ai][1][m][1];
                u32x4 w;
                w.x = cvt_pk_bf16(siluf_(g0[0]) * u0[0], siluf_(g0[1]) * u0[1]); w.y = cvt_pk_bf16(siluf_(g0[2]) * u0[2], siluf_(g0[3]) * u0[3]);
                w.z = cvt_pk_bf16(siluf_(g1[0]) * u1[0], siluf_(g1[1]) * u1[1]); w.w = cvt_pk_bf16(siluf_(g1[2]) * u1[2], siluf_(g1[3]) * u1[3]);
                st16_wt(rowp, w); }
    }
};

template <class Epi, int K, int LDA, int LDB, int ADIV, int ACOLS, class Sched = StaticOrder, int MIDK = 0, bool ALIGN_EPI = true>
__device__ __forceinline__ void gemm_phase(LAS unsigned char* lds, const Gemm g, const Sched& S, const Epi& E, int tid_) {
    const int tid = tid_, wid = __builtin_amdgcn_readfirstlane(tid >> 6), lane = tid & 63, wr = wid >> 2, wc = wid & 3, fr = lane & 15, fq = lane >> 4;
    constexpr int nt = K / BK;
    unsigned voffA, voffB;
    { int R, C; stage_rc(tid * 16, R, C); const int Rb = (R & ~31) + perm32(R & 31); voffA = (unsigned)(R * LDA + C) * 2u; voffB = (unsigned)(Rb * LDB + C) * 2u; }
    constexpr size_t p1offA = (size_t)64 * LDA * 2, p1offB = (size_t)64 * LDB * 2;
    constexpr size_t kstep = (size_t)(BK * 2);
    constexpr size_t hstepA = (size_t)HALF * LDA * 2, hstepB = (size_t)HALF * LDB * 2;
    constexpr size_t tstepA = 2 * hstepA, tstepB = 2 * hstepB;
    const unsigned ldsw = (unsigned)wid * 1024u;
    const int aoff = lds_byte(wr * 64 + fr, fq * 8), boff = lds_byte(wc * 32 + fr, fq * 8);
#define PG8_SA(b, h) (((b) * 2 + (h)) * HTB)
#define PG8_SB(b, h) ((4 + (b) * 2 + (h)) * HTB)
#define PG8_STAGE(bufoff, gbase, voff) do { _Pragma("unroll") for (int _i = 0; _i < 2; ++_i) \
        __builtin_amdgcn_global_load_lds((const unsigned*)((const char*)(gbase) + _i * p1##voff + (v##voff)), (LAS unsigned*)(lds + (bufoff) + ldsw + _i * 8192), 16, 0, 0); } while (0)
#define PG8_LDA(dst, b, h) do { _Pragma("unroll") for (int m = 0; m < 4; ++m) _Pragma("unroll") for (int k = 0; k < 2; ++k) dst[m][k] = *(const LAS bf16x8*)(lds + PG8_SA(b, h) + aoff + m * 2048 + k * 1024); } while (0)
#define PG8_LDB(dst, b, h) do { _Pragma("unroll") for (int n = 0; n < 2; ++n) _Pragma("unroll") for (int k = 0; k < 2; ++k) dst[n][k] = *(const LAS bf16x8*)(lds + PG8_SB(b, h) + boff + n * 2048 + k * 1024); } while (0)
#define PG8_MMA(ai, bj, At, Bt) do { __builtin_amdgcn_s_setprio(1); _Pragma("unroll") for (int m = 0; m < 4; ++m) _Pragma("unroll") for (int n = 0; n < 2; ++n) _Pragma("unroll") for (int k = 0; k < 2; ++k) \
        acc[ai][bj][m][n] = __builtin_amdgcn_mfma_f32_16x16x32_bf16(Bt[n][k], At[m][k], acc[ai][bj][m][n], 0, 0, 0); __builtin_amdgcn_s_setprio(0); } while (0)
#define PG8_WAIT_V(n) asm volatile("s_waitcnt vmcnt(" #n ")" ::: "memory")
#define PG8_WAIT_L(n) asm volatile("s_waitcnt lgkmcnt(" #n ")" ::: "memory")
#define PG8_BAR __builtin_amdgcn_s_barrier()
#define PG8_SCHED __builtin_amdgcn_sched_barrier(0)
#define PG8_ACOL(pn) (ADIV ? (size_t)(((pn) / (ADIV ? ADIV : 1)) * ACOLS) * 2 : (size_t)0)
    Unit cur, nxt; int ui = 0;
    if (!S.next(0, cur)) return;
    S.a_ready(cur, wid, lane);
    f32x4 acc[2][2][4][2];
#pragma unroll
    for (int a = 0; a < 2; ++a)
#pragma unroll
        for (int b = 0; b < 2; ++b)
#pragma unroll
            for (int m = 0; m < 4; ++m)
#pragma unroll
                for (int n = 0; n < 2; ++n) acc[a][b][m][n] = (f32x4){0.f, 0.f, 0.f, 0.f};
    bf16x8 At[4][2], B0[2][2], B1[2][2];
    const char* cA = (const char*)g.A + (size_t)cur.pm * tstepA + PG8_ACOL(cur.pn) + (size_t)cur.kc * (K * 2); const char* cB = (const char*)g.Bt + (size_t)cur.pn * tstepB + (size_t)cur.kc * (K * 2);
    PG8_STAGE(PG8_SB(0, 0), cB, offB); PG8_STAGE(PG8_SB(0, 1), cB + hstepB, offB); PG8_STAGE(PG8_SA(0, 0), cA, offA); PG8_STAGE(PG8_SA(0, 1), cA + hstepA, offA);
    if (wr == 1) PG8_BAR;
    PG8_WAIT_V(2); PG8_BAR;
    PG8_STAGE(PG8_SB(1, 0), cB + kstep, offB); PG8_STAGE(PG8_SA(1, 0), cA + kstep, offA); PG8_STAGE(PG8_SB(1, 1), cB + hstepB + kstep, offB);
    PG8_WAIT_V(6); PG8_BAR;
    for (;;) {
        const bool has_next = S.next(ui + 1, nxt);
        const char* nA = has_next ? (const char*)g.A + (size_t)nxt.pm * tstepA + PG8_ACOL(nxt.pn) + (size_t)nxt.kc * (K * 2) : cA; const char* nB = has_next ? (const char*)g.Bt + (size_t)nxt.pn * tstepB + (size_t)nxt.kc * (K * 2) : cB;
#pragma unroll 1
        for (int t = 0; t < nt; t += 2) {
            const bool last = (t == nt - 2);
            if (last && has_next) S.a_ready(nxt, wid, lane);
            const char* a1 = cA + (size_t)(t + 1) * kstep;
            const char* a2 = last ? nA : cA + (size_t)(t + 2) * kstep; const char* b2 = last ? nB : cB + (size_t)(t + 2) * kstep;
            const char* a3 = a2 + kstep; const char* b3 = b2 + kstep;
            PG8_LDB(B0, 0, 0); PG8_LDB(B1, 0, 1); PG8_SCHED; PG8_LDA(At, 0, 0); PG8_STAGE(PG8_SA(1, 1), a1 + hstepA, offA);
            PG8_WAIT_V(8); PG8_WAIT_L(0); PG8_BAR; PG8_MMA(0, 0, At, B0); PG8_MMA(0, 1, At, B1); PG8_BAR; PG8_SCHED;
            PG8_LDA(At, 0, 1); PG8_STAGE(PG8_SB(0, 0), b2, offB); PG8_STAGE(PG8_SB(0, 1), b2 + hstepB, offB); PG8_STAGE(PG8_SA(0, 0), a2, offA);
            PG8_WAIT_V(8); PG8_WAIT_L(0); PG8_BAR; PG8_MMA(1, 0, At, B0); PG8_MMA(1, 1, At, B1); PG8_BAR; PG8_SCHED;
            PG8_LDB(B0, 1, 0); PG8_LDB(B1, 1, 1); PG8_SCHED; PG8_LDA(At, 1, 0); PG8_STAGE(PG8_SA(0, 1), a2 + hstepA, offA);
            PG8_WAIT_V(8); PG8_WAIT_L(0); PG8_BAR; PG8_MMA(0, 0, At, B0); PG8_MMA(0, 1, At, B1); PG8_BAR; PG8_SCHED;
            PG8_LDA(At, 1, 1); PG8_STAGE(PG8_SB(1, 0), b3, offB); PG8_STAGE(PG8_SB(1, 1), b3 + hstepB, offB); PG8_STAGE(PG8_SA(1, 0), a3, offA);
            PG8_WAIT_V(8); PG8_WAIT_L(0); PG8_BAR; PG8_MMA(1, 0, At, B0); PG8_MMA(1, 1, At, B1); PG8_BAR; PG8_SCHED;
            if constexpr (MIDK > 0) {
                constexpr int seg = MIDK / BK; if (((t + 2) % seg) == 0 && t + 2 < nt) E.mid(acc, cur, wr, wc, fr, fq, (t + 2) / seg - 1); }
        }
        if constexpr (ALIGN_EPI) { if (wr == 0) PG8_BAR; }
        E(acc, cur, wr, wc, fr, fq); S.done(cur, lane);
        if (!has_next) break;
#pragma unroll
        for (int a = 0; a < 2; ++a)
#pragma unroll
            for (int b = 0; b < 2; ++b)
#pragma unroll
                for (int m = 0; m < 4; ++m)
#pragma unroll
                    for (int n = 0; n < 2; ++n) acc[a][b][m][n] = (f32x4){0.f, 0.f, 0.f, 0.f};
        cur = nxt; cA = nA; cB = nB; ++ui;
        if constexpr (ALIGN_EPI) { if (wr == 1) PG8_BAR; }
    }
    PG8_WAIT_V(0);
    if constexpr (!ALIGN_EPI) { if (wr == 0) PG8_BAR; }
    PG8_BAR;
#undef PG8_SA
#undef PG8_SB
#undef PG8_STAGE
#undef PG8_LDA
#undef PG8_LDB
#undef PG8_MMA
#undef PG8_WAIT_V
#undef PG8_WAIT_L
#undef PG8_BAR
#undef PG8_SCHED
#undef PG8_ACOL
}
}

#define GAS __attribute__((address_space(1)))
struct Args { GAS const float* in[26]; GAS float* out; GAS unsigned char* ws; };

struct Frame {
    LAS unsigned char* lds;
    int tid, lane, wave, G, bid, wave_s;
    const Args* a; GAS unsigned char* ws; GAS unsigned char* ws0;
};
constexpr int TIDTAB_OFF = 8 * 19456 + 64;
__device__ __forceinline__ int tid_from_lds(LAS unsigned char* lds, int wave_s) {
    int ln; asm volatile("v_mbcnt_lo_u32_b32 %0, -1, 0\n\tv_mbcnt_hi_u32_b32 %0, -1, %0" : "=v"(ln));
    const int t = *(const volatile LAS int*)(lds + TIDTAB_OFF + (wave_s * 64 + ln) * 4);
    __builtin_assume(t >= 0 && t < 512);
    return t;
}
#define FIN(i) ((const float*)(F.a->in[i]))
__device__ __forceinline__ void refresh(Frame& F) { const int t = tid_from_lds(F.lds, F.wave_s); F.tid = t; F.lane = t & 63; F.wave = __builtin_amdgcn_readfirstlane(t >> 6);
    GAS unsigned char* w = F.ws0; asm volatile("" : "+s"(w)); F.ws = w; }

__device__ __forceinline__ void transpose_item(const float* W, int ldw, int k0, int nsrc0, bf16_t* WT, int ldt, int drow0, int dcol0, int nrep, int drep, LAS float* scr, int lane) {
    float tv[32];
#pragma unroll
    for (int i = 0; i < 32; ++i) { const int kk = 2 * i + (lane >> 5); tv[i] = __builtin_nontemporal_load(W + (size_t)(k0 + kk) * ldw + nsrc0 + (lane & 31)); }
#pragma unroll
    for (int i = 0; i < 32; ++i) { const int kk = 2 * i + (lane >> 5); scr[kk * 33 + (lane & 31)] = tv[i]; }
    LDS_WAIT(); asm volatile("" ::: "memory");
    const int c = lane & 7;
#pragma unroll
    for (int j = 0; j < 4; ++j) { const int n = (lane >> 3) + 8 * j; const LAS float* s = scr + (8 * c) * 33 + n;
        u32x4 o; o.x = pk2(s[0 * 33], s[1 * 33]); o.y = pk2(s[2 * 33], s[3 * 33]); o.z = pk2(s[4 * 33], s[5 * 33]); o.w = pk2(s[6 * 33], s[7 * 33]);
        for (int r = 0; r < nrep; ++r) *(u32x4*)(WT + (size_t)(drow0 + n) * ldt + dcol0 + r * drep + k0 + 8 * c) = o; }
    LDS_WAIT(); asm volatile("" ::: "memory");
}
template <int PART>
__device__ __forceinline__ void convert_weights(Frame& F, int l, int b0 = 0, int nb = 0) {
    refresh(F);
    LAS float* scr = (LAS float*)(F.lds + F.wave * 16384);
    if (nb == 0) nb = F.G;
    if (F.bid < b0 || F.bid >= b0 + nb) return;
    const int gw = (F.bid - b0) * NWAVES + F.wave, NGW = nb * NWAVES;
    const float* w_in = FIN(6) + (size_t)l * DM * INC;
    const float* w_br = FIN(18) + (size_t)l * 4 * 256 * DM;
    const float* w_out = FIN(19) + (size_t)l * DM * DM;
    const float* w_up = FIN(22) + (size_t)l * DM * 2 * FFH;
    const float* w_dn = FIN(23) + (size_t)l * FFH * DM;
    bf16_t* WIN = (bf16_t*)(F.ws + WS_WIN); bf16_t* WBR = (bf16_t*)(F.ws + WS_WBR); bf16_t* WOUT = (bf16_t*)(F.ws + WS_WOUT);
    bf16_t* WUP = (bf16_t*)(F.ws + WS_WUP); bf16_t* WDN = (bf16_t*)(F.ws + WS_WDN);
    constexpr int I_IN = 16 * 240, I_BR = 4 * 4 * 32, I_OUT = 16 * 32, I_UP = 16 * 176, I_DN = 44 * 32;
    if (PART == 0) {
        for (int it = gw; it < I_IN + I_BR + I_OUT; it += NGW) {
            int r = it;
            if (r < I_IN) { const int kb = r / 240, nb = r % 240, d0 = nb * 32; const int s0 = d0 < 2304 ? d0 : d0 + 8;
                transpose_item(w_in, INC, kb * 64, s0, WIN, DM, d0, 0, 1, 0, scr, F.lane); continue; } r -= I_IN;
            if (r < I_BR) { const int n = r / 128, rr = r % 128, kb = rr / 32, nb = rr % 32;
                transpose_item(w_br + (size_t)n * 256 * DM, DM, kb * 64, nb * 32, WBR, DM, nb * 32, n * 256, 1, 0, scr, F.lane); continue; } r -= I_BR;
            { const int kb = r / 32, nb = r % 32; transpose_item(w_out, DM, kb * 64, nb * 32, WOUT, DM, nb * 32, 0, 1, 0, scr, F.lane); }
        }
    } else {
        for (int it = gw; it < I_UP + I_DN; it += NGW) {
            int r = it;
            if (r < I_UP) { const int kb = r / 176, nb = r % 176, d0 = nb * 32, tile = d0 >> 8, within = d0 & 255;
                const int s0 = within < 128 ? tile * 128 + within : FFH + tile * 128 + (within - 128);
                transpose_item(w_up, 2 * FFH, kb * 64, s0, WUP, DM, d0, 0, 1, 0, scr, F.lane); continue; } r -= I_UP;
            { const int kb = r / 32, nb = r % 32; transpose_item(w_dn, DM, kb * 64, nb * 32, WDN, FFH, nb * 32, 0, 1, 0, scr, F.lane); }
        }
    }
}

__device__ __forceinline__ void mods_phase(Frame& F) {
    refresh(F);
    LAS float* sil = (LAS float*)(F.lds);
    LAS float* part = sil + 5 * 1024;
    if (F.bid >= 192) return;
    const int l = F.bid / 96, cgp = F.bid % 96;
    for (int i = F.tid; i < 5 * 1024; i += NTHREADS) { const int r = i >> 10, k = i & 1023; const float cv = r < 4 ? FIN(1)[r * 1024 + k] : FIN(3)[k]; sil[i] = siluf_(cv); }
    __syncthreads();
    const float* aw = FIN(4) + (size_t)l * DM * 6144 + cgp * 64 + F.lane;
    float a0 = 0.f, a1 = 0.f, a2 = 0.f, a3 = 0.f, a4 = 0.f;
    const int kb = F.wave * 128;
#pragma unroll 32
    for (int k = 0; k < 128; ++k) { const float w = __builtin_nontemporal_load(aw + (size_t)(kb + k) * 6144);
        a0 += sil[kb + k] * w; a1 += sil[1024 + kb + k] * w; a2 += sil[2048 + kb + k] * w; a3 += sil[3072 + kb + k] * w; a4 += sil[4096 + kb + k] * w; }
    part[(F.wave * 5 + 0) * 64 + F.lane] = a0; part[(F.wave * 5 + 1) * 64 + F.lane] = a1; part[(F.wave * 5 + 2) * 64 + F.lane] = a2;
    part[(F.wave * 5 + 3) * 64 + F.lane] = a3; part[(F.wave * 5 + 4) * 64 + F.lane] = a4;
    __syncthreads();
    if (F.wave < 5) { float s = FIN(5)[l * 6144 + cgp * 64 + F.lane];
#pragma unroll
        for (int w = 0; w < 8; ++w) s += part[(w * 5 + F.wave) * 64 + F.lane];
        ((float*)(F.ws + WS_MODS))[(size_t)(l * 5 + F.wave) * 6144 + cgp * 64 + F.lane] = s; }
    __syncthreads();
}

struct RowOp {
    int nrows;
    const float* xlat_in; const float* xctx_in;
    bool post;
    const bf16_t* Y; const bf16_t* slabs; int nslab; int slab_row0;
    int gate_chunk; const float* lng; const float* lnb; const float* mods_post;
    float* xlat_out; float* xctx_out;
    bool domod;
    const float* mods_mod; int shift_chunk, scale_chunk; bf16_t* Hout;
    bool dodt; float* DTout;
};
__device__ __forceinline__ void row_pass(Frame& F, const RowOp& R, const float* w_in_l) {
    refresh(F);
    LAS float* wdt = (LAS float*)F.lds;
    if (R.dodt) {
        for (int i = F.tid; i < 8192; i += NTHREADS) { const int c = i >> 10, k = i & 1023; wdt[i] = w_in_l[(size_t)k * INC + 2304 + c]; }
    }
    __syncthreads();
    const int gw = F.bid * NWAVES + F.wave, NGW = F.G * NWAVES;
    const int m0 = gw, m1 = R.nrows;
    const int lane = F.lane;
    f32x4 lg[4], lb[4], gt4[4], sh4[4], sc4[4];
    if (R.post) {
#pragma unroll
        for (int j = 0; j < 4; ++j) { lg[j] = *(const f32x4*)(R.lng + 4 * (lane + 64 * j)); lb[j] = *(const f32x4*)(R.lnb + 4 * (lane + 64 * j)); }
    }
    int cur_r5 = -1;
    f32x4 xn[4]; u32x2 yn[4];
#define RP_LOAD(M) do { const int m_ = (M); const float* xr_ = m_ < MLAT ? R.xlat_in + (size_t)m_ * DM : R.xctx_in + (size_t)(m_ - MLAT) * DM; \
        _Pragma("unroll") for (int j = 0; j < 4; ++j) xn[j] = __builtin_nontemporal_load((const f32x4*)(xr_ + 4 * (lane + 64 * j))); \
        if (R.post && !(R.nslab > 0 && m_ >= R.slab_row0)) { const bf16_t* yr_ = R.Y + (size_t)m_ * DM; _Pragma("unroll") for (int j = 0; j < 4; ++j) yn[j] = __builtin_nontemporal_load((const u32x2*)(yr_ + 4 * (lane + 64 * j))); } } while (0)
    if (m0 < m1) RP_LOAD(m0);
#pragma unroll 1
    for (int m = m0; m < m1; m += NGW) {
        const int r5 = m < MLAT ? (m >> 12) : 4;
        if (r5 != cur_r5) { cur_r5 = r5;
            if (R.post) { const float* gt = R.mods_post + (size_t)r5 * 6144 + R.gate_chunk * 1024;
#pragma unroll
                for (int j = 0; j < 4; ++j) gt4[j] = *(const f32x4*)(gt + 4 * (lane + 64 * j)); }
            if (R.domod) { const float* sh = R.mods_mod + (size_t)r5 * 6144 + R.shift_chunk * 1024; const float* sc = R.mods_mod + (size_t)r5 * 6144 + R.scale_chunk * 1024;
#pragma unroll
                for (int j = 0; j < 4; ++j) { sh4[j] = *(const f32x4*)(sh + 4 * (lane + 64 * j)); sc4[j] = *(const f32x4*)(sc + 4 * (lane + 64 * j)); } }
        }
        f32x4 v[4]; u32x2 yv[4];
#pragma unroll
        for (int j = 0; j < 4; ++j) { v[j] = xn[j]; yv[j] = yn[j]; }
        const bool slabrow = R.post && R.nslab > 0 && m >= R.slab_row0;
        float ys[4][4];
        if (slabrow) {
#pragma unroll
            for (int j = 0; j < 4; ++j) { const int c = 4 * (lane + 64 * j); ys[j][0] = ys[j][1] = ys[j][2] = ys[j][3] = 0.f; const bf16_t* sp = R.slabs + (size_t)(m - R.slab_row0) * 1024 + c;
                for (int sidx = 0; sidx < R.nslab; ++sidx) { const u32x2 yw = *(const u32x2*)(sp + (size_t)sidx * (MALL - R.slab_row0) * 1024); ys[j][0] += bflo(yw.x); ys[j][1] += bfhi(yw.x); ys[j][2] += bflo(yw.y); ys[j][3] += bfhi(yw.y); } }
        }
        if (m + NGW < m1) RP_LOAD(m + NGW);
        if (R.post) {
#pragma unroll
            for (int j = 0; j < 4; ++j) { const f32x4 g4 = gt4[j];
                const float y0 = slabrow ? ys[j][0] : bflo(yv[j].x), y1 = slabrow ? ys[j][1] : bfhi(yv[j].x), y2 = slabrow ? ys[j][2] : bflo(yv[j].y), y3 = slabrow ? ys[j][3] : bfhi(yv[j].y);
                v[j].x = ALPHA * v[j].x + g4.x * y0; v[j].y = ALPHA * v[j].y + g4.y * y1;
                v[j].z = ALPHA * v[j].z + g4.z * y2; v[j].w = ALPHA * v[j].w + g4.w * y3; }
            float s = 0.f;
#pragma unroll
            for (int j = 0; j < 4; ++j) s += (v[j].x + v[j].y) + (v[j].z + v[j].w);
            const float mean = wave_sum(s) * (1.f / DM); float s2 = 0.f;
#pragma unroll
            for (int j = 0; j < 4; ++j) { v[j] = v[j] - mean; s2 += (v[j].x * v[j].x + v[j].y * v[j].y) + (v[j].z * v[j].z + v[j].w * v[j].w); }
            const float rstd = 1.f / sqrtf(wave_sum(s2) * (1.f / DM) + LN_EPS);
            float* xo = m < MLAT ? R.xlat_out + (size_t)m * DM : R.xctx_out + (size_t)(m - MLAT) * DM;
#pragma unroll
            for (int j = 0; j < 4; ++j) { const int c = 4 * (lane + 64 * j); v[j] = v[j] * rstd * lg[j] + lb[j]; __builtin_nontemporal_store(v[j], (f32x4*)(xo + c)); }
        }
        if (R.domod) {
            float s = 0.f;
#pragma unroll
            for (int j = 0; j < 4; ++j) s += (v[j].x + v[j].y) + (v[j].z + v[j].w);
            const float mean = wave_sum(s) * (1.f / DM); float s2 = 0.f;
#pragma unroll
            for (int j = 0; j < 4; ++j) { v[j] = v[j] - mean; s2 += (v[j].x * v[j].x + v[j].y * v[j].y) + (v[j].z * v[j].z + v[j].w * v[j].w); }
            const float rstd = 1.f / sqrtf(wave_sum(s2) * (1.f / DM) + LN_EPS);
            bf16_t* hr = R.Hout + (size_t)m * DM;
#pragma unroll
            for (int j = 0; j < 4; ++j) { const int c = 4 * (lane + 64 * j);
                v[j] = v[j] * rstd * (sc4[j] + 1.f) + sh4[j];
                u32x2 w; w.x = pk2(v[j].x, v[j].y); w.y = pk2(v[j].z, v[j].w); *(u32x2*)(hr + c) = w; }
            if (R.dodt) {
                float d[8];
#pragma unroll
                for (int c = 0; c < 8; ++c) { float a = 0.f;
                    asm volatile("" ::: "memory");
#pragma unroll
                    for (int j = 0; j < 4; ++j) { const f32x4 w4 = *(const LAS f32x4*)(wdt + c * 1024 + 4 * (lane + 64 * j)); a += (v[j].x * w4.x + v[j].y * w4.y) + (v[j].z * w4.z + v[j].w * w4.w); }
                    d[c] = wave_sum(a); }
                if (lane == 0) { *(f32x4*)(R.DTout + (size_t)m * 8) = (f32x4){d[0], d[1], d[2], d[3]}; *(f32x4*)(R.DTout + (size_t)m * 8 + 4) = (f32x4){d[4], d[5], d[6], d[7]}; }
            }
        }
    }
#undef RP_LOAD
    __syncthreads();
}

__device__ __forceinline__ void prep_phase(Frame& F, int l) {
    refresh(F);
    bf16_t* MIX = (bf16_t*)(F.ws + WS_RC);
    const float* qn = FIN(16) + l * 64; const float* kn = FIN(17) + l * 64;
    const int gt = F.bid * NTHREADS + F.tid, NGT = F.G * NTHREADS;
    for (int it = gt; it < MALL * 6; it += NGT) {
        const int m = it / 6, slot = it % 6;
        bf16_t* p = MIX + (size_t)m * NMIX + (slot < 4 ? C_DQ + 64 * slot : C_DK + 64 * (slot - 4));
        const float* nw = slot < 4 ? qn : kn;
        float x[64];
#pragma unroll
        for (int w = 0; w < 8; ++w) { const u32x4 u = *(const u32x4*)(p + 8 * w);
            x[8 * w + 0] = bflo(u.x); x[8 * w + 1] = bfhi(u.x); x[8 * w + 2] = bflo(u.y); x[8 * w + 3] = bfhi(u.y);
            x[8 * w + 4] = bflo(u.z); x[8 * w + 5] = bfhi(u.z); x[8 * w + 6] = bflo(u.w); x[8 * w + 7] = bfhi(u.w); }
        float ss = 0.f;
#pragma unroll
        for (int d = 0; d < 64; ++d) ss += x[d] * x[d];
        const float rs = 1.f / sqrtf(ss * (1.f / 64.f) + LN_EPS);
#pragma unroll
        for (int d = 0; d < 64; ++d) x[d] = x[d] * rs * nw[d];
        if (m < MLAT && slot < 4) {
#pragma unroll
            for (int d = 0; d < 64; ++d) x[d] *= 0.125f * 1.4426950408889634f; }
        if (m < MLAT) {
            const int t = m & 4095; const float prow = (float)(t >> 6), pcol = (float)(t & 63);
#pragma unroll
            for (int i = 0; i < 16; ++i) {
                const float inv = expf(-(float)i * (9.210340371976184f / 16.f));
                const float ar = prow * inv, ac = pcol * inv;
                const float sr = __sinf(ar), cr = __cosf(ar), sc = __sinf(ac), cc = __cosf(ac);
                const float a1 = x[i], a2 = x[16 + i]; x[i] = a1 * cr - a2 * sr; x[16 + i] = a2 * cr + a1 * sr;
                const float b1 = x[32 + i], b2 = x[48 + i]; x[32 + i] = b1 * cc - b2 * sc; x[48 + i] = b2 * cc + b1 * sc;
            }
        }
#pragma unroll
        for (int w = 0; w < 8; ++w) { u32x4 u; u.x = pk2(x[8 * w], x[8 * w + 1]); u.y = pk2(x[8 * w + 2], x[8 * w + 3]); u.z = pk2(x[8 * w + 4], x[8 * w + 5]); u.w = pk2(x[8 * w + 6], x[8 * w + 7]);
            *(u32x4*)(p + 8 * w) = u; }
    }
}

__device__ __forceinline__ void conv_to_lds(Frame& F, int l) {
    refresh(F);
    const bf16_t* MIX = (const bf16_t*)(F.ws + WS_RC);
    const float* cw = FIN(9) + (size_t)l * 5 * 768; const float* cb = FIN(10) + l * 768;
    LAS unsigned* cv = (LAS unsigned*)F.lds;
    if (F.tid < 384) {
        const int c = 2 * F.tid, r0 = 68 * F.bid;
        float w0[5], w1[5];
#pragma unroll
        for (int j = 0; j < 5; ++j) { w0[j] = cw[j * 768 + c]; w1[j] = cw[j * 768 + c + 1]; }
        const float b0 = cb[c], b1 = cb[c + 1];
        unsigned win[72];
#pragma unroll
        for (int j = 0; j < 72; ++j) { const int mm = r0 - 2 + j; win[j] = (mm >= 0 && mm < MALL) ? *(const unsigned*)(MIX + (size_t)mm * NMIX + C_BX + c) : 0u; }
#pragma unroll
        for (int r = 0; r < 68; ++r) {
            const int m = r0 + r;
            const int lo = m < MLAT ? (m & ~4095) : MLAT + ((m - MLAT) & ~255), hi = lo + (m < MLAT ? SEQ : CTXL);
            float a0 = b0, a1 = b1;
#pragma unroll
            for (int j = 0; j < 5; ++j) { const int mm = m + j - 2; const bool ok = (mm >= lo) && (mm < hi); a0 += ok ? w0[j] * bflo(win[r + j]) : 0.f; a1 += ok ? w1[j] * bfhi(win[r + j]) : 0.f; }
            cv[r * 384 + F.tid] = pk2(siluf_(a0), siluf_(a1));
        }
    }
}
__device__ __forceinline__ void conv_from_lds(Frame& F) {
    refresh(F);
    bf16_t* MIX = (bf16_t*)(F.ws + WS_RC);
    const LAS unsigned* cv = (const LAS unsigned*)F.lds;
    if (F.tid < 384) { const int r0 = 68 * F.bid;
        for (int r = 0; r < 68; ++r) *(unsigned*)(MIX + (size_t)(r0 + r) * NMIX + C_BX + 2 * F.tid) = cv[r * 384 + F.tid]; }
}

typedef short s16x4 __attribute__((ext_vector_type(4)));
typedef float f32x16 __attribute__((ext_vector_type(16)));
typedef float f32x2_t __attribute__((ext_vector_type(2))); typedef __bf16 bf16x2_t __attribute__((ext_vector_type(2)));
#define MFMA32(a, b, c) __builtin_amdgcn_mfma_f32_32x32x16_bf16((a), (b), (c), 0, 0, 0)
__device__ __forceinline__ unsigned cvtpk(float lo, float hi) { f32x2_t v = {lo, hi}; bf16x2_t b = __builtin_convertvector(v, bf16x2_t); return __builtin_bit_cast(unsigned, b); }
__device__ __forceinline__ int crow(int reg, int h) { return (reg & 3) + 8 * (reg >> 2) + 4 * h; }
template <int S_> __device__ __forceinline__ bf16x8 pack8(const f32x16& x) {
    u32x4 p; p.x = cvtpk(x[8 * S_], x[8 * S_ + 1]); p.y = cvtpk(x[8 * S_ + 2], x[8 * S_ + 3]); p.z = cvtpk(x[8 * S_ + 4], x[8 * S_ + 5]); p.w = cvtpk(x[8 * S_ + 6], x[8 * S_ + 7]);
    return __builtin_bit_cast(bf16x8, p);
}
__device__ __forceinline__ bf16x8 ld_row8(const LAS unsigned char* tb, int P, int r, int c0) { return *(const LAS bf16x8*)(tb + r * P + c0 * 2); }
__device__ __forceinline__ bf16x8 ld_row8_perm(const LAS unsigned char* tb, int P, int r, int c0, int h) {
    const s16x4 lo = *(const LAS s16x4*)(tb + r * P + (c0 + 4 * h) * 2), hi = *(const LAS s16x4*)(tb + r * P + (c0 + 8 + 4 * h) * 2);
    return __builtin_shufflevector(lo, hi, 0, 1, 2, 3, 4, 5, 6, 7);
}
__device__ __forceinline__ s16x4 tr4(const LAS unsigned char* tb, int P, int row0, int col0, int lane) {
    const int q = (lane & 15) >> 2, p = lane & 3, blk = (lane >> 4) & 1;
    return __builtin_bit_cast(s16x4, __builtin_amdgcn_ds_read_tr16_b64_v4i16((LAS s16x4*)(tb + (row0 + q) * P + (col0 + 16 * blk + 4 * p) * 2)));
}
__device__ __forceinline__ bf16x8 ld_tr8(const LAS unsigned char* tb, int P, int row_lo, int row_hi, int col0, int lane) {
    const s16x4 lo = tr4(tb, P, row_lo, col0, lane), hi = tr4(tb, P, row_hi, col0, lane);
    return __builtin_shufflevector(lo, hi, 0, 1, 2, 3, 4, 5, 6, 7);
}
__device__ __forceinline__ float bperm_(float v, int src_lane) { return __int_as_float(__builtin_amdgcn_ds_bpermute(src_lane * 4, __float_as_int(v))); }
__device__ __forceinline__ float softplusf_(float x) { return fmaxf(x, 0.f) + __logf(1.f + __expf(-fabsf(x))); }
constexpr int NCH = 17;
constexpr int TP64 = 144, TP32 = 80;

template <int NC> __device__ __forceinline__ void stage_tile(LAS unsigned char* tb, const bf16_t* MIX, int R0, int dir, int I, int col, int lane) {
    constexpr int CPR = NC / 8, NP = 32 * CPR / 64, P = NC == 64 ? TP64 : TP32;
#pragma unroll
    for (int t = 0; t < NP; ++t) { const int id = lane + 64 * t, r = id / CPR, ck = id % CPR; const int i = 32 * I + r; const int m = dir ? R0 + 255 - i : R0 + i;
        *(LAS u32x4*)(tb + r * P + ck * 16) = *(const u32x4*)(MIX + (size_t)m * NMIX + col + ck * 8); }
}

template <int NC> __device__ __forceinline__ void tile_load(u32x4 (&rg)[NC / 16], const bf16_t* MIX, int R0, int dir, int I, int col, int lane) {
    constexpr int CPR = NC / 8, NP = NC / 16;
#pragma unroll
    for (int t = 0; t < NP; ++t) { const int id = lane + 64 * t, r = id / CPR, ck = id % CPR; const int i = 32 * I + r; const int m = dir ? R0 + 255 - i : R0 + i;
        const unsigned off = (unsigned)m * (unsigned)(NMIX * 2) + (unsigned)((col + ck * 8) * 2);
        rg[t] = *(const u32x4*)((const char*)MIX + off); }
}
template <int NC> __device__ __forceinline__ void tile_store(LAS unsigned char* tb, const u32x4 (&rg)[NC / 16], int lane) {
    constexpr int CPR = NC / 8, NP = NC / 16, P = NC == 64 ? TP64 : TP32;
#pragma unroll
    for (int t = 0; t < NP; ++t) { const int id = lane + 64 * t, r = id / CPR, ck = id % CPR; *(LAS u32x4*)(tb + r * P + ck * 16) = rg[t]; }
}

template <bool PASS_C>
__device__ __forceinline__ void hgrn_task(Frame& F, int l, int seq, int pc, bf16_t* OUT, int ldo) {
    const bf16_t* MIX = (const bf16_t*)(F.ws + WS_RC);
    const int lane_ = tid_from_lds(F.lds, F.wave_s) & 63;
    const int lane = lane_, h = lane >> 5, c31 = lane & 31;
    const int dir = seq >> 4, b = (seq >> 2) & 3, head = seq & 3;
    LAS unsigned char* wl = F.lds + F.wave * WLDS;
    LAS unsigned char* TQ = wl; LAS unsigned char* TK = wl + 4608; LAS unsigned char* TH = wl + 9216; LAS unsigned char* TV = wl + 13824; LAS float* Dv = (LAS float*)(wl + 18432);
    const int R0 = pc == 0 ? MLAT + b * CTXL : b * SEQ + (dir ? 16 - pc : pc - 1) * 256;
    const int fcol = (dir ? C_AFB : C_AFF) + head * 64;
    bf16_t* ST = (bf16_t*)(F.ws + WS_STA) + ((size_t)seq * NCH + pc) * 4096;
    f32x16 S[2][2];
#pragma unroll
    for (int kb = 0; kb < 2; ++kb)
#pragma unroll
        for (int vb = 0; vb < 2; ++vb) {
            if (PASS_C) {
#pragma unroll
                for (int q4 = 0; q4 < 2; ++q4) { const u32x4 w = *(const u32x4*)(ST + lane * 64 + (kb * 2 + vb) * 16 + q4 * 8);
                    S[kb][vb][8 * q4 + 0] = bflo(w.x); S[kb][vb][8 * q4 + 1] = bfhi(w.x); S[kb][vb][8 * q4 + 2] = bflo(w.y); S[kb][vb][8 * q4 + 3] = bfhi(w.y);
                    S[kb][vb][8 * q4 + 4] = bflo(w.z); S[kb][vb][8 * q4 + 5] = bfhi(w.z); S[kb][vb][8 * q4 + 6] = bflo(w.w); S[kb][vb][8 * q4 + 7] = bfhi(w.w); }
            } else {
#pragma unroll
                for (int reg = 0; reg < 16; ++reg) S[kb][vb][reg] = 0.f; } }
    float gtot = 0.f;
    u32x4 pg[4], pq[4], pv[4];
    tile_load<64>(pg, MIX, R0, dir, 0, fcol, lane); if (PASS_C) tile_load<64>(pq, MIX, R0, dir, 0, C_AQ + head * 64, lane); tile_load<64>(pv, MIX, R0, dir, 0, C_AV + head * 64, lane);
#pragma unroll 1
    for (int I = 0; I < 8; ++I) {
        tile_store<64>(TH, pg, lane); if (PASS_C) tile_store<64>(TQ, pq, lane); tile_store<64>(TV, pv, lane);
        LDS_WAIT();
        if (I + 1 < 8) { tile_load<64>(pg, MIX, R0, dir, I + 1, fcol, lane); if (PASS_C) tile_load<64>(pq, MIX, R0, dir, I + 1, C_AQ + head * 64, lane); tile_load<64>(pv, MIX, R0, dir, I + 1, C_AV + head * 64, lane); }
        float br[32], kkv[32];
        float run = 0.f;
#pragma unroll
        for (int r = 0; r < 32; ++r) {
            if ((r & 7) == 0) asm volatile("" ::: "memory");
            const float g2 = bf2f(*(const LAS bf16_t*)(TH + r * TP64 + lane * 2));
            run += g2; br[r] = run; const float kk = 1.f - __builtin_amdgcn_exp2f(g2); kkv[r] = kk;
            if (PASS_C) { const float e = __builtin_amdgcn_exp2f(fmaxf(run, -120.f)); const float q = bf2f(*(const LAS bf16_t*)(TQ + r * TP64 + lane * 2));
                const unsigned w = cvtpk(q * e, kk * __builtin_amdgcn_rcpf(e));
                *(LAS bf16_t*)(TQ + r * TP64 + lane * 2) = (bf16_t)w; *(LAS bf16_t*)(TK + r * TP64 + lane * 2) = (bf16_t)(w >> 16); }
        }
        const float total = run; gtot += total;
#pragma unroll
        for (int r = 0; r < 32; r += 2) { const unsigned w = cvtpk(kkv[r] * __builtin_amdgcn_exp2f(total - br[r]), kkv[r + 1] * __builtin_amdgcn_exp2f(total - br[r + 1]));
            *(LAS bf16_t*)(TH + r * TP64 + lane * 2) = (bf16_t)w; *(LAS bf16_t*)(TH + (r + 1) * TP64 + lane * 2) = (bf16_t)(w >> 16); }
        Dv[lane] = __builtin_amdgcn_exp2f(total);
        LDS_WAIT();
        if (PASS_C) {
            f32x16 P;
#pragma unroll
            for (int reg = 0; reg < 16; ++reg) P[reg] = 0.f;
#pragma unroll
            for (int s = 0; s < 4; ++s) P = MFMA32(ld_row8(TK, TP64, c31, 16 * s + 8 * h), ld_row8(TQ, TP64, c31, 16 * s + 8 * h), P);
#pragma unroll
            for (int reg = 0; reg < 16; ++reg) if (crow(reg, h) > c31) P[reg] = 0.f;
            const bf16x8 pa0 = pack8<0>(P), pa1 = pack8<1>(P);
#pragma unroll
            for (int vb = 0; vb < 2; ++vb) {
                f32x16 o;
#pragma unroll
                for (int reg = 0; reg < 16; ++reg) o[reg] = 0.f;
                o = MFMA32(pa0, ld_tr8(TV, TP64, 4 * h, 8 + 4 * h, 32 * vb, lane), o);
                o = MFMA32(pa1, ld_tr8(TV, TP64, 16 + 4 * h, 24 + 4 * h, 32 * vb, lane), o);
#pragma unroll
                for (int kb = 0; kb < 2; ++kb) {
                    o = MFMA32(ld_row8_perm(TQ, TP64, c31, 32 * kb, h), pack8<0>(S[kb][vb]), o);
                    o = MFMA32(ld_row8_perm(TQ, TP64, c31, 32 * kb + 16, h), pack8<1>(S[kb][vb]), o);
                }
#pragma unroll
                for (int reg = 0; reg < 16; reg += 2) { const unsigned w0 = cvtpk(o[reg], o[reg + 1]);
                    *(LAS bf16_t*)(TK + crow(reg, h) * TP64 + (32 * vb + c31) * 2) = (bf16_t)w0; *(LAS bf16_t*)(TK + crow(reg + 1, h) * TP64 + (32 * vb + c31) * 2) = (bf16_t)(w0 >> 16); }
            }
            LDS_WAIT();
#pragma unroll
            for (int t = 0; t < 4; ++t) { const int id = lane + 64 * t, r = id >> 3, ck = id & 7; const int i = 32 * I + r; const int m = dir ? R0 + 255 - i : R0 + i;
                __builtin_nontemporal_store(*(const LAS u32x4*)(TK + r * TP64 + ck * 16), (u32x4*)((char*)OUT + ((unsigned)m * (unsigned)ldo + (unsigned)(head * 64 + ck * 8)) * 2u)); }
        }
#pragma unroll
        for (int kb = 0; kb < 2; ++kb) {
            float dr[16];
#pragma unroll
            for (int g = 0; g < 4; ++g) { const f32x4 d4 = *(const LAS f32x4*)(Dv + 32 * kb + 8 * g + 4 * h); dr[4 * g] = d4.x; dr[4 * g + 1] = d4.y; dr[4 * g + 2] = d4.z; dr[4 * g + 3] = d4.w; }
#pragma unroll
            for (int vb = 0; vb < 2; ++vb)
#pragma unroll
                for (int reg = 0; reg < 16; ++reg) S[kb][vb][reg] *= dr[reg];
#pragma unroll
            for (int s = 0; s < 2; ++s) { const bf16x8 a = ld_tr8(TH, TP64, 16 * s + 8 * h, 16 * s + 8 * h + 4, 32 * kb, lane);
#pragma unroll
                for (int vb = 0; vb < 2; ++vb) S[kb][vb] = MFMA32(a, ld_tr8(TV, TP64, 16 * s + 8 * h, 16 * s + 8 * h + 4, 32 * vb, lane), S[kb][vb]); }
        }
        LDS_WAIT();
    }
    if (!PASS_C) {
#pragma unroll
        for (int kb = 0; kb < 2; ++kb)
#pragma unroll
            for (int vb = 0; vb < 2; ++vb)
#pragma unroll
                for (int q4 = 0; q4 < 2; ++q4) { const f32x16& T = S[kb][vb]; u32x4 w; w.x = cvtpk(T[8 * q4], T[8 * q4 + 1]); w.y = cvtpk(T[8 * q4 + 2], T[8 * q4 + 3]); w.z = cvtpk(T[8 * q4 + 4], T[8 * q4 + 5]); w.w = cvtpk(T[8 * q4 + 6], T[8 * q4 + 7]);
                    *(u32x4*)(ST + lane * 64 + (kb * 2 + vb) * 16 + q4 * 8) = w; }
        ((float*)(F.ws + WS_DLA))[((size_t)seq * NCH + pc) * 64 + lane] = gtot;
    }
}

template <bool PASS_C>
__device__ __forceinline__ void ssd_task(Frame& F, int l, int seq2, int pc, bf16_t* OUT, int ldo) {
    const bf16_t* MIX = (const bf16_t*)(F.ws + WS_RC);
    const float* DT = (const float*)(F.ws + WS_DT);
    const int lane_ = tid_from_lds(F.lds, F.wave_s) & 63;
    const int lane = lane_, h = lane >> 5, c31 = lane & 31;
    const int seq = seq2 >> 1, vb = seq2 & 1, dir = seq >> 4, b = (seq >> 2) & 3, head = seq & 3, g = head >> 1;
    LAS unsigned char* wl = F.lds + F.wave * WLDS;
    LAS unsigned char* TC = wl; LAS unsigned char* TB = wl + 4608; LAS unsigned char* TX = wl + 9216; LAS unsigned char* TXh = wl + 11776;
    LAS float* brn = (LAS float*)(wl + 18432); LAS float* dtv = brn + 32;
    const int R0 = pc == 0 ? MLAT + b * CTXL : b * SEQ + (dir ? 16 - pc : pc - 1) * 256;
    const float Aneg = -expf(FIN(12)[(l * 2 + dir) * 4 + head]); const float dtb = FIN(11)[(l * 2 + dir) * 4 + head];
    bf16_t* ST = (bf16_t*)(F.ws + WS_STB) + ((size_t)seq2 * NCH + pc) * 4096;
    f32x16 S[4];
#pragma unroll
    for (int kb = 0; kb < 4; ++kb) {
        if (PASS_C) {
#pragma unroll
            for (int q4 = 0; q4 < 2; ++q4) { const u32x4 w = *(const u32x4*)(ST + lane * 64 + kb * 16 + q4 * 8);
                S[kb][8 * q4 + 0] = bflo(w.x); S[kb][8 * q4 + 1] = bfhi(w.x); S[kb][8 * q4 + 2] = bflo(w.y); S[kb][8 * q4 + 3] = bfhi(w.y);
                S[kb][8 * q4 + 4] = bflo(w.z); S[kb][8 * q4 + 5] = bfhi(w.z); S[kb][8 * q4 + 6] = bflo(w.w); S[kb][8 * q4 + 7] = bfhi(w.w); }
        } else {
#pragma unroll
            for (int reg = 0; reg < 16; ++reg) S[kb][reg] = 0.f; } }
    float gtot = 0.f;
    u32x4 pxx[2], pcq[4], pbb[4]; float dtraw;
    const int xcol = C_BX + head * 64 + vb * 32, ccol = C_BC + g * 128, bcol = C_BB + g * 128;
    { const int i_o = c31; const int m_o = dir ? R0 + 255 - i_o : R0 + i_o; dtraw = DT[(size_t)m_o * 8 + dir * 4 + head]; }
    if (PASS_C) tile_load<64>(pcq, MIX, R0, dir, 0, ccol, lane); tile_load<64>(pbb, MIX, R0, dir, 0, bcol, lane);
#pragma unroll 1
    for (int I = 0; I < 8; ++I) {
        tile_load<32>(pxx, MIX, R0, dir, I, xcol, lane);
        const float dt = softplusf_(dtraw + dtb);
        float run = dt * Aneg;
#pragma unroll
        for (int off = 1; off < 32; off <<= 1) { const float t = bperm_(run, (lane - off) & 63); if (c31 >= off) run += t; }
        const float total = bperm_(run, (lane & 32) | 31); gtot += total;
        const float wown = dt * __expf(total - run);
        if (lane < 32) { brn[c31] = run; dtv[c31] = dt; }
        tile_store<32>(TX, pxx, lane);
#pragma unroll
        for (int t = 0; t < 2; ++t) { const int id = lane + 64 * t, r = id >> 2, ck = id & 3;
            const u32x4 x4 = pxx[t];
            const float w = bperm_(wown, r);
            u32x4 y; y.x = cvtpk(bflo(x4.x) * w, bfhi(x4.x) * w); y.y = cvtpk(bflo(x4.y) * w, bfhi(x4.y) * w); y.z = cvtpk(bflo(x4.z) * w, bfhi(x4.z) * w); y.w = cvtpk(bflo(x4.w) * w, bfhi(x4.w) * w);
            *(LAS u32x4*)(TXh + r * TP32 + ck * 16) = y; }
        const float dsub = __expf(total);
        f32x16 P, oi;
#pragma unroll
        for (int reg = 0; reg < 16; ++reg) { P[reg] = 0.f; oi[reg] = 0.f; }
#pragma unroll
        for (int nh = 0; nh < 2; ++nh) {
            if (PASS_C) tile_store<64>(TC, pcq, lane);
            tile_store<64>(TB, pbb, lane);
            LDS_WAIT();
            if (nh == 0) { if (PASS_C) tile_load<64>(pcq, MIX, R0, dir, I, ccol + 64, lane); tile_load<64>(pbb, MIX, R0, dir, I, bcol + 64, lane); }
            else if (I + 1 < 8) { if (PASS_C) tile_load<64>(pcq, MIX, R0, dir, I + 1, ccol, lane); tile_load<64>(pbb, MIX, R0, dir, I + 1, bcol, lane);
                const int i_o = 32 * (I + 1) + c31; const int m_o = dir ? R0 + 255 - i_o : R0 + i_o; dtraw = DT[(size_t)m_o * 8 + dir * 4 + head]; }
            if (PASS_C) {
#pragma unroll
                for (int s = 0; s < 4; ++s) P = MFMA32(ld_row8(TB, TP64, c31, 16 * s + 8 * h), ld_row8(TC, TP64, c31, 16 * s + 8 * h), P);
#pragma unroll
                for (int kk = 0; kk < 2; ++kk) {
                    oi = MFMA32(ld_row8_perm(TC, TP64, c31, 32 * kk, h), pack8<0>(S[2 * nh + kk]), oi);
                    oi = MFMA32(ld_row8_perm(TC, TP64, c31, 32 * kk + 16, h), pack8<1>(S[2 * nh + kk]), oi);
                }
            }
#pragma unroll
            for (int kk = 0; kk < 2; ++kk) {
#pragma unroll
                for (int reg = 0; reg < 16; ++reg) S[2 * nh + kk][reg] *= dsub;
#pragma unroll
                for (int s = 0; s < 2; ++s)
                    S[2 * nh + kk] = MFMA32(ld_tr8(TB, TP64, 16 * s + 8 * h, 16 * s + 8 * h + 4, 32 * kk, lane), ld_tr8(TXh, TP32, 16 * s + 8 * h, 16 * s + 8 * h + 4, 0, lane), S[2 * nh + kk]);
            }
            LDS_WAIT();
        }
        if (PASS_C) {
            float bj[16], dj[16];
#pragma unroll
            for (int gq = 0; gq < 4; ++gq) { const f32x4 b4 = *(const LAS f32x4*)(brn + 8 * gq + 4 * h), d4 = *(const LAS f32x4*)(dtv + 8 * gq + 4 * h);
                bj[4 * gq] = b4.x; bj[4 * gq + 1] = b4.y; bj[4 * gq + 2] = b4.z; bj[4 * gq + 3] = b4.w; dj[4 * gq] = d4.x; dj[4 * gq + 1] = d4.y; dj[4 * gq + 2] = d4.z; dj[4 * gq + 3] = d4.w; }
#pragma unroll
            for (int reg = 0; reg < 16; ++reg) P[reg] = (crow(reg, h) <= c31) ? P[reg] * dj[reg] * __expf(run - bj[reg]) : 0.f;
#pragma unroll
            for (int reg = 0; reg < 16; ++reg) oi[reg] = oi[reg] * __expf(bj[reg]);
            oi = MFMA32(pack8<0>(P), ld_tr8(TX, TP32, 4 * h, 8 + 4 * h, 0, lane), oi);
            oi = MFMA32(pack8<1>(P), ld_tr8(TX, TP32, 16 + 4 * h, 24 + 4 * h, 0, lane), oi);
#pragma unroll
            for (int reg = 0; reg < 16; reg += 2) { const unsigned w0 = cvtpk(oi[reg], oi[reg + 1]);
                *(LAS bf16_t*)(TXh + crow(reg, h) * TP32 + c31 * 2) = (bf16_t)w0; *(LAS bf16_t*)(TXh + crow(reg + 1, h) * TP32 + c31 * 2) = (bf16_t)(w0 >> 16); }
            LDS_WAIT();
#pragma unroll
            for (int t = 0; t < 2; ++t) { const int id = lane + 64 * t, r = id >> 2, ck = id & 3; const int i = 32 * I + r; const int m = dir ? R0 + 255 - i : R0 + i;
                __builtin_nontemporal_store(*(const LAS u32x4*)(TXh + r * TP32 + ck * 16), (u32x4*)((char*)OUT + ((unsigned)m * (unsigned)ldo + (unsigned)(head * 64 + 32 * vb + ck * 8)) * 2u)); }
        }
        LDS_WAIT();
    }
    if (!PASS_C) {
#pragma unroll
        for (int kb = 0; kb < 4; ++kb)
#pragma unroll
            for (int q4 = 0; q4 < 2; ++q4) { const f32x16& T = S[kb]; u32x4 w; w.x = cvtpk(T[8 * q4], T[8 * q4 + 1]); w.y = cvtpk(T[8 * q4 + 2], T[8 * q4 + 3]); w.z = cvtpk(T[8 * q4 + 4], T[8 * q4 + 5]); w.w = cvtpk(T[8 * q4 + 6], T[8 * q4 + 7]);
                *(u32x4*)(ST + lane * 64 + kb * 16 + q4 * 8) = w; }
        if (vb == 0 && lane == 0) ((float*)(F.ws + WS_DLB))[seq * NCH + pc] = gtot;
    }
}

constexpr int NA_GQA = 2048, NA_NA = 2048, NA_CTX = 256;
template <int TYPE> __device__ __forceinline__ void attn_task(Frame& F, int l, int u, bf16_t* BR) {
    const bf16_t* MIX = (const bf16_t*)(F.ws + WS_RC);
    const int lane_ = tid_from_lds(F.lds, F.wave_s) & 63;
    const int lane = lane_, h = lane >> 5, c31 = lane & 31;
    LAS unsigned char* wl = F.lds + F.wave * WLDS; LAS unsigned char* TV = wl; LAS float* al = (LAS float*)(wl + 4608);
    int qrow0, qcol, kcol, vcol, ocol, b, ntiles, r = 0, c0 = 0, hh = 0;
    if (TYPE == 0) { b = u >> 9; const int hq = (u >> 7) & 3, tb = u & 127; qrow0 = b * SEQ + tb * 32; qcol = C_DQ + hq * 64; kcol = C_DK + (hq >> 1) * 64; vcol = C_DV + (hq >> 1) * 64; ocol = 768 + hq * 64; ntiles = 8 + 128; }
    else if (TYPE == 1) { b = u >> 9; hh = (u >> 7) & 3; r = (u >> 1) & 63; c0 = (u & 1) * 32; qrow0 = b * SEQ + r * 64 + c0; qcol = C_CQ + hh * 64; kcol = C_CK + hh * 64; vcol = C_CV + hh * 64; ocol = 512 + hh * 64; ntiles = 8 + 16; }
    else { b = u >> 6; const int h8 = (u >> 3) & 7, tb = u & 7; qrow0 = MLAT + b * CTXL + tb * 32; ntiles = 8;
        if (h8 < 4) { qcol = C_CQ + h8 * 64; kcol = C_CK + h8 * 64; vcol = C_CV + h8 * 64; ocol = 512 + h8 * 64; } else { const int hq = h8 - 4; qcol = C_DQ + hq * 64; kcol = C_DK + (hq >> 1) * 64; vcol = C_DV + (hq >> 1) * 64; ocol = 768 + hq * 64; } }
    const int rs = min(max(r - 4, 0), 56);
    const float* rpb = FIN(15) + (size_t)(l * 4 + hh) * 15 * 31;
    const int cq = c0 + c31, cs = min(max(cq - 8, 0), 48);
#define TILE_ROW(t) ((t) < 8 ? MLAT + b * CTXL + 32 * (t) : (TYPE == 1 ? b * SEQ + (rs + (((t) - 8) >> 1)) * 64 + 32 * (((t) - 8) & 1) : b * SEQ + 32 * ((t) - 8)))
    bf16x8 qf[4];
#pragma unroll
    for (int s = 0; s < 4; ++s) qf[s] = *(const bf16x8*)(MIX + (size_t)(qrow0 + c31) * NMIX + qcol + 16 * s + 8 * h);
    f32x16 O0, O1;
#pragma unroll
    for (int reg = 0; reg < 16; ++reg) { O0[reg] = 0.f; O1[reg] = 0.f; }
    float m_run = -1e30f, l_run = 0.f;
    bf16x8 kf[4]; u32x4 vr[4];
    { const int kr0 = TILE_ROW(0);
#pragma unroll
      for (int s = 0; s < 4; ++s) kf[s] = *(const bf16x8*)(MIX + (size_t)(kr0 + c31) * NMIX + kcol + 16 * s + 8 * h);
#pragma unroll
      for (int t4 = 0; t4 < 4; ++t4) { const int id = lane + 64 * t4; vr[t4] = *(const u32x4*)(MIX + (size_t)(kr0 + (id >> 3)) * NMIX + vcol + (id & 7) * 8); } }
#pragma unroll 1
    for (int t = 0; t < ntiles; ++t) {
#pragma unroll
        for (int t4 = 0; t4 < 4; ++t4) { const int id = lane + 64 * t4; *(LAS u32x4*)(TV + (id >> 3) * TP64 + (id & 7) * 16) = vr[t4]; }
        asm volatile("" ::: "memory");
        f32x16 S;
#pragma unroll
        for (int reg = 0; reg < 16; ++reg) S[reg] = 0.f;
#pragma unroll
        for (int s = 0; s < 4; ++s) S = MFMA32(kf[s], qf[s], S);
        if (t + 1 < ntiles) { const int kr1 = TILE_ROW(t + 1);
#pragma unroll
            for (int s = 0; s < 4; ++s) kf[s] = *(const bf16x8*)(MIX + (size_t)(kr1 + c31) * NMIX + kcol + 16 * s + 8 * h);
#pragma unroll
            for (int t4 = 0; t4 < 4; ++t4) { const int id = lane + 64 * t4; vr[t4] = *(const u32x4*)(MIX + (size_t)(kr1 + (id >> 3)) * NMIX + vcol + (id & 7) * 8); } }
        if (TYPE == 1 && t >= 8) {
            const int kr = rs + ((t - 8) >> 1), kc0 = 32 * ((t - 8) & 1); const float* rb = rpb + (kr - r + 7) * 31 + (15 - cq);
#pragma unroll
            for (int reg = 0; reg < 16; ++reg) { const int kc = kc0 + crow(reg, h); const bool ok = (kc >= cs) && (kc < cs + 16);
                const float bias = ok ? rb[kc] : 0.f; S[reg] = ok ? S[reg] * 0.125f + bias : -1e30f; }
        } else {
#pragma unroll
            for (int reg = 0; reg < 16; ++reg) S[reg] *= 0.125f;
        }
        float mloc = fmaxf(fmaxf(fmaxf(S[0], S[1]), fmaxf(S[2], S[3])), fmaxf(fmaxf(S[4], S[5]), fmaxf(S[6], S[7])));
        mloc = fmaxf(mloc, fmaxf(fmaxf(fmaxf(S[8], S[9]), fmaxf(S[10], S[11])), fmaxf(fmaxf(S[12], S[13]), fmaxf(S[14], S[15]))));
        mloc = fmaxf(mloc, bperm_(mloc, lane ^ 32));
        const float m_new = fmaxf(m_run, mloc);
        const float alpha = __expf(m_run - m_new);
        m_run = m_new;
        float ls = 0.f;
#pragma unroll
        for (int reg = 0; reg < 16; ++reg) { const float p = __expf(S[reg] - m_new); ls += p; S[reg] = p; }
        l_run = l_run * alpha + ls;
        if (lane < 32) al[c31] = alpha;
        LDS_WAIT();
        const bf16x8 pa0 = pack8<0>(S), pa1 = pack8<1>(S);
        {
#pragma unroll
            for (int g = 0; g < 4; ++g) { const f32x4 a4 = *(const LAS f32x4*)(al + 8 * g + 4 * h);
                O0[4 * g] *= a4.x; O0[4 * g + 1] *= a4.y; O0[4 * g + 2] *= a4.z; O0[4 * g + 3] *= a4.w;
                O1[4 * g] *= a4.x; O1[4 * g + 1] *= a4.y; O1[4 * g + 2] *= a4.z; O1[4 * g + 3] *= a4.w; }
        }
        O0 = MFMA32(pa0, ld_tr8(TV, TP64, 4 * h, 8 + 4 * h, 0, lane), O0);
        O0 = MFMA32(pa1, ld_tr8(TV, TP64, 16 + 4 * h, 24 + 4 * h, 0, lane), O0);
        O1 = MFMA32(pa0, ld_tr8(TV, TP64, 4 * h, 8 + 4 * h, 32, lane), O1);
        O1 = MFMA32(pa1, ld_tr8(TV, TP64, 16 + 4 * h, 24 + 4 * h, 32, lane), O1);
    }
#undef TILE_ROW
    l_run += bperm_(l_run, lane ^ 32);
    if (lane < 32) al[c31] = 1.f / l_run;
    LDS_WAIT();
#pragma unroll
    for (int g = 0; g < 4; ++g) { const f32x4 a4 = *(const LAS f32x4*)(al + 8 * g + 4 * h);
        O0[4 * g] *= a4.x; O0[4 * g + 1] *= a4.y; O0[4 * g + 2] *= a4.z; O0[4 * g + 3] *= a4.w;
        O1[4 * g] *= a4.x; O1[4 * g + 1] *= a4.y; O1[4 * g + 2] *= a4.z; O1[4 * g + 3] *= a4.w; }
#pragma unroll
    for (int reg = 0; reg < 16; ++reg) { bf16_t* op = BR + (size_t)(qrow0 + crow(reg, h)) * DM + ocol + c31; op[0] = (bf16_t)f2bf(O0[reg]); op[32] = (bf16_t)f2bf(O1[reg]); }
    LDS_WAIT();
}

constexpr int AB_TILE = 9216;
constexpr int AB_AL = 4 * AB_TILE;
template <int TYPE>
__device__ __forceinline__ void attn_block_task(Frame& F, int l, int u, bf16_t* BR) {
    const bf16_t* MIX = (const bf16_t*)(F.ws + WS_RC);
    const int lane_ = tid_from_lds(F.lds, F.wave_s) & 63;
    const int lane = lane_, h = lane >> 5, c31 = lane & 31, tid = F.wave * 64 + lane;
    int b, qrow0, qcol, kcol, vcol, ocol, ntile, r = 0, c0 = 0, hh = 0, r0 = 0;
    if (TYPE == 0) { b = u >> 6; const int hq = (u >> 4) & 3, qblk = u & 15; qrow0 = b * SEQ + qblk * 256 + F.wave * 32; qcol = C_DQ + hq * 64; kcol = C_DK + (hq >> 1) * 64; vcol = C_DV + (hq >> 1) * 64; ocol = 768 + hq * 64; ntile = 4 + 64; }
    else { b = u >> 6; hh = (u >> 4) & 3; r0 = (u & 15) * 4; r = r0 + (F.wave >> 1); c0 = (F.wave & 1) * 32; qrow0 = b * SEQ + r * 64 + c0; qcol = C_CQ + hh * 64; kcol = C_CK + hh * 64; vcol = C_CV + hh * 64; ocol = 512 + hh * 64;
           ntile = 4 + (min(max(r0 + 3 - 4, 0), 56) - min(max(r0 - 4, 0), 56) + 8); }
    const int rs_blk = min(max(r0 - 4, 0), 56), rs = min(max(r - 4, 0), 56);
    const float* rpb = FIN(15) + (size_t)(l * 4 + hh) * 15 * 31;
    const int cq = c0 + c31, cs = min(max(cq - 8, 0), 48);
    LAS unsigned char* lds = F.lds; LAS float* al = (LAS float*)(lds + AB_AL + F.wave * 128);
    LAS float* rpbL = (LAS float*)(lds + AB_AL + 1024);
    if (TYPE == 1) { if (tid < 465) rpbL[tid] = rpb[tid]; }
    const int prow = tid >> 3, pck = tid & 7;
    const unsigned pdst = prow * TP64 + pck * 16;
    const int NTILE = ntile;
#define AB_TROW(t) ((t) < 4 ? MLAT + b * CTXL + 64 * (t) : (TYPE == 0 ? b * SEQ + 64 * ((t) - 4) : b * SEQ + 64 * (rs_blk + (t) - 4)))
    bf16x8 qf[4];
#pragma unroll
    for (int s = 0; s < 4; ++s) qf[s] = *(const bf16x8*)(MIX + (size_t)(qrow0 + c31) * NMIX + qcol + 16 * s + 8 * h);
    f32x16 O0, O1;
#pragma unroll
    for (int reg = 0; reg < 16; ++reg) { O0[reg] = 0.f; O1[reg] = 0.f; }
    float m_run = -1e30f, l_run = 0.f;
    constexpr float SC2 = 0.125f * 1.4426950408889634f;
    constexpr float L2E = 1.4426950408889634f;
    u32x4 kr0, vr0, kr1, vr1, kr2, vr2;
#define AB_LOAD(T, KR, VR) do { const size_t ro_ = (size_t)(AB_TROW(T) + prow) * NMIX + pck * 8; KR = *(const u32x4*)(MIX + ro_ + kcol); VR = *(const u32x4*)(MIX + ro_ + vcol); } while (0)
    AB_LOAD(0, kr0, vr0);
    *(LAS u32x4*)(lds + pdst) = kr0; *(LAS u32x4*)(lds + AB_TILE + pdst) = vr0;
    AB_LOAD(1, kr0, vr0); AB_LOAD(2, kr1, vr1); AB_LOAD(3, kr2, vr2);
    __syncthreads();
#define AB_BODY(T, KR, VR) do { \
        LAS unsigned char* KB = lds + ((T) & 1) * 2 * AB_TILE; LAS unsigned char* VB = KB + AB_TILE; \
        const int kr_ = rs_blk + (T) - 4;                                  \
        if (TYPE == 0 || (T) < 4 || (kr_ >= rs && kr_ < rs + 8)) {         \
        f32x16 S0, S1; \
        _Pragma("unroll") for (int reg = 0; reg < 16; ++reg) { S0[reg] = 0.f; S1[reg] = 0.f; } \
        _Pragma("unroll") for (int s = 0; s < 4; ++s) { S0 = MFMA32(ld_row8(KB, TP64, c31, 16 * s + 8 * h), qf[s], S0); S1 = MFMA32(ld_row8(KB, TP64, 32 + c31, 16 * s + 8 * h), qf[s], S1); } \
        if (TYPE == 1 && (T) >= 4) {                                       \
            const LAS float* rbl = rpbL + (kr_ - r + 7) * 31; \
            _Pragma("unroll") for (int reg = 0; reg < 16; ++reg) { const int kc = crow(reg, h); \
                const bool ok0 = (kc >= cs) && (kc < cs + 16), ok1 = (kc + 32 >= cs) && (kc + 32 < cs + 16); \
                const float b0 = rbl[min(max(kc - cq + 15, 0), 30)], b1 = rbl[min(max(kc + 32 - cq + 15, 0), 30)];     \
                S0[reg] = ok0 ? fmaf(S0[reg], SC2, b0 * L2E) : -1e30f; S1[reg] = ok1 ? fmaf(S1[reg], SC2, b1 * L2E) : -1e30f; } \
        } \
        const bool pre = (TYPE == 1 && (T) >= 4);                  \
        float mloc = fmaxf(fmaxf(fmaxf(S0[0], S0[1]), fmaxf(S0[2], S0[3])), fmaxf(fmaxf(S0[4], S0[5]), fmaxf(S0[6], S0[7]))); \
        mloc = fmaxf(mloc, fmaxf(fmaxf(fmaxf(S0[8], S0[9]), fmaxf(S0[10], S0[11])), fmaxf(fmaxf(S0[12], S0[13]), fmaxf(S0[14], S0[15])))); \
        mloc = fmaxf(mloc, fmaxf(fmaxf(fmaxf(S1[0], S1[1]), fmaxf(S1[2], S1[3])), fmaxf(fmaxf(S1[4], S1[5]), fmaxf(S1[6], S1[7])))); \
        mloc = fmaxf(mloc, fmaxf(fmaxf(fmaxf(S1[8], S1[9]), fmaxf(S1[10], S1[11])), fmaxf(fmaxf(S1[12], S1[13]), fmaxf(S1[14], S1[15])))); \
        if (!pre) mloc *= SC2; \
        { const auto rr_ = __builtin_amdgcn_permlane32_swap(__float_as_uint(mloc), __float_as_uint(mloc), false, false); mloc = fmaxf(__uint_as_float(rr_[0]), __uint_as_float(rr_[1])); } \
        if (__any(mloc > m_run + 8.f)) {                         \
            const float m_new = fmaxf(m_run, mloc); \
            const float alpha = __builtin_amdgcn_exp2f(m_run - m_new); \
            m_run = m_new; l_run *= alpha; \
            if (lane < 32) al[c31] = alpha; \
            LDS_WAIT(); \
            _Pragma("unroll") for (int g = 0; g < 4; ++g) { const f32x4 a4 = *(const LAS f32x4*)(al + 8 * g + 4 * h); \
                O0[4 * g] *= a4.x; O0[4 * g + 1] *= a4.y; O0[4 * g + 2] *= a4.z; O0[4 * g + 3] *= a4.w; \
                O1[4 * g] *= a4.x; O1[4 * g + 1] *= a4.y; O1[4 * g + 2] *= a4.z; O1[4 * g + 3] *= a4.w; } \
            LDS_WAIT(); \
        } \
        float ls = 0.f; \
        if (pre) { _Pragma("unroll") for (int reg = 0; reg < 16; ++reg) { const float p0 = __builtin_amdgcn_exp2f(S0[reg] - m_run), p1 = __builtin_amdgcn_exp2f(S1[reg] - m_run); ls += p0 + p1; S0[reg] = p0; S1[reg] = p1; } } \
        else     { _Pragma("unroll") for (int reg = 0; reg < 16; ++reg) { const float p0 = __builtin_amdgcn_exp2f(fmaf(S0[reg], SC2, -m_run)), p1 = __builtin_amdgcn_exp2f(fmaf(S1[reg], SC2, -m_run)); ls += p0 + p1; S0[reg] = p0; S1[reg] = p1; } } \
        l_run += ls; \
        const bf16x8 pa0 = pack8<0>(S0), pa1 = pack8<1>(S0), pa2 = pack8<0>(S1), pa3 = pack8<1>(S1); \
        O0 = MFMA32(pa0, ld_tr8(VB, TP64, 4 * h, 8 + 4 * h, 0, lane), O0); \
        O1 = MFMA32(pa0, ld_tr8(VB, TP64, 4 * h, 8 + 4 * h, 32, lane), O1); \
        O0 = MFMA32(pa1, ld_tr8(VB, TP64, 16 + 4 * h, 24 + 4 * h, 0, lane), O0); \
        O1 = MFMA32(pa1, ld_tr8(VB, TP64, 16 + 4 * h, 24 + 4 * h, 32, lane), O1); \
        O0 = MFMA32(pa2, ld_tr8(VB, TP64, 32 + 4 * h, 40 + 4 * h, 0, lane), O0); \
        O1 = MFMA32(pa2, ld_tr8(VB, TP64, 32 + 4 * h, 40 + 4 * h, 32, lane), O1); \
        O0 = MFMA32(pa3, ld_tr8(VB, TP64, 48 + 4 * h, 56 + 4 * h, 0, lane), O0); \
        O1 = MFMA32(pa3, ld_tr8(VB, TP64, 48 + 4 * h, 56 + 4 * h, 32, lane), O1); \
        } \
        if ((T) + 1 < NTILE) { LAS unsigned char* KN = lds + (((T) + 1) & 1) * 2 * AB_TILE; *(LAS u32x4*)(KN + pdst) = KR; *(LAS u32x4*)(KN + AB_TILE + pdst) = VR; } \
        if ((T) + 4 < NTILE) AB_LOAD((T) + 4, KR, VR); \
        __syncthreads(); \
    } while (0)
#pragma unroll 1
    for (int t = 0; t < NTILE; t += 3) {
        AB_BODY(t, kr0, vr0);
        if (t + 1 < NTILE) AB_BODY(t + 1, kr1, vr1);
        if (t + 2 < NTILE) AB_BODY(t + 2, kr2, vr2);
    }
#undef AB_BODY
#undef AB_LOAD
#undef AB_TROW
    l_run += bperm_(l_run, lane ^ 32);
    if (lane < 32) al[c31] = 1.f / l_run;
    LDS_WAIT();
#pragma unroll
    for (int g = 0; g < 4; ++g) { const f32x4 a4 = *(const LAS f32x4*)(al + 8 * g + 4 * h);
        O0[4 * g] *= a4.x; O0[4 * g + 1] *= a4.y; O0[4 * g + 2] *= a4.z; O0[4 * g + 3] *= a4.w;
        O1[4 * g] *= a4.x; O1[4 * g + 1] *= a4.y; O1[4 * g + 2] *= a4.z; O1[4 * g + 3] *= a4.w; }
#pragma unroll
    for (int reg = 0; reg < 16; ++reg) { bf16_t* op = BR + (size_t)(qrow0 + crow(reg, h)) * DM + ocol + c31; op[0] = (bf16_t)f2bf(O0[reg]); op[32] = (bf16_t)f2bf(O1[reg]); }
    __syncthreads();
}


namespace gx {
constexpr int NSLOT = 3, SLOTB = 8192, KVBLK = 64;
constexpr int LDS_K = 0, LDS_V = NSLOT * SLOTB, LDS_WS = 2 * NSLOT * SLOTB, LDS_OST = LDS_WS + 8 * 64 * 4, LDS_BYTES_GX = LDS_OST + 8 * 4096;
typedef LAS const char* lds_cptr;
typedef short v4i16_t __attribute__((ext_vector_type(4)));
#define GX_SBAR() __builtin_amdgcn_sched_barrier(0)
__device__ __forceinline__ void glds16(const void* gsrc, unsigned lds_dst) { unsigned keep;
    asm volatile("s_mov_b32 %0, m0\n\ts_mov_b32 m0, %2\n\ts_nop 0\n\tglobal_load_lds_dwordx4 %1, off\n\ts_mov_b32 m0, %0" : "=&s"(keep) : "v"(gsrc), "s"(lds_dst) : "memory"); }
__device__ __forceinline__ float max3f(float a, float b, float c) { float r; asm("v_max3_f32 %0, %1, %2, %3" : "=v"(r) : "v"(a), "v"(b), "v"(c)); return r; }
__device__ __forceinline__ float max2f(float a, float b) { float r; asm("v_max_f32_e32 %0, %1, %2" : "=v"(r) : "v"(a), "v"(b)); return r; }
__device__ __forceinline__ float fadd_s(float a, float b) { float r; asm("v_add_f32_e32 %0, %1, %2" : "=v"(r) : "v"(a), "v"(b)); return r; }
__device__ __forceinline__ float fsub_s(float a, float b) { float r; asm("v_sub_f32_e32 %0, %1, %2" : "=v"(r) : "v"(a), "v"(b)); return r; }
__device__ __forceinline__ unsigned cvtpk_s(float lo, float hi) { f32x2_t v = {lo, hi}; bf16x2_t b = __builtin_convertvector(v, bf16x2_t); return __builtin_bit_cast(unsigned, b); }
#define GX_WAIT_BAR(N) asm volatile("s_waitcnt vmcnt(" #N ") lgkmcnt(0)\n\ts_barrier" ::: "memory")
__device__ __forceinline__ void qkt(f32x16& p0, f32x16& p1, lds_cptr Kslot, const bf16x8* qr, const f32x16& negm, int r32, int hi) {
    lds_cptr kb = Kslot + hi * 1024 + r32 * 16;
#pragma unroll
    for (int d0 = 0; d0 < 4; ++d0) {
        const bf16x8 b0 = *(const LAS bf16x8*)(kb + d0 * 2048);
        const bf16x8 b1 = *(const LAS bf16x8*)(kb + d0 * 2048 + 512);
        if (d0 == 0) { p0 = __builtin_amdgcn_mfma_f32_32x32x16_bf16(b0, qr[0], negm, 0, 0, 0); p1 = __builtin_amdgcn_mfma_f32_32x32x16_bf16(b1, qr[0], negm, 0, 0, 0); }
        else { p0 = __builtin_amdgcn_mfma_f32_32x32x16_bf16(b0, qr[d0], p0, 0, 0, 0); p1 = __builtin_amdgcn_mfma_f32_32x32x16_bf16(b1, qr[d0], p1, 0, 0, 0); } }
}
__device__ __forceinline__ void kload8(bf16x8* kf, lds_cptr kp) {
    kf[0] = *(const LAS bf16x8*)(kp);        kf[1] = *(const LAS bf16x8*)(kp + 512);
    kf[2] = *(const LAS bf16x8*)(kp + 2048); kf[3] = *(const LAS bf16x8*)(kp + 2560);
    kf[4] = *(const LAS bf16x8*)(kp + 4096); kf[5] = *(const LAS bf16x8*)(kp + 4608);
    kf[6] = *(const LAS bf16x8*)(kp + 6144); kf[7] = *(const LAS bf16x8*)(kp + 6656);
}
__device__ __forceinline__ void kload2(bf16x8* kf, lds_cptr kp, int j) { kf[2 * j] = *(const LAS bf16x8*)(kp + j * 2048); kf[2 * j + 1] = *(const LAS bf16x8*)(kp + j * 2048 + 512); }
__device__ __forceinline__ s16x4 vtr(lds_cptr p) { return __builtin_bit_cast(s16x4, __builtin_amdgcn_ds_read_tr16_b64_v4i16((LAS v4i16_t*)p)); }
__device__ __forceinline__ float rowmax(const f32x16& p0, const f32x16& p1) {
    float a = max3f(p0[0], p0[1], p1[0]), b = max3f(p0[2], p0[3], p1[1]); a = max3f(a, p1[2], p1[3]);
#pragma unroll
    for (int r = 4; r < 16; r += 4) { a = max3f(a, p0[r], p0[r + 1]); b = max3f(b, p0[r + 2], p0[r + 3]); a = max3f(a, p1[r], p1[r + 1]); b = max3f(b, p1[r + 2], p1[r + 3]); }
    const float m = max2f(a, b);
    auto rr = __builtin_amdgcn_permlane32_swap(__float_as_uint(m), __float_as_uint(m), false, false);
    return max2f(__uint_as_float(rr[0]), __uint_as_float(rr[1]));
}
__device__ __forceinline__ void pv(f32x16* o, int vb, bf16x8 pa0, bf16x8 pa1, bf16x8 pa2, bf16x8 pa3) {
#pragma unroll
    for (int d0 = 0; d0 < 2; ++d0) { s16x4 lo[4], hi[4];
#pragma unroll
        for (int ks = 0; ks < 4; ++ks) {
            asm volatile("ds_read_b64_tr_b16 %0,%1 offset:%c2" : "=&v"(lo[ks]) : "v"(vb), "i"(d0 * 4096 + ks * 1024) : "memory");
            asm volatile("ds_read_b64_tr_b16 %0,%1 offset:%c2" : "=&v"(hi[ks]) : "v"(vb), "i"(d0 * 4096 + ks * 1024 + 512) : "memory"); }
        asm volatile("s_waitcnt lgkmcnt(0)" ::: "memory"); GX_SBAR();
#define GX_PK(k) (bf16x8){lo[k][0], lo[k][1], lo[k][2], lo[k][3], hi[k][0], hi[k][1], hi[k][2], hi[k][3]}
        o[d0] = __builtin_amdgcn_mfma_f32_32x32x16_bf16(pa0, GX_PK(0), o[d0], 0, 0, 0);
        o[d0] = __builtin_amdgcn_mfma_f32_32x32x16_bf16(pa1, GX_PK(1), o[d0], 0, 0, 0);
        o[d0] = __builtin_amdgcn_mfma_f32_32x32x16_bf16(pa2, GX_PK(2), o[d0], 0, 0, 0);
        o[d0] = __builtin_amdgcn_mfma_f32_32x32x16_bf16(pa3, GX_PK(3), o[d0], 0, 0, 0);
#undef GX_PK
    }
}
template <int THRL> __device__ __forceinline__ void gqa_unit(Frame& F, int u, bf16_t* BR) {
    const bf16_t* MIX = (const bf16_t*)(F.ws + WS_RC);
    const int lane_ = tid_from_lds(F.lds, F.wave_s) & 63;
    const int lane = lane_, r32 = lane & 31, hi = lane >> 5, wid = F.wave;
    const int ux = u & 7, uj = u >> 3;
    const int b = ux >> 1, hq = 2 * (ux & 1) + (uj >> 4), qblk = uj & 15;
    const int qrow0 = b * SEQ + qblk * 256 + wid * 32, qcol = C_DQ + hq * 64, kcol = C_DK + (hq >> 1) * 64, vcol = C_DV + (hq >> 1) * 64, ocol = 768 + hq * 64;
    constexpr int NT = 64 + 4;
#define GX_TROW(t) ((t) < 64 ? b * SEQ + 64 * (t) : MLAT + b * CTXL + 64 * ((t) - 64))
    const bf16_t* Qw = MIX + (size_t)qrow0 * NMIX + qcol;
    LAS unsigned char* shm = F.lds;
    const unsigned lds0 = 0u;
    LAS float* wsf = (LAS float*)(shm + LDS_WS) + wid * 64;
    const bf16_t* ksrc = MIX + (size_t)lane * NMIX + kcol + wid * 8;
    const bf16_t* vsrc = MIX + (size_t)(16 * (wid & 3) + (lane >> 2)) * NMIX + vcol + (wid >> 2) * 32 + (lane & 3) * 8;
    const unsigned kdst = lds0 + LDS_K + wid * 1024, vdst = lds0 + LDS_V + wid * 1024;
#define GX_DMA_K(t, slot) glds16(ksrc + (size_t)GX_TROW(t) * NMIX, (unsigned)__builtin_amdgcn_readfirstlane(kdst + (slot)))
#define GX_DMA_V(t, slot) glds16(vsrc + (size_t)GX_TROW(t) * NMIX, (unsigned)__builtin_amdgcn_readfirstlane(vdst + (slot)))
    const int vb0 = (int)(lds0 + LDS_V) + ((lane >> 4) & 1) * 32 + (lane & 3) * 8 + (4 * hi + ((lane & 15) >> 2)) * 64;
    bf16x8 kf[8];
    const lds_cptr shm3 = (lds_cptr)shm; const lds_cptr kp0 = shm3 + LDS_K + hi * 1024 + r32 * 16; const lds_cptr vp0 = shm3 + LDS_V + ((lane >> 4) & 1) * 32 + (lane & 3) * 8 + (4 * hi + ((lane & 15) >> 2)) * 64;
    GX_DMA_K(0, 0); GX_DMA_V(0, 0); GX_DMA_K(1, SLOTB);
    bf16x8 qr[4];
#pragma unroll
    for (int d0 = 0; d0 < 4; ++d0) qr[d0] = *(const bf16x8*)(Qw + (size_t)r32 * NMIX + d0 * 16 + hi * 8);
    float mhat = 0.f, l_reg = 0.f; f32x16 o[2]; o[0] = f32x16{}; o[1] = f32x16{}; f32x16 negm = f32x16{}; asm volatile("" : "+v"(negm));
    bool resc = false;
#define GX_START(P0, P1) do { const float rm = rowmax(P0, P1); resc = false; \
    { const float dl = rm; mhat = fadd_s(mhat, dl); \
      _Pragma("unroll") for (int r = 0; r < 16; ++r) { P0[r] = fsub_s(P0[r], dl); P1[r] = fsub_s(P1[r], dl); } \
      _Pragma("unroll") for (int r = 0; r < 16; ++r) negm[r] = -mhat; asm volatile("" : "+v"(negm)); } \
    _Pragma("unroll") for (int r = 0; r < 16; ++r) P0[r] = __builtin_amdgcn_exp2f(P0[r]); } while (0)
#define GX_RESC() do { if (resc) { asm volatile("s_waitcnt lgkmcnt(0)" ::: "memory"); \
      _Pragma("unroll") for (int d_ = 0; d_ < 2; ++d_) _Pragma("unroll") for (int r = 0; r < 16; ++r) o[d_][r] *= wsf[crow(r, hi)]; } } while (0)
    f32x16 pA0, pA1, pB0, pB1;
    int sl_prev = 0, sl_cur = 0, sl_next = SLOTB;
#define GX_ROT() do { sl_prev = sl_cur; sl_cur = sl_next; sl_next = (sl_next == (NSLOT - 1) * SLOTB) ? 0 : sl_next + SLOTB; } while (0)
    GX_DMA_K(2, 2 * SLOTB);
    GX_WAIT_BAR(3);
    qkt(pA0, pA1, shm3 + LDS_K, qr, negm, r32, hi); asm volatile("s_nop 15\n\ts_nop 7" : "+v"(pA0), "+v"(pA1));
    GX_START(pA0, pA1);
    _Pragma("unroll") for (int r = 0; r < 16; ++r) pA1[r] = __builtin_amdgcn_exp2f(pA1[r]);
    GX_WAIT_BAR(0);
    GX_DMA_K(3, 0); GX_DMA_V(1, SLOTB);
    GX_ROT();
    kload8(kf, kp0 + sl_cur);
    GX_WAIT_BAR(2);
    s16x4 vlo[8], vhi[8]; u32x4 pw0, pw1, pw2, pw3;
#define GX_PKW(P, B) cvtpk_s(P[B], P[B + 1])
#define GX_PAF(k) __builtin_bit_cast(bf16x8, pw##k)
#define GX_VFR(i) (bf16x8){vlo[i][0], vlo[i][1], vlo[i][2], vlo[i][3], vhi[i][0], vhi[i][1], vhi[i][2], vhi[i][3]}
#define GX_PIN(x) asm volatile("" : "+v"(x))
#define GX_MX3(a, b, c) __builtin_fmaxf(__builtin_fmaxf((a), (b)), (c))
#define GX_GAPA(MF, A0, A1, A2, A3, W0, W1, PW) do { MF; sacc += A0; sacc += A1; sacc += A2; sacc += A3; GX_PIN(sacc); W0; W1; GX_PIN(PW); GX_SBAR(); } while (0)
#define GX_EX(v) __builtin_amdgcn_exp2f(v)
#define GX_GAPB(MF, X, B) do { MF; X[B] = GX_EX(X[B]); X[B + 1] = GX_EX(X[B + 1]); X[B + 2] = GX_EX(X[B + 2]); X[B + 3] = GX_EX(X[B + 3]); GX_PIN(X); GX_SBAR(); } while (0)
#define GX_VRD(i) do { vlo[i] = vtr(vp_ + (((i) >> 2) * 4096 + ((i) & 3) * 1024)); vhi[i] = vtr(vp_ + (((i) >> 2) * 4096 + ((i) & 3) * 1024 + 512)); } while (0)
#define GX_KRD(G, j) do { if (G) { kload2(kf, kp0 + sl_next, j); GX_SBAR(); } } while (0)
#define GX_MFMA __builtin_amdgcn_mfma_f32_32x32x16_bf16
#define GX_STEP(C0, C1, P0, P1, t, GK, GV, GL) do { GX_SBAR(); \
    const lds_cptr vp_ = vp0 + sl_prev; \
    GX_VRD(0); GX_SBAR(); float sacc = (P0[0] + P0[1]); \
    GX_GAPA(C0 = GX_MFMA(kf[0], qr[0], negm, 0, 0, 0), P0[2], P0[3], P0[4], P0[5],     pw0[0] = GX_PKW(P0, 0), pw0[1] = GX_PKW(P0, 2), pw0); \
    GX_VRD(4); GX_SBAR(); GX_GAPA(C1 = GX_MFMA(kf[1], qr[0], negm, 0, 0, 0), P0[6], P0[7], P0[8], P0[9],     pw0[2] = GX_PKW(P0, 4), pw0[3] = GX_PKW(P0, 6), pw0); \
    GX_VRD(1); GX_SBAR(); GX_GAPA(C0 = GX_MFMA(kf[2], qr[1], C0, 0, 0, 0),   P0[10], P0[11], P0[12], P0[13], pw1[0] = GX_PKW(P0, 8), pw1[1] = GX_PKW(P0, 10), pw1); \
    GX_VRD(5); GX_SBAR(); GX_GAPA(C1 = GX_MFMA(kf[3], qr[1], C1, 0, 0, 0),   P0[14], P0[15], P1[0], P1[1],   pw1[2] = GX_PKW(P0, 12), pw1[3] = GX_PKW(P0, 14), pw1); \
    GX_VRD(2); GX_SBAR(); GX_GAPA(C0 = GX_MFMA(kf[4], qr[2], C0, 0, 0, 0),   P1[2], P1[3], P1[4], P1[5],     pw2[0] = GX_PKW(P1, 0), pw2[1] = GX_PKW(P1, 2), pw2); \
    GX_VRD(6); GX_SBAR(); GX_GAPA(C1 = GX_MFMA(kf[5], qr[2], C1, 0, 0, 0),   P1[6], P1[7], P1[8], P1[9],     pw2[2] = GX_PKW(P1, 4), pw2[3] = GX_PKW(P1, 6), pw2); \
    GX_VRD(3); GX_SBAR(); GX_GAPA(C0 = GX_MFMA(kf[6], qr[3], C0, 0, 0, 0),   P1[10], P1[11], P1[12], P1[13], pw3[0] = GX_PKW(P1, 8), pw3[1] = GX_PKW(P1, 10), pw3); \
    GX_VRD(7); GX_SBAR(); GX_GAPA(C1 = GX_MFMA(kf[7], qr[3], C1, 0, 0, 0),   P1[14], P1[15], 0.f, 0.f,       pw3[2] = GX_PKW(P1, 12), pw3[3] = GX_PKW(P1, 14), pw3); \
    l_reg += sacc; \
    if (GK) { GX_DMA_K((t) + 3, sl_cur); } if (GV) { GX_DMA_V((t) + 1, sl_next); } \
    { float a = GX_MX3(C0[0], C0[1], C1[0]), b_ = GX_MX3(C0[2], C0[3], C1[1]); a = GX_MX3(a, C1[2], C1[3]); \
      _Pragma("unroll") for (int r = 4; r < 16; r += 4) { a = GX_MX3(a, C0[r], C0[r + 1]); b_ = GX_MX3(b_, C0[r + 2], C0[r + 3]); a = GX_MX3(a, C1[r], C1[r + 1]); b_ = GX_MX3(b_, C1[r + 2], C1[r + 3]); } \
      float rm = __builtin_fmaxf(a, b_); { auto rr = __builtin_amdgcn_permlane32_swap(__float_as_uint(rm), __float_as_uint(rm), false, false); rm = __builtin_fmaxf(__uint_as_float(rr[0]), __uint_as_float(rr[1])); } \
      resc = false; \
      if (__builtin_expect(__any(rm > (float)THRL), 0)) { const float dl = __builtin_fmaxf(rm, 0.f); mhat += dl; \
        _Pragma("unroll") for (int r = 0; r < 16; ++r) { C0[r] -= dl; C1[r] -= dl; } \
        _Pragma("unroll") for (int r = 0; r < 16; ++r) negm[r] = -mhat; asm volatile("" : "+v"(negm)); \
        const float f = __builtin_amdgcn_exp2f(-dl); l_reg *= f; if (hi == 0) wsf[r32] = f; resc = true; } } \
    GX_SBAR(); \
    GX_GAPB(o[0] = GX_MFMA(GX_PAF(0), GX_VFR(0), o[0], 0, 0, 0), C0, 0); \
    GX_GAPB(o[1] = GX_MFMA(GX_PAF(0), GX_VFR(4), o[1], 0, 0, 0), C0, 4); \
    GX_KRD(GL, 0); GX_GAPB(o[0] = GX_MFMA(GX_PAF(1), GX_VFR(1), o[0], 0, 0, 0), C0, 8); \
    GX_KRD(GL, 1); GX_GAPB(o[1] = GX_MFMA(GX_PAF(1), GX_VFR(5), o[1], 0, 0, 0), C0, 12); \
    GX_KRD(GL, 2); GX_GAPB(o[0] = GX_MFMA(GX_PAF(2), GX_VFR(2), o[0], 0, 0, 0), C1, 0); \
    GX_KRD(GL, 3); GX_GAPB(o[1] = GX_MFMA(GX_PAF(2), GX_VFR(6), o[1], 0, 0, 0), C1, 4); \
    GX_GAPB(o[0] = GX_MFMA(GX_PAF(3), GX_VFR(3), o[0], 0, 0, 0), C1, 8); \
    GX_GAPB(o[1] = GX_MFMA(GX_PAF(3), GX_VFR(7), o[1], 0, 0, 0), C1, 12); \
    } while (0)
    int t = 1;
#pragma unroll 1
    for (; t + 5 < NT; t += 2) {
        GX_STEP(pB0, pB1, pA0, pA1, t, true, true, true);     GX_WAIT_BAR(2); GX_RESC(); GX_ROT();
        GX_STEP(pA0, pA1, pB0, pB1, t + 1, true, true, true); GX_WAIT_BAR(2); GX_RESC(); GX_ROT();
    }
#define GX_ENDW(tt) do { if ((tt) + 3 < NT) { GX_WAIT_BAR(2); } else if ((tt) + 2 < NT) { GX_WAIT_BAR(1); } else { GX_WAIT_BAR(0); } } while (0)
#pragma unroll 1
    for (; t + 1 < NT; t += 2) {
        GX_STEP(pB0, pB1, pA0, pA1, t, (t + 3 < NT), (t + 1 < NT), (t + 1 < NT));         GX_ENDW(t);     GX_RESC(); GX_ROT();
        GX_STEP(pA0, pA1, pB0, pB1, t + 1, (t + 4 < NT), (t + 2 < NT), (t + 2 < NT));     GX_ENDW(t + 1); GX_RESC(); GX_ROT();
    }
    GX_STEP(pB0, pB1, pA0, pA1, NT - 1, false, false, false); GX_RESC();
    { float sacc = pB0[0] + pB0[1]; _Pragma("unroll") for (int r = 2; r < 16; ++r) sacc += pB0[r]; _Pragma("unroll") for (int r = 0; r < 16; ++r) sacc += pB1[r]; l_reg += sacc;
      pw0 = (u32x4){GX_PKW(pB0, 0), GX_PKW(pB0, 2), GX_PKW(pB0, 4), GX_PKW(pB0, 6)}; pw1 = (u32x4){GX_PKW(pB0, 8), GX_PKW(pB0, 10), GX_PKW(pB0, 12), GX_PKW(pB0, 14)};
      pw2 = (u32x4){GX_PKW(pB1, 0), GX_PKW(pB1, 2), GX_PKW(pB1, 4), GX_PKW(pB1, 6)}; pw3 = (u32x4){GX_PKW(pB1, 8), GX_PKW(pB1, 10), GX_PKW(pB1, 12), GX_PKW(pB1, 14)};
      GX_SBAR(); pv(o, vb0 + sl_cur, GX_PAF(0), GX_PAF(1), GX_PAF(2), GX_PAF(3)); }
    { auto rr = __builtin_amdgcn_permlane32_swap(__float_as_uint(l_reg), __float_as_uint(l_reg), false, false); l_reg = __uint_as_float(rr[0]) + __uint_as_float(rr[1]); }
    if (hi == 0) wsf[32 + r32] = l_reg; asm volatile("s_waitcnt lgkmcnt(0)" ::: "memory");
    float rli[16];
#pragma unroll
    for (int r = 0; r < 16; ++r) rli[r] = __builtin_amdgcn_rcpf(wsf[32 + crow(r, hi)]);
    bf16_t* Ow = BR + (size_t)qrow0 * DM + ocol;
    { LAS bf16_t* stg = (LAS bf16_t*)(shm + LDS_OST) + wid * 2048;
#pragma unroll
      for (int r = 0; r < 16; ++r) { const int orow = crow(r, hi);
#pragma unroll
        for (int d0 = 0; d0 < 2; ++d0) stg[orow * 64 + d0 * 32 + r32] = (bf16_t)f2bf(o[d0][r] * rli[r]); }
      asm volatile("s_waitcnt lgkmcnt(0)" ::: "memory");
#pragma unroll
      for (int i = 0; i < 4; ++i) { const int row = i * 8 + (lane >> 3), ch = lane & 7; const u32x4 v = *(const LAS u32x4*)(stg + row * 64 + ch * 8); pg8::st16_wt(Ow + (size_t)row * DM + ch * 8, v); } }
    asm volatile("s_waitcnt lgkmcnt(0)\n\ts_barrier" ::: "memory");
#undef GX_TROW
#undef GX_DMA_K
#undef GX_DMA_V
#undef GX_START
#undef GX_RESC
#undef GX_ROT
#undef GX_PKW
#undef GX_PAF
#undef GX_VFR
#undef GX_PIN
#undef GX_MX3
#undef GX_GAPA
#undef GX_EX
#undef GX_GAPB
#undef GX_VRD
#undef GX_KRD
#undef GX_MFMA
#undef GX_STEP
#undef GX_ENDW
}
}

constexpr int NT_HGRN = 32 * NCH, NT_SSD = 64 * NCH, NT_SCAN = NT_HGRN + NT_SSD;
template <bool PASS_C> __device__ __forceinline__ void scan_tasks(Frame& F, int l, bf16_t* BR) {
    bf16_t* OBA = (bf16_t*)(F.ws + WS_OBA); bf16_t* OBB = (bf16_t*)(F.ws + WS_OBB);
    const int slot = F.wave * F.G + F.bid, nslots = NWAVES * F.G;
#pragma unroll 1
    for (int t = slot; t < NT_SCAN; t += nslots) {
        if (t < NT_HGRN) { const int seq = t / NCH, pc = t % NCH; if (PASS_C && l == 1 && pc == 0) continue;
            hgrn_task<PASS_C>(F, l, seq, pc, seq < 16 ? BR : OBA, seq < 16 ? DM : 256);
        } else { const int t2 = t - NT_HGRN, seq2 = t2 / NCH, pc = t2 % NCH; if (PASS_C && l == 1 && pc == 0) continue;
            ssd_task<PASS_C>(F, l, seq2, pc, seq2 < 32 ? BR + 256 : OBB, seq2 < 32 ? DM : 256);
        }
    }
}
__device__ __forceinline__ void scan_carry(Frame& F) {
    refresh(F);
    bf16_t* STA = (bf16_t*)(F.ws + WS_STA); bf16_t* STB = (bf16_t*)(F.ws + WS_STB);
    const float* DLA = (const float*)(F.ws + WS_DLA); const float* DLB = (const float*)(F.ws + WS_DLB);
    const int gt = F.bid * NTHREADS + F.tid, NGT = F.G * NTHREADS;
    for (int e = gt; e < (32 * 4096 + 64 * 4096) / 2; e += NGT) {
        unsigned kvw[NCH]; float d0[NCH], d1[NCH];
        const bool isA = e < 32 * 2048;
        bf16_t* base;
        if (isA) { const int seq = e >> 11, idx = (e & 2047) * 2; base = STA + (size_t)seq * NCH * 4096 + idx;
            const int k = 32 * (((idx >> 4) & 3) >> 1) + crow(idx & 15, idx >> 11);
#pragma unroll
            for (int pc = 0; pc < NCH; ++pc) { kvw[pc] = *(const unsigned*)(base + (size_t)pc * 4096); const float* dl = DLA + ((size_t)seq * NCH + pc) * 64 + k; d0[pc] = dl[0]; d1[pc] = dl[1]; }
        } else { const int e2 = e - 32 * 2048, seq2 = e2 >> 11, idx = (e2 & 2047) * 2; base = STB + (size_t)seq2 * NCH * 4096 + idx;
#pragma unroll
            for (int pc = 0; pc < NCH; ++pc) { kvw[pc] = *(const unsigned*)(base + (size_t)pc * 4096); d0[pc] = d1[pc] = DLB[(seq2 >> 1) * NCH + pc] * 1.4426950408889634f; }
        }
        float S0 = 0.f, S1 = 0.f;
#pragma unroll
        for (int pc = 0; pc < NCH; ++pc) { const unsigned out = cvtpk(S0, S1);
            S0 = __builtin_amdgcn_exp2f(d0[pc]) * S0 + bflo(kvw[pc]); S1 = __builtin_amdgcn_exp2f(d1[pc]) * S1 + bfhi(kvw[pc]); kvw[pc] = out; }
#pragma unroll
        for (int pc = 0; pc < NCH; ++pc) *(unsigned*)(base + (size_t)pc * 4096) = kvw[pc];
    }
}

template <int STAGE> __device__ __forceinline__ void mixers_phase(Frame& F, int l, bf16_t* BR) {
    refresh(F);
    scan_tasks<STAGE == 2>(F, l, BR);
    refresh(F);
    const int slot = F.wave * F.G + F.bid, nslots = NWAVES * F.G;
    if (STAGE == 0) {
        if (l == 0) {
#pragma unroll 1
            for (int u = nslots - 1 - slot; u < NA_CTX; u += nslots) attn_task<2>(F, l, u, BR); }
        __syncthreads();
#pragma unroll 1
        for (int u = F.bid; u < 256; u += F.G) attn_block_task<1>(F, l, u, BR);
    } else {
        __syncthreads();
#pragma unroll 1
        for (int u = F.bid; u < 256; u += F.G) gx::gqa_unit<8>(F, u, BR);
    }
}

__device__ __forceinline__ void combine_phase(Frame& F, int l, bf16_t* BR, int nrows) {
    refresh(F);
    const bf16_t* MIX = (const bf16_t*)(F.ws + WS_RC);
    const bf16_t* OBA = (const bf16_t*)(F.ws + WS_OBA); const bf16_t* OBB = (const bf16_t*)(F.ws + WS_OBB);
    const int gw = F.bid * NWAVES + F.wave, NGW = F.G * NWAVES;
    const int m0 = gw, m1 = nrows;
    const int c0 = 4 * F.lane, head = F.lane >> 4;
    const f32x4 hw4 = *(const f32x4*)(FIN(8) + l * 256 + c0), sw4 = *(const f32x4*)(FIN(14) + l * 256 + c0); const float dk = FIN(13)[l * 4 + head];
    u32x2 n_of, n_ob, n_ag, n_sf, n_sb, n_zz, n_xc;
#define CB_LOAD(M) do { const size_t m_ = (size_t)(M); const bf16_t* br_ = BR + m_ * DM; const bf16_t* mx_ = MIX + m_ * NMIX; \
        n_of = __builtin_nontemporal_load((const u32x2*)(br_ + c0)); n_ob = __builtin_nontemporal_load((const u32x2*)(OBA + m_ * 256 + c0)); n_ag = __builtin_nontemporal_load((const u32x2*)(mx_ + C_AG + c0)); \
        n_sf = __builtin_nontemporal_load((const u32x2*)(br_ + 256 + c0)); n_sb = __builtin_nontemporal_load((const u32x2*)(OBB + m_ * 256 + c0)); n_zz = __builtin_nontemporal_load((const u32x2*)(mx_ + C_BZ + c0)); n_xc = __builtin_nontemporal_load((const u32x2*)(mx_ + C_BX + c0)); } while (0)
    if (m0 < m1) CB_LOAD(m0);
#pragma unroll 1
    for (int m = m0; m < m1; m += NGW) {
        const u32x2 of = n_of, ob = n_ob, ag = n_ag, sf = n_sf, sb = n_sb, zz = n_zz, xc = n_xc;
        if (m + NGW < m1) CB_LOAD(m + NGW);
        bf16_t* br = BR + (size_t)m * DM;
        { float t0 = bflo(of.x) + bflo(ob.x), t1 = bfhi(of.x) + bfhi(ob.x), t2 = bflo(of.y) + bflo(ob.y), t3 = bfhi(of.y) + bfhi(ob.y);
          float ss = (t0 * t0 + t1 * t1) + (t2 * t2 + t3 * t3);
          ss += dppf_<0xB1, 0xF, true>(ss); ss += dppf_<0x4E, 0xF, true>(ss); ss += dppf_<0x141, 0xF, true>(ss); ss += dppf_<0x140, 0xF, true>(ss);
          const float rs = 1.f / sqrtf(ss * (1.f / 64.f) + LN_EPS);
          u32x2 w; w.x = pk2(t0 * rs * hw4.x * siluf_(bflo(ag.x)), t1 * rs * hw4.y * siluf_(bfhi(ag.x)));
          w.y = pk2(t2 * rs * hw4.z * siluf_(bflo(ag.y)), t3 * rs * hw4.w * siluf_(bfhi(ag.y)));
          wt8a(br + c0, w); }
        { float y0 = (bflo(sf.x) + bflo(sb.x) + bflo(xc.x) * dk) * siluf_(bflo(zz.x));
          float y1 = (bfhi(sf.x) + bfhi(sb.x) + bfhi(xc.x) * dk) * siluf_(bfhi(zz.x));
          float y2 = (bflo(sf.y) + bflo(sb.y) + bflo(xc.y) * dk) * siluf_(bflo(zz.y));
          float y3 = (bfhi(sf.y) + bfhi(sb.y) + bfhi(xc.y) * dk) * siluf_(bfhi(zz.y));
          const float ss = wave_sum((y0 * y0 + y1 * y1) + (y2 * y2 + y3 * y3));
          const float rs = 1.f / sqrtf(ss * (1.f / 256.f) + LN_EPS);
          u32x2 w; w.x = pk2(y0 * rs * sw4.x, y1 * rs * sw4.y); w.y = pk2(y2 * rs * sw4.z, y3 * rs * sw4.w);
          wt8a(br + 256 + c0, w); }
    }
#undef CB_LOAD
}

#define XB_TMO      128
#define XB_XCNT(j)  (256  + 64 * (j))
#define XB_XSUB(j)  (1280 + 64 * (j))
#define XB_XGEN(j)  (2304 + 64 * (j))
#define XB_TOP      3328
#define XB_TOPGEN   3392
#define XCD_BAR_WORDS 3456
#define XB_SPIN_CAP (1u << 18)
__device__ __forceinline__ unsigned xb_ld(unsigned* p)              { return __hip_atomic_load(p, __ATOMIC_RELAXED, __HIP_MEMORY_SCOPE_AGENT); }
__device__ __forceinline__ unsigned xb_add(unsigned* p, unsigned v) { return __hip_atomic_fetch_add(p, v, __ATOMIC_RELAXED, __HIP_MEMORY_SCOPE_AGENT); }
__device__ __forceinline__ unsigned xb_xcc_id() { return (unsigned)__builtin_amdgcn_s_getreg((3 << 11) | 20) & 0xFu; }
#define XB_SPIN(cond, bar) do { unsigned _sp = 0; while (cond) { __builtin_amdgcn_s_sleep(1); \
    if ((++_sp & 255u) == 0u) { if (xb_ld(&(bar)[XB_TMO])) break; if (_sp > XB_SPIN_CAP) { atomicAdd(&(bar)[XB_TMO], 1u); break; } } } } while (0)
struct XcdBarrier { unsigned* bar; unsigned x; volatile LAS unsigned* st; };
__device__ __forceinline__ XcdBarrier xcd_barrier_post(unsigned* bar, volatile LAS unsigned* st, bool t0) {
    XcdBarrier b; b.bar = bar; b.x = xb_xcc_id(); b.st = st;
    if (t0) (void)xb_add(&bar[XB_XCNT(b.x)], 1u);
    return b;
}
__device__ __forceinline__ void xcd_barrier_complete(unsigned* bar, unsigned x, unsigned& nloc, unsigned& nx) {
    const unsigned G = gridDim.x * gridDim.y * gridDim.z;
    unsigned sum, cnt, mine, sp = 0u;
    for (;;) {
        sum = 0u; cnt = 0u; mine = 0u;
#pragma unroll
        for (unsigned j = 0; j < 16; ++j) { const unsigned c = xb_ld(&bar[XB_XCNT(j)]); sum += c; cnt += (c > 0u) ? 1u : 0u; mine = (j == x) ? c : mine; }
        if (sum == G) break;
        __builtin_amdgcn_s_sleep(1);
        if ((++sp & 255u) == 0u) { if (xb_ld(&bar[XB_TMO])) break; if (sp > XB_SPIN_CAP) { atomicAdd(&bar[XB_TMO], 1u); break; } }
    }
    nloc = mine > 0u ? mine : 1u; nx = cnt > 0u ? cnt : 1u;
}
__device__ __forceinline__ void xcd_barrier(const XcdBarrier& b, int wave_s) {
    asm volatile("s_waitcnt vmcnt(0)" ::: "memory");
    __syncthreads();
    int ln_; asm volatile("v_mbcnt_lo_u32_b32 %0, -1, 0\n\tv_mbcnt_hi_u32_b32 %0, -1, %0" : "=v"(ln_));
    if (wave_s == 0 && ln_ == 0) {
        unsigned* bar = b.bar;
        __builtin_amdgcn_s_waitcnt(0);
        unsigned nloc = b.st[0], nx = b.st[1];
        if (nloc == 0u) { xcd_barrier_complete(bar, b.x, nloc, nx); b.st[0] = nloc; b.st[1] = nx; }
        const unsigned old = xb_add(&bar[XB_XSUB(b.x)], 1u);
        const unsigned gen = old / nloc;
        if (old + 1u == (gen + 1u) * nloc) {
            __builtin_amdgcn_fence(__ATOMIC_RELEASE, "agent");
            asm volatile("s_waitcnt vmcnt(0)" ::: "memory");
            const unsigned og = xb_add(&bar[XB_TOP], 1u);
            const unsigned tg = og / nx;
            if (og + 1u == (tg + 1u) * nx) xb_add(&bar[XB_TOPGEN], 1u);
            else XB_SPIN(xb_ld(&bar[XB_TOPGEN]) == tg, bar);
            __builtin_amdgcn_fence(__ATOMIC_ACQUIRE, "agent");
            asm volatile("s_waitcnt vmcnt(0)" ::: "memory");
        } else {
            XB_SPIN(xb_ld(&bar[XB_TOPGEN]) == gen, bar);
            __builtin_amdgcn_fence(__ATOMIC_ACQUIRE, "agent");
            asm volatile("s_waitcnt vmcnt(0)" ::: "memory");
        }
    }
    __syncthreads();
}

#define GSYNC() xcd_barrier(bar, F.wave_s)
#define MODS ((float*)(F.ws + WS_MODS))
#define DT ((float*)(F.ws + WS_DT))
#define XC ((float*)(F.ws + WS_XC))
#define MIX ((bf16_t*)(F.ws + WS_RC))
#define WIN ((const bf16_t*)(F.ws + WS_WIN))
#define WBR ((const bf16_t*)(F.ws + WS_WBR))
#define WOUT ((const bf16_t*)(F.ws + WS_WOUT))
#define WUP ((const bf16_t*)(F.ws + WS_WUP))
#define WDN ((const bf16_t*)(F.ws + WS_WDN))
#define SLABS ((bf16_t*)(F.ws + WS_RC + (size_t)94 * MiB))
template <int l> __device__ __forceinline__ void layer_body(Frame& F, const XcdBarrier& bar) {
        constexpr bool last = (l == DEPTH - 1);
#define H ((bf16_t*)(F.ws + WS_RA))
#define BR ((bf16_t*)(F.ws + WS_RB))
#define mods_l (MODS + (size_t)l * 5 * 6144)
        constexpr int Mpost = last ? MLAT : MALL;
#define xlat (l == 0 ? FIN(0) : ((float*)(F.a->out)))
#define xctx (l == 0 ? FIN(2) : XC)

        { pg8::Gemm g{H, WIN, MALL, NMIX}; pg8::StaticOrder S; S.init(MALL, NMIX, F.G, F.bid);
          pg8::EpiStoreFG E{MIX, NMIX, l == 1 ? FIN(7) : (const float*)nullptr}; pg8::gemm_phase<pg8::EpiStoreFG, DM, DM, DM, 0, 0>(F.lds, g, S, E, tid_from_lds(F.lds, F.wave_s)); }
        GSYNC();
        prep_phase(F, l);
        conv_to_lds(F, l);
        GSYNC();
        conv_from_lds(F);
        GSYNC();
        mixers_phase<0>(F, l, BR);
        GSYNC();
        scan_carry(F);
        GSYNC();
        mixers_phase<2>(F, l, BR);
        GSYNC();
        combine_phase(F, l, BR, Mpost);
        if constexpr (last) convert_weights<1>(F, l);
        GSYNC();
        unsigned* seam34 = (unsigned*)(F.ws + WS_SEAM) + (size_t)(l * 4 + 1) * 68 * 64;
        unsigned* seam45 = (unsigned*)(F.ws + WS_SEAM) + (size_t)(l * 4 + 0) * 68 * 64; unsigned* btmo = (unsigned*)(F.ws + WS_CTL) + XB_TMO;
        { pg8::Gemm g{H, WIN + (size_t)NMIX * DM, Mpost, 4096}; pg8::SeamOrder S; S.init(Mpost, 4096, F.G, F.bid); S.ready = nullptr; S.need = 0u; S.pub = last ? nullptr : seam34; S.tmo = btmo; S.off1 = -1;
          pg8::EpiGateStore E{MIX}; pg8::gemm_phase<pg8::EpiGateStore, DM, DM, DM, 0, 0, pg8::SeamOrder>(F.lds, g, S, E, tid_from_lds(F.lds, F.wave_s)); }
        if constexpr (!last) convert_weights<1>(F, l, 96, F.G - 96);
        if constexpr (last) GSYNC();
        { pg8::Gemm g{BR, WBR, Mpost, DM}; pg8::SeamOrder S; S.init(Mpost, DM, F.G, F.bid); S.ready = last ? nullptr : seam34; S.need = 128u; S.pub = last ? nullptr : seam45; S.tmo = btmo; S.off1 = last ? -1 : 64;
          pg8::EpiHorner E{MIX, H}; pg8::gemm_phase<pg8::EpiHorner, DM, DM, DM, 0, 0, pg8::SeamOrder, 256>(F.lds, g, S, E, tid_from_lds(F.lds, F.wave_s)); }
        if constexpr (last) GSYNC();
        { pg8::Gemm g{H, WOUT, Mpost, DM}; pg8::SeamOrder S; S.init(Mpost, DM, F.G, F.bid); S.ready = last ? nullptr : seam45; S.need = 32u; S.pub = nullptr; S.tmo = btmo; S.off1 = last ? -1 : 80;
          pg8::EpiStore E{BR, DM}; pg8::gemm_phase<pg8::EpiStore, DM, DM, DM, 0, 0, pg8::SeamOrder>(F.lds, g, S, E, tid_from_lds(F.lds, F.wave_s)); }
        GSYNC();
        {
            RowOp R{}; R.nrows = Mpost; R.xlat_in = xlat; R.xctx_in = xctx; R.post = true; R.Y = BR; R.gate_chunk = 2; R.lng = FIN(20) + l * DM; R.lnb = FIN(21) + l * DM; R.mods_post = mods_l;
            R.xlat_out = ((float*)(F.a->out)); R.xctx_out = XC; R.domod = true; R.mods_mod = mods_l; R.shift_chunk = 3; R.scale_chunk = 4; R.Hout = H; R.dodt = false; R.DTout = DT;
            row_pass(F, R, FIN(6));
        }
        GSYNC();
        { pg8::Gemm g{H, WUP, Mpost, 2 * FFH}; pg8::StaticOrder S; S.init(Mpost, 2 * FFH, F.G, F.bid);
          pg8::EpiSwiGLU E{MIX, FFH}; pg8::gemm_phase<pg8::EpiSwiGLU, DM, DM, DM, 0, 0>(F.lds, g, S, E, tid_from_lds(F.lds, F.wave_s)); }
        GSYNC();
        { pg8::Gemm g{MIX, WDN, MLAT, DM}; pg8::StaticOrder S; S.init(MLAT, DM, F.G, F.bid);
          pg8::EpiStore E{BR, DM}; pg8::gemm_phase<pg8::EpiStore, FFH, FFH, FFH, 0, 0>(F.lds, g, S, E, tid_from_lds(F.lds, F.wave_s)); }
        if (!last) {
          pg8::Gemm g{MIX, WDN, MALL, DM}; pg8::SplitOrder S; S.init(MCTX / 256, DM / 256, FFH / 256, MLAT / 256, F.G, F.bid);
          pg8::EpiSlab E{SLABS, MLAT / 256, MCTX}; pg8::gemm_phase<pg8::EpiSlab, 256, FFH, FFH, 0, 0, pg8::SplitOrder>(F.lds, g, S, E, tid_from_lds(F.lds, F.wave_s)); }
        GSYNC();
        {
            RowOp R{}; R.nrows = Mpost; R.xlat_in = ((float*)(F.a->out)); R.xctx_in = XC; R.post = true; R.Y = BR; R.slabs = SLABS; R.nslab = last ? 0 : FFH / 256; R.slab_row0 = MLAT; R.gate_chunk = 5; R.lng = FIN(24) + l * DM; R.lnb = FIN(25) + l * DM; R.mods_post = mods_l;
            R.xlat_out = ((float*)(F.a->out)); R.xctx_out = XC; R.domod = !last; R.mods_mod = MODS + (size_t)(l + 1) * 5 * 6144; R.shift_chunk = 0; R.scale_chunk = 1; R.Hout = H; R.dodt = !last; R.DTout = DT;
            row_pass(F, R, FIN(6) + (size_t)(last ? l : l + 1) * DM * INC);
            if (!last) { convert_weights<0>(F, l + 1); GSYNC(); }
        }
}

__global__ void __launch_bounds__(NTHREADS, 2) fwd_megakernel(Args args) {
    extern __shared__ __attribute__((aligned(16))) unsigned char lds_raw[];
    Frame F;
    F.lds = (LAS unsigned char*)lds_raw;
    F.G = gridDim.x; F.bid = blockIdx.x; F.a = &args; F.ws = args.ws; F.ws0 = args.ws;
    { const int t0 = threadIdx.x; F.wave_s = __builtin_amdgcn_readfirstlane(t0 >> 6);
      *(LAS int*)(F.lds + TIDTAB_OFF + t0 * 4) = t0;
      volatile LAS unsigned* bst0 = (volatile LAS unsigned*)(F.lds + 8 * WLDS); if (t0 < 2) bst0[t0] = 0u; }
    __syncthreads();
    refresh(F);
    volatile LAS unsigned* bst = (volatile LAS unsigned*)(F.lds + 8 * WLDS);
    const XcdBarrier bar = xcd_barrier_post((unsigned*)(F.ws + WS_CTL), bst, F.tid == 0);

    mods_phase(F);
    convert_weights<0>(F, 0);
    GSYNC();
    {
        RowOp R{}; R.nrows = MALL; R.xlat_in = FIN(0); R.xctx_in = FIN(2); R.post = false; R.domod = true; R.mods_mod = MODS; R.shift_chunk = 0; R.scale_chunk = 1;
        R.Hout = (bf16_t*)(F.ws + WS_RA); R.dodt = true; R.DTout = DT;
        row_pass(F, R, FIN(6));
    }
    GSYNC();

    layer_body<0>(F, bar);
    layer_body<1>(F, bar);
}

extern "C" void kernel_launch(void* const* d_in, const int* in_sizes, int n_in, void* d_out, int out_size, void* d_ws, size_t ws_size, hipStream_t stream) {
    static int grid = 0;
    if (grid == 0) {
        if (n_in != 26 || out_size != MLAT * DM || ws_size < WS_END) { fprintf(stderr, "kernel_launch: unexpected shapes (n_in %d out %d ws %zu)\n", n_in, out_size, ws_size); grid = -1; return; }
        int dev = 0, cus = 0, per_cu = 0;
        hipGetDevice(&dev); hipDeviceGetAttribute(&cus, hipDeviceAttributeMultiprocessorCount, dev);
        hipFuncSetAttribute((const void*)fwd_megakernel, hipFuncAttributeMaxDynamicSharedMemorySize, LDS_BYTES);
        hipOccupancyMaxActiveBlocksPerMultiprocessor(&per_cu, (const void*)fwd_megakernel, NTHREADS, LDS_BYTES);
        if (per_cu < 1) { fprintf(stderr, "kernel_launch: occupancy query says %d\n", per_cu); per_cu = 1; }
        (void)hipGetLastError();
        grid = cus * 1;
    }
    if (grid < 0) return;
    if (hipMemsetAsync((char*)d_ws + WS_CTL, 0, CTL_ZERO_BYTES, stream) != hipSuccess) { fprintf(stderr, "kernel_launch: memset failed\n"); return; }
    Args a{};
    for (int i = 0; i < 26; ++i) a.in[i] = (GAS const float*)d_in[i];
    a.out = (GAS float*)d_out; a.ws = (GAS unsigned char*)d_ws;
    hipLaunchKernelGGL(fwd_megakernel, dim3(grid), dim3(NTHREADS), LDS_BYTES, stream, a);
    hipError_t e = hipPeekAtLastError();
    if (e != hipSuccess) fprintf(stderr, "launch failed: %s (grid %d)\n", hipGetErrorString(e), grid);
}
```
